# Optimizing an MI355X kernel written in HIP

```python
import math
import jax, jax.numpy as jnp
from jax import lax
import numpy as np

D_MODEL = 2048
BATCH = 1
SEQ = 16384
DEPTH = 1

CHUNK = 64
SSD_HEAD_DIM = 64
SSD_INNER = D_MODEL
SSD_HEADS = SSD_INNER // SSD_HEAD_DIM
SSD_GROUPS = 8
SSD_HEADS_PER_GROUP = SSD_HEADS // SSD_GROUPS
SSD_STATE = 128
CONV_WIDTH = 4
XBC_DIM = SSD_INNER + 2 * SSD_GROUPS * SSD_STATE
S5_WIDTH = D_MODEL // 2
S5_GROUP_CH = 16
S5_GROUPS = S5_WIDTH // S5_GROUP_CH
S5_STATE = 64
N_EXPERT_GROUPS = 4
EXPERTS_PER_GROUP = 8
N_EXPERTS = N_EXPERT_GROUPS * EXPERTS_PER_GROUP
TOP_K_INNER = 2
EXPERT_FF = D_MODEL // 4
MOE_BLOCK = 128
IN_SIZES = (SSD_INNER, XBC_DIM, SSD_HEADS, S5_WIDTH, 2 * D_MODEL)
IN_DIM = sum(IN_SIZES)
IN_SPLITS = tuple(int(s) for s in np.cumsum(IN_SIZES)[:-1])
RMS_EPS = 1e-6

kernel_name = "hybrid_ssd_s5_hmoe_block"


def rmsnorm(v, w):
    vf = v.astype(jnp.float32)
    vf = vf * lax.rsqrt(jnp.mean(vf * vf, axis=-1, keepdims=True) + RMS_EPS)
    return vf.astype(v.dtype) * w


def causal_depthwise_conv(v, w, bias):
    seq = v.shape[1]
    vp = jnp.pad(v, ((0, 0), (CONV_WIDTH - 1, 0), (0, 0)))
    out = bias
    for k in range(CONV_WIDTH):
        out = out + vp[:, k:k + seq] * w[k]
    return out


def ssd_chunked(xh, dt, a_log, bmat, cmat, d_skip):
    b, seq = xh.shape[0], xh.shape[1]
    nc = seq // CHUNK
    G, R, P, N = SSD_GROUPS, SSD_HEADS_PER_GROUP, SSD_HEAD_DIM, SSD_STATE
    a = -jnp.exp(a_log.astype(jnp.float32))
    a_dt = (dt * a).reshape(b, nc, CHUNK, G, R).transpose(0, 3, 4, 1, 2)
    xdt = (xh * dt[..., None]).reshape(b, nc, CHUNK, G, R, P)
    bc = bmat.reshape(b, nc, CHUNK, G, N)
    cc = cmat.reshape(b, nc, CHUNK, G, N)
    a_cs = jnp.cumsum(a_dt, axis=-1)
    causal = jnp.tril(jnp.ones((CHUNK, CHUNK), dtype=bool))
    seg = a_cs[..., :, None] - a_cs[..., None, :]
    decay_in = jnp.where(causal, jnp.exp(jnp.where(causal, seg, 0.0)), 0.0)
    cb = jnp.einsum('bclgn,bcsgn->bgcls', cc, bc)
    y_diag = jnp.einsum('bgcls,bgrcls,bcsgrp->bclgrp', cb, decay_in, xdt)
    decay_states = jnp.exp(a_cs[..., -1:] - a_cs)
    states = jnp.einsum('bclgn,bgrcl,bclgrp->bcgrpn', bc, decay_states, xdt)
    chunk_decay = jnp.exp(a_cs[..., -1])

    def step(carry, inp):
        st, dec = inp
        return carry * dec[..., None, None] + st, carry

    init = jnp.zeros((b, G, R, P, N), states.dtype)
    _, prev = lax.scan(step, init, (jnp.moveaxis(states, 1, 0), jnp.moveaxis(chunk_decay, -1, 0)))
    prev = jnp.moveaxis(prev, 0, 1)
    y_off = jnp.einsum('bclgn,bcgrpn,bgrcl->bclgrp', cc, prev, jnp.exp(a_cs))
    y = (y_diag + y_off).reshape(b, seq, SSD_HEADS, P) + xh * d_skip[:, None]
    return y.reshape(b, seq, SSD_HEADS * P)


def s5_combine(e1, e2):
    a1r, a1i, b1r, b1i = e1
    a2r, a2i, b2r, b2i = e2
    return (a2r * a1r - a2i * a1i,
            a2r * a1i + a2i * a1r,
            a2r * b1r - a2i * b1i + b2r,
            a2r * b1i + a2i * b1r + b2i)


def s5_mixer(u, lam_re, lam_im, log_dt, b_re, b_im, c_re, c_im, d_skip):
    b, seq, w = u.shape
    ug = u.reshape(b, seq, S5_GROUPS, S5_GROUP_CH)
    f32 = jnp.float32
    lr, li = lam_re.astype(f32), lam_im.astype(f32)
    dt = jnp.exp(log_dt.astype(f32))[:, None]
    mag = jnp.exp(lr * dt)
    ang = li * dt
    abar_r, abar_i = mag * jnp.cos(ang), mag * jnp.sin(ang)
    den = lr * lr + li * li
    nr, ni = abar_r - 1.0, abar_i
    coef_r = (nr * lr + ni * li) / den
    coef_i = (ni * lr - nr * li) / den
    bre, bim = b_re.astype(f32), b_im.astype(f32)
    bb_r = coef_r[..., None] * bre - coef_i[..., None] * bim
    bb_i = coef_r[..., None] * bim + coef_i[..., None] * bre
    bu_r = jnp.einsum('blgc,gnc->blgn', ug, bb_r)
    bu_i = jnp.einsum('blgc,gnc->blgn', ug, bb_i)
    a_r = jnp.broadcast_to(abar_r, bu_r.shape)
    a_i = jnp.broadcast_to(abar_i, bu_i.shape)
    _, _, s_r, s_i = lax.associative_scan(s5_combine, (a_r, a_i, bu_r, bu_i), axis=1)
    y = (jnp.einsum('blgn,gcn->blgc', s_r, c_re.astype(f32))
         - jnp.einsum('blgn,gcn->blgc', s_i, c_im.astype(f32)))
    return y.reshape(b, seq, w) + d_skip * u


def hierarchical_moe(h, w_rg, b_rg, w_re, b_re, w_g, w_u, w_d):
    b, seq, d = h.shape
    T = b * seq
    ht = h.reshape(T, d)
    f32 = jnp.float32
    logit_g = (ht @ w_rg).astype(f32) + b_rg.astype(f32)
    p_g = jax.nn.softmax(logit_g, axis=-1)
    grp = jnp.argmax(logit_g, axis=-1).astype(jnp.int32)
    pg_sel = jnp.take_along_axis(p_g, grp[:, None], axis=-1)
    logit_e = ((ht @ w_re).astype(f32) + b_re.astype(f32)).reshape(T, N_EXPERT_GROUPS, EXPERTS_PER_GROUP)
    logit_e = jnp.take_along_axis(logit_e, grp[:, None, None], axis=1)[:, 0]
    top_v, top_i = lax.top_k(logit_e, TOP_K_INNER)
    w_sel = jax.nn.softmax(top_v, axis=-1) * pg_sel
    expert_ids = (grp[:, None] * EXPERTS_PER_GROUP + top_i).reshape(-1).astype(jnp.int32)
    weights = w_sel.reshape(-1)
    token_idx = jnp.repeat(jnp.arange(T, dtype=jnp.int32), TOP_K_INNER)
    n_assign = T * TOP_K_INNER
    order = jnp.argsort(expert_ids)
    e_sorted = expert_ids[order]
    counts = jnp.bincount(expert_ids, length=N_EXPERTS)
    padded = ((counts + MOE_BLOCK - 1) // MOE_BLOCK) * MOE_BLOCK
    start_sorted = jnp.cumsum(counts) - counts
    ends_padded = jnp.cumsum(padded)
    start_padded = ends_padded - padded
    rank = jnp.arange(n_assign, dtype=jnp.int32) - start_sorted[e_sorted]
    dest = start_padded[e_sorted] + rank
    n_rows = n_assign + N_EXPERTS * MOE_BLOCK
    n_blocks = n_rows // MOE_BLOCK
    row_token = jnp.full((n_rows,), T, jnp.int32).at[dest].set(token_idx[order])
    row_weight = jnp.zeros((n_rows,), weights.dtype).at[dest].set(weights[order])
    block_start = jnp.arange(n_blocks, dtype=jnp.int32) * MOE_BLOCK
    block_expert = jnp.clip(jnp.searchsorted(ends_padded, block_start, side='right'), 0, N_EXPERTS - 1)
    ht_pad = jnp.concatenate([ht, jnp.zeros((1, d), ht.dtype)], axis=0)

    def run_block(args):
        tok, wgt, e = args
        xb = ht_pad[tok]
        y = (jax.nn.silu(xb @ w_g[e]) * (xb @ w_u[e])) @ w_d[e]
        return y * wgt[:, None].astype(y.dtype)

    ys = lax.map(run_block, (row_token.reshape(n_blocks, MOE_BLOCK),
                             row_weight.reshape(n_blocks, MOE_BLOCK), block_expert))
    out = jnp.zeros((T + 1, d), ys.dtype).at[row_token].add(ys.reshape(n_rows, d))[:T]
    return out.reshape(b, seq, d).astype(h.dtype)


def setup_inputs(seed: int = 0) -> dict:
    key = jax.random.key(seed)
    ks = jax.random.split(key, 32)
    f32 = jnp.float32
    L = DEPTH

    def nrm(k, shape, scale):
        return jax.random.normal(k, shape, f32) * scale

    def gain(k, shape):
        return 1.0 + 0.02 * jax.random.normal(k, shape, f32)

    dt0 = jnp.exp(jax.random.uniform(ks[5], (L, SSD_HEADS), f32, math.log(1e-3), math.log(1e-1)))
    return {
        "x": nrm(ks[0], (BATCH, SEQ, D_MODEL), 1.0),
        "norm_mix_w": gain(ks[1], (L, D_MODEL)),
        "w_in": nrm(ks[2], (L, D_MODEL, IN_DIM), D_MODEL ** -0.5),
        "conv_w": nrm(ks[3], (L, CONV_WIDTH, XBC_DIM), CONV_WIDTH ** -0.5),
        "conv_b": nrm(ks[4], (L, XBC_DIM), 0.02),
        "dt_bias": dt0 + jnp.log(-jnp.expm1(-dt0)),
        "a_log": jnp.log(jax.random.uniform(ks[6], (L, SSD_HEADS), f32, 1.0, 16.0)),
        "d_ssd": gain(ks[7], (L, SSD_HEADS)),
        "norm_ssd_w": gain(ks[8], (L, SSD_INNER)),
        "w_a_up": nrm(ks[9], (L, SSD_INNER, D_MODEL), SSD_INNER ** -0.5),
        "s5_lambda_re": -0.5 + nrm(ks[10], (L, S5_GROUPS, S5_STATE), 0.01),
        "s5_lambda_im": math.pi * jnp.arange(S5_STATE, dtype=f32) + nrm(ks[11], (L, S5_GROUPS, S5_STATE), 0.01),
        "s5_log_dt": jax.random.uniform(ks[12], (L, S5_GROUPS), f32, math.log(1e-3), math.log(1e-1)),
        "s5_b_re": nrm(ks[13], (L, S5_GROUPS, S5_STATE, S5_GROUP_CH), (2.0 * S5_GROUP_CH) ** -0.5),
        "s5_b_im": nrm(ks[14], (L, S5_GROUPS, S5_STATE, S5_GROUP_CH), (2.0 * S5_GROUP_CH) ** -0.5),
        "s5_c_re": nrm(ks[15], (L, S5_GROUPS, S5_GROUP_CH, S5_STATE), (2.0 * S5_STATE) ** -0.5),
        "s5_c_im": nrm(ks[16], (L, S5_GROUPS, S5_GROUP_CH, S5_STATE), (2.0 * S5_STATE) ** -0.5),
        "s5_d": nrm(ks[17], (L, S5_WIDTH), 1.0),
        "w_glu": nrm(ks[18], (L, S5_WIDTH, S5_WIDTH), S5_WIDTH ** -0.5),
        "w_b_up": nrm(ks[19], (L, S5_WIDTH, D_MODEL), S5_WIDTH ** -0.5),
        "gate_b": nrm(ks[20], (L, 2 * D_MODEL), 0.02),
        "w_out": nrm(ks[21], (L, D_MODEL, D_MODEL), D_MODEL ** -0.5),
        "norm_ffn_w": gain(ks[22], (L, D_MODEL)),
        "w_route_group": nrm(ks[23], (L, D_MODEL, N_EXPERT_GROUPS), D_MODEL ** -0.5),
        "b_route_group": nrm(ks[24], (L, N_EXPERT_GROUPS), 0.01),
        "w_route_expert": nrm(ks[25], (L, D_MODEL, N_EXPERTS), D_MODEL ** -0.5),
        "b_route_expert": nrm(ks[26], (L, N_EXPERTS), 0.01),
        "w_exp_gate": nrm(ks[27], (L, N_EXPERTS, D_MODEL, EXPERT_FF), D_MODEL ** -0.5),
        "w_exp_up": nrm(ks[28], (L, N_EXPERTS, D_MODEL, EXPERT_FF), D_MODEL ** -0.5),
        "w_exp_down": nrm(ks[29], (L, N_EXPERTS, EXPERT_FF, D_MODEL), EXPERT_FF ** -0.5),
        "norm_final_w": gain(ks[30], (D_MODEL,)),
    }


def reference(x, norm_mix_w, w_in, conv_w, conv_b, dt_bias, a_log, d_ssd, norm_ssd_w, w_a_up,
              s5_lambda_re, s5_lambda_im, s5_log_dt, s5_b_re, s5_b_im, s5_c_re, s5_c_im, s5_d,
              w_glu, w_b_up, gate_b, w_out, norm_ffn_w, w_route_group, b_route_group,
              w_route_expert, b_route_expert, w_exp_gate, w_exp_up, w_exp_down, norm_final_w):
    b, seq, _ = x.shape
    for i in range(DEPTH):
        h = rmsnorm(x, norm_mix_w[i])
        proj = h @ w_in[i]
        z, xbc, dt_raw, u, gate_logits = jnp.split(proj, IN_SPLITS, axis=-1)
        xbc = jax.nn.silu(causal_depthwise_conv(xbc, conv_w[i], conv_b[i]))
        xs, bm, cm = jnp.split(xbc, (SSD_INNER, SSD_INNER + SSD_GROUPS * SSD_STATE), axis=-1)
        dt = jax.nn.softplus(dt_raw.astype(jnp.float32) + dt_bias[i].astype(jnp.float32))
        ya = ssd_chunked(xs.reshape(b, seq, SSD_HEADS, SSD_HEAD_DIM), dt, a_log[i],
                         bm.reshape(b, seq, SSD_GROUPS, SSD_STATE),
                         cm.reshape(b, seq, SSD_GROUPS, SSD_STATE), d_ssd[i])
        ya = rmsnorm(ya.astype(x.dtype) * jax.nn.silu(z), norm_ssd_w[i]) @ w_a_up[i]
        yb = s5_mixer(u, s5_lambda_re[i], s5_lambda_im[i], s5_log_dt[i], s5_b_re[i], s5_b_im[i],
                      s5_c_re[i], s5_c_im[i], s5_d[i]).astype(x.dtype)
        v = jax.nn.gelu(yb)
        yb = (v * jax.nn.sigmoid(v @ w_glu[i])) @ w_b_up[i]
        g = jax.nn.sigmoid(gate_logits + gate_b[i])
        merged = g[..., :D_MODEL] * ya + g[..., D_MODEL:] * yb
        x = x + merged @ w_out[i]
        h2 = rmsnorm(x, norm_ffn_w[i])
        x = x + hierarchical_moe(h2, w_route_group[i], b_route_group[i], w_route_expert[i],
                                 b_route_expert[i], w_exp_gate[i], w_exp_up[i], w_exp_down[i])
    return rmsnorm(x, norm_final_w)
```

```cpp
#include <hip/hip_runtime.h>
#include <cstdio>
#include <cstdint>

#ifndef MK_N_LAUNCHES
#define MK_N_LAUNCHES 1
#endif
#ifndef EXP_VARIANT
#define EXP_VARIANT 0
#endif
#ifndef NAIVE_GEMM
#define NAIVE_GEMM 0
#endif

#define LAS __attribute__((address_space(3)))
#define GAS __attribute__((address_space(1)))
typedef unsigned short bf16;
typedef short bf16x8 __attribute__((ext_vector_type(8)));
typedef float f32x4 __attribute__((ext_vector_type(4)));
typedef float f32x2 __attribute__((ext_vector_type(2)));
typedef float f32x16 __attribute__((ext_vector_type(16)));
typedef unsigned v4u __attribute__((ext_vector_type(4)));
typedef unsigned v2u __attribute__((ext_vector_type(2)));
typedef GAS unsigned gu32;
typedef int v4i_ __attribute__((ext_vector_type(4)));
typedef int v8i_ __attribute__((ext_vector_type(8)));

constexpr int T = 16384, D = 2048;
constexpr int NH = 32, HP = 64, NGRP = 8, NST = 128, CHK = 64, NCHK = T / CHK;
constexpr int XBCD = 4096;
constexpr int S5W = 1024, S5G = 64, S5C = 16, S5N = 64, LS = 16, S5NC = T / LS;
constexpr int APK = 384;
constexpr int NE = 32, EPG = 8, FF = 512, CAPL = 16384;
constexpr int IN_DIM = 11296;
constexpr float EPS = 1e-6f;
constexpr int NWAVES = 8;

constexpr size_t MiB = 1u << 20;
constexpr size_t WS_CTL = 0, CTL_ZERO_BYTES = 1 * MiB;
constexpr size_t WS_WIN = 1 * MiB;
constexpr size_t WS_WAB = 46 * MiB;
constexpr size_t WS_WGLU = 58 * MiB, WS_WOUT = 80 * MiB;
constexpr size_t WS_S5WS = 60 * MiB;
constexpr size_t WS_S5TW = 68 * MiB;
constexpr size_t WS_XD = 1 * MiB;
constexpr size_t WS_H = 88 * MiB;
constexpr int YVP = 3072;
constexpr size_t WS_YV = 152 * MiB;
constexpr size_t WS_XBC = 248 * MiB;
constexpr size_t WS_ST = 376 * MiB;
constexpr size_t WS_AP = 504 * MiB;
constexpr size_t WS_DT = 552 * MiB;
constexpr size_t WS_MISC = 554 * MiB;
constexpr size_t WS_SL = 555 * MiB;
constexpr size_t WS_LST = 587 * MiB;
constexpr size_t WS_RT = 591 * MiB;
constexpr size_t WS_H8 = 592 * MiB;
constexpr size_t WS_LR = 624 * MiB;
constexpr size_t WS_END = 627 * MiB;
constexpr int CW_BAR = 4096;
constexpr int CW_CNT = 16384;

constexpr int LDS_BYTES = 163840;
constexpr int LDSCTL_OFF = 161792;

typedef __bf16 bf16x2_t __attribute__((ext_vector_type(2)));
__device__ __forceinline__ unsigned f2bf(float f) { return (unsigned)__builtin_bit_cast(unsigned short, (__bf16)f); }
__device__ __forceinline__ unsigned pk2(float lo, float hi) { const f32x2 v = {lo, hi}; const bf16x2_t b = __builtin_convertvector(v, bf16x2_t); return __builtin_bit_cast(unsigned, b); }
__device__ __forceinline__ unsigned pk4_fp8(float a, float b, float c, float d) { unsigned w = 0u; w = (unsigned)__builtin_amdgcn_cvt_pk_fp8_f32(a, b, (int)w, false); w = (unsigned)__builtin_amdgcn_cvt_pk_fp8_f32(c, d, (int)w, true); return w; }
__device__ __forceinline__ float bflo(unsigned w) { return __builtin_bit_cast(float, w << 16); }
__device__ __forceinline__ float bfhi(unsigned w) { return __builtin_bit_cast(float, w & 0xffff0000u); }
__device__ __forceinline__ float bf2f(bf16 h) { return __builtin_bit_cast(float, (unsigned)h << 16); }
__device__ __forceinline__ float wave_sum(float v) {
#pragma unroll
    for (int o = 1; o < 64; o <<= 1) v += __shfl_xor(v, o);
    return v;
}
__device__ __forceinline__ float sigmoidf_(float x) { return __builtin_amdgcn_rcpf(1.0f + __builtin_amdgcn_exp2f(-1.4426950408889634f * x)); }
__device__ __forceinline__ float siluf_(float x) { return x * __builtin_amdgcn_rcpf(1.0f + __builtin_amdgcn_exp2f(-1.4426950408889634f * x)); }
__device__ __forceinline__ float gelu_tanh(float x) { const float u = 0.7978845608028654f * (x + 0.044715f * x * x * x); return x * __builtin_amdgcn_rcpf(1.0f + __builtin_amdgcn_exp2f(-2.8853900817779268f * u)); }
#define LDS_WAIT() asm volatile("s_waitcnt lgkmcnt(0)" ::: "memory")
#define VM_WAIT() asm volatile("s_waitcnt vmcnt(0)" ::: "memory")

namespace pg8 {
constexpr int BM = 256, BK = 64, HALF = 128, HTB = HALF * BK * 2, STAGE_BYTES = 8 * HTB, NXCD = 8, WGM = 8;
__host__ __device__ __forceinline__ int lds_byte(int r, int c) { const int st = (r >> 4) * 2 + (c >> 5), rr = r & 15, cc = c & 31, ob = rr * 64 + cc * 2; return st * 1024 + (ob ^ (((ob >> 9) & 1) << 5)); }
__host__ __device__ __forceinline__ void stage_rc(int b, int& R, int& C) { const int st = b / 1024, sb = b % 1024, swz = sb ^ (((sb >> 9) & 1) << 5); R = (st >> 1) * 16 + swz / 64; C = (st & 1) * 32 + (swz % 64) / 2; }
__host__ __device__ __forceinline__ int perm32(int rho) { const int n = rho >> 4, i = rho & 15; return 8 * (i >> 2) + 4 * n + (i & 3); }

struct Unit { const char* A; const char* B; int row0, col0, e, nvalid, slot0; };

struct StaticOrder {
    int nM, nN, nwg, G, c;
    __device__ void init(int nM_, int nN_, int G_, int c_) { nM = nM_; nN = nN_; nwg = nM * nN; G = G_; c = c_; }
    __device__ bool next(int i, int& pm, int& pn) const {
        const long L = (long)i * G + c; if (L >= nwg) return false;
        int wgid = (int)L; { const int q = nwg / NXCD, r = nwg % NXCD, xcd = wgid % NXCD, off = wgid / NXCD; wgid = (xcd < r ? xcd * (q + 1) : r * (q + 1) + (xcd - r) * q) + off; }
        const int nig = WGM * nN, gid = wgid / nig, fm = gid * WGM, gsz = (nM - fm) < WGM ? (nM - fm) : WGM;
        pm = fm + ((wgid % nig) % gsz); pn = (wgid % nig) / gsz; return true;
    }
};

#if !NAIVE_GEMM
template <class Epi, class Sched, bool GATHER, bool SP2 = true, int MIDT = 0, bool FP8 = false, int SCA = 127, int SCB = 127>
__device__ __forceinline__ void gemm_phase(LAS unsigned char* lds, const int K, const unsigned lda, const unsigned ldb, const Sched& S, const Epi& E, const bool noepi = false) {
    const int tid = threadIdx.x, wid = __builtin_amdgcn_readfirstlane(tid >> 6), lane = tid & 63, wr = wid >> 2, wc = wid & 3, fr = lane & 15, fq = lane >> 4;
    const int nt = FP8 ? K / 128 : K / BK;
    unsigned voffA[2], voffB[2]; int gC0 = 0;
#pragma unroll
    for (int i = 0; i < 2; ++i) { int R, C; stage_rc(tid * 16 + i * 8192, R, C); const int Rb = (R & ~31) + perm32(R & 31);
        voffA[i] = (unsigned)R * lda + (unsigned)C * 2u; voffB[i] = (unsigned)Rb * ldb + (unsigned)C * 2u; if (i == 0) gC0 = C * 2; }
    const size_t kstep = (size_t)(BK * 2);
    const size_t hstepA = (size_t)HALF * lda, hstepB = (size_t)HALF * ldb;
    const unsigned ldsw = (unsigned)wid * 1024u;
    const int aoff = FP8 ? lds_byte(wr * 64 + fr, fq * 16) : lds_byte(wr * 64 + fr, fq * 8), boff = FP8 ? lds_byte(wc * 32 + fr, fq * 16) : lds_byte(wc * 32 + fr, fq * 8);
    constexpr int PIECE1 = FP8 ? 16 : 1024;
    unsigned gcur[2], gnxt[2];
    int scav = SCA, scbv = SCB;
    if constexpr (FP8) { asm volatile("" : "+v"(scav), "+v"(scbv)); }
#define PG8_SA(b, h) (((b) * 2 + (h)) * HTB)
#define PG8_SB(b, h) ((4 + (b) * 2 + (h)) * HTB)
#define PG8_GLDS(gptr, bufoff, i) __builtin_amdgcn_global_load_lds((const unsigned*)(gptr), (LAS unsigned*)(lds + (bufoff) + ldsw + (i) * 8192), 16, 0, 0)
#define PG8_STAGEB(bufoff, gbase) do { _Pragma("unroll") for (int _i = 0; _i < 2; ++_i) PG8_GLDS((const char*)(gbase) + voffB[0] + (size_t)(_i * 64) * ldb, bufoff, _i); } while (0)
#define PG8_STAGEA(bufoff, gbase, h, nx) do { _Pragma("unroll") for (int _i = 0; _i < 2; ++_i) { \
        const unsigned _pk = (nx) ? gnxt[h] : gcur[h]; const size_t _o = GATHER ? (size_t)((_i ? (_pk >> 16) : (_pk & 0xffffu)) * lda + (unsigned)gC0) : (size_t)voffA[0] + (size_t)(_i * 64) * lda + (size_t)(h) * hstepA; PG8_GLDS((const char*)(gbase) + _o, bufoff, _i); } } while (0)
#define PG8_LD16(off) (*(const LAS v4i_*)(lds + (off)))
#define PG8_LDA(dst, b, h) do { _Pragma("unroll") for (int m = 0; m < 4; ++m) { const v4i_ _lo = PG8_LD16(PG8_SA(b, h) + aoff + m * 2048), _hi = PG8_LD16(PG8_SA(b, h) + aoff + PIECE1 + m * 2048); \
        if constexpr (FP8) dst##8[m] = __builtin_shufflevector(_lo, _hi, 0, 1, 2, 3, 4, 5, 6, 7); else { dst##4[m][0] = _lo; dst##4[m][1] = _hi; } } } while (0)
#define PG8_LDB(dst, b, h) do { _Pragma("unroll") for (int n = 0; n < 2; ++n) { const v4i_ _lo = PG8_LD16(PG8_SB(b, h) + boff + n * 2048), _hi = PG8_LD16(PG8_SB(b, h) + boff + PIECE1 + n * 2048); \
        if constexpr (FP8) dst##8[n] = __builtin_shufflevector(_lo, _hi, 0, 1, 2, 3, 4, 5, 6, 7); else { dst##4[n][0] = _lo; dst##4[n][1] = _hi; } } } while (0)
#define PG8_MMA(ai, bj, At, Bt) do { __builtin_amdgcn_s_setprio(1); _Pragma("unroll") for (int m = 0; m < 4; ++m) _Pragma("unroll") for (int n = 0; n < 2; ++n) { \
        if constexpr (FP8) { asm volatile("v_mfma_scale_f32_16x16x128_f8f6f4 %0, %1, %2, %0, %3, %4 op_sel_hi:[0,0,0]" : "+v"(acc[ai][bj][m][n]) : "v"(Bt##8[n]), "v"(At##8[m]), "v"(scbv), "v"(scav)); } \
        else { _Pragma("unroll") for (int k = 0; k < 2; ++k) acc[ai][bj][m][n] = __builtin_amdgcn_mfma_f32_16x16x32_bf16(__builtin_bit_cast(bf16x8, Bt##4[n][k]), __builtin_bit_cast(bf16x8, At##4[m][k]), acc[ai][bj][m][n], 0, 0, 0); } } \
        __builtin_amdgcn_s_setprio(0); } while (0)
#define PG8_WAIT_V(n) asm volatile("s_waitcnt vmcnt(" #n ")" ::: "memory")
#define PG8_WAIT_L(n) asm volatile("s_waitcnt lgkmcnt(" #n ")" ::: "memory")
#define PG8_BAR __builtin_amdgcn_s_barrier()
#define PG8_SCHED __builtin_amdgcn_sched_barrier(0)
#define PG8_GOFFS(dst, u) do { if constexpr (GATHER) { int _r0, _r1, _c; stage_rc(tid * 16, _r0, _c); stage_rc(tid * 16 + 8192, _r1, _c); _Pragma("unroll") for (int _h = 0; _h < 2; ++_h) dst[_h] = S.row_idx(u, _h * HALF + _r0) | (S.row_idx(u, _h * HALF + _r1) << 16); } } while (0)
    Unit cur, nxt; int ui = 0;
    if (!S.next(0, cur)) return;
    f32x4 acc[2][2][4][2];
#pragma unroll
    for (int a = 0; a < 2; ++a)
#pragma unroll
        for (int b = 0; b < 2; ++b)
#pragma unroll
            for (int m = 0; m < 4; ++m)
#pragma unroll
                for (int n = 0; n < 2; ++n) acc[a][b][m][n] = (f32x4){0.f, 0.f, 0.f, 0.f};
    v8i_ At8[4], B08[2], B18[2]; v4i_ At4[4][2], B04[2][2], B14[2][2];
    const char* cA = cur.A; const char* cB = cur.B;
#pragma unroll
    for (int h = 0; h < 2; ++h) { gcur[h] = 0u; gnxt[h] = 0u; }
    PG8_GOFFS(gcur, cur);
    if constexpr (SP2) {
    PG8_STAGEB(PG8_SB(0, 0), cB); PG8_STAGEB(PG8_SB(0, 1), cB + hstepB); PG8_STAGEA(PG8_SA(0, 0), cA, 0, false); PG8_STAGEA(PG8_SA(0, 1), cA, 1, false);
    if (wr == 1) PG8_BAR;
    PG8_WAIT_V(2); PG8_BAR;
    PG8_STAGEB(PG8_SB(1, 0), cB + kstep); PG8_STAGEA(PG8_SA(1, 0), cA + kstep, 0, false); PG8_STAGEB(PG8_SB(1, 1), cB + hstepB + kstep);
    PG8_WAIT_V(6); PG8_BAR;
    } else {
    PG8_STAGEB(PG8_SB(0, 0), cB); PG8_STAGEA(PG8_SA(0, 0), cA, 0, false); PG8_STAGEB(PG8_SB(0, 1), cB + hstepB); PG8_STAGEA(PG8_SA(0, 1), cA, 1, false);
    if (wr == 1) PG8_BAR;
    PG8_WAIT_V(4); PG8_BAR;
    PG8_STAGEB(PG8_SB(1, 0), cB + kstep); PG8_STAGEA(PG8_SA(1, 0), cA + kstep, 0, false); PG8_STAGEB(PG8_SB(1, 1), cB + hstepB + kstep);
    PG8_WAIT_V(6); PG8_BAR;
    }
    for (;;) {
        const bool has_next = S.next(ui + 1, nxt);
        const char* nA = has_next ? nxt.A : cA; const char* nB = has_next ? nxt.B : cB;
        if constexpr (GATHER) { if (has_next) { PG8_GOFFS(gnxt, nxt); } else {
            gnxt[0] = gcur[0]; gnxt[1] = gcur[1]; } }
#pragma unroll 1
        for (int t = 0; t < nt; t += 2) {
            const bool last = (t == nt - 2);
            if constexpr (MIDT > 0) { if (t == MIDT) E.mid(acc, cur, wr, wc, fr, fq); }
            const char* a1 = cA + (size_t)(t + 1) * kstep;
            const char* a2 = last ? nA : cA + (size_t)(t + 2) * kstep; const char* b2 = last ? nB : cB + (size_t)(t + 2) * kstep;
            const char* a3 = a2 + kstep; const char* b3 = b2 + kstep;
            if constexpr (SP2) {
            PG8_LDB(B0, 0, 0); PG8_LDB(B1, 0, 1); PG8_SCHED; PG8_LDA(At, 0, 0); PG8_STAGEA(PG8_SA(1, 1), a1, 1, false);
            PG8_WAIT_V(8); PG8_WAIT_L(0); PG8_BAR; PG8_MMA(0, 0, At, B0); PG8_MMA(0, 1, At, B1); PG8_BAR; PG8_SCHED;
            PG8_LDA(At, 0, 1); PG8_STAGEB(PG8_SB(0, 0), b2); PG8_STAGEB(PG8_SB(0, 1), b2 + hstepB); PG8_STAGEA(PG8_SA(0, 0), a2, 0, last);
            PG8_WAIT_V(8); PG8_WAIT_L(0); PG8_BAR; PG8_MMA(1, 0, At, B0); PG8_MMA(1, 1, At, B1); PG8_BAR; PG8_SCHED;
            PG8_LDB(B0, 1, 0); PG8_LDB(B1, 1, 1); PG8_SCHED; PG8_LDA(At, 1, 0); PG8_STAGEA(PG8_SA(0, 1), a2, 1, last);
            PG8_WAIT_V(8); PG8_WAIT_L(0); PG8_BAR; PG8_MMA(0, 0, At, B0); PG8_MMA(0, 1, At, B1); PG8_BAR; PG8_SCHED;
            PG8_LDA(At, 1, 1); PG8_STAGEB(PG8_SB(1, 0), b3); PG8_STAGEB(PG8_SB(1, 1), b3 + hstepB); PG8_STAGEA(PG8_SA(1, 0), a3, 0, last);
            PG8_WAIT_V(8); PG8_WAIT_L(0); PG8_BAR; PG8_MMA(1, 0, At, B0); PG8_MMA(1, 1, At, B1); PG8_BAR; PG8_SCHED;
            } else {
            PG8_LDB(B0, 0, 0); PG8_SCHED; PG8_LDA(At, 0, 0); PG8_STAGEA(PG8_SA(1, 1), a1, 1, false);
            PG8_WAIT_L(8); PG8_BAR; PG8_WAIT_L(0); PG8_MMA(0, 0, At, B0); PG8_BAR; PG8_SCHED;
            PG8_LDB(B1, 0, 1); PG8_STAGEB(PG8_SB(0, 0), b2);
            PG8_BAR; PG8_WAIT_L(0); PG8_MMA(0, 1, At, B1); PG8_BAR;
            PG8_LDA(At, 0, 1); PG8_STAGEA(PG8_SA(0, 0), a2, 0, last);
            PG8_BAR; PG8_WAIT_L(0); PG8_MMA(1, 0, At, B0); PG8_BAR; PG8_SCHED;
            PG8_STAGEB(PG8_SB(0, 1), b2 + hstepB);
            PG8_WAIT_V(6); PG8_BAR; PG8_MMA(1, 1, At, B1); PG8_BAR;
            PG8_LDB(B0, 1, 0); PG8_SCHED; PG8_LDA(At, 1, 0); PG8_STAGEA(PG8_SA(0, 1), a2, 1, last);
            PG8_WAIT_L(8); PG8_BAR; PG8_WAIT_L(0); PG8_MMA(0, 0, At, B0); PG8_BAR; PG8_SCHED;
            PG8_LDB(B1, 1, 1); PG8_STAGEB(PG8_SB(1, 0), b3);
            PG8_BAR; PG8_WAIT_L(0); PG8_MMA(0, 1, At, B1); PG8_BAR;
            PG8_LDA(At, 1, 1); PG8_STAGEA(PG8_SA(1, 0), a3, 0, last);
            PG8_BAR; PG8_WAIT_L(0); PG8_MMA(1, 0, At, B0); PG8_BAR; PG8_SCHED;
            PG8_STAGEB(PG8_SB(1, 1), b3 + hstepB);
            PG8_WAIT_V(6); PG8_BAR; PG8_MMA(1, 1, At, B1); PG8_BAR;
            }
        }
        if constexpr (FP8) { asm volatile("s_nop 15\n\ts_nop 15" ::: "memory"); }
        if (wr == 0) PG8_BAR;
        if (!noepi) E(acc, cur, wr, wc, fr, fq);
        else {
#pragma unroll
            for (int a = 0; a < 2; ++a)
#pragma unroll
                for (int b = 0; b < 2; ++b)
#pragma unroll
                    for (int m = 0; m < 4; ++m)
#pragma unroll
                        for (int n = 0; n < 2; ++n) asm volatile("" :: "v"(acc[a][b][m][n])); }
        if (!has_next) break;
#pragma unroll
        for (int a = 0; a < 2; ++a)
#pragma unroll
            for (int b = 0; b < 2; ++b)
#pragma unroll
                for (int m = 0; m < 4; ++m)
#pragma unroll
                    for (int n = 0; n < 2; ++n) acc[a][b][m][n] = (f32x4){0.f, 0.f, 0.f, 0.f};
        cur = nxt; cA = nA; cB = nB; ++ui;
        if constexpr (GATHER) {
            gcur[0] = gnxt[0]; gcur[1] = gnxt[1]; }
        if (wr == 1) PG8_BAR;
    }
    PG8_WAIT_V(0);
    PG8_BAR;
#undef PG8_SA
#undef PG8_SB
#undef PG8_GLDS
#undef PG8_STAGEA
#undef PG8_STAGEB
#undef PG8_LDA
#undef PG8_LDB
#undef PG8_MMA
#undef PG8_WAIT_V
#undef PG8_WAIT_L
#undef PG8_BAR
#undef PG8_SCHED
#undef PG8_GOFFS
}
#else
template <class Epi, class Sched, bool GATHER>
__device__ __forceinline__ void gemm_phase(LAS unsigned char* lds, const int K, const unsigned lda, const unsigned ldb, const Sched& S, const Epi& E, const bool noepi = false) {
    const int tid = threadIdx.x, wid = __builtin_amdgcn_readfirstlane(tid >> 6), lane = tid & 63, wr = wid >> 2, wc = wid & 3, fr = lane & 15, fq = lane >> 4;
    Unit cur;
    for (int ui = 0; S.next(ui, cur); ++ui) {
        f32x4 acc[2][2][4][2];
#pragma unroll
        for (int a = 0; a < 2; ++a)
#pragma unroll
            for (int b = 0; b < 2; ++b)
#pragma unroll
                for (int m = 0; m < 4; ++m)
#pragma unroll
                    for (int n = 0; n < 2; ++n) acc[a][b][m][n] = (f32x4){0.f, 0.f, 0.f, 0.f};
        for (int k = 0; k < K; k += 8) {
            v4u av[2][4];
#pragma unroll
            for (int ai = 0; ai < 2; ++ai)
#pragma unroll
                for (int m = 0; m < 4; ++m) { const int r = ai * 128 + wr * 64 + m * 16 + fr; const size_t ro = GATHER ? (size_t)S.row_idx(cur, r) * lda : (size_t)r * lda; av[ai][m] = *(const v4u*)(cur.A + ro + (size_t)k * 2); }
#pragma unroll
            for (int bj = 0; bj < 2; ++bj)
#pragma unroll
                for (int n = 0; n < 2; ++n)
#pragma unroll
                    for (int j = 0; j < 4; ++j) { const int c = bj * 128 + wc * 32 + 8 * fq + 4 * n + j; const v4u bv = *(const v4u*)(cur.B + (size_t)c * ldb + (size_t)k * 2);
#pragma unroll
                        for (int ai = 0; ai < 2; ++ai)
#pragma unroll
                            for (int m = 0; m < 4; ++m) { const v4u a = av[ai][m]; float s = acc[ai][bj][m][n][j];
                                s += bflo(a.x) * bflo(bv.x) + bfhi(a.x) * bfhi(bv.x); s += bflo(a.y) * bflo(bv.y) + bfhi(a.y) * bfhi(bv.y);
                                s += bflo(a.z) * bflo(bv.z) + bfhi(a.z) * bfhi(bv.z); s += bflo(a.w) * bflo(bv.w) + bfhi(a.w) * bfhi(bv.w); acc[ai][bj][m][n][j] = s; } }
        }
        E(acc, cur, wr, wc, fr, fq);
    }
    __syncthreads();
}
#endif
}
using pg8::Unit;

#define XB_TMO      128
#define XB_XCNT(j)  (256  + 64 * (j))
#define XB_XSUB(j)  (1280 + 64 * (j))
#define XB_XGEN(j)  (2304 + 64 * (j))
#define XB_TOP      3328
#define XB_TOPGEN   3392
#define XCD_BAR_WORDS 3456
#define XB_SPIN_CAP (1u << 22)
__device__ __forceinline__ unsigned xb_ld(unsigned* p)              { return __hip_atomic_load(p, __ATOMIC_RELAXED, __HIP_MEMORY_SCOPE_AGENT); }
__device__ __forceinline__ unsigned xb_add(unsigned* p, unsigned v) { return __hip_atomic_fetch_add(p, v, __ATOMIC_RELAXED, __HIP_MEMORY_SCOPE_AGENT); }
__device__ __forceinline__ unsigned xb_xcc_id() { return (unsigned)__builtin_amdgcn_s_getreg((3 << 11) | 20) & 0xFu; }
#define XB_SPIN(cond, bar) do { unsigned _sp = 0; while (cond) { __builtin_amdgcn_s_sleep(1); \
    if ((++_sp & 255u) == 0u) { if (xb_ld(&(bar)[XB_TMO])) break; if (_sp > XB_SPIN_CAP) { atomicAdd(&(bar)[XB_TMO], 1u); break; } } } } while (0)
struct XcdBarrier { unsigned* bar; unsigned x; volatile LAS unsigned* st; };
__device__ __forceinline__ XcdBarrier xcd_barrier_post(unsigned* bar, volatile LAS unsigned* st) {
    XcdBarrier b; b.bar = bar; b.x = xb_xcc_id(); b.st = st;
    if (threadIdx.x == 0) (void)xb_add(&bar[XB_XCNT(b.x)], 1u);
    return b;
}
__device__ __forceinline__ void xcd_barrier_complete(unsigned* bar, unsigned x, unsigned& nloc, unsigned& nx) {
    const unsigned G = gridDim.x * gridDim.y * gridDim.z;
    unsigned sum, cnt, mine, sp = 0u;
    for (;;) {
        sum = 0u; cnt = 0u; mine = 0u;
#pragma unroll
        for (unsigned j = 0; j < 16; ++j) { const unsigned c = xb_ld(&bar[XB_XCNT(j)]); sum += c; cnt += (c > 0u) ? 1u : 0u; mine = (j == x) ? c : mine; }
        if (sum == G) break;
        __builtin_amdgcn_s_sleep(1);
        if ((++sp & 255u) == 0u) { if (xb_ld(&bar[XB_TMO])) break; if (sp > XB_SPIN_CAP) { atomicAdd(&bar[XB_TMO], 1u); break; } }
    }
    nloc = mine > 0u ? mine : 1u; nx = cnt > 0u ? cnt : 1u;
}
__device__ __forceinline__ void xcd_barrier(const XcdBarrier& b) {
    asm volatile("s_waitcnt vmcnt(0)" ::: "memory");
    __syncthreads();
    if (threadIdx.x == 0) {
        unsigned* bar = b.bar;
        __builtin_amdgcn_s_waitcnt(0);
        unsigned nloc = b.st[0], nx = b.st[1];
        if (nloc == 0u) { xcd_barrier_complete(bar, b.x, nloc, nx); b.st[0] = nloc; b.st[1] = nx; }
        const unsigned old = xb_add(&bar[XB_XSUB(b.x)], 1u);
        const unsigned gen = old / nloc;
        if (old + 1u == (gen + 1u) * nloc) {
            __builtin_amdgcn_fence(__ATOMIC_RELEASE, "agent");
            asm volatile("s_waitcnt vmcnt(0)" ::: "memory");
            const unsigned og = xb_add(&bar[XB_TOP], 1u);
            const unsigned tg = og / nx;
            if (og + 1u == (tg + 1u) * nx) xb_add(&bar[XB_TOPGEN], 1u);
            else XB_SPIN(xb_ld(&bar[XB_TOPGEN]) == tg, bar);
            __builtin_amdgcn_fence(__ATOMIC_ACQUIRE, "agent");
            xb_add(&bar[XB_XGEN(b.x)], 1u);
            asm volatile("s_waitcnt vmcnt(0)" ::: "memory");
        } else {
            XB_SPIN(xb_ld(&bar[XB_XGEN(b.x)]) == gen, bar);
            __builtin_amdgcn_fence(__ATOMIC_ACQUIRE, "agent");
            asm volatile("s_waitcnt vmcnt(0)" ::: "memory");
        }
    }
    __syncthreads();
}

struct Args { const float* in[31]; float* out; unsigned char* ws; unsigned mask; int variant, bar_region, pad; };
enum { I_X = 0, I_NMW, I_WIN, I_CONVW, I_CONVB, I_DTB, I_ALOG, I_DSSD, I_NSW, I_WAUP, I_LRE, I_LIM, I_LOGDT, I_BRE, I_BIM, I_CRE, I_CIM, I_S5D,
       I_WGLU, I_WBUP, I_GATEB, I_WOUT, I_NFW, I_WRG, I_BRG, I_WRE, I_BRE2, I_WEG, I_WEU, I_WED, I_NFINAL };
struct Ctx { LAS unsigned char* lds; volatile LAS unsigned* ctl; int tid, lane, wave, vcu, G; };
constexpr int PTAB_OFF = LDSCTL_OFF + 1024;
__device__ __forceinline__ unsigned long long ptab_get(LAS unsigned char* lds, int i) {
    const LAS unsigned* p = (const LAS unsigned*)(lds + PTAB_OFF + 8 * i); const unsigned lo = __builtin_amdgcn_readfirstlane(p[0]), hi = __builtin_amdgcn_readfirstlane(p[1]); return ((unsigned long long)hi << 32) | lo; }
#define PIN(i) ((const float*)ptab_get(F.lds, (i)))
#define POUT ((float*)ptab_get(F.lds, 31))
#define PWS ((unsigned char*)ptab_get(F.lds, 32))

struct TJob { const float* src; unsigned char* dst; int N, K; float scale; int fp8; };
__device__ __forceinline__ void tj_load(const TJob& j, int lane, f32x4 (&v)[8]) {
    const float* p = j.src + (size_t)(lane >> 3) * j.N + (lane & 7) * 4;
#pragma unroll
    for (int i = 0; i < 8; ++i) v[i] = __builtin_nontemporal_load((const f32x4*)(p + (size_t)(8 * i) * j.N));
}
__device__ __forceinline__ void tj_store(const TJob& j, int lane, const f32x4 (&v)[8], LAS float* scr) {
    LAS float* w = scr + (lane >> 3) * 33 + (lane & 7) * 4;
#pragma unroll
    for (int i = 0; i < 8; ++i) { w[i * 264 + 0] = v[i][0]; w[i * 264 + 1] = v[i][1]; w[i * 264 + 2] = v[i][2]; w[i * 264 + 3] = v[i][3]; }
    LDS_WAIT(); asm volatile("" ::: "memory");
    const int c = lane & 7;
#pragma unroll
    for (int jj = 0; jj < 4; ++jj) { const int n = (lane >> 3) + 8 * jj; const LAS float* s = scr + (8 * c) * 33 + n;
        if (j.fp8) { const float q = j.scale; v2u o; o.x = pk4_fp8(s[0 * 33] * q, s[1 * 33] * q, s[2 * 33] * q, s[3 * 33] * q); o.y = pk4_fp8(s[4 * 33] * q, s[5 * 33] * q, s[6 * 33] * q, s[7 * 33] * q);
            *(v2u*)(j.dst + (size_t)n * j.K + 8 * c) = o; }
        else { v4u o; o.x = pk2(s[0 * 33], s[1 * 33]); o.y = pk2(s[2 * 33], s[3 * 33]); o.z = pk2(s[4 * 33], s[5 * 33]); o.w = pk2(s[6 * 33], s[7 * 33]);
            *(v4u*)(j.dst + ((size_t)n * j.K + 8 * c) * 2) = o; } }
    LDS_WAIT(); asm volatile("" ::: "memory");
}
template <class Dec>
__device__ __forceinline__ void transpose_jobs(int first, int stride, int nitems, const Dec dec, LAS float* scr, int lane) {
    int it = first; if (it >= nitems) return;
    TJob cur; f32x4 v[8]; dec(it, cur); tj_load(cur, lane, v);
    for (;;) { const int nx = it + stride; const bool hn = nx < nitems; TJob nj = cur; f32x4 nv[8];
        if (hn) { dec(nx, nj); tj_load(nj, lane, nv); }
        tj_store(cur, lane, v, scr);
        if (!hn) break;
        cur = nj; it = nx;
#pragma unroll
        for (int i = 0; i < 8; ++i) v[i] = nv[i]; }
}
struct DecP0 {
    static constexpr int I_IN = 32 * (IN_DIM / 32), I_A = 32 * 64, I_G = 16 * 32, I_B = 16 * 64, I_O = 32 * 64, NITEMS = I_IN + I_A + I_G + I_B + I_O;
    const float *win, *wa, *wg, *wb, *wo; unsigned char* ws;
    __device__ __forceinline__ void operator()(int r, TJob& j) const {
        if (r < I_IN) { const int nb = r % (IN_DIM / 32), kb = r / (IN_DIM / 32); const int dr = 32 * nb; int sc; if (dr < 6144) sc = dr; else if (dr < 7168) sc = dr + 32; else if (dr < 11264) { const int rel = dr - 7168, within = rel & 255; sc = 7200 + (within >> 7) * 2048 + (rel >> 8) * 128 + (within & 127); } else sc = dr - 11264 + 6144;
            j.src = win + (size_t)(64 * kb) * IN_DIM + sc; if (dr >= 7168 && dr < 11264) { j.dst = ws + WS_WIN + (size_t)7168 * D * 2 + (size_t)(dr - 7168) * D + 64 * kb; j.scale = 32.f; j.fp8 = 1; } else { j.dst = ws + WS_WIN + ((size_t)dr * D + 64 * kb) * 2; j.scale = 1.f; j.fp8 = 0; } j.N = IN_DIM; j.K = D; return; } r -= I_IN;
        if (r < I_A) { j.src = wa + (size_t)(64 * (r / 64)) * D + 32 * (r % 64); j.dst = ws + WS_WAB + ((size_t)(32 * (r % 64)) * YVP + 64 * (r / 64)) * 2; j.scale = 1.f; j.fp8 = 0; j.N = D; j.K = YVP; return; } r -= I_A;
        if (r < I_G) { j.src = wg + (size_t)(64 * (r / 32)) * S5W + 32 * (r % 32); j.dst = ws + WS_WGLU + (size_t)(32 * (r % 32)) * S5W + 64 * (r / 32); j.scale = 32.f; j.fp8 = 1; j.N = S5W; j.K = S5W; return; } r -= I_G;
        if (r < I_B) { j.src = wb + (size_t)(64 * (r / 64)) * D + 32 * (r % 64); j.dst = ws + WS_WAB + ((size_t)(32 * (r % 64)) * YVP + 2048 + 64 * (r / 64)) * 2; j.scale = 1.f; j.fp8 = 0; j.N = D; j.K = YVP; return; } r -= I_B;
        j.src = wo + (size_t)(64 * (r / 64)) * D + 32 * (r % 64); j.dst = ws + WS_WOUT + ((size_t)(32 * (r % 64)) * D + 64 * (r / 64)) * 2; j.scale = 1.f; j.fp8 = 0; j.N = D; j.K = D; }
};
constexpr float WGU_SCALE = 64.f, WD_SCALE = 32.f, HID_SCALE = 4.f;
struct DecExp {
    static constexpr int I_GU = NE * 32 * 16, NITEMS = 3 * I_GU;
    const float *wg, *wu, *wd; unsigned char* ws;
    __device__ __forceinline__ void operator()(int it, TJob& j) const {
        if (it < 2 * I_GU) { const int which = it / I_GU, r = it % I_GU, e = r / 512, q = r % 512, kb = q / 16, nb = q % 16; const int j0 = 32 * nb;
            const int drow = (j0 >> 7) * 256 + which * 128 + (j0 & 127);
            j.src = (which ? wu : wg) + (size_t)e * D * FF + (size_t)(64 * kb) * FF + j0; j.dst = ws + WS_ST + ((size_t)e * 1024 + drow) * D + 64 * kb; j.N = FF; j.K = D; j.scale = WGU_SCALE; j.fp8 = 1; }
        else { const int r = it - 2 * I_GU, e = r / 512, q = r % 512, kb = q / 64, nb = q % 64;
            j.src = wd + (size_t)e * FF * D + (size_t)(64 * kb) * D + 32 * nb; j.dst = ws + WS_YV + ((size_t)e * D + 32 * nb) * FF + 64 * kb; j.N = D; j.K = FF; j.scale = WD_SCALE; j.fp8 = 1; }
    }
};
__device__ __forceinline__ void rms_row_to_bf16(const float* xrow, const float* w, bf16* orow, unsigned char* orow8, int lane) {
    const f32x4* xr = (const f32x4*)xrow + lane; const f32x4* wr4 = (const f32x4*)w + lane;
    f32x4 v[8]; float s = 0.f;
#pragma unroll
    for (int j = 0; j < 8; ++j) { v[j] = xr[64 * j]; s += (v[j].x * v[j].x + v[j].y * v[j].y) + (v[j].z * v[j].z + v[j].w * v[j].w); }
    const float rstd = 1.0f / sqrtf(wave_sum(s) * (1.f / D) + EPS);
    v2u* o8 = (v2u*)orow + lane; unsigned* q8 = (unsigned*)orow8 + lane;
#pragma unroll
    for (int j = 0; j < 8; ++j) { const f32x4 g = wr4[64 * j]; const f32x4 hv = {v[j].x * rstd * g.x, v[j].y * rstd * g.y, v[j].z * rstd * g.z, v[j].w * rstd * g.w};
        v2u o; o.x = pk2(hv.x, hv.y); o.y = pk2(hv.z, hv.w); o8[64 * j] = o; q8[64 * j] = pk4_fp8(hv.x, hv.y, hv.z, hv.w); }
}

__device__ __forceinline__ void s5_mats_group(const Args& a, const Ctx& F, int g) {
    LAS float* L = (LAS float*)F.lds;
    LAS float* apr = L; LAS float* api = L + 17 * 64; LAS float* bbr = L + 2 * 17 * 64; LAS float* bbi = bbr + 1024; LAS float* cr = bbi + 1024; LAS float* ci = cr + 1024; LAS float* kt = ci + 1024;
    LAS float* cof = kt + 4096;
    const float dt = expf(PIN(I_LOGDT)[g]);
    if (F.tid < 64) { const int n = F.tid; const float lr = PIN(I_LRE)[g * 64 + n], li = PIN(I_LIM)[g * 64 + n];
        for (int m = 0; m <= 16; ++m) { const float mag = expf((float)m * lr * dt), ang = (float)m * li * dt; apr[m * 64 + n] = mag * cosf(ang); api[m * 64 + n] = mag * sinf(ang); }
        const float ar = expf(lr * dt) * cosf(li * dt), ai = expf(lr * dt) * sinf(li * dt);
        const float den = lr * lr + li * li, nr = ar - 1.0f, ni = ai;
        cof[n] = (nr * lr + ni * li) / den; cof[64 + n] = (ni * lr - nr * li) / den; }
    for (int i = F.tid; i < 1024; i += 512) { const int co = i >> 6, n = i & 63; cr[i] = PIN(I_CRE)[(size_t)g * 1024 + co * 64 + n]; ci[i] = PIN(I_CIM)[(size_t)g * 1024 + co * 64 + n]; }
    __syncthreads();
    for (int i = F.tid; i < 1024; i += 512) { const int n = i >> 4; const float br = PIN(I_BRE)[(size_t)g * 1024 + i], bi = PIN(I_BIM)[(size_t)g * 1024 + i]; const float c0 = cof[n], c1 = cof[64 + n];
        bbr[i] = c0 * br - c1 * bi; bbi[i] = c0 * bi + c1 * br; }
    __syncthreads();
    for (int i = F.tid; i < 4096; i += 512) { const int lag = i >> 8, co = (i >> 4) & 15, cin = i & 15; float s = 0.f;
        for (int n = 0; n < 64; ++n) { const float wr_ = apr[lag * 64 + n] * bbr[n * 16 + cin] - api[lag * 64 + n] * bbi[n * 16 + cin], wi_ = apr[lag * 64 + n] * bbi[n * 16 + cin] + api[lag * 64 + n] * bbr[n * 16 + cin];
            s += cr[co * 64 + n] * wr_ - ci[co * 64 + n] * wi_; }
        kt[i] = s; }
    __syncthreads();
    bf16* TW = (bf16*)(PWS + WS_S5TW) + (size_t)g * 256 * APK;
    for (int i = F.tid; i < 256 * APK / 2; i += 512) { const int row = (2 * i) / APK, k0 = (2 * i) % APK; const int l = row >> 4, co = row & 15; float v[2];
#pragma unroll
        for (int q = 0; q < 2; ++q) { const int k = k0 + q; float val;
            if (k < 256) { const int j = k >> 4, cin = k & 15; val = (l >= j) ? kt[(l - j) * 256 + co * 16 + cin] : 0.f; if (l == j && cin == co) val += PIN(I_S5D)[g * 16 + co]; }
            else if (k < 320) { const int n = k - 256; val = cr[co * 64 + n] * apr[(l + 1) * 64 + n] - ci[co * 64 + n] * api[(l + 1) * 64 + n]; }
            else { const int n = k - 320; val = -(cr[co * 64 + n] * api[(l + 1) * 64 + n] + ci[co * 64 + n] * apr[(l + 1) * 64 + n]); }
            v[q] = val; }
        *(unsigned*)(TW + 2 * i) = pk2(v[0], v[1]); }
    bf16* WS = (bf16*)(PWS + WS_S5WS) + (size_t)g * 256 * 256;
    for (int i = F.tid; i < 256 * 256 / 2; i += 512) { const int row = (2 * i) >> 8, k0 = (2 * i) & 255; float v[2];
#pragma unroll
        for (int q = 0; q < 2; ++q) { const int k = k0 + q, j = k >> 4, cin = k & 15; float val = 0.f;
            if (row < 64) { const int n = row; val = apr[(15 - j) * 64 + n] * bbr[n * 16 + cin] - api[(15 - j) * 64 + n] * bbi[n * 16 + cin]; }
            else if (row < 128) { const int n = row - 64; val = apr[(15 - j) * 64 + n] * bbi[n * 16 + cin] + api[(15 - j) * 64 + n] * bbr[n * 16 + cin]; }
            v[q] = val; }
        *(unsigned*)(WS + 2 * i) = pk2(v[0], v[1]); }
    __syncthreads();
}

__device__ __forceinline__ void p0_prologue(const Args& a, const Ctx& F) {
    if (F.vcu < S5G) s5_mats_group(a, F, F.vcu);
    LAS float* scr = (LAS float*)(F.lds + F.wave * 16384);
    const int gw = F.vcu * NWAVES + F.wave, NGW = F.G * NWAVES;
    { DecP0 dec{PIN(I_WIN), PIN(I_WAUP), PIN(I_WGLU), PIN(I_WBUP), PIN(I_WOUT), PWS};
      transpose_jobs<DecP0>(gw, NGW, DecP0::NITEMS, dec, scr, F.lane); }
    {
        unsigned* gctr = (unsigned*)(PWS + WS_CTL) + CW_CNT + a.bar_region * 4096 + 2624; const float* X = PIN(I_X); const float* nmw = PIN(I_NMW); unsigned char* wsb = PWS;
        unsigned bv = 0u; if (F.lane == 0) bv = __hip_atomic_fetch_add(gctr, 1u, __ATOMIC_RELAXED, __HIP_MEMORY_SCOPE_AGENT);
        int b = (int)__builtin_amdgcn_readfirstlane(bv);
        while (b < T / 8) { unsigned nv = 0u; if (F.lane == 0) nv = __hip_atomic_fetch_add(gctr, 1u, __ATOMIC_RELAXED, __HIP_MEMORY_SCOPE_AGENT);
            for (int m = 8 * b; m < 8 * b + 8; ++m) rms_row_to_bf16(X + (size_t)m * D, nmw, (bf16*)(wsb + WS_H) + (size_t)m * D, wsb + WS_H8 + (size_t)m * D, F.lane);
            b = (int)__builtin_amdgcn_readfirstlane(nv); } }
    for (int i = gw * 64 + F.lane; i < 48 * D; i += NGW * 64) { const int col = i / D, k = i % D; float w = 0.f;
        if (col < 4) w = PIN(I_WRG)[k * 4 + col]; else if (col >= 16) w = PIN(I_WRE)[k * 32 + (col - 16)];
        const unsigned hi = f2bf(w); const float lo = w - bf2f((bf16)hi);
        ((bf16*)(PWS + WS_RT))[i] = (bf16)hi; ((bf16*)(PWS + WS_RT))[48 * D + i] = (bf16)f2bf(lo); }
}

struct SchedDense {
    pg8::StaticOrder so; const char* A; const char* B; unsigned lda, ldb;
    __device__ __forceinline__ bool next(int i, Unit& u) const { int pm, pn; if (!so.next(i, pm, pn)) return false;
        u.A = A + (size_t)pm * 256 * lda; u.B = B + (size_t)pn * 256 * ldb; u.row0 = pm * 256; u.col0 = pn * 256; u.e = 0; u.nvalid = 256; return true; }
    __device__ __forceinline__ unsigned row_idx(const Unit&, int) const { return 0u; }
};
struct SchedS5 {
    const char* A; const char* B; unsigned ldb; int G, c;
    __device__ __forceinline__ bool next(int i, Unit& u) const { const int idx = i * G + c; if (idx >= 256) return false; const int g = idx >> 2, mt = idx & 3;
        u.A = A + (size_t)(g * 1024 + mt * 256) * (APK * 2); u.B = B + (size_t)g * 256 * ldb; u.row0 = g * 1024 + mt * 256; u.col0 = 0; u.e = g; u.nvalid = 256; return true; }
    __device__ __forceinline__ unsigned row_idx(const Unit&, int) const { return 0u; }
};
struct SchedMoE {
    volatile LAS unsigned* ctl; const char* A; const char* B; const unsigned* list_tok; unsigned lda; size_t bstride_e; unsigned ldb; int NN, G, c; bool gather;
    __device__ __forceinline__ bool next(int i, Unit& u) const { const int idx = i * G + c; const int NT = (int)ctl[72]; if (idx >= NT * NN) return false;
        const int mtg = idx / NN, pn = idx % NN; const int e = (int)ctl[80 + mtg]; const int rb = (int)ctl[40 + e]; const int mtl = mtg - (rb >> 8); const int cnt = (int)ctl[8 + e];
        u.e = e; u.nvalid = cnt - mtl * 256; u.slot0 = mtl * 256; u.B = B + (size_t)e * bstride_e + (size_t)pn * 256 * ldb;
        if (gather) { u.A = A; u.row0 = rb + mtl * 256; u.col0 = pn * 128; }
        else { u.A = A + (size_t)(rb + mtl * 256) * lda; u.row0 = rb + mtl * 256; u.col0 = pn * 256; }
        return true; }
    __device__ __forceinline__ unsigned row_idx(const Unit& u, int r) const {
        const unsigned tokk = (r < u.nvalid) ? list_tok[(size_t)u.e * CAPL + u.slot0 + r] : 0u; return tokk >> 1; }
};

#define EPI_BEGIN _Pragma("unroll") for (int ai = 0; ai < 2; ++ai) _Pragma("unroll") for (int m = 0; m < 4; ++m) { const int r = ai * 128 + wr * 64 + m * 16 + fr; \
    _Pragma("unroll") for (int bj = 0; bj < 2; ++bj) { const int c = bj * 128 + wc * 32 + 8 * fq; const f32x4 v0 = acc[ai][bj][m][0], v1 = acc[ai][bj][m][1];
#define EPI_END } }
__device__ __forceinline__ v4u pack8(const f32x4 a, const f32x4 b) { v4u w; w.x = pk2(a[0], a[1]); w.y = pk2(a[2], a[3]); w.z = pk2(b[0], b[1]); w.w = pk2(b[2], b[3]); return w; }
__device__ __forceinline__ void unpack8(const v4u w, float (&f)[8]) { f[0] = bflo(w.x); f[1] = bfhi(w.x); f[2] = bflo(w.y); f[3] = bfhi(w.y); f[4] = bflo(w.z); f[5] = bfhi(w.z); f[6] = bflo(w.w); f[7] = bfhi(w.w); }

struct Epi1a {
    bf16* ZS; bf16* XBC; bf16* AP;
    __device__ __forceinline__ void operator()(const f32x4 (&acc)[2][2][4][2], const Unit& u, int wr, int wc, int fr, int fq) const {
        EPI_BEGIN  const int row = u.row0 + r, col = u.col0 + c;
            if (col < 2048) { f32x4 a = v0, b = v1;
#pragma unroll
                for (int j = 0; j < 4; ++j) { a[j] = siluf_(a[j]); b[j] = siluf_(b[j]); }
                *(v4u*)(ZS + (size_t)row * YVP + col) = pack8(a, b); }
            else if (col < 6144) { *(v4u*)(XBC + (size_t)row * XBCD + (col - 2048)) = pack8(v0, v1); }
            else { const int cc = col - 6144, g = cc >> 4, ci0 = cc & 15; *(v4u*)(AP + ((size_t)(g * S5NC + (row >> 4)) * APK + (row & 15) * 16 + ci0)) = pack8(v0, v1); }  EPI_END
    }
};
struct EpiS5a {
    float* SL;
    __device__ __forceinline__ void operator()(const f32x4 (&acc)[2][2][4][2], const Unit& u, int wr, int wc, int fr, int fq) const {
        EPI_BEGIN  if (bj == 0) { float* p = SL + (size_t)(u.row0 + r) * 128 + c; *(f32x4*)p = v0; *(f32x4*)(p + 4) = v1; }  EPI_END
    }
};
struct EpiS5b {
    bf16* V; unsigned char* V8;
    __device__ __forceinline__ void operator()(const f32x4 (&acc)[2][2][4][2], const Unit& u, int wr, int wc, int fr, int fq) const {
        EPI_BEGIN const int chunk = (u.row0 + r) & 1023, g = u.e, l = c >> 4, co0 = c & 15; f32x4 a = v0, b = v1;
#pragma unroll
            for (int j = 0; j < 4; ++j) { a[j] = gelu_tanh(a[j]); b[j] = gelu_tanh(b[j]); }
            const size_t o = (size_t)(chunk * 16 + l) * S5W + g * 16 + co0;
            *(v4u*)(V + o) = pack8(a, b); v2u o8; o8.x = pk4_fp8(a[0], a[1], a[2], a[3]); o8.y = pk4_fp8(b[0], b[1], b[2], b[3]); *(v2u*)(V8 + o) = o8; EPI_END
    }
};
struct Epi1b {
    bf16* Gt; const float* gb; const float* ssq;
    __device__ __forceinline__ void operator()(const f32x4 (&acc)[2][2][4][2], const Unit& u, int wr, int wc, int fr, int fq) const {
        const int j0 = (u.col0 >> 1) + wc * 32 + 8 * fq;
        const f32x4 ba0 = *(const f32x4*)(gb + j0), ba1 = *(const f32x4*)(gb + j0 + 4), bb0 = *(const f32x4*)(gb + 2048 + j0), bb1 = *(const f32x4*)(gb + 2048 + j0 + 4);
#pragma unroll
        for (int ai = 0; ai < 2; ++ai)
#pragma unroll
            for (int m = 0; m < 4; ++m) { const int row = u.row0 + ai * 128 + wr * 64 + m * 16 + fr; const f32x4 s0 = *(const f32x4*)(ssq + (size_t)row * 8), s1 = *(const f32x4*)(ssq + (size_t)row * 8 + 4);
                const float tot = ((s0[0] + s0[1]) + (s0[2] + s0[3])) + ((s1[0] + s1[1]) + (s1[2] + s1[3])); const float rstd = 1.0f / sqrtf(tot * (1.f / D) + EPS);
                f32x4 r0, r1, g0, g1;
#pragma unroll
                for (int j = 0; j < 4; ++j) { const float a0 = sigmoidf_(acc[ai][0][m][0][j] + ba0[j]), a1 = sigmoidf_(acc[ai][0][m][1][j] + ba1[j]);
                    g0[j] = fmaxf(sigmoidf_(acc[ai][1][m][0][j] + bb0[j]), 1e-20f); g1[j] = fmaxf(sigmoidf_(acc[ai][1][m][1][j] + bb1[j]), 1e-20f);
                    r0[j] = a0 * rstd * __builtin_amdgcn_rcpf(g0[j]); r1[j] = a1 * rstd * __builtin_amdgcn_rcpf(g1[j]); }
                *(v4u*)(Gt + (size_t)row * 4096 + j0) = pack8(r0, r1); *(v4u*)(Gt + (size_t)row * 4096 + 2048 + j0) = pack8(g0, g1); }
    }
};
struct EpiGlu {
    const bf16* V; bf16* YV;
    __device__ __forceinline__ void operator()(const f32x4 (&acc)[2][2][4][2], const Unit& u, int wr, int wc, int fr, int fq) const {
        EPI_BEGIN const size_t o = (size_t)(u.row0 + r) * S5W + u.col0 + c; float vv[8]; unpack8(*(const v4u*)(V + o), vv); f32x4 a, b;
#pragma unroll
            for (int j = 0; j < 4; ++j) { a[j] = vv[j] * sigmoidf_(v0[j]); b[j] = vv[4 + j] * sigmoidf_(v1[j]); }
            *(v4u*)(YV + (size_t)(u.row0 + r) * YVP + 2048 + u.col0 + c) = pack8(a, b); EPI_END
    }
};
struct EpiAB {
    const bf16* Gt; bf16* MG;
    __device__ __forceinline__ void mid(f32x4 (&acc)[2][2][4][2], const Unit& u, int wr, int wc, int fr, int fq) const {
        unsigned base = (unsigned)((u.row0 + wr * 64 + fr) * 4096 + u.col0 + wc * 32 + 8 * fq) * 2u;
        asm volatile("" : "+v"(base));
        const char* gp = (const char*)Gt;
#pragma unroll
        for (int ai = 0; ai < 2; ++ai)
#pragma unroll
            for (int m = 0; m < 4; ++m)
#pragma unroll
                for (int bj = 0; bj < 2; ++bj) { float rr[8]; unpack8(*(const v4u*)(gp + (size_t)(base + (unsigned)((ai * 128 + m * 16) * 4096 + bj * 128) * 2u)), rr);
#pragma unroll
                    for (int j = 0; j < 4; ++j) { acc[ai][bj][m][0][j] *= rr[j]; acc[ai][bj][m][1][j] *= rr[4 + j]; } }
    }
    __device__ __forceinline__ void operator()(const f32x4 (&acc)[2][2][4][2], const Unit& u, int wr, int wc, int fr, int fq) const {
        EPI_BEGIN const int row = u.row0 + r, col = u.col0 + c; float gg[8]; unpack8(*(const v4u*)(Gt + (size_t)row * 4096 + 2048 + col), gg); f32x4 a, b;
#pragma unroll
            for (int j = 0; j < 4; ++j) { a[j] = gg[j] * v0[j]; b[j] = gg[4 + j] * v1[j]; }
            *(v4u*)(MG + (size_t)row * D + col) = pack8(a, b); EPI_END
    }
};
struct EpiOut {
    bf16* XD;
    __device__ __forceinline__ void operator()(const f32x4 (&acc)[2][2][4][2], const Unit& u, int wr, int wc, int fr, int fq) const {
        EPI_BEGIN *(v4u*)(XD + (size_t)(u.row0 + r) * D + u.col0 + c) = pack8(v0, v1); EPI_END
    }
};
struct EpiGU {
    bf16* HID; const unsigned* list_tok; const float* rstd2;
    __device__ __forceinline__ void operator()(const f32x4 (&acc)[2][2][4][2], const Unit& u, int wr, int wc, int fr, int fq) const {
#pragma unroll
        for (int ai = 0; ai < 2; ++ai)
#pragma unroll
            for (int m = 0; m < 4; ++m) { const int r = ai * 128 + wr * 64 + m * 16 + fr; if (r < u.nvalid) { const float sc = rstd2[(size_t)u.e * CAPL + u.slot0 + r]; f32x4 a, b;
#pragma unroll
                for (int j = 0; j < 4; ++j) { a[j] = siluf_(sc * acc[ai][0][m][0][j]) * (sc * acc[ai][1][m][0][j]); b[j] = siluf_(sc * acc[ai][0][m][1][j]) * (sc * acc[ai][1][m][1][j]); }
                { v2u o8; o8.x = pk4_fp8(a[0] * HID_SCALE, a[1] * HID_SCALE, a[2] * HID_SCALE, a[3] * HID_SCALE); o8.y = pk4_fp8(b[0] * HID_SCALE, b[1] * HID_SCALE, b[2] * HID_SCALE, b[3] * HID_SCALE);
                  *(v2u*)((unsigned char*)HID + (size_t)(u.row0 + r) * FF + u.col0 + wc * 32 + 8 * fq) = o8; } } }
    }
};
constexpr float Y_SCALE = 16.f;
struct EpiDn {
    const float* list_w; unsigned char* Y;
    __device__ __forceinline__ void operator()(const f32x4 (&acc)[2][2][4][2], const Unit& u, int wr, int wc, int fr, int fq) const {
        const float* wp = list_w + (unsigned)(u.e * CAPL + u.slot0 + wr * 64 + fr);
#pragma unroll
        for (int ai = 0; ai < 2; ++ai)
#pragma unroll
            for (int m = 0; m < 4; ++m) { const int r = ai * 128 + wr * 64 + m * 16 + fr; const float w = wp[ai * 128 + m * 16] * Y_SCALE;
#pragma unroll
                for (int bj = 0; bj < 2; ++bj) { const int col = u.col0 + bj * 128 + wc * 32 + 8 * fq; const f32x4 a = acc[ai][bj][m][0] * w, b = acc[ai][bj][m][1] * w;
                    v2u o; o.x = pk4_fp8(a[0], a[1], a[2], a[3]); o.y = pk4_fp8(b[0], b[1], b[2], b[3]); if (r < u.nvalid) *(v2u*)(Y + (size_t)(u.row0 + r) * D + col) = o; } }
    }
};

__device__ __forceinline__ void dt_gemm(const Args& a, const Ctx& F) {
    const bf16* Hb = (const bf16*)(PWS + WS_H); const bf16* Wd = (const bf16*)(PWS + WS_WIN) + (size_t)11264 * D; float* DT = (float*)(PWS + WS_DT);
    LAS float* part = (LAS float*)F.lds;
    const int r = F.lane & 31, hh = F.lane >> 5;
    for (int unit = F.vcu; unit < T / 64; unit += F.G) {
        const int r0 = unit * 64; f32x16 acc0, acc1;
#pragma unroll
        for (int j = 0; j < 16; ++j) { acc0[j] = 0.f; acc1[j] = 0.f; }
#pragma unroll 4
        for (int ks = 0; ks < 16; ++ks) { const int k = F.wave * 256 + ks * 16 + hh * 8;
            const bf16x8 a0 = *(const bf16x8*)(Hb + (size_t)(r0 + r) * D + k), a1 = *(const bf16x8*)(Hb + (size_t)(r0 + 32 + r) * D + k), b = *(const bf16x8*)(Wd + (size_t)r * D + k);
            acc0 = __builtin_amdgcn_mfma_f32_32x32x16_bf16(a0, b, acc0, 0, 0, 0); acc1 = __builtin_amdgcn_mfma_f32_32x32x16_bf16(a1, b, acc1, 0, 0, 0); }
#pragma unroll
        for (int j = 0; j < 16; ++j) { part[((F.wave * 2 + 0) * 16 + j) * 64 + F.lane] = acc0[j]; part[((F.wave * 2 + 1) * 16 + j) * 64 + F.lane] = acc1[j]; }
        __syncthreads();
        for (int o = F.tid; o < 2048; o += 512) { const int row = o >> 5, col = o & 31; const int i = row >> 5, rr = row & 31, h2 = (rr >> 2) & 1, reg = (rr & 3) + 4 * (rr >> 3), ln = col + 32 * h2; float s = 0.f;
#pragma unroll
            for (int w = 0; w < 8; ++w) s += part[((w * 2 + i) * 16 + reg) * 64 + ln];
            s += PIN(I_DTB)[col]; DT[(size_t)(r0 + row) * 32 + col] = s > 20.f ? s : log1pf(expf(s)); }
        __syncthreads();
    }
}

constexpr int SEGC = 8, NSEG = NCHK / SEGC;
constexpr int SQ_XT = 0;
constexpr int SQ_BC = 36864;
constexpr int SQ_BT = SQ_BC + 17408;
constexpr int SQ_CC = SQ_BT + 18432;
constexpr int SQ_DT = SQ_CC + 17408;
constexpr int SQ_Y = SQ_DT + 4352;
constexpr int SQ_W = SQ_Y + 33792;
static_assert(SQ_W + 10240 <= LDSCTL_OFF, "SSD (sequential) LDS map");

template <int NTOK>
__device__ __forceinline__ void conv_pair(const LAS float* wl, int lc, const v4u (&rawv)[NTOK + 3], int d, float (&o)[NTOK][2]) {
    f32x2 w[4]; const f32x2 bias = *(const LAS f32x2*)(wl + 4 * 512 + lc);
#pragma unroll
    for (int k = 0; k < 4; ++k) w[k] = *(const LAS f32x2*)(wl + k * 512 + lc);
#pragma unroll
    for (int tt = 0; tt < NTOK; ++tt) { float s0 = bias[0], s1 = bias[1];
#pragma unroll
        for (int k = 0; k < 4; ++k) { const unsigned uu = rawv[tt + k][d]; s0 += w[k][0] * bflo(uu); s1 += w[k][1] * bfhi(uu); }
        o[tt][0] = siluf_(s0); o[tt][1] = siluf_(s1); }
}
template <bool SCALE>
__device__ __forceinline__ void conv_xs_to_lds(const LAS float* wl, int lc, const v4u (&rx)[7], LAS bf16* dst  , const f32x4 sc) {
#pragma unroll
    for (int d = 0; d < 4; ++d) { float o[4][2]; conv_pair<4>(wl, lc + 2 * d, rx, d, o);
        if constexpr (SCALE) {
#pragma unroll
            for (int tt = 0; tt < 4; ++tt) { o[tt][0] *= sc[tt]; o[tt][1] *= sc[tt]; } }
        v2u w0, w1; w0.x = pk2(o[0][0], o[1][0]); w0.y = pk2(o[2][0], o[3][0]); w1.x = pk2(o[0][1], o[1][1]); w1.y = pk2(o[2][1], o[3][1]);
        *(LAS v2u*)(dst + (2 * d) * 72) = w0; *(LAS v2u*)(dst + (2 * d + 1) * 72) = w1; }
}
template <bool NAT, bool TR>
__device__ __forceinline__ void conv_bc_to_lds(const LAS float* wl, int lc, const v4u (&rb)[5], LAS bf16* nat, LAS bf16* tr) {
    v4u n0, n1;
#pragma unroll
    for (int d = 0; d < 4; ++d) { float o[2][2]; conv_pair<2>(wl, lc + 2 * d, rb, d, o);
        if constexpr (NAT) { n0[d] = pk2(o[0][0], o[0][1]); n1[d] = pk2(o[1][0], o[1][1]); }
        if constexpr (TR) { *(LAS unsigned*)(tr + (2 * d) * 72) = pk2(o[0][0], o[1][0]); *(LAS unsigned*)(tr + (2 * d + 1) * 72) = pk2(o[0][1], o[1][1]); } }
    if constexpr (NAT) { *(LAS v4u*)nat = n0; *(LAS v4u*)(nat + 136) = n1; }
}
__device__ __forceinline__ void conv_weights_to_lds(const Args& a, const Ctx& F, int g) {
    LAS float* wl = (LAS float*)(F.lds + SQ_W);
    for (int i = F.tid; i < 5 * 512; i += NWAVES * 64) { const int k = i >> 9, lc = i & 511; const int ch = lc < 256 ? g * 256 + lc : (lc < 384 ? 2048 + g * 128 + (lc - 256) : 3072 + g * 128 + (lc - 384));
        wl[i] = k < 4 ? PIN(I_CONVW)[k * XBCD + ch] : PIN(I_CONVB)[ch]; }
    __syncthreads();
}
template <int NR>
__device__ __forceinline__ void rows_load(const unsigned char* ws, unsigned off, int t0, v4u (&raw)[NR]) {
#pragma unroll
    for (int i = 0; i < NR; ++i) { v4u v = (v4u){0u, 0u, 0u, 0u}; if (t0 + i >= 0) v = *(const v4u*)(ws + (size_t)(off + (unsigned)i * (XBCD * 2))); raw[i] = v; }
}

__device__ __forceinline__ float seq_dt_setup(const Args& a, const Ctx& F, int g, float dtv, int buf) {
    LAS float* dts = (LAS float*)(F.lds + SQ_DT); LAS float* acs = dts + 256; LAS float* wsc = dts + 512; LAS float* eacs = dts + 768; LAS float* cdec = dts + 1024;
    float tot = 0.f;
    if (F.wave < 4) { const int hd = 4 * g + F.wave; const float av = -expf(PIN(I_ALOG)[hd]);
        float s = dtv * av;
#pragma unroll
        for (int o = 1; o < 64; o <<= 1) { const float t = __shfl_up(s, o); if (F.lane >= o) s += t; }
        tot = __shfl(s, 63);
        dts[F.wave * 64 + F.lane] = dtv; acs[F.wave * 64 + F.lane] = s; wsc[F.wave * 64 + F.lane] = dtv * __expf(tot - s); eacs[F.wave * 64 + F.lane] = __expf(s);
        if (F.lane == 63) cdec[buf * 4 + F.wave] = __expf(tot); }
    return tot;
}
__device__ __forceinline__ bf16x8 pack_frag(const f32x16& X, int kk) { v4u w; w.x = pk2(X[8 * kk], X[8 * kk + 1]); w.y = pk2(X[8 * kk + 2], X[8 * kk + 3]); w.z = pk2(X[8 * kk + 4], X[8 * kk + 5]); w.w = pk2(X[8 * kk + 6], X[8 * kk + 7]); return __builtin_bit_cast(bf16x8, w); }
__device__ __forceinline__ void seq_state_update(const Ctx& F, f32x16 (&acc)[4], int hd, int pt, float cd) {
    const LAS bf16* xT = (const LAS bf16*)(F.lds + SQ_XT); const LAS bf16* Bt = (const LAS bf16*)(F.lds + SQ_BT); const LAS float* wsc = (const LAS float*)(F.lds + SQ_DT) + 512;
    const int r = F.lane & 31, hh = F.lane >> 5;
#pragma unroll
    for (int i = 0; i < 4; ++i) acc[i] = acc[i] * cd;
#pragma unroll
    for (int ks = 0; ks < 4; ++ks) { const v4u xw = *(const LAS v4u*)(xT + (hd * 64 + 32 * pt + r) * 72 + 16 * ks + 8 * hh); float xv[8]; unpack8(xw, xv);
        const f32x4 w0 = *(const LAS f32x4*)(wsc + hd * 64 + 16 * ks + 8 * hh), w1 = *(const LAS f32x4*)(wsc + hd * 64 + 16 * ks + 8 * hh + 4);
        v4u sw; sw.x = pk2(xv[0] * w0[0], xv[1] * w0[1]); sw.y = pk2(xv[2] * w0[2], xv[3] * w0[3]); sw.z = pk2(xv[4] * w1[0], xv[5] * w1[1]); sw.w = pk2(xv[6] * w1[2], xv[7] * w1[3]);
        const bf16x8 bfr = __builtin_bit_cast(bf16x8, sw);
#pragma unroll
        for (int i = 0; i < 4; ++i) { const bf16x8 afr = *(const LAS bf16x8*)(Bt + (32 * i + r) * 72 + 16 * ks + 8 * hh); acc[i] = __builtin_amdgcn_mfma_f32_32x32x16_bf16(afr, bfr, acc[i], 0, 0, 0); }
        if (ks & 1) __builtin_amdgcn_sched_barrier(0); }
}
__device__ __forceinline__ size_t seg_state_off(int g, int seg, int hd) { return ((size_t)(g * NSEG + seg) * 4 + hd) * 8192; }

__device__ __forceinline__ void ssd_pass_a(const Args& a, const Ctx& F) {
    LAS bf16* xT = (LAS bf16*)(F.lds + SQ_XT); LAS bf16* Bt = (LAS bf16*)(F.lds + SQ_BT); const LAS float* cdec = (const LAS float*)(F.lds + SQ_DT) + 1024; const LAS float* wl = (const LAS float*)(F.lds + SQ_W);
    for (int u = F.vcu; u < NGRP * NSEG; u += F.G) {
        const int g = u >> 5, seg = u & 31; const int hd = F.wave >> 1, pt = F.wave & 1, r = F.lane & 31, hh = F.lane >> 5;
        const int cgx = F.tid >> 4, l0x = (F.tid & 15) * 4, cgb = F.tid >> 5, l0b = (F.tid & 31) * 2;
        conv_weights_to_lds(a, F, g);
        f32x16 acc[4];
#pragma unroll
        for (int i = 0; i < 4; ++i)
#pragma unroll
            for (int j = 0; j < 16; ++j) acc[i][j] = 0.f;
        float totsum = 0.f;
        const int t0 = seg * SEGC * CHK;
        const unsigned char* wsb = PWS;
        unsigned ox = (unsigned)(WS_XBC + ((size_t)(t0 + l0x) * XBCD + g * 256 + cgx * 8) * 2 - 3 * XBCD * 2);
        unsigned ob = (unsigned)(WS_XBC + ((size_t)(t0 + l0b) * XBCD + 2048 + g * 128 + cgb * 8) * 2 - 3 * XBCD * 2);
        unsigned odt = (unsigned)(WS_DT + ((size_t)(t0 + F.lane) * 32 + 4 * g + (F.wave & 3)) * 4);
        v4u rx[7];
        rows_load<7>(wsb, ox, t0 + l0x - 3, rx);
        float dtv = *(const float*)(wsb + odt);
#pragma unroll 1
        for (int k = 0; k < SEGC; ++k) {
            v4u rb[5];
            rows_load<5>(wsb, ob, t0 + k * CHK + l0b - 3, rb);
            totsum += seq_dt_setup(a, F, g, dtv, k & 1);
            { const int hx = cgx >> 3, p0 = (cgx & 7) * 8;
              conv_xs_to_lds<false>(wl, cgx * 8, rx, xT + (hx * 64 + p0) * 72 + l0x, (f32x4){1.f, 1.f, 1.f, 1.f});
              conv_bc_to_lds<false, true>(wl, 256 + cgb * 8, rb, Bt, Bt + (cgb * 8) * 72 + l0b); }
            ox += CHK * XBCD * 2; ob += CHK * XBCD * 2; odt += CHK * 32 * 4;
            if (k + 1 < SEGC) { rows_load<7>(wsb, ox, 0, rx); dtv = *(const float*)(wsb + odt); }
            __syncthreads();
            seq_state_update(F, acc, hd, pt, cdec[(k & 1) * 4 + hd]);
            __syncthreads();
        }
        bf16* st = (bf16*)(PWS + WS_ST) + seg_state_off(g, seg, hd); const int p = 32 * pt + r;
#pragma unroll
        for (int i = 0; i < 4; ++i)
#pragma unroll
            for (int q = 0; q < 4; ++q) { v2u w; w.x = pk2(acc[i][4 * q], acc[i][4 * q + 1]); w.y = pk2(acc[i][4 * q + 2], acc[i][4 * q + 3]); *(v2u*)(st + ((4 * i + q) * 64 + p) * 8 + 4 * hh) = w; }
        if (F.wave < 4 && F.lane == 63) ((float*)(PWS + WS_MISC + 768 * 1024))[(g * NSEG + seg) * 4 + F.wave] = __expf(totsum);
        __syncthreads();
    }
}

__device__ __forceinline__ void ssd_pass_b(const Args& a, const Ctx& F) {
    LAS bf16* xT = (LAS bf16*)(F.lds + SQ_XT); LAS bf16* Bc = (LAS bf16*)(F.lds + SQ_BC); LAS bf16* Bt = (LAS bf16*)(F.lds + SQ_BT); LAS bf16* Cc = (LAS bf16*)(F.lds + SQ_CC);
    LAS float* dts = (LAS float*)(F.lds + SQ_DT); LAS float* acs = dts + 256; LAS float* eacs = dts + 768; const LAS float* cdec = dts + 1024; LAS bf16* yb = (LAS bf16*)(F.lds + SQ_Y); const LAS float* wl = (const LAS float*)(F.lds + SQ_W);
    for (int u = F.vcu; u < NGRP * NSEG; u += F.G) {
        const int g = u >> 5, seg = u & 31; const int hd = F.wave >> 1, pt = F.wave & 1, r = F.lane & 31, hh = F.lane >> 5, head = 4 * g + hd;
        const int cgx = F.tid >> 4, l0x = (F.tid & 15) * 4, cgb = F.tid >> 5, l0b = (F.tid & 31) * 2;
        conv_weights_to_lds(a, F, g);
        f32x16 acc[4];
        { const bf16* st = (const bf16*)(PWS + WS_ST) + seg_state_off(g, seg, hd); const int p = 32 * pt + r;
#pragma unroll
          for (int i = 0; i < 4; ++i)
#pragma unroll
              for (int q = 0; q < 4; ++q) { const v2u w = *(const v2u*)(st + ((4 * i + q) * 64 + p) * 8 + 4 * hh); acc[i][4 * q] = bflo(w.x); acc[i][4 * q + 1] = bfhi(w.x); acc[i][4 * q + 2] = bflo(w.y); acc[i][4 * q + 3] = bfhi(w.y); } }
        const float dsk = PIN(I_DSSD)[head];
        const int t0 = seg * SEGC * CHK;
        unsigned char* wsb = PWS;
        unsigned ox = (unsigned)(WS_XBC + ((size_t)(t0 + l0x) * XBCD + g * 256 + cgx * 8) * 2 - 3 * XBCD * 2);
        unsigned ob = (unsigned)(WS_XBC + ((size_t)(t0 + l0b) * XBCD + 2048 + g * 128 + cgb * 8) * 2 - 3 * XBCD * 2);
        unsigned odt = (unsigned)(WS_DT + ((size_t)(t0 + F.lane) * 32 + 4 * g + (F.wave & 3)) * 4);
        const int gcx = F.tid & 31;
        unsigned oz = (unsigned)(WS_YV + ((size_t)(t0 + (F.tid >> 5) * 4) * YVP + g * 256 + gcx * 8) * 2);
        unsigned oss = (unsigned)(WS_MISC + ((size_t)(t0 + (F.tid >> 5) * 4) * 8 + g) * 4);
#pragma unroll 1
        for (int k = 0; k < SEGC; ++k) {
            v4u rx[7], rb[5], rc[5];
            const float dtv = *(const float*)(wsb + odt);
            rows_load<7>(wsb, ox, t0 + k * CHK + l0x - 3, rx); rows_load<5>(wsb, ob, t0 + k * CHK + l0b - 3, rb); rows_load<5>(wsb, ob + 2048, t0 + k * CHK + l0b - 3, rc);
            (void)seq_dt_setup(a, F, g, dtv, k & 1);
            { const int hx = cgx >> 3, p0 = (cgx & 7) * 8;
              conv_xs_to_lds<false>(wl, cgx * 8, rx, xT + (hx * 64 + p0) * 72 + l0x, (f32x4){1.f, 1.f, 1.f, 1.f});
              conv_bc_to_lds<true, true>(wl, 256 + cgb * 8, rb, Bc + l0b * 136 + cgb * 8, Bt + (cgb * 8) * 72 + l0b);
              conv_bc_to_lds<true, false>(wl, 384 + cgb * 8, rc, Cc + l0b * 136 + cgb * 8, Cc); }
            __syncthreads();
            {
                const LAS bf16* xrow = xT + (hd * 64 + 32 * pt + r) * 72; const int pcol = hd * 64 + 32 * pt + r;
#pragma unroll
                for (int lt = 0; lt < 2; ++lt) {
                    f32x16 y;
#pragma unroll
                    for (int j = 0; j < 16; ++j) y[j] = 0.f;
#pragma unroll
                    for (int i = 0; i < 4; ++i)
#pragma unroll
                        for (int kk = 0; kk < 2; ++kk) { const bf16x8 bs = pack_frag(acc[i], kk); const int nb = 32 * i + 16 * kk + 4 * hh;
                            const v2u lo = *(const LAS v2u*)(Cc + (32 * lt + r) * 136 + nb), hi = *(const LAS v2u*)(Cc + (32 * lt + r) * 136 + nb + 8); const v4u c0 = (v4u){lo.x, lo.y, hi.x, hi.y};
                            y = __builtin_amdgcn_mfma_f32_32x32x16_bf16(__builtin_bit_cast(bf16x8, c0), bs, y, 0, 0, 0); }
#pragma unroll
                    for (int q = 0; q < 4; ++q) { const f32x4 e0 = *(const LAS f32x4*)(eacs + hd * 64 + 32 * lt + 8 * q + 4 * hh);
#pragma unroll
                        for (int i = 0; i < 4; ++i) y[4 * q + i] *= e0[i]; }
                    __builtin_amdgcn_sched_barrier(0);
                    const float al = acs[hd * 64 + 32 * lt + r];
#pragma unroll
                    for (int st = 0; st <= lt; ++st) {
                        f32x16 X;
#pragma unroll
                        for (int j = 0; j < 16; ++j) X[j] = 0.f;
#pragma unroll
                        for (int ks = 0; ks < 8; ++ks) { const int ko = 16 * ks + 8 * hh;
                            const bf16x8 a0 = *(const LAS bf16x8*)(Bc + (32 * st + r) * 136 + ko), b0 = *(const LAS bf16x8*)(Cc + (32 * lt + r) * 136 + ko);
                            X = __builtin_amdgcn_mfma_f32_32x32x16_bf16(a0, b0, X, 0, 0, 0); }
#pragma unroll
                        for (int q = 0; q < 4; ++q) { const int sb = 8 * q + 4 * hh;
                            const f32x4 as0 = *(const LAS f32x4*)(acs + hd * 64 + 32 * st + sb), ds0 = *(const LAS f32x4*)(dts + hd * 64 + 32 * st + sb);
#pragma unroll
                            for (int i = 0; i < 4; ++i) { const int j = 4 * q + i; const float v = X[j] * __expf(al - as0[i]) * ds0[i]; X[j] = (st < lt || r >= sb + i) ? v : 0.f; } }
#pragma unroll
                        for (int kk = 0; kk < 2; ++kk) { const int sb = 32 * st + 16 * kk + 4 * hh;
                            const v2u lo = *(const LAS v2u*)(xrow + sb), hi = *(const LAS v2u*)(xrow + sb + 8); const v4u wa = (v4u){lo.x, lo.y, hi.x, hi.y};
                            y = __builtin_amdgcn_mfma_f32_32x32x16_bf16(pack_frag(X, kk), __builtin_bit_cast(bf16x8, wa), y, 0, 0, 0); }
                        __builtin_amdgcn_sched_barrier(0);
                    }
#pragma unroll
                    for (int q = 0; q < 4; ++q) { const int lb = 32 * lt + 8 * q + 4 * hh;
                        const v2u xa = *(const LAS v2u*)(xrow + lb); const float xa4[4] = {bflo(xa.x), bfhi(xa.x), bflo(xa.y), bfhi(xa.y)};
#pragma unroll
                        for (int i = 0; i < 4; ++i) yb[(lb + i) * 264 + pcol] = (bf16)f2bf(y[4 * q + i] + dsk * xa4[i]); }
                    __builtin_amdgcn_sched_barrier(0);
                }
                seq_state_update(F, acc, hd, pt, cdec[(k & 1) * 4 + hd]);
            }
            ox += CHK * XBCD * 2; ob += CHK * XBCD * 2; odt += CHK * 32 * 4;
            v4u zq[4];
#pragma unroll
            for (int i = 0; i < 4; ++i) zq[i] = *(const v4u*)(wsb + (size_t)(oz + (unsigned)i * (YVP * 2)));
            __syncthreads();
            { const float* nw = PIN(I_NSW) + g * 256 + gcx * 8; const f32x4 n0 = *(const f32x4*)nw, n1 = *(const f32x4*)(nw + 4);
#pragma unroll
              for (int i = 0; i < 4; ++i) { const int l = (F.tid >> 5) * 4 + i;
                  float zz[8], yy[8]; unpack8(zq[i], zz); unpack8(*(const LAS v4u*)(yb + l * 264 + gcx * 8), yy);
                  f32x4 g0, g1; float sq = 0.f;
#pragma unroll
                  for (int j = 0; j < 4; ++j) { g0[j] = yy[j] * zz[j]; g1[j] = yy[4 + j] * zz[4 + j]; sq += g0[j] * g0[j] + g1[j] * g1[j]; }
                  *(v4u*)(wsb + (size_t)(oz + (unsigned)i * (YVP * 2))) = pack8(g0 * n0, g1 * n1);
#pragma unroll
                  for (int o = 1; o < 32; o <<= 1) sq += __shfl_xor(sq, o);
                  if (gcx == 0) *(float*)(wsb + (size_t)(oss + (unsigned)i * 32)) = sq; } }
            oz += CHK * YVP * 2; oss += CHK * 8 * 4;
        }
        __syncthreads();
    }
}

__device__ __forceinline__ void seg_scan(const Args& a, const Ctx& F) {
    for (int it = F.vcu * NWAVES + F.wave; it < 2048; it += F.G * NWAVES) { const int gh = it >> 6, sl = it & 63, g = gh >> 2, hd = gh & 3;
        bf16* base = (bf16*)(PWS + WS_ST) + seg_state_off(g, 0, hd) + sl * 128 + F.lane * 2; const float* cd = (const float*)(PWS + WS_MISC + 768 * 1024) + (size_t)g * NSEG * 4 + hd; constexpr size_t CS = (size_t)4 * 8192;
        unsigned v[NSEG]; float d[NSEG];
#pragma unroll
        for (int j = 0; j < NSEG; ++j) { v[j] = *(const unsigned*)(base + (size_t)j * CS); d[j] = cd[j * 4]; }
        float c0 = 0.f, c1 = 0.f;
#pragma unroll
        for (int j = 0; j < NSEG; ++j) { *(unsigned*)(base + (size_t)j * CS) = pk2(c0, c1); c0 = c0 * d[j] + bflo(v[j]); c1 = c1 * d[j] + bfhi(v[j]); } }
}

__device__ __forceinline__ void scans(const Args& a, const Ctx& F) {
    if (F.vcu < S5G) {
        const int g = F.vcu, n = F.lane; const float dt = expf(PIN(I_LOGDT)[g]), lr = PIN(I_LRE)[g * 64 + n], li = PIN(I_LIM)[g * 64 + n];
        const float mag = expf(16.f * lr * dt), ang = 16.f * li * dt, ar = mag * cosf(ang), ai = mag * sinf(ang);
        const float* SLp = (const float*)(PWS + WS_SL) + ((size_t)g * S5NC + 128 * F.wave) * 128 + n; bf16* AP = (bf16*)(PWS + WS_AP) + ((size_t)g * S5NC + 128 * F.wave) * APK + 256 + n;
        LAS float* ex = (LAS float*)F.lds;
        float sr = 0.f, si = 0.f;
        for (int cb = 0; cb < 128; cb += 16) { float ra[16], ia[16];
#pragma unroll
            for (int j = 0; j < 16; ++j) { ra[j] = SLp[(size_t)(cb + j) * 128]; ia[j] = SLp[(size_t)(cb + j) * 128 + 64]; }
#pragma unroll
            for (int j = 0; j < 16; ++j) { const float nr = ar * sr - ai * si + ra[j], ni = ar * si + ai * sr + ia[j]; sr = nr; si = ni; } }
        ex[F.wave * 128 + n] = sr; ex[F.wave * 128 + 64 + n] = si;
        __syncthreads();
        float pr = ar, pi = ai;
#pragma unroll
        for (int q = 0; q < 7; ++q) { const float t = pr * pr - pi * pi; pi = 2.f * pr * pi; pr = t; }
        sr = 0.f; si = 0.f;
        for (int w = 0; w < F.wave; ++w) { const float er = ex[w * 128 + n], ei = ex[w * 128 + 64 + n]; const float nr = pr * sr - pi * si + er, ni = pr * si + pi * sr + ei; sr = nr; si = ni; }
        for (int cb = 0; cb < 128; cb += 16) { float ra[16], ia[16];
#pragma unroll
            for (int j = 0; j < 16; ++j) { ra[j] = SLp[(size_t)(cb + j) * 128]; ia[j] = SLp[(size_t)(cb + j) * 128 + 64]; }
#pragma unroll
            for (int j = 0; j < 16; ++j) { AP[(size_t)(cb + j) * APK] = (bf16)f2bf(sr); AP[(size_t)(cb + j) * APK + 64] = (bf16)f2bf(si);
                const float nr = ar * sr - ai * si + ra[j], ni = ar * si + ai * sr + ia[j]; sr = nr; si = ni; } }
        __syncthreads();
    }
    seg_scan(a, F);
}

__device__ __forceinline__ void route_unit(const Args& a, const Ctx& F, int unit, LAS float* lg  ) {
    const int t0 = unit * 16, row = F.lane & 15, kq = F.lane >> 4;
    const float* xr = PIN(I_X) + (size_t)(t0 + row) * D + 8 * kq; const bf16* xd = (const bf16*)(PWS + WS_XD) + (size_t)(t0 + row) * D + 8 * kq; unsigned char* h2 = PWS + WS_H + (size_t)(t0 + row) * D + 8 * kq;
    const float* nf = PIN(I_NFW) + 8 * kq; const bf16* wt = (const bf16*)(PWS + WS_RT) + (size_t)row * D + 8 * kq;
    f32x4 acc0 = {0.f, 0.f, 0.f, 0.f}, acc1 = acc0, acc2 = acc0; float ssq = 0.f;
#pragma unroll 4
    for (int ks = 0; ks < 64; ++ks) { const int k = 32 * ks;
        const f32x4 x0 = *(const f32x4*)(xr + k), x1 = *(const f32x4*)(xr + k + 4), g0 = *(const f32x4*)(nf + k), g1 = *(const f32x4*)(nf + k + 4); float dd[8]; unpack8(*(const v4u*)(xd + k), dd);
        f32x4 m0, m1;
#pragma unroll
        for (int j = 0; j < 4; ++j) { m0[j] = x0[j] + dd[j]; m1[j] = x1[j] + dd[4 + j]; ssq += m0[j] * m0[j] + m1[j] * m1[j]; }
        const f32x4 hq0 = m0 * g0, hq1 = m1 * g1; const v4u hv = pack8(hq0, hq1); { v2u o8; o8.x = pk4_fp8(hq0[0], hq0[1], hq0[2], hq0[3]); o8.y = pk4_fp8(hq1[0], hq1[1], hq1[2], hq1[3]); *(v2u*)(h2 + k) = o8; } const bf16x8 af = __builtin_bit_cast(bf16x8, hv);
        const bf16x8 b0h = *(const bf16x8*)(wt + k), b1h = *(const bf16x8*)(wt + (size_t)16 * D + k), b2h = *(const bf16x8*)(wt + (size_t)32 * D + k);
        const bf16x8 b0l = *(const bf16x8*)(wt + (size_t)48 * D + k), b1l = *(const bf16x8*)(wt + (size_t)64 * D + k), b2l = *(const bf16x8*)(wt + (size_t)80 * D + k);
        acc0 = __builtin_amdgcn_mfma_f32_16x16x32_bf16(af, b0h, acc0, 0, 0, 0); acc1 = __builtin_amdgcn_mfma_f32_16x16x32_bf16(af, b1h, acc1, 0, 0, 0); acc2 = __builtin_amdgcn_mfma_f32_16x16x32_bf16(af, b2h, acc2, 0, 0, 0);
        acc0 = __builtin_amdgcn_mfma_f32_16x16x32_bf16(af, b0l, acc0, 0, 0, 0); acc1 = __builtin_amdgcn_mfma_f32_16x16x32_bf16(af, b1l, acc1, 0, 0, 0); acc2 = __builtin_amdgcn_mfma_f32_16x16x32_bf16(af, b2l, acc2, 0, 0, 0); }
    ssq += __shfl_xor(ssq, 16); ssq += __shfl_xor(ssq, 32);
    const float rstd = 1.0f / sqrtf(ssq * (1.f / D) + EPS);
    if (kq == 0) ((float*)(PWS + WS_MISC + 800 * 1024))[t0 + row] = rstd;
#pragma unroll
    for (int reg = 0; reg < 4; ++reg) { const int tok = 4 * kq + reg; const float rs = __shfl(rstd, tok);
        lg[tok * 48 + row] = rs * acc0[reg]; lg[tok * 48 + 16 + row] = rs * acc1[reg]; lg[tok * 48 + 32 + row] = rs * acc2[reg]; }
    LDS_WAIT(); asm volatile("" ::: "memory");
    if (F.lane < 16) { const int tok = F.lane; const LAS float* lq = lg + tok * 48;
        unsigned* cnt = (unsigned*)(PWS + WS_CTL) + CW_CNT + a.bar_region * 4096; unsigned* list_tok = (unsigned*)(PWS + WS_LST); float* list_w = (float*)(PWS + WS_LST + 2 * MiB);
        float g4[4]; int grp = 0; float gmax;
#pragma unroll
        for (int j = 0; j < 4; ++j) g4[j] = lq[j] + PIN(I_BRG)[j];
        gmax = g4[0];
#pragma unroll
        for (int j = 1; j < 4; ++j) if (g4[j] > gmax) { gmax = g4[j]; grp = j; }
        float den = 0.f;
#pragma unroll
        for (int j = 0; j < 4; ++j) den += expf(g4[j] - gmax);
        const float pg = 1.0f / den;
        float v1 = -INFINITY, v2 = -INFINITY; int i1 = 0, i2 = 0;
        for (int j = 0; j < 8; ++j) { const float le = lq[16 + grp * 8 + j] + PIN(I_BRE2)[grp * 8 + j];
            if (le > v1) { v2 = v1; i2 = i1; v1 = le; i1 = j; } else if (le > v2) { v2 = le; i2 = j; } }
        const float e2 = expf(v2 - v1), w1 = pg / (1.0f + e2), w2 = pg * e2 / (1.0f + e2);
        const int ea = grp * 8 + i1, eb = grp * 8 + i2; const unsigned tk = (unsigned)(t0 + tok);
        float* list_r = (float*)(PWS + WS_LR); unsigned* tokslot = (unsigned*)(PWS + WS_LR + 2 * MiB);
        const unsigned s1 = atomicAdd(cnt + 64 * ea, 1u); list_tok[(size_t)ea * CAPL + s1] = tk * 2u; list_w[(size_t)ea * CAPL + s1] = w1; list_r[(size_t)ea * CAPL + s1] = rstd; tokslot[tk * 2u] = (unsigned)ea * CAPL + s1;
        const unsigned s2 = atomicAdd(cnt + 64 * eb, 1u); list_tok[(size_t)eb * CAPL + s2] = tk * 2u + 1u; list_w[(size_t)eb * CAPL + s2] = w2; list_r[(size_t)eb * CAPL + s2] = rstd; tokslot[tk * 2u + 1u] = (unsigned)eb * CAPL + s2; }
    LDS_WAIT(); asm volatile("" ::: "memory");
}
template <class Dec>
__device__ __forceinline__ void transpose_jobs_dyn(volatile LAS unsigned* ctr, int cu, int ncu, int nitems, const Dec dec, LAS float* scr, int lane) {
    auto grab = [&]() -> int { unsigned j = 0; if (lane == 0) j = __hip_atomic_fetch_add((LAS unsigned*)ctr, 1u, __ATOMIC_RELAXED, __HIP_MEMORY_SCOPE_WORKGROUP); j = __builtin_amdgcn_readfirstlane(j); return cu + (int)j * ncu; };
    int it = grab(); if (it >= nitems) return;
    TJob cur; f32x4 v[8]; dec(it, cur); tj_load(cur, lane, v);
    for (;;) { const int nx = grab(); const bool hn = nx < nitems; TJob nj = cur; f32x4 nv[8];
        if (hn) { dec(nx, nj); tj_load(nj, lane, nv); }
        tj_store(cur, lane, v, scr);
        if (!hn) break;
        cur = nj;
#pragma unroll
        for (int i = 0; i < 8; ++i) v[i] = nv[i]; }
}
template <class Dec>
__device__ __forceinline__ void transpose_jobs_queue(unsigned* gctr, int first_item, int nbatches, const Dec dec, LAS float* scr, int lane) {
    unsigned bv = 0u; if (lane == 0) bv = __hip_atomic_fetch_add(gctr, 1u, __ATOMIC_RELAXED, __HIP_MEMORY_SCOPE_AGENT);
    int b = (int)__builtin_amdgcn_readfirstlane(bv);
    while (b < nbatches) {
        unsigned nv = 0u; if (lane == 0) nv = __hip_atomic_fetch_add(gctr, 1u, __ATOMIC_RELAXED, __HIP_MEMORY_SCOPE_AGENT);
        transpose_jobs<Dec>(first_item + 8 * b, 1, first_item + 8 * b + 8, dec, scr, lane);
        b = (int)__builtin_amdgcn_readfirstlane(nv); }
}
__device__ __forceinline__ void route_phase(const Args& a, const Ctx& F) {
    if (F.wave < 4) { LAS float* lg = (LAS float*)(F.lds + 8 * 16384) + F.wave * 768;
        for (int unit = F.vcu * 4 + F.wave; unit < T / 16; unit += F.G * 4) route_unit(a, F, unit, lg); }
    { LAS float* scr = (LAS float*)(F.lds + F.wave * 16384);
      DecExp dec{PIN(I_WEG), PIN(I_WEU), PIN(I_WED), PWS};
      transpose_jobs_dyn<DecExp>(F.ctl + 76, F.vcu, F.G, 2 * DecExp::I_GU, dec, scr, F.lane); }
}
__device__ __forceinline__ void moe_tables(const Args& a, const Ctx& F) {
    if (F.tid == 0) { const unsigned* cnt = (const unsigned*)(PWS + WS_CTL) + CW_CNT + a.bar_region * 4096; unsigned rb = 0, nt = 0;
        for (int e = 0; e < NE; ++e) { const unsigned c = __hip_atomic_load(cnt + 64 * e, __ATOMIC_RELAXED, __HIP_MEMORY_SCOPE_AGENT); const unsigned tiles = (c + 255u) >> 8; F.ctl[8 + e] = c; F.ctl[40 + e] = rb;
            for (unsigned i = 0; i < tiles && nt < 160u; ++i) F.ctl[80 + nt++] = (unsigned)e; rb += tiles * 256u; }
        F.ctl[72] = nt; }
    __syncthreads();
}
__device__ __forceinline__ void final_phase(const Args& a, const Ctx& F) {
    const int lane = (int)__builtin_amdgcn_mbcnt_hi(~0u, __builtin_amdgcn_mbcnt_lo(~0u, 0u));
    const int gw = F.vcu * NWAVES + F.wave, NGW = F.G * NWAVES; const unsigned char* Y = PWS + WS_XBC; const bf16* XD = (const bf16*)(PWS + WS_XD); const unsigned* tokslot = (const unsigned*)(PWS + WS_LR + 2 * MiB);
    for (int m = gw; m < T; m += NGW) { float* orow = POUT + (size_t)m * D; const f32x4* x4 = (const f32x4*)(PIN(I_X) + (size_t)m * D) + lane; const v2u* xd = (const v2u*)(XD + (size_t)m * D) + lane;
        const unsigned ts0 = tokslot[2 * m], ts1 = tokslot[2 * m + 1];
        const size_t r0 = (size_t)F.ctl[40 + (ts0 >> 14)] + (ts0 & 16383u), r1 = (size_t)F.ctl[40 + (ts1 >> 14)] + (ts1 & 16383u);
        const unsigned* y0 = (const unsigned*)(Y + r0 * D) + lane; const unsigned* y1 = (const unsigned*)(Y + r1 * D) + lane;
        const f32x4* w4 = (const f32x4*)PIN(I_NFINAL) + lane; f32x4 v[8]; float s = 0.f;
#pragma unroll
        for (int j = 0; j < 8; ++j) { const f32x4 x = x4[64 * j]; const unsigned p = y0[64 * j], q = y1[64 * j]; const v2u d2 = xd[64 * j];
            const f32x2 p0 = __builtin_amdgcn_cvt_pk_f32_fp8((int)p, false), p1 = __builtin_amdgcn_cvt_pk_f32_fp8((int)p, true), q0 = __builtin_amdgcn_cvt_pk_f32_fp8((int)q, false), q1 = __builtin_amdgcn_cvt_pk_f32_fp8((int)q, true);
            constexpr float ys = 1.0f / Y_SCALE;
            v[j] = (f32x4){x.x + bflo(d2.x) + ys * (p0[0] + q0[0]), x.y + bfhi(d2.x) + ys * (p0[1] + q0[1]), x.z + bflo(d2.y) + ys * (p1[0] + q1[0]), x.w + bfhi(d2.y) + ys * (p1[1] + q1[1])};
            s += (v[j].x * v[j].x + v[j].y * v[j].y) + (v[j].z * v[j].z + v[j].w * v[j].w); }
        const float rstd = 1.0f / sqrtf(wave_sum(s) * (1.f / D) + EPS);
#pragma unroll
        for (int j = 0; j < 8; ++j) { const f32x4 g = w4[64 * j]; ((f32x4*)orow + lane)[64 * j] = (f32x4){v[j].x * rstd * g.x, v[j].y * rstd * g.y, v[j].z * rstd * g.z, v[j].w * rstd * g.w}; } }
}

constexpr int N_PHASES = 12;
template <int VARIANT>
__global__ void __launch_bounds__(NWAVES * 64, 2) hybrid_fwd(Args args) {
    extern __shared__ __attribute__((aligned(16))) unsigned char lds_raw[];
    Ctx F; F.lds = (LAS unsigned char*)lds_raw; F.ctl = (volatile LAS unsigned*)(F.lds + LDSCTL_OFF);
    F.tid = threadIdx.x; F.lane = F.tid & 63; F.wave = __builtin_amdgcn_readfirstlane(F.tid >> 6);
    F.G = gridDim.x; { const int bx = blockIdx.x; F.vcu = (F.G % 8 == 0) ? (bx % 8) * (F.G / 8) + bx / 8 : bx; }
    for (int u = F.tid; u < (LDS_BYTES - LDSCTL_OFF) / 4; u += NWAVES * 64) ((LAS unsigned*)(F.lds + LDSCTL_OFF))[u] = 0u;
    __syncthreads();
    if (F.tid == 0) { LAS unsigned long long* pt = (LAS unsigned long long*)(F.lds + PTAB_OFF);
        pt[0] = (unsigned long long)args.in[0];
        pt[1] = (unsigned long long)args.in[1];
        pt[2] = (unsigned long long)args.in[2];
        pt[3] = (unsigned long long)args.in[3];
        pt[4] = (unsigned long long)args.in[4];
        pt[5] = (unsigned long long)args.in[5];
        pt[6] = (unsigned long long)args.in[6];
        pt[7] = (unsigned long long)args.in[7];
        pt[8] = (unsigned long long)args.in[8];
        pt[9] = (unsigned long long)args.in[9];
        pt[10] = (unsigned long long)args.in[10];
        pt[11] = (unsigned long long)args.in[11];
        pt[12] = (unsigned long long)args.in[12];
        pt[13] = (unsigned long long)args.in[13];
        pt[14] = (unsigned long long)args.in[14];
        pt[15] = (unsigned long long)args.in[15];
        pt[16] = (unsigned long long)args.in[16];
        pt[17] = (unsigned long long)args.in[17];
        pt[18] = (unsigned long long)args.in[18];
        pt[19] = (unsigned long long)args.in[19];
        pt[20] = (unsigned long long)args.in[20];
        pt[21] = (unsigned long long)args.in[21];
        pt[22] = (unsigned long long)args.in[22];
        pt[23] = (unsigned long long)args.in[23];
        pt[24] = (unsigned long long)args.in[24];
        pt[25] = (unsigned long long)args.in[25];
        pt[26] = (unsigned long long)args.in[26];
        pt[27] = (unsigned long long)args.in[27];
        pt[28] = (unsigned long long)args.in[28];
        pt[29] = (unsigned long long)args.in[29];
        pt[30] = (unsigned long long)args.in[30];
        pt[31] = (unsigned long long)args.out; pt[32] = (unsigned long long)args.ws; }
    __syncthreads();
    const unsigned mask = args.mask; const int lastp = 31 - __builtin_clz(mask | 1u);
    if (__builtin_popcount(mask) > 1) (void)xcd_barrier_post((unsigned*)(PWS + WS_CTL) + CW_BAR + args.bar_region * XCD_BAR_WORDS, F.ctl);
#define IN(k) (((mask >> (k)) & 1u) && (F.lane = (int)__builtin_amdgcn_mbcnt_hi(~0u, __builtin_amdgcn_mbcnt_lo(~0u, 0u)), F.tid = F.wave * 64 + F.lane, true))
#define SEAM(k) do { if (IN(k) && (k) != lastp) { XcdBarrier bar_; bar_.bar = (unsigned*)(PWS + WS_CTL) + CW_BAR + args.bar_region * XCD_BAR_WORDS; bar_.x = xb_xcc_id(); bar_.st = F.ctl; xcd_barrier(bar_); } } while (0)
    unsigned char* ws = PWS;
    if (IN(0)) { p0_prologue(args, F); } SEAM(0);
    if (IN(1)) { SchedDense S; S.so.init(T / 256, 28, F.G, (int)blockIdx.x); S.A = (const char*)(ws + WS_H); S.B = (const char*)(ws + WS_WIN); S.lda = D * 2; S.ldb = D * 2;
        Epi1a E{(bf16*)(ws + WS_YV), (bf16*)(ws + WS_XBC), (bf16*)(ws + WS_AP)};
        pg8::gemm_phase<Epi1a, SchedDense, false>(F.lds, D, D * 2, D * 2, S, E, (VARIANT & 1) != 0);
        dt_gemm(args, F); } SEAM(1);
    if (IN(2)) { ssd_pass_a(args, F);
        SchedS5 S{(const char*)(ws + WS_AP), (const char*)(ws + WS_S5WS), 512u, F.G, F.vcu}; EpiS5a E{(float*)(ws + WS_SL)};
        pg8::gemm_phase<EpiS5a, SchedS5, false>(F.lds, 256, APK * 2, 512, S, E, (VARIANT & 1) != 0); } SEAM(2);
    if (IN(3)) { scans(args, F); } SEAM(3);
    if (IN(4)) { ssd_pass_b(args, F);
        SchedS5 S{(const char*)(ws + WS_AP), (const char*)(ws + WS_S5TW), (unsigned)(APK * 2), F.G, F.vcu}; EpiS5b E{(bf16*)(ws + WS_SL), ws + WS_H};
        pg8::gemm_phase<EpiS5b, SchedS5, false>(F.lds, APK, APK * 2, APK * 2, S, E, (VARIANT & 1) != 0); } SEAM(4);
    if (IN(5)) { { SchedDense S; S.so.init(T / 256, 16, F.G, (int)blockIdx.x); S.A = (const char*)(ws + WS_H8); S.B = (const char*)(ws + WS_WIN) + (size_t)7168 * D * 2; S.lda = D; S.ldb = D;
          Epi1b E{(bf16*)(ws + WS_XBC), PIN(I_GATEB), (const float*)(ws + WS_MISC)};
          pg8::gemm_phase<Epi1b, SchedDense, false, true, 0, true, 127, 122>(F.lds, D, D, D, S, E, (VARIANT & 1) != 0); }
        { SchedDense S; S.so.init(T / 256, 4, F.G, (int)blockIdx.x); S.A = (const char*)(ws + WS_H); S.B = (const char*)(ws + WS_WGLU); S.lda = S5W; S.ldb = S5W;
          EpiGlu E{(const bf16*)(ws + WS_SL), (bf16*)(ws + WS_YV)};
          pg8::gemm_phase<EpiGlu, SchedDense, false, true, 0, true, 127, 122>(F.lds, S5W, S5W, S5W, S, E, (VARIANT & 1) != 0); } } SEAM(5);
    if (IN(6)) { SchedDense S; S.so.init(T / 256, 8, F.G, (int)blockIdx.x); S.A = (const char*)(ws + WS_YV); S.B = (const char*)(ws + WS_WAB); S.lda = YVP * 2; S.ldb = YVP * 2;
        EpiAB E{(const bf16*)(ws + WS_XBC), (bf16*)(ws + WS_ST)};
        pg8::gemm_phase<EpiAB, SchedDense, false, true, 32>(F.lds, YVP, YVP * 2, YVP * 2, S, E, (VARIANT & 1) != 0); } SEAM(6);
    if (IN(8)) { SchedDense S; S.so.init(T / 256, 8, F.G, (int)blockIdx.x); S.A = (const char*)(ws + WS_ST); S.B = (const char*)(ws + WS_WOUT); S.lda = D * 2; S.ldb = D * 2;
        EpiOut E{(bf16*)(ws + WS_XD)};
        pg8::gemm_phase<EpiOut, SchedDense, false>(F.lds, D, D * 2, D * 2, S, E, (VARIANT & 1) != 0); } SEAM(8);
    if (IN(9)) { route_phase(args, F); } SEAM(9);
    if (IN(10)) { moe_tables(args, F);
        SchedMoE S{F.ctl, (const char*)(ws + WS_H), (const char*)(ws + WS_ST), (const unsigned*)(ws + WS_LST), (unsigned)D, (size_t)1024 * D, (unsigned)D, 4, F.G, F.vcu, true};
        EpiGU E{(bf16*)(ws + WS_AP), (const unsigned*)(ws + WS_LST), (const float*)(ws + WS_LR)};
        pg8::gemm_phase<EpiGU, SchedMoE, true, true, 0, true, 127, 121>(F.lds, D, D, D, S, E, (VARIANT & 1) != 0);
        { LAS float* scr = (LAS float*)(F.lds + F.wave * 16384); DecExp dec{PIN(I_WEG), PIN(I_WEU), PIN(I_WED), PWS};
          transpose_jobs_queue<DecExp>((unsigned*)(ws + WS_CTL) + CW_CNT + args.bar_region * 4096 + 2560, 2 * DecExp::I_GU, DecExp::I_GU / 8, dec, scr, F.lane); } } SEAM(10);
    if (IN(11)) { moe_tables(args, F);
        SchedMoE S{F.ctl, (const char*)(ws + WS_AP), (const char*)(ws + WS_YV), (const unsigned*)(ws + WS_LST), (unsigned)FF, (size_t)D * FF, (unsigned)FF, 8, F.G, F.vcu, false};
        EpiDn E{(const float*)(ws + WS_LST + 2 * MiB), ws + WS_XBC};
        pg8::gemm_phase<EpiDn, SchedMoE, false, true, 0, true, 125, 122>(F.lds, FF, FF, FF, S, E, (VARIANT & 1) != 0); } SEAM(11);
    if (IN(12)) { moe_tables(args, F); final_phase(args, F); }
#undef IN
#undef SEAM
}

extern "C" void kernel_launch(void* const* d_in, const int* in_sizes, int n_in, void* d_out, int out_size, void* d_ws, size_t ws_size, hipStream_t stream) {
    static int grid = 0;
    if (grid == 0) {
        if (n_in != 31 || in_sizes[0] != T * D || out_size != T * D || ws_size < WS_END) { fprintf(stderr, "kernel_launch: unexpected shapes / workspace (n_in %d, ws %zu, need %zu)\n", n_in, ws_size, (size_t)WS_END); grid = -1; return; }
        int dev = 0, cus = 0;
        if (hipGetDevice(&dev) != hipSuccess || hipDeviceGetAttribute(&cus, hipDeviceAttributeMultiprocessorCount, dev) != hipSuccess) { grid = -1; return; }
        if (hipFuncSetAttribute((const void*)hybrid_fwd<0>, hipFuncAttributeMaxDynamicSharedMemorySize, LDS_BYTES) != hipSuccess) { fprintf(stderr, "kernel_launch: hipFuncSetAttribute failed\n"); grid = -1; return; }
#if defined(EXP_MASK)
        (void)hipFuncSetAttribute((const void*)hybrid_fwd<EXP_VARIANT>, hipFuncAttributeMaxDynamicSharedMemorySize, LDS_BYTES);
#endif
        int per_cu = 0;
        if (hipOccupancyMaxActiveBlocksPerMultiprocessor(&per_cu, (const void*)hybrid_fwd<0>, NWAVES * 64, LDS_BYTES) != hipSuccess || per_cu < 1) fprintf(stderr, "kernel_launch: occupancy query reports %d\n", per_cu);
        (void)hipGetLastError();
        grid = cus;
    }
    if (grid < 0) return;
    (void)hipMemsetAsync((char*)d_ws + WS_CTL, 0, CTL_ZERO_BYTES, stream);
    Args a{};
    for (int i = 0; i < 31; ++i) a.in[i] = (const float*)d_in[i];
    a.out = (float*)d_out; a.ws = (unsigned char*)d_ws;
#if defined(EXP_MASK)
    a.mask = EXP_MASK; a.variant = EXP_VARIANT; a.bar_region = 0;
    hipLaunchKernelGGL(hybrid_fwd<EXP_VARIANT>, dim3(grid), dim3(NWAVES * 64), LDS_BYTES, stream, a);
    a.mask = ((1u << (N_PHASES + 1)) - 1u) & ~(1u << 7); a.variant = 0; a.bar_region = 1;
    hipLaunchKernelGGL(hybrid_fwd<0>, dim3(grid), dim3(NWAVES * 64), LDS_BYTES, stream, a);
#elif MK_N_LAUNCHES == 1
    a.mask = ((1u << (N_PHASES + 1)) - 1u) & ~(1u << 7); a.variant = 0; a.bar_region = 0;
    hipLaunchKernelGGL(hybrid_fwd<0>, dim3(grid), dim3(NWAVES * 64), LDS_BYTES, stream, a);
#else
    for (int p = 0; p <= N_PHASES; ++p) { if (p == 7) continue; a.mask = 1u << p; a.variant = 0; a.bar_region = 0; hipLaunchKernelGGL(hybrid_fwd<0>, dim3(grid), dim3(NWAVES * 64), LDS_BYTES, stream, a); }
#endif
}
```

```cpp
#include <hip/hip_runtime.h>
#include <cstdio>
#include <cstdint>

#ifndef MK_N_LAUNCHES
#define MK_N_LAUNCHES 1
#endif
#ifndef EXP_VARIANT
#define EXP_VARIANT 0
#endif
#ifndef NAIVE_GEMM
#define NAIVE_GEMM 0
#endif

#define LAS __attribute__((address_space(3)))
#define GAS __attribute__((address_space(1)))
typedef unsigned short bf16;
typedef short bf16x8 __attribute__((ext_vector_type(8)));
typedef float f32x4 __attribute__((ext_vector_type(4)));
typedef float f32x2 __attribute__((ext_vector_type(2)));
typedef float f32x16 __attribute__((ext_vector_type(16)));
typedef unsigned v4u __attribute__((ext_vector_type(4)));
typedef unsigned v2u __attribute__((ext_vector_type(2)));
typedef GAS unsigned gu32;
typedef int v4i_ __attribute__((ext_vector_type(4)));
typedef int v8i_ __attribute__((ext_vector_type(8)));

constexpr int T = 16384, D = 2048;
constexpr int NH = 32, HP = 64, NGRP = 8, NST = 128, CHK = 64, NCHK = T / CHK;
constexpr int XBCD = 4096;
constexpr int S5W = 1024, S5G = 64, S5C = 16, S5N = 64, LS = 16, S5NC = T / LS;
constexpr int APK = 384;
constexpr int NE = 32, EPG = 8, FF = 512, CAPL = 16384;
constexpr int IN_DIM = 11296;
constexpr float EPS = 1e-6f;
constexpr int NWAVES = 8;

constexpr size_t MiB = 1u << 20;
constexpr size_t WS_CTL = 0, CTL_ZERO_BYTES = 1 * MiB;
constexpr size_t WS_WIN = 1 * MiB;
constexpr size_t WS_WAB = 46 * MiB;
constexpr size_t WS_WGLU = 58 * MiB, WS_WOUT = 80 * MiB;
constexpr size_t WS_S5WS = 60 * MiB;
constexpr size_t WS_S5TW = 68 * MiB;
constexpr size_t WS_XD = 1 * MiB;
constexpr size_t WS_H = 88 * MiB;
constexpr int YVP = 3072;
constexpr size_t WS_YV = 152 * MiB;
constexpr size_t WS_XBC = 248 * MiB;
constexpr size_t WS_ST = 376 * MiB;
constexpr size_t WS_AP = 504 * MiB;
constexpr size_t WS_DT = 552 * MiB;
constexpr size_t WS_MISC = 554 * MiB;
constexpr size_t WS_SL = 555 * MiB;
constexpr size_t WS_LST = 587 * MiB;
constexpr size_t WS_RT = 591 * MiB;
constexpr size_t WS_H8 = 592 * MiB;
constexpr size_t WS_LR = 624 * MiB;
constexpr size_t WS_END = 627 * MiB;
constexpr int CW_BAR = 4096;
constexpr int CW_CNT = 16384;

constexpr int LDS_BYTES = 163840;
constexpr int LDSCTL_OFF = 161792;

typedef __bf16 bf16x2_t __attribute__((ext_vector_type(2)));
__device__ __forceinline__ unsigned f2bf(float f) { return (unsigned)__builtin_bit_cast(unsigned short, (__bf16)f); }
__device__ __forceinline__ unsigned pk2(float lo, float hi) { const f32x2 v = {lo, hi}; const bf16x2_t b = __builtin_convertvector(v, bf16x2_t); return __builtin_bit_cast(unsigned, b); }
__device__ __forceinline__ unsigned pk4_fp8(float a, float b, float c, float d) { unsigned w = 0u; w = (unsigned)__builtin_amdgcn_cvt_pk_fp8_f32(a, b, (int)w, false); w = (unsigned)__builtin_amdgcn_cvt_pk_fp8_f32(c, d, (int)w, true); return w; }
__device__ __forceinline__ float bflo(unsigned w) { return __builtin_bit_cast(float, w << 16); }
__device__ __forceinline__ float bfhi(unsigned w) { return __builtin_bit_cast(float, w & 0xffff0000u); }
__device__ __forceinline__ float bf2f(bf16 h) { return __builtin_bit_cast(float, (unsigned)h << 16); }
__device__ __forceinline__ float wave_sum(float v) {
#pragma unroll
    for (int o = 1; o < 64; o <<= 1) v += __shfl_xor(v, o);
    return v;
}
__device__ __forceinline__ float sigmoidf_(float x) { return __builtin_amdgcn_rcpf(1.0f + __builtin_amdgcn_exp2f(-1.4426950408889634f * x)); }
__device__ __forceinline__ float siluf_(float x) { return x * __builtin_amdgcn_rcpf(1.0f + __builtin_amdgcn_exp2f(-1.4426950408889634f * x)); }
__device__ __forceinline__ float gelu_tanh(float x) { const float u = 0.7978845608028654f * (x + 0.044715f * x * x * x); return x * __builtin_amdgcn_rcpf(1.0f + __builtin_amdgcn_exp2f(-2.8853900817779268f * u)); }
#define LDS_WAIT() asm volatile("s_waitcnt lgkmcnt(0)" ::: "memory")
#define VM_WAIT() asm volatile("s_waitcnt vmcnt(0)" ::: "memory")

namespace pg8 {
constexpr int BM = 256, BK = 64, HALF = 128, HTB = HALF * BK * 2, STAGE_BYTES = 8 * HTB, NXCD = 8, WGM = 8;
__host__ __device__ __forceinline__ int lds_byte(int r, int c) { const int st = (r >> 4) * 2 + (c >> 5), rr = r & 15, cc = c & 31, ob = rr * 64 + cc * 2; return st * 1024 + (ob ^ (((ob >> 9) & 1) << 5)); }
__host__ __device__ __forceinline__ void stage_rc(int b, int& R, int& C) { const int st = b / 1024, sb = b % 1024, swz = sb ^ (((sb >> 9) & 1) << 5); R = (st >> 1) * 16 + swz / 64; C = (st & 1) * 32 + (swz % 64) / 2; }
__host__ __device__ __forceinline__ int perm32(int rho) { const int n = rho >> 4, i = rho & 15; return 8 * (i >> 2) + 4 * n + (i & 3); }

struct Unit { const char* A; const char* B; int row0, col0, e, nvalid, slot0; };

struct StaticOrder {
    int nM, nN, nwg, G, c;
    __device__ void init(int nM_, int nN_, int G_, int c_) { nM = nM_; nN = nN_; nwg = nM * nN; G = G_; c = c_; }
    __device__ bool next(int i, int& pm, int& pn) const {
        const long L = (long)i * G + c; if (L >= nwg) return false;
        int wgid = (int)L; { const int q = nwg / NXCD, r = nwg % NXCD, xcd = wgid % NXCD, off = wgid / NXCD; wgid = (xcd < r ? xcd * (q + 1) : r * (q + 1) + (xcd - r) * q) + off; }
        const int nig = WGM * nN, gid = wgid / nig, fm = gid * WGM, gsz = (nM - fm) < WGM ? (nM - fm) : WGM;
        pm = fm + ((wgid % nig) % gsz); pn = (wgid % nig) / gsz; return true;
    }
};

#if !NAIVE_GEMM
template <class Epi, class Sched, bool GATHER, bool SP2 = true, int MIDT = 0, bool FP8 = false, int SCA = 127, int SCB = 127>
__device__ __forceinline__ void gemm_phase(LAS unsigned char* lds, const int K, const unsigned lda, const unsigned ldb, const Sched& S, const Epi& E, const bool noepi = false) {
    const int tid = threadIdx.x, wid = __builtin_amdgcn_readfirstlane(tid >> 6), lane = tid & 63, wr = wid >> 2, wc = wid & 3, fr = lane & 15, fq = lane >> 4;
    const int nt = FP8 ? K / 128 : K / BK;
    unsigned voffA[2], voffB[2]; int gC0 = 0;
#pragma unroll
    for (int i = 0; i < 2; ++i) { int R, C; stage_rc(tid * 16 + i * 8192, R, C); const int Rb = (R & ~31) + perm32(R & 31);
        voffA[i] = (unsigned)R * lda + (unsigned)C * 2u; voffB[i] = (unsigned)Rb * ldb + (unsigned)C * 2u; if (i == 0) gC0 = C * 2; }
    const size_t kstep = (size_t)(BK * 2);
    const size_t hstepA = (size_t)HALF * lda, hstepB = (size_t)HALF * ldb;
    const unsigned ldsw = (unsigned)wid * 1024u;
    const int aoff = FP8 ? lds_byte(wr * 64 + fr, fq * 16) : lds_byte(wr * 64 + fr, fq * 8), boff = FP8 ? lds_byte(wc * 32 + fr, fq * 16) : lds_byte(wc * 32 + fr, fq * 8);
    constexpr int PIECE1 = FP8 ? 16 : 1024;
    unsigned gcur[2], gnxt[2];
    int scav = SCA, scbv = SCB;
    if constexpr (FP8) { asm volatile("" : "+v"(scav), "+v"(scbv)); }
#define PG8_SA(b, h) (((b) * 2 + (h)) * HTB)
#define PG8_SB(b, h) ((4 + (b) * 2 + (h)) * HTB)
#define PG8_GLDS(gptr, bufoff, i) __builtin_amdgcn_global_load_lds((const unsigned*)(gptr), (LAS unsigned*)(lds + (bufoff) + ldsw + (i) * 8192), 16, 0, 0)
#define PG8_STAGEB(bufoff, gbase) do { _Pragma("unroll") for (int _i = 0; _i < 2; ++_i) PG8_GLDS((const char*)(gbase) + voffB[0] + (size_t)(_i * 64) * ldb, bufoff, _i); } while (0)
#define PG8_STAGEA(bufoff, gbase, h, nx) do { _Pragma("unroll") for (int _i = 0; _i < 2; ++_i) { \
        const unsigned _pk = (nx) ? gnxt[h] : gcur[h]; const size_t _o = GATHER ? (size_t)((_i ? (_pk >> 16) : (_pk & 0xffffu)) * lda + (unsigned)gC0) : (size_t)voffA[0] + (size_t)(_i * 64) * lda + (size_t)(h) * hstepA; PG8_GLDS((const char*)(gbase) + _o, bufoff, _i); } } while (0)
#define PG8_LD16(off) (*(const LAS v4i_*)(lds + (off)))
#define PG8_LDA(dst, b, h) do { _Pragma("unroll") for (int m = 0; m < 4; ++m) { const v4i_ _lo = PG8_LD16(PG8_SA(b, h) + aoff + m * 2048), _hi = PG8_LD16(PG8_SA(b, h) + aoff + PIECE1 + m * 2048); \
        if constexpr (FP8) dst##8[m] = __builtin_shufflevector(_lo, _hi, 0, 1, 2, 3, 4, 5, 6, 7); else { dst##4[m][0] = _lo; dst##4[m][1] = _hi; } } } while (0)
#define PG8_LDB(dst, b, h) do { _Pragma("unroll") for (int n = 0; n < 2; ++n) { const v4i_ _lo = PG8_LD16(PG8_SB(b, h) + boff + n * 2048), _hi = PG8_LD16(PG8_SB(b, h) + boff + PIECE1 + n * 2048); \
        if constexpr (FP8) dst##8[n] = __builtin_shufflevector(_lo, _hi, 0, 1, 2, 3, 4, 5, 6, 7); else { dst##4[n][0] = _lo; dst##4[n][1] = _hi; } } } while (0)
#define PG8_MMA(ai, bj, At, Bt) do { __builtin_amdgcn_s_setprio(1); _Pragma("unroll") for (int m = 0; m < 4; ++m) _Pragma("unroll") for (int n = 0; n < 2; ++n) { \
        if constexpr (FP8) { asm volatile("v_mfma_scale_f32_16x16x128_f8f6f4 %0, %1, %2, %0, %3, %4 op_sel_hi:[0,0,0]" : "+v"(acc[ai][bj][m][n]) : "v"(Bt##8[n]), "v"(At##8[m]), "v"(scbv), "v"(scav)); } \
        else { _Pragma("unroll") for (int k = 0; k < 2; ++k) acc[ai][bj][m][n] = __builtin_amdgcn_mfma_f32_16x16x32_bf16(__builtin_bit_cast(bf16x8, Bt##4[n][k]), __builtin_bit_cast(bf16x8, At##4[m][k]), acc[ai][bj][m][n], 0, 0, 0); } } \
        __builtin_amdgcn_s_setprio(0); } while (0)
#define PG8_WAIT_V(n) asm volatile("s_waitcnt vmcnt(" #n ")" ::: "memory")
#define PG8_WAIT_L(n) asm volatile("s_waitcnt lgkmcnt(" #n ")" ::: "memory")
#define PG8_BAR __builtin_amdgcn_s_barrier()
#define PG8_SCHED __builtin_amdgcn_sched_barrier(0)
#define PG8_GOFFS(dst, u) do { if constexpr (GATHER) { int _r0, _r1, _c; stage_rc(tid * 16, _r0, _c); stage_rc(tid * 16 + 8192, _r1, _c); _Pragma("unroll") for (int _h = 0; _h < 2; ++_h) dst[_h] = S.row_idx(u, _h * HALF + _r0) | (S.row_idx(u, _h * HALF + _r1) << 16); } } while (0)
    Unit cur, nxt; int ui = 0;
    if (!S.next(0, cur)) return;
    f32x4 acc[2][2][4][2];
#pragma unroll
    for (int a = 0; a < 2; ++a)
#pragma unroll
        for (int b = 0; b < 2; ++b)
#pragma unroll
            for (int m = 0; m < 4; ++m)
#pragma unroll
                for (int n = 0; n < 2; ++n) acc[a][b][m][n] = (f32x4){0.f, 0.f, 0.f, 0.f};
    v8i_ At8[4], B08[2], B18[2]; v4i_ At4[4][2], B04[2][2], B14[2][2];
    const char* cA = cur.A; const char* cB = cur.B;
#pragma unroll
    for (int h = 0; h < 2; ++h) { gcur[h] = 0u; gnxt[h] = 0u; }
    PG8_GOFFS(gcur, cur);
    if constexpr (SP2) {
    PG8_STAGEB(PG8_SB(0, 0), cB); PG8_STAGEB(PG8_SB(0, 1), cB + hstepB); PG8_STAGEA(PG8_SA(0, 0), cA, 0, false); PG8_STAGEA(PG8_SA(0, 1), cA, 1, false);
    if (wr == 1) PG8_BAR;
    PG8_WAIT_V(2); PG8_BAR;
    PG8_STAGEB(PG8_SB(1, 0), cB + kstep); PG8_STAGEA(PG8_SA(1, 0), cA + kstep, 0, false); PG8_STAGEB(PG8_SB(1, 1), cB + hstepB + kstep);
    PG8_WAIT_V(6); PG8_BAR;
    } else {
    PG8_STAGEB(PG8_SB(0, 0), cB); PG8_STAGEA(PG8_SA(0, 0), cA, 0, false); PG8_STAGEB(PG8_SB(0, 1), cB + hstepB); PG8_STAGEA(PG8_SA(0, 1), cA, 1, false);
    if (wr == 1) PG8_BAR;
    PG8_WAIT_V(4); PG8_BAR;
    PG8_STAGEB(PG8_SB(1, 0), cB + kstep); PG8_STAGEA(PG8_SA(1, 0), cA + kstep, 0, false); PG8_STAGEB(PG8_SB(1, 1), cB + hstepB + kstep);
    PG8_WAIT_V(6); PG8_BAR;
    }
    for (;;) {
        const bool has_next = S.next(ui + 1, nxt);
        const char* nA = has_next ? nxt.A : cA; const char* nB = has_next ? nxt.B : cB;
        if constexpr (GATHER) { if (has_next) { PG8_GOFFS(gnxt, nxt); } else {
            gnxt[0] = gcur[0]; gnxt[1] = gcur[1]; } }
#pragma unroll 1
        for (int t = 0; t < nt; t += 2) {
            const bool last = (t == nt - 2);
            if constexpr (MIDT > 0) { if (t == MIDT) E.mid(acc, cur, wr, wc, fr, fq); }
            const char* a1 = cA + (size_t)(t + 1) * kstep;
            const char* a2 = last ? nA : cA + (size_t)(t + 2) * kstep; const char* b2 = last ? nB : cB + (size_t)(t + 2) * kstep;
            const char* a3 = a2 + kstep; const char* b3 = b2 + kstep;
            if constexpr (SP2) {
            PG8_LDB(B0, 0, 0); PG8_LDB(B1, 0, 1); PG8_SCHED; PG8_LDA(At, 0, 0); PG8_STAGEA(PG8_SA(1, 1), a1, 1, false);
            PG8_WAIT_V(8); PG8_WAIT_L(0); PG8_BAR; PG8_MMA(0, 0, At, B0); PG8_MMA(0, 1, At, B1); PG8_BAR; PG8_SCHED;
            PG8_LDA(At, 0, 1); PG8_STAGEB(PG8_SB(0, 0), b2); PG8_STAGEB(PG8_SB(0, 1), b2 + hstepB); PG8_STAGEA(PG8_SA(0, 0), a2, 0, last);
            PG8_WAIT_V(8); PG8_WAIT_L(0); PG8_BAR; PG8_MMA(1, 0, At, B0); PG8_MMA(1, 1, At, B1); PG8_BAR; PG8_SCHED;
            PG8_LDB(B0, 1, 0); PG8_LDB(B1, 1, 1); PG8_SCHED; PG8_LDA(At, 1, 0); PG8_STAGEA(PG8_SA(0, 1), a2, 1, last);
            PG8_WAIT_V(8); PG8_WAIT_L(0); PG8_BAR; PG8_MMA(0, 0, At, B0); PG8_MMA(0, 1, At, B1); PG8_BAR; PG8_SCHED;
            PG8_LDA(At, 1, 1); PG8_STAGEB(PG8_SB(1, 0), b3); PG8_STAGEB(PG8_SB(1, 1), b3 + hstepB); PG8_STAGEA(PG8_SA(1, 0), a3, 0, last);
            PG8_WAIT_V(8); PG8_WAIT_L(0); PG8_BAR; PG8_MMA(1, 0, At, B0); PG8_MMA(1, 1, At, B1); PG8_BAR; PG8_SCHED;
            } else {
            PG8_LDB(B0, 0, 0); PG8_SCHED; PG8_LDA(At, 0, 0); PG8_STAGEA(PG8_SA(1, 1), a1, 1, false);
            PG8_WAIT_L(8); PG8_BAR; PG8_WAIT_L(0); PG8_MMA(0, 0, At, B0); PG8_BAR; PG8_SCHED;
            PG8_LDB(B1, 0, 1); PG8_STAGEB(PG8_SB(0, 0), b2);
            PG8_BAR; PG8_WAIT_L(0); PG8_MMA(0, 1, At, B1); PG8_BAR;
            PG8_LDA(At, 0, 1); PG8_STAGEA(PG8_SA(0, 0), a2, 0, last);
            PG8_BAR; PG8_WAIT_L(0); PG8_MMA(1, 0, At, B0); PG8_BAR; PG8_SCHED;
            PG8_STAGEB(PG8_SB(0, 1), b2 + hstepB);
            PG8_WAIT_V(6); PG8_BAR; PG8_MMA(1, 1, At, B1); PG8_BAR;
            PG8_LDB(B0, 1, 0); PG8_SCHED; PG8_LDA(At, 1, 0); PG8_STAGEA(PG8_SA(0, 1), a2, 1, last);
            PG8_WAIT_L(8); PG8_BAR; PG8_WAIT_L(0); PG8_MMA(0, 0, At, B0); PG8_BAR; PG8_SCHED;
            PG8_LDB(B1, 1, 1); PG8_STAGEB(PG8_SB(1, 0), b3);
            PG8_BAR; PG8_WAIT_L(0); PG8_MMA(0, 1, At, B1); PG8_BAR;
            PG8_LDA(At, 1, 1); PG8_STAGEA(PG8_SA(1, 0), a3, 0, last);
            PG8_BAR; PG8_WAIT_L(0); PG8_MMA(1, 0, At, B0); PG8_BAR; PG8_SCHED;
            PG8_STAGEB(PG8_SB(1, 1), b3 + hstepB);
            PG8_WAIT_V(6); PG8_BAR; PG8_MMA(1, 1, At, B1); PG8_BAR;
            }
        }
        if constexpr (FP8) { asm volatile("s_nop 15\n\ts_nop 15" ::: "memory"); }
        if (wr == 0) PG8_BAR;
        if (!noepi) E(acc, cur, wr, wc, fr, fq);
        else {
#pragma unroll
            for (int a = 0; a < 2; ++a)
#pragma unroll
                for (int b = 0; b < 2; ++b)
#pragma unroll
                    for (int m = 0; m < 4; ++m)
#pragma unroll
                        for (int n = 0; n < 2; ++n) asm volatile("" :: "v"(acc[a][b][m][n])); }
        if (!has_next) break;
#pragma unroll
        for (int a = 0; a < 2; ++a)
#pragma unroll
            for (int b = 0; b < 2; ++b)
#pragma unroll
                for (int m = 0; m < 4; ++m)
#pragma unroll
                    for (int n = 0; n < 2; ++n) acc[a][b][m][n] = (f32x4){0.f, 0.f, 0.f, 0.f};
        cur = nxt; cA = nA; cB = nB; ++ui;
        if constexpr (GATHER) {
            gcur[0] = gnxt[0]; gcur[1] = gnxt[1]; }
        if (wr == 1) PG8_BAR;
    }
    PG8_WAIT_V(0);
    PG8_BAR;
#undef PG8_SA
#undef PG8_SB
#undef PG8_GLDS
#undef PG8_STAGEA
#undef PG8_STAGEB
#undef PG8_LDA
#undef PG8_LDB
#undef PG8_MMA
#undef PG8_WAIT_V
#undef PG8_WAIT_L
#undef PG8_BAR
#undef PG8_SCHED
#undef PG8_GOFFS
}
#else
template <class Epi, class Sched, bool GATHER>
__device__ __forceinline__ void gemm_phase(LAS unsigned char* lds, const int K, const unsigned lda, const unsigned ldb, const Sched& S, const Epi& E, const bool noepi = false) {
    const int tid = threadIdx.x, wid = __builtin_amdgcn_readfirstlane(tid >> 6), lane = tid & 63, wr = wid >> 2, wc = wid & 3, fr = lane & 15, fq = lane >> 4;
    Unit cur;
    for (int ui = 0; S.next(ui, cur); ++ui) {
        f32x4 acc[2][2][4][2];
#pragma unroll
        for (int a = 0; a < 2; ++a)
#pragma unroll
            for (int b = 0; b < 2; ++b)
#pragma unroll
                for (int m = 0; m < 4; ++m)
#pragma unroll
                    for (int n = 0; n < 2; ++n) acc[a][b][m][n] = (f32x4){0.f, 0.f, 0.f, 0.f};
        for (int k = 0; k < K; k += 8) {
            v4u av[2][4];
#pragma unroll
            for (int ai = 0; ai < 2; ++ai)
#pragma unroll
                for (int m = 0; m < 4; ++m) { const int r = ai * 128 + wr * 64 + m * 16 + fr; const size_t ro = GATHER ? (size_t)S.row_idx(cur, r) * lda : (size_t)r * lda; av[ai][m] = *(const v4u*)(cur.A + ro + (size_t)k * 2); }
#pragma unroll
            for (int bj = 0; bj < 2; ++bj)
#pragma unroll
                for (int n = 0; n < 2; ++n)
#pragma unroll
                    for (int j = 0; j < 4; ++j) { const int c = bj * 128 + wc * 32 + 8 * fq + 4 * n + j; const v4u bv = *(const v4u*)(cur.B + (size_t)c * ldb + (size_t)k * 2);
#pragma unroll
                        for (int ai = 0; ai < 2; ++ai)
#pragma unroll
                            for (int m = 0; m < 4; ++m) { const v4u a = av[ai][m]; float s = acc[ai][bj][m][n][j];
                                s += bflo(a.x) * bflo(bv.x) + bfhi(a.x) * bfhi(bv.x); s += bflo(a.y) * bflo(bv.y) + bfhi(a.y) * bfhi(bv.y);
                                s += bflo(a.z) * bflo(bv.z) + bfhi(a.z) * bfhi(bv.z); s += bflo(a.w) * bflo(bv.w) + bfhi(a.w) * bfhi(bv.w); acc[ai][bj][m][n][j] = s; } }
        }
        E(acc, cur, wr, wc, fr, fq);
    }
    __syncthreads();
}
#endif
}
using pg8::Unit;

#define XB_TMO      128
#define XB_XCNT(j)  (256  + 64 * (j))
#define XB_XSUB(j)  (1280 + 64 * (j))
#define XB_XGEN(j)  (2304 + 64 * (j))
#define XB_TOP      3328
#define XB_TOPGEN   3392
#define XCD_BAR_WORDS 3456
#define XB_SPIN_CAP (1u << 22)
__device__ __forceinline__ unsigned xb_ld(unsigned* p)              { return __hip_atomic_load(p, __ATOMIC_RELAXED, __HIP_MEMORY_SCOPE_AGENT); }
__device__ __forceinline__ unsigned xb_add(unsigned* p, unsigned v) { return __hip_atomic_fetch_add(p, v, __ATOMIC_RELAXED, __HIP_MEMORY_SCOPE_AGENT); }
__device__ __forceinline__ unsigned xb_xcc_id() { return (unsigned)__builtin_amdgcn_s_getreg((3 << 11) | 20) & 0xFu; }
#define XB_SPIN(cond, bar) do { unsigned _sp = 0; while (cond) { __builtin_amdgcn_s_sleep(1); \
    if ((++_sp & 255u) == 0u) { if (xb_ld(&(bar)[XB_TMO])) break; if (_sp > XB_SPIN_CAP) { atomicAdd(&(bar)[XB_TMO], 1u); break; } } } } while (0)
struct XcdBarrier { unsigned* bar; unsigned x; volatile LAS unsigned* st; };
__device__ __forceinline__ XcdBarrier xcd_barrier_post(unsigned* bar, volatile LAS unsigned* st) {
    XcdBarrier b; b.bar = bar; b.x = xb_xcc_id(); b.st = st;
    if (threadIdx.x == 0) (void)xb_add(&bar[XB_XCNT(b.x)], 1u);
    return b;
}
__device__ __forceinline__ void xcd_barrier_complete(unsigned* bar, unsigned x, unsigned& nloc, unsigned& nx) {
    const unsigned G = gridDim.x * gridDim.y * gridDim.z;
    unsigned sum, cnt, mine, sp = 0u;
    for (;;) {
        sum = 0u; cnt = 0u; mine = 0u;
#pragma unroll
        for (unsigned j = 0; j < 16; ++j) { const unsigned c = xb_ld(&bar[XB_XCNT(j)]); sum += c; cnt += (c > 0u) ? 1u : 0u; mine = (j == x) ? c : mine; }
        if (sum == G) break;
        __builtin_amdgcn_s_sleep(1);
        if ((++sp & 255u) == 0u) { if (xb_ld(&bar[XB_TMO])) break; if (sp > XB_SPIN_CAP) { atomicAdd(&bar[XB_TMO], 1u); break; } }
    }
    nloc = mine > 0u ? mine : 1u; nx = cnt > 0u ? cnt : 1u;
}
__device__ __forceinline__ void xcd_barrier(const XcdBarrier& b) {
    asm volatile("s_waitcnt vmcnt(0)" ::: "memory");
    __syncthreads();
    if (threadIdx.x == 0) {
        unsigned* bar = b.bar;
        __builtin_amdgcn_s_waitcnt(0);
        unsigned nloc = b.st[0], nx = b.st[1];
        if (nloc == 0u) { xcd_barrier_complete(bar, b.x, nloc, nx); b.st[0] = nloc; b.st[1] = nx; }
        const unsigned old = xb_add(&bar[XB_XSUB(b.x)], 1u);
        const unsigned gen = old / nloc;
        if (old + 1u == (gen + 1u) * nloc) {
            __builtin_amdgcn_fence(__ATOMIC_RELEASE, "agent");
            asm volatile("s_waitcnt vmcnt(0)" ::: "memory");
            const unsigned og = xb_add(&bar[XB_TOP], 1u);
            const unsigned tg = og / nx;
            if (og + 1u == (tg + 1u) * nx) xb_add(&bar[XB_TOPGEN], 1u);
            else XB_SPIN(xb_ld(&bar[XB_TOPGEN]) == tg, bar);
            __builtin_amdgcn_fence(__ATOMIC_ACQUIRE, "agent");
            xb_add(&bar[XB_XGEN(b.x)], 1u);
            asm volatile("s_waitcnt vmcnt(0)" ::: "memory");
        } else {
            XB_SPIN(xb_ld(&bar[XB_XGEN(b.x)]) == gen, bar);
            __builtin_amdgcn_fence(__ATOMIC_ACQUIRE, "agent");
            asm volatile("s_waitcnt vmcnt(0)" ::: "memory");
        }
    }
    __syncthreads();
}

struct Args { const float* in[31]; float* out; unsigned char* ws; unsigned mask; int variant, bar_region, pad; };
enum { I_X = 0, I_NMW, I_WIN, I_CONVW, I_CONVB, I_DTB, I_ALOG, I_DSSD, I_NSW, I_WAUP, I_LRE, I_LIM, I_LOGDT, I_BRE, I_BIM, I_CRE, I_CIM, I_S5D,
       I_WGLU, I_WBUP, I_GATEB, I_WOUT, I_NFW, I_WRG, I_BRG, I_WRE, I_BRE2, I_WEG, I_WEU, I_WED, I_NFINAL };
struct Ctx { LAS unsigned char* lds; volatile LAS unsigned* ctl; int tid, lane, wave, vcu, G; };
constexpr int PTAB_OFF = LDSCTL_OFF + 1024;
__device__ __forceinline__ unsigned long long ptab_get(LAS unsigned char* lds, int i) {
    const LAS unsigned* p = (const LAS unsigned*)(lds + PTAB_OFF + 8 * i); const unsigned lo = __builtin_amdgcn_readfirstlane(p[0]), hi = __builtin_amdgcn_readfirstlane(p[1]); return ((unsigned long long)hi << 32) | lo; }
#define PIN(i) ((const float*)ptab_get(F.lds, (i)))
#define POUT ((float*)ptab_get(F.lds, 31))
#define PWS ((unsigned char*)ptab_get(F.lds, 32))

struct TJob { const float* src; unsigned char* dst; int N, K; float scale; int fp8; };
__device__ __forceinline__ void tj_load(const TJob& j, int lane, f32x4 (&v)[8]) {
    const float* p = j.src + (size_t)(lane >> 3) * j.N + (lane & 7) * 4;
#pragma unroll
    for (int i = 0; i < 8; ++i) v[i] = __builtin_nontemporal_load((const f32x4*)(p + (size_t)(8 * i) * j.N));
}
__device__ __forceinline__ void tj_store(const TJob& j, int lane, const f32x4 (&v)[8], LAS float* scr) {
    LAS float* w = scr + (lane >> 3) * 33 + (lane & 7) * 4;
#pragma unroll
    for (int i = 0; i < 8; ++i) { w[i * 264 + 0] = v[i][0]; w[i * 264 + 1] = v[i][1]; w[i * 264 + 2] = v[i][2]; w[i * 264 + 3] = v[i][3]; }
    LDS_WAIT(); asm volatile("" ::: "memory");
    const int c = lane & 7;
#pragma unroll
    for (int jj = 0; jj < 4; ++jj) { const int n = (lane >> 3) + 8 * jj; const LAS float* s = scr + (8 * c) * 33 + n;
        if (j.fp8) { const float q = j.scale; v2u o; o.x = pk4_fp8(s[0 * 33] * q, s[1 * 33] * q, s[2 * 33] * q, s[3 * 33] * q); o.y = pk4_fp8(s[4 * 33] * q, s[5 * 33] * q, s[6 * 33] * q, s[7 * 33] * q);
            *(v2u*)(j.dst + (size_t)n * j.K + 8 * c) = o; }
        else { v4u o; o.x = pk2(s[0 * 33], s[1 * 33]); o.y = pk2(s[2 * 33], s[3 * 33]); o.z = pk2(s[4 * 33], s[5 * 33]); o.w = pk2(s[6 * 33], s[7 * 33]);
            *(v4u*)(j.dst + ((size_t)n * j.K + 8 * c) * 2) = o; } }
    LDS_WAIT(); asm volatile("" ::: "memory");
}
template <class Dec>
__device__ __forceinline__ void transpose_jobs(int first, int stride, int nitems, const Dec dec, LAS float* scr, int lane) {
    int it = first; if (it >= nitems) return;
    TJob cur; f32x4 v[8]; dec(it, cur); tj_load(cur, lane, v);
    for (;;) { const int nx = it + stride; const bool hn = nx < nitems; TJob nj = cur; f32x4 nv[8];
        if (hn) { dec(nx, nj); tj_load(nj, lane, nv); }
        tj_store(cur, lane, v, scr);
        if (!hn) break;
        cur = nj; it = nx;
#pragma unroll
        for (int i = 0; i < 8; ++i) v[i] = nv[i]; }
}
struct DecP0 {
    static constexpr int I_IN = 32 * (IN_DIM / 32), I_A = 32 * 64, I_G = 16 * 32, I_B = 16 * 64, I_O = 32 * 64, NITEMS = I_IN + I_A + I_G + I_B + I_O;
    const float *win, *wa, *wg, *wb, *wo; unsigned char* ws;
    __device__ __forceinline__ void operator()(int r, TJob& j) const {
        if (r < I_IN) { const int nb = r % (IN_DIM / 32), kb = r / (IN_DIM / 32); const int dr = 32 * nb; int sc; if (dr < 6144) sc = dr; else if (dr < 7168) sc = dr + 32; else if (dr < 11264) { const int rel = dr - 7168, within = rel & 255; sc = 7200 + (within >> 7) * 2048 + (rel >> 8) * 128 + (within & 127); } else sc = dr - 11264 + 6144;
            j.src = win + (size_t)(64 * kb) * IN_DIM + sc; if (dr >= 7168 && dr < 11264) { j.dst = ws + WS_WIN + (size_t)7168 * D * 2 + (size_t)(dr - 7168) * D + 64 * kb; j.scale = 32.f; j.fp8 = 1; } else { j.dst = ws + WS_WIN + ((size_t)dr * D + 64 * kb) * 2; j.scale = 1.f; j.fp8 = 0; } j.N = IN_DIM; j.K = D; return; } r -= I_IN;
        if (r < I_A) { j.src = wa + (size_t)(64 * (r / 64)) * D + 32 * (r % 64); j.dst = ws + WS_WAB + ((size_t)(32 * (r % 64)) * YVP + 64 * (r / 64)) * 2; j.scale = 1.f; j.fp8 = 0; j.N = D; j.K = YVP; return; } r -= I_A;
        if (r < I_G) { j.src = wg + (size_t)(64 * (r / 32)) * S5W + 32 * (r % 32); j.dst = ws + WS_WGLU + ((size_t)(32 * (r % 32)) * S5W + 64 * (r / 32)) * 2; j.scale = 1.f; j.fp8 = 0; j.N = S5W; j.K = S5W; return; } r -= I_G;
        if (r < I_B) { j.src = wb + (size_t)(64 * (r / 64)) * D + 32 * (r % 64); j.dst = ws + WS_WAB + ((size_t)(32 * (r % 64)) * YVP + 2048 + 64 * (r / 64)) * 2; j.scale = 1.f; j.fp8 = 0; j.N = D; j.K = YVP; return; } r -= I_B;
        j.src = wo + (size_t)(64 * (r / 64)) * D + 32 * (r % 64); j.dst = ws + WS_WOUT + ((size_t)(32 * (r % 64)) * D + 64 * (r / 64)) * 2; j.scale = 1.f; j.fp8 = 0; j.N = D; j.K = D; }
};
constexpr float WGU_SCALE = 64.f, WD_SCALE = 32.f, HID_SCALE = 4.f;
struct DecExp {
    static constexpr int I_GU = NE * 32 * 16, NITEMS = 3 * I_GU;
    const float *wg, *wu, *wd; unsigned char* ws;
    __device__ __forceinline__ void operator()(int it, TJob& j) const {
        if (it < 2 * I_GU) { const int which = it / I_GU, r = it % I_GU, e = r / 512, q = r % 512, kb = q / 16, nb = q % 16; const int j0 = 32 * nb;
            const int drow = (j0 >> 7) * 256 + which * 128 + (j0 & 127);
            j.src = (which ? wu : wg) + (size_t)e * D * FF + (size_t)(64 * kb) * FF + j0; j.dst = ws + WS_ST + ((size_t)e * 1024 + drow) * D + 64 * kb; j.N = FF; j.K = D; j.scale = WGU_SCALE; j.fp8 = 1; }
        else { const int r = it - 2 * I_GU, e = r / 512, q = r % 512, kb = q / 64, nb = q % 64;
            j.src = wd + (size_t)e * FF * D + (size_t)(64 * kb) * D + 32 * nb; j.dst = ws + WS_YV + ((size_t)e * D + 32 * nb) * FF + 64 * kb; j.N = D; j.K = FF; j.scale = WD_SCALE; j.fp8 = 1; }
    }
};
__device__ __forceinline__ void rms_row_to_bf16(const float* xrow, const float* w, bf16* orow, unsigned char* orow8, int lane) {
    const f32x4* xr = (const f32x4*)xrow + lane; const f32x4* wr4 = (const f32x4*)w + lane;
    f32x4 v[8]; float s = 0.f;
#pragma unroll
    for (int j = 0; j < 8; ++j) { v[j] = xr[64 * j]; s += (v[j].x * v[j].x + v[j].y * v[j].y) + (v[j].z * v[j].z + v[j].w * v[j].w); }
    const float rstd = 1.0f / sqrtf(wave_sum(s) * (1.f / D) + EPS);
    v2u* o8 = (v2u*)orow + lane; unsigned* q8 = (unsigned*)orow8 + lane;
#pragma unroll
    for (int j = 0; j < 8; ++j) { const f32x4 g = wr4[64 * j]; const f32x4 hv = {v[j].x * rstd * g.x, v[j].y * rstd * g.y, v[j].z * rstd * g.z, v[j].w * rstd * g.w};
        v2u o; o.x = pk2(hv.x, hv.y); o.y = pk2(hv.z, hv.w); o8[64 * j] = o; q8[64 * j] = pk4_fp8(hv.x, hv.y, hv.z, hv.w); }
}

__device__ __forceinline__ void s5_mats_group(const Args& a, const Ctx& F, int g) {
    LAS float* L = (LAS float*)F.lds;
    LAS float* apr = L; LAS float* api = L + 17 * 64; LAS float* bbr = L + 2 * 17 * 64; LAS float* bbi = bbr + 1024; LAS float* cr = bbi + 1024; LAS float* ci = cr + 1024; LAS float* kt = ci + 1024;
    LAS float* cof = kt + 4096;
    const float dt = expf(PIN(I_LOGDT)[g]);
    if (F.tid < 64) { const int n = F.tid; const float lr = PIN(I_LRE)[g * 64 + n], li = PIN(I_LIM)[g * 64 + n];
        for (int m = 0; m <= 16; ++m) { const float mag = expf((float)m * lr * dt), ang = (float)m * li * dt; apr[m * 64 + n] = mag * cosf(ang); api[m * 64 + n] = mag * sinf(ang); }
        const float ar = expf(lr * dt) * cosf(li * dt), ai = expf(lr * dt) * sinf(li * dt);
        const float den = lr * lr + li * li, nr = ar - 1.0f, ni = ai;
        cof[n] = (nr * lr + ni * li) / den; cof[64 + n] = (ni * lr - nr * li) / den; }
    for (int i = F.tid; i < 1024; i += 512) { const int co = i >> 6, n = i & 63; cr[i] = PIN(I_CRE)[(size_t)g * 1024 + co * 64 + n]; ci[i] = PIN(I_CIM)[(size_t)g * 1024 + co * 64 + n]; }
    __syncthreads();
    for (int i = F.tid; i < 1024; i += 512) { const int n = i >> 4; const float br = PIN(I_BRE)[(size_t)g * 1024 + i], bi = PIN(I_BIM)[(size_t)g * 1024 + i]; const float c0 = cof[n], c1 = cof[64 + n];
        bbr[i] = c0 * br - c1 * bi; bbi[i] = c0 * bi + c1 * br; }
    __syncthreads();
    for (int i = F.tid; i < 4096; i += 512) { const int lag = i >> 8, co = (i >> 4) & 15, cin = i & 15; float s = 0.f;
        for (int n = 0; n < 64; ++n) { const float wr_ = apr[lag * 64 + n] * bbr[n * 16 + cin] - api[lag * 64 + n] * bbi[n * 16 + cin], wi_ = apr[lag * 64 + n] * bbi[n * 16 + cin] + api[lag * 64 + n] * bbr[n * 16 + cin];
            s += cr[co * 64 + n] * wr_ - ci[co * 64 + n] * wi_; }
        kt[i] = s; }
    __syncthreads();
    bf16* TW = (bf16*)(PWS + WS_S5TW) + (size_t)g * 256 * APK;
    for (int i = F.tid; i < 256 * APK / 2; i += 512) { const int row = (2 * i) / APK, k0 = (2 * i) % APK; const int l = row >> 4, co = row & 15; float v[2];
#pragma unroll
        for (int q = 0; q < 2; ++q) { const int k = k0 + q; float val;
            if (k < 256) { const int j = k >> 4, cin = k & 15; val = (l >= j) ? kt[(l - j) * 256 + co * 16 + cin] : 0.f; if (l == j && cin == co) val += PIN(I_S5D)[g * 16 + co]; }
            else if (k < 320) { const int n = k - 256; val = cr[co * 64 + n] * apr[(l + 1) * 64 + n] - ci[co * 64 + n] * api[(l + 1) * 64 + n]; }
            else { const int n = k - 320; val = -(cr[co * 64 + n] * api[(l + 1) * 64 + n] + ci[co * 64 + n] * apr[(l + 1) * 64 + n]); }
            v[q] = val; }
        *(unsigned*)(TW + 2 * i) = pk2(v[0], v[1]); }
    bf16* WS = (bf16*)(PWS + WS_S5WS) + (size_t)g * 256 * 256;
    for (int i = F.tid; i < 256 * 256 / 2; i += 512) { const int row = (2 * i) >> 8, k0 = (2 * i) & 255; float v[2];
#pragma unroll
        for (int q = 0; q < 2; ++q) { const int k = k0 + q, j = k >> 4, cin = k & 15; float val = 0.f;
            if (row < 64) { const int n = row; val = apr[(15 - j) * 64 + n] * bbr[n * 16 + cin] - api[(15 - j) * 64 + n] * bbi[n * 16 + cin]; }
            else if (row < 128) { const int n = row - 64; val = apr[(15 - j) * 64 + n] * bbi[n * 16 + cin] + api[(15 - j) * 64 + n] * bbr[n * 16 + cin]; }
            v[q] = val; }
        *(unsigned*)(WS + 2 * i) = pk2(v[0], v[1]); }
    __syncthreads();
}

__device__ __forceinline__ void p0_prologue(const Args& a, const Ctx& F) {
    if (F.vcu < S5G) s5_mats_group(a, F, F.vcu);
    LAS float* scr = (LAS float*)(F.lds + F.wave * 16384);
    const int gw = F.vcu * NWAVES + F.wave, NGW = F.G * NWAVES;
    { DecP0 dec{PIN(I_WIN), PIN(I_WAUP), PIN(I_WGLU), PIN(I_WBUP), PIN(I_WOUT), PWS};
      transpose_jobs<DecP0>(gw, NGW, DecP0::NITEMS, dec, scr, F.lane); }
    {
        unsigned* gctr = (unsigned*)(PWS + WS_CTL) + CW_CNT + a.bar_region * 4096 + 2624; const float* X = PIN(I_X); const float* nmw = PIN(I_NMW); unsigned char* wsb = PWS;
        unsigned bv = 0u; if (F.lane == 0) bv = __hip_atomic_fetch_add(gctr, 1u, __ATOMIC_RELAXED, __HIP_MEMORY_SCOPE_AGENT);
        int b = (int)__builtin_amdgcn_readfirstlane(bv);
        while (b < T / 8) { unsigned nv = 0u; if (F.lane == 0) nv = __hip_atomic_fetch_add(gctr, 1u, __ATOMIC_RELAXED, __HIP_MEMORY_SCOPE_AGENT);
            for (int m = 8 * b; m < 8 * b + 8; ++m) rms_row_to_bf16(X + (size_t)m * D, nmw, (bf16*)(wsb + WS_H) + (size_t)m * D, wsb + WS_H8 + (size_t)m * D, F.lane);
            b = (int)__builtin_amdgcn_readfirstlane(nv); } }
    for (int i = gw * 64 + F.lane; i < 48 * D; i += NGW * 64) { const int col = i / D, k = i % D; float w = 0.f;
        if (col < 4) w = PIN(I_WRG)[k * 4 + col]; else if (col >= 16) w = PIN(I_WRE)[k * 32 + (col - 16)];
        const unsigned hi = f2bf(w); const float lo = w - bf2f((bf16)hi);
        ((bf16*)(PWS + WS_RT))[i] = (bf16)hi; ((bf16*)(PWS + WS_RT))[48 * D + i] = (bf16)f2bf(lo); }
}

struct SchedDense {
    pg8::StaticOrder so; const char* A; const char* B; unsigned lda, ldb;
    __device__ __forceinline__ bool next(int i, Unit& u) const { int pm, pn; if (!so.next(i, pm, pn)) return false;
        u.A = A + (size_t)pm * 256 * lda; u.B = B + (size_t)pn * 256 * ldb; u.row0 = pm * 256; u.col0 = pn * 256; u.e = 0; u.nvalid = 256; return true; }
    __device__ __forceinline__ unsigned row_idx(const Unit&, int) const { return 0u; }
};
struct SchedS5 {
    const char* A; const char* B; unsigned ldb; int G, c;
    __device__ __forceinline__ bool next(int i, Unit& u) const { const int idx = i * G + c; if (idx >= 256) return false; const int g = idx >> 2, mt = idx & 3;
        u.A = A + (size_t)(g * 1024 + mt * 256) * (APK * 2); u.B = B + (size_t)g * 256 * ldb; u.row0 = g * 1024 + mt * 256; u.col0 = 0; u.e = g; u.nvalid = 256; return true; }
    __device__ __forceinline__ unsigned row_idx(const Unit&, int) const { return 0u; }
};
struct SchedMoE {
    volatile LAS unsigned* ctl; const char* A; const char* B; const unsigned* list_tok; unsigned lda; size_t bstride_e; unsigned ldb; int NN, G, c; bool gather;
    __device__ __forceinline__ bool next(int i, Unit& u) const { const int idx = i * G + c; const int NT = (int)ctl[72]; if (idx >= NT * NN) return false;
        const int mtg = idx / NN, pn = idx % NN; const int e = (int)ctl[80 + mtg]; const int rb = (int)ctl[40 + e]; const int mtl = mtg - (rb >> 8); const int cnt = (int)ctl[8 + e];
        u.e = e; u.nvalid = cnt - mtl * 256; u.slot0 = mtl * 256; u.B = B + (size_t)e * bstride_e + (size_t)pn * 256 * ldb;
        if (gather) { u.A = A; u.row0 = rb + mtl * 256; u.col0 = pn * 128; }
        else { u.A = A + (size_t)(rb + mtl * 256) * lda; u.row0 = rb + mtl * 256; u.col0 = pn * 256; }
        return true; }
    __device__ __forceinline__ unsigned row_idx(const Unit& u, int r) const {
        const unsigned tokk = (r < u.nvalid) ? list_tok[(size_t)u.e * CAPL + u.slot0 + r] : 0u; return tokk >> 1; }
};

#define EPI_BEGIN _Pragma("unroll") for (int ai = 0; ai < 2; ++ai) _Pragma("unroll") for (int m = 0; m < 4; ++m) { const int r = ai * 128 + wr * 64 + m * 16 + fr; \
    _Pragma("unroll") for (int bj = 0; bj < 2; ++bj) { const int c = bj * 128 + wc * 32 + 8 * fq; const f32x4 v0 = acc[ai][bj][m][0], v1 = acc[ai][bj][m][1];
#define EPI_END } }
__device__ __forceinline__ v4u pack8(const f32x4 a, const f32x4 b) { v4u w; w.x = pk2(a[0], a[1]); w.y = pk2(a[2], a[3]); w.z = pk2(b[0], b[1]); w.w = pk2(b[2], b[3]); return w; }
__device__ __forceinline__ void unpack8(const v4u w, float (&f)[8]) { f[0] = bflo(w.x); f[1] = bfhi(w.x); f[2] = bflo(w.y); f[3] = bfhi(w.y); f[4] = bflo(w.z); f[5] = bfhi(w.z); f[6] = bflo(w.w); f[7] = bfhi(w.w); }

struct Epi1a {
    bf16* ZS; bf16* XBC; bf16* AP;
    __device__ __forceinline__ void operator()(const f32x4 (&acc)[2][2][4][2], const Unit& u, int wr, int wc, int fr, int fq) const {
        EPI_BEGIN  const int row = u.row0 + r, col = u.col0 + c;
            if (col < 2048) { f32x4 a = v0, b = v1;
#pragma unroll
                for (int j = 0; j < 4; ++j) { a[j] = siluf_(a[j]); b[j] = siluf_(b[j]); }
                *(v4u*)(ZS + (size_t)row * YVP + col) = pack8(a, b); }
            else if (col < 6144) { *(v4u*)(XBC + (size_t)row * XBCD + (col - 2048)) = pack8(v0, v1); }
            else { const int cc = col - 6144, g = cc >> 4, ci0 = cc & 15; *(v4u*)(AP + ((size_t)(g * S5NC + (row >> 4)) * APK + (row & 15) * 16 + ci0)) = pack8(v0, v1); }  EPI_END
    }
};
struct EpiS5a {
    float* SL;
    __device__ __forceinline__ void operator()(const f32x4 (&acc)[2][2][4][2], const Unit& u, int wr, int wc, int fr, int fq) const {
        EPI_BEGIN  if (bj == 0) { float* p = SL + (size_t)(u.row0 + r) * 128 + c; *(f32x4*)p = v0; *(f32x4*)(p + 4) = v1; }  EPI_END
    }
};
struct EpiS5b {
    bf16* V;
    __device__ __forceinline__ void operator()(const f32x4 (&acc)[2][2][4][2], const Unit& u, int wr, int wc, int fr, int fq) const {
        EPI_BEGIN  const int chunk = (u.row0 + r) & 1023, g = u.e, l = c >> 4, co0 = c & 15; f32x4 a = v0, b = v1;
#pragma unroll
            for (int j = 0; j < 4; ++j) { a[j] = gelu_tanh(a[j]); b[j] = gelu_tanh(b[j]); }
            *(v4u*)(V + (size_t)(chunk * 16 + l) * S5W + g * 16 + co0) = pack8(a, b);  EPI_END
    }
};
struct Epi1b {
    bf16* Gt; const float* gb; const float* ssq;
    __device__ __forceinline__ void operator()(const f32x4 (&acc)[2][2][4][2], const Unit& u, int wr, int wc, int fr, int fq) const {
        const int j0 = (u.col0 >> 1) + wc * 32 + 8 * fq;
        const f32x4 ba0 = *(const f32x4*)(gb + j0), ba1 = *(const f32x4*)(gb + j0 + 4), bb0 = *(const f32x4*)(gb + 2048 + j0), bb1 = *(const f32x4*)(gb + 2048 + j0 + 4);
#pragma unroll
        for (int ai = 0; ai < 2; ++ai)
#pragma unroll
            for (int m = 0; m < 4; ++m) { const int row = u.row0 + ai * 128 + wr * 64 + m * 16 + fr; const f32x4 s0 = *(const f32x4*)(ssq + (size_t)row * 8), s1 = *(const f32x4*)(ssq + (size_t)row * 8 + 4);
                const float tot = ((s0[0] + s0[1]) + (s0[2] + s0[3])) + ((s1[0] + s1[1]) + (s1[2] + s1[3])); const float rstd = 1.0f / sqrtf(tot * (1.f / D) + EPS);
                f32x4 r0, r1, g0, g1;
#pragma unroll
                for (int j = 0; j < 4; ++j) { const float a0 = sigmoidf_(acc[ai][0][m][0][j] + ba0[j]), a1 = sigmoidf_(acc[ai][0][m][1][j] + ba1[j]);
                    g0[j] = fmaxf(sigmoidf_(acc[ai][1][m][0][j] + bb0[j]), 1e-20f); g1[j] = fmaxf(sigmoidf_(acc[ai][1][m][1][j] + bb1[j]), 1e-20f);
                    r0[j] = a0 * rstd * __builtin_amdgcn_rcpf(g0[j]); r1[j] = a1 * rstd * __builtin_amdgcn_rcpf(g1[j]); }
                *(v4u*)(Gt + (size_t)row * 4096 + j0) = pack8(r0, r1); *(v4u*)(Gt + (size_t)row * 4096 + 2048 + j0) = pack8(g0, g1); }
    }
};
struct EpiGlu {
    const bf16* V; bf16* YV;
    __device__ __forceinline__ void operator()(const f32x4 (&acc)[2][2][4][2], const Unit& u, int wr, int wc, int fr, int fq) const {
        EPI_BEGIN const size_t o = (size_t)(u.row0 + r) * S5W + u.col0 + c; float vv[8]; unpack8(*(const v4u*)(V + o), vv); f32x4 a, b;
#pragma unroll
            for (int j = 0; j < 4; ++j) { a[j] = vv[j] * sigmoidf_(v0[j]); b[j] = vv[4 + j] * sigmoidf_(v1[j]); }
            *(v4u*)(YV + (size_t)(u.row0 + r) * YVP + 2048 + u.col0 + c) = pack8(a, b); EPI_END
    }
};
struct EpiAB {
    const bf16* Gt; bf16* MG;
    __device__ __forceinline__ void mid(f32x4 (&acc)[2][2][4][2], const Unit& u, int wr, int wc, int fr, int fq) const {
        unsigned base = (unsigned)((u.row0 + wr * 64 + fr) * 4096 + u.col0 + wc * 32 + 8 * fq) * 2u;
        asm volatile("" : "+v"(base));
        const char* gp = (const char*)Gt;
#pragma unroll
        for (int ai = 0; ai < 2; ++ai)
#pragma unroll
            for (int m = 0; m < 4; ++m)
#pragma unroll
                for (int bj = 0; bj < 2; ++bj) { float rr[8]; unpack8(*(const v4u*)(gp + (size_t)(base + (unsigned)((ai * 128 + m * 16) * 4096 + bj * 128) * 2u)), rr);
#pragma unroll
                    for (int j = 0; j < 4; ++j) { acc[ai][bj][m][0][j] *= rr[j]; acc[ai][bj][m][1][j] *= rr[4 + j]; } }
    }
    __device__ __forceinline__ void operator()(const f32x4 (&acc)[2][2][4][2], const Unit& u, int wr, int wc, int fr, int fq) const {
        EPI_BEGIN const int row = u.row0 + r, col = u.col0 + c; float gg[8]; unpack8(*(const v4u*)(Gt + (size_t)row * 4096 + 2048 + col), gg); f32x4 a, b;
#pragma unroll
            for (int j = 0; j < 4; ++j) { a[j] = gg[j] * v0[j]; b[j] = gg[4 + j] * v1[j]; }
            *(v4u*)(MG + (size_t)row * D + col) = pack8(a, b); EPI_END
    }
};
struct EpiOut {
    bf16* XD;
    __device__ __forceinline__ void operator()(const f32x4 (&acc)[2][2][4][2], const Unit& u, int wr, int wc, int fr, int fq) const {
        EPI_BEGIN *(v4u*)(XD + (size_t)(u.row0 + r) * D + u.col0 + c) = pack8(v0, v1); EPI_END
    }
};
struct EpiGU {
    bf16* HID; const unsigned* list_tok; const float* rstd2;
    __device__ __forceinline__ void operator()(const f32x4 (&acc)[2][2][4][2], const Unit& u, int wr, int wc, int fr, int fq) const {
#pragma unroll
        for (int ai = 0; ai < 2; ++ai)
#pragma unroll
            for (int m = 0; m < 4; ++m) { const int r = ai * 128 + wr * 64 + m * 16 + fr; if (r < u.nvalid) { const float sc = rstd2[(size_t)u.e * CAPL + u.slot0 + r]; f32x4 a, b;
#pragma unroll
                for (int j = 0; j < 4; ++j) { a[j] = siluf_(sc * acc[ai][0][m][0][j]) * (sc * acc[ai][1][m][0][j]); b[j] = siluf_(sc * acc[ai][0][m][1][j]) * (sc * acc[ai][1][m][1][j]); }
                { v2u o8; o8.x = pk4_fp8(a[0] * HID_SCALE, a[1] * HID_SCALE, a[2] * HID_SCALE, a[3] * HID_SCALE); o8.y = pk4_fp8(b[0] * HID_SCALE, b[1] * HID_SCALE, b[2] * HID_SCALE, b[3] * HID_SCALE);
                  *(v2u*)((unsigned char*)HID + (size_t)(u.row0 + r) * FF + u.col0 + wc * 32 + 8 * fq) = o8; } } }
    }
};
constexpr float Y_SCALE = 16.f;
struct EpiDn {
    const float* list_w; unsigned char* Y;
    __device__ __forceinline__ void operator()(const f32x4 (&acc)[2][2][4][2], const Unit& u, int wr, int wc, int fr, int fq) const {
        const float* wp = list_w + (unsigned)(u.e * CAPL + u.slot0 + wr * 64 + fr);
#pragma unroll
        for (int ai = 0; ai < 2; ++ai)
#pragma unroll
            for (int m = 0; m < 4; ++m) { const int r = ai * 128 + wr * 64 + m * 16 + fr; const float w = wp[ai * 128 + m * 16] * Y_SCALE;
#pragma unroll
                for (int bj = 0; bj < 2; ++bj) { const int col = u.col0 + bj * 128 + wc * 32 + 8 * fq; const f32x4 a = acc[ai][bj][m][0] * w, b = acc[ai][bj][m][1] * w;
                    v2u o; o.x = pk4_fp8(a[0], a[1], a[2], a[3]); o.y = pk4_fp8(b[0], b[1], b[2], b[3]); if (r < u.nvalid) *(v2u*)(Y + (size_t)(u.row0 + r) * D + col) = o; } }
    }
};

__device__ __forceinline__ void dt_gemm(const Args& a, const Ctx& F) {
    const bf16* Hb = (const bf16*)(PWS + WS_H); const bf16* Wd = (const bf16*)(PWS + WS_WIN) + (size_t)11264 * D; float* DT = (float*)(PWS + WS_DT);
    LAS float* part = (LAS float*)F.lds;
    const int r = F.lane & 31, hh = F.lane >> 5;
    for (int unit = F.vcu; unit < T / 64; unit += F.G) {
        const int r0 = unit * 64; f32x16 acc0, acc1;
#pragma unroll
        for (int j = 0; j < 16; ++j) { acc0[j] = 0.f; acc1[j] = 0.f; }
#pragma unroll 4
        for (int ks = 0; ks < 16; ++ks) { const int k = F.wave * 256 + ks * 16 + hh * 8;
            const bf16x8 a0 = *(const bf16x8*)(Hb + (size_t)(r0 + r) * D + k), a1 = *(const bf16x8*)(Hb + (size_t)(r0 + 32 + r) * D + k), b = *(const bf16x8*)(Wd + (size_t)r * D + k);
            acc0 = __builtin_amdgcn_mfma_f32_32x32x16_bf16(a0, b, acc0, 0, 0, 0); acc1 = __builtin_amdgcn_mfma_f32_32x32x16_bf16(a1, b, acc1, 0, 0, 0); }
#pragma unroll
        for (int j = 0; j < 16; ++j) { part[((F.wave * 2 + 0) * 16 + j) * 64 + F.lane] = acc0[j]; part[((F.wave * 2 + 1) * 16 + j) * 64 + F.lane] = acc1[j]; }
        __syncthreads();
        for (int o = F.tid; o < 2048; o += 512) { const int row = o >> 5, col = o & 31; const int i = row >> 5, rr = row & 31, h2 = (rr >> 2) & 1, reg = (rr & 3) + 4 * (rr >> 3), ln = col + 32 * h2; float s = 0.f;
#pragma unroll
            for (int w = 0; w < 8; ++w) s += part[((w * 2 + i) * 16 + reg) * 64 + ln];
            s += PIN(I_DTB)[col]; DT[(size_t)(r0 + row) * 32 + col] = s > 20.f ? s : log1pf(expf(s)); }
        __syncthreads();
    }
}

constexpr int SEGC = 8, NSEG = NCHK / SEGC;
constexpr int SQ_XT = 0;
constexpr int SQ_BC = 36864;
constexpr int SQ_BT = SQ_BC + 17408;
constexpr int SQ_CC = SQ_BT + 18432;
constexpr int SQ_DT = SQ_CC + 17408;
constexpr int SQ_Y = SQ_DT + 4352;
constexpr int SQ_W = SQ_Y + 33792;
static_assert(SQ_W + 10240 <= LDSCTL_OFF, "SSD (sequential) LDS map");

template <int NTOK>
__device__ __forceinline__ void conv_pair(const LAS float* wl, int lc, const v4u (&rawv)[NTOK + 3], int d, float (&o)[NTOK][2]) {
    f32x2 w[4]; const f32x2 bias = *(const LAS f32x2*)(wl + 4 * 512 + lc);
#pragma unroll
    for (int k = 0; k < 4; ++k) w[k] = *(const LAS f32x2*)(wl + k * 512 + lc);
#pragma unroll
    for (int tt = 0; tt < NTOK; ++tt) { float s0 = bias[0], s1 = bias[1];
#pragma unroll
        for (int k = 0; k < 4; ++k) { const unsigned uu = rawv[tt + k][d]; s0 += w[k][0] * bflo(uu); s1 += w[k][1] * bfhi(uu); }
        o[tt][0] = siluf_(s0); o[tt][1] = siluf_(s1); }
}
template <bool SCALE>
__device__ __forceinline__ void conv_xs_to_lds(const LAS float* wl, int lc, const v4u (&rx)[7], LAS bf16* dst  , const f32x4 sc) {
#pragma unroll
    for (int d = 0; d < 4; ++d) { float o[4][2]; conv_pair<4>(wl, lc + 2 * d, rx, d, o);
        if constexpr (SCALE) {
#pragma unroll
            for (int tt = 0; tt < 4; ++tt) { o[tt][0] *= sc[tt]; o[tt][1] *= sc[tt]; } }
        v2u w0, w1; w0.x = pk2(o[0][0], o[1][0]); w0.y = pk2(o[2][0], o[3][0]); w1.x = pk2(o[0][1], o[1][1]); w1.y = pk2(o[2][1], o[3][1]);
        *(LAS v2u*)(dst + (2 * d) * 72) = w0; *(LAS v2u*)(dst + (2 * d + 1) * 72) = w1; }
}
template <bool NAT, bool TR>
__device__ __forceinline__ void conv_bc_to_lds(const LAS float* wl, int lc, const v4u (&rb)[5], LAS bf16* nat, LAS bf16* tr) {
    v4u n0, n1;
#pragma unroll
    for (int d = 0; d < 4; ++d) { float o[2][2]; conv_pair<2>(wl, lc + 2 * d, rb, d, o);
        if constexpr (NAT) { n0[d] = pk2(o[0][0], o[0][1]); n1[d] = pk2(o[1][0], o[1][1]); }
        if constexpr (TR) { *(LAS unsigned*)(tr + (2 * d) * 72) = pk2(o[0][0], o[1][0]); *(LAS unsigned*)(tr + (2 * d + 1) * 72) = pk2(o[0][1], o[1][1]); } }
    if constexpr (NAT) { *(LAS v4u*)nat = n0; *(LAS v4u*)(nat + 136) = n1; }
}
__device__ __forceinline__ void conv_weights_to_lds(const Args& a, const Ctx& F, int g) {
    LAS float* wl = (LAS float*)(F.lds + SQ_W);
    for (int i = F.tid; i < 5 * 512; i += NWAVES * 64) { const int k = i >> 9, lc = i & 511; const int ch = lc < 256 ? g * 256 + lc : (lc < 384 ? 2048 + g * 128 + (lc - 256) : 3072 + g * 128 + (lc - 384));
        wl[i] = k < 4 ? PIN(I_CONVW)[k * XBCD + ch] : PIN(I_CONVB)[ch]; }
    __syncthreads();
}
template <int NR>
__device__ __forceinline__ void rows_load(const unsigned char* ws, unsigned off, int t0, v4u (&raw)[NR]) {
#pragma unroll
    for (int i = 0; i < NR; ++i) { v4u v = (v4u){0u, 0u, 0u, 0u}; if (t0 + i >= 0) v = *(const v4u*)(ws + (size_t)(off + (unsigned)i * (XBCD * 2))); raw[i] = v; }
}

__device__ __forceinline__ float seq_dt_setup(const Args& a, const Ctx& F, int g, float dtv, int buf) {
    LAS float* dts = (LAS float*)(F.lds + SQ_DT); LAS float* acs = dts + 256; LAS float* wsc = dts + 512; LAS float* eacs = dts + 768; LAS float* cdec = dts + 1024;
    float tot = 0.f;
    if (F.wave < 4) { const int hd = 4 * g + F.wave; const float av = -expf(PIN(I_ALOG)[hd]);
        float s = dtv * av;
#pragma unroll
        for (int o = 1; o < 64; o <<= 1) { const float t = __shfl_up(s, o); if (F.lane >= o) s += t; }
        tot = __shfl(s, 63);
        dts[F.wave * 64 + F.lane] = dtv; acs[F.wave * 64 + F.lane] = s; wsc[F.wave * 64 + F.lane] = dtv * __expf(tot - s); eacs[F.wave * 64 + F.lane] = __expf(s);
        if (F.lane == 63) cdec[buf * 4 + F.wave] = __expf(tot); }
    return tot;
}
__device__ __forceinline__ bf16x8 pack_frag(const f32x16& X, int kk) { v4u w; w.x = pk2(X[8 * kk], X[8 * kk + 1]); w.y = pk2(X[8 * kk + 2], X[8 * kk + 3]); w.z = pk2(X[8 * kk + 4], X[8 * kk + 5]); w.w = pk2(X[8 * kk + 6], X[8 * kk + 7]); return __builtin_bit_cast(bf16x8, w); }
__device__ __forceinline__ void seq_state_update(const Ctx& F, f32x16 (&acc)[4], int hd, int pt, float cd) {
    const LAS bf16* xT = (const LAS bf16*)(F.lds + SQ_XT); const LAS bf16* Bt = (const LAS bf16*)(F.lds + SQ_BT); const LAS float* wsc = (const LAS float*)(F.lds + SQ_DT) + 512;
    const int r = F.lane & 31, hh = F.lane >> 5;
#pragma unroll
    for (int i = 0; i < 4; ++i) acc[i] = acc[i] * cd;
#pragma unroll
    for (int ks = 0; ks < 4; ++ks) { const v4u xw = *(const LAS v4u*)(xT + (hd * 64 + 32 * pt + r) * 72 + 16 * ks + 8 * hh); float xv[8]; unpack8(xw, xv);
        const f32x4 w0 = *(const LAS f32x4*)(wsc + hd * 64 + 16 * ks + 8 * hh), w1 = *(const LAS f32x4*)(wsc + hd * 64 + 16 * ks + 8 * hh + 4);
        v4u sw; sw.x = pk2(xv[0] * w0[0], xv[1] * w0[1]); sw.y = pk2(xv[2] * w0[2], xv[3] * w0[3]); sw.z = pk2(xv[4] * w1[0], xv[5] * w1[1]); sw.w = pk2(xv[6] * w1[2], xv[7] * w1[3]);
        const bf16x8 bfr = __builtin_bit_cast(bf16x8, sw);
#pragma unroll
        for (int i = 0; i < 4; ++i) { const bf16x8 afr = *(const LAS bf16x8*)(Bt + (32 * i + r) * 72 + 16 * ks + 8 * hh); acc[i] = __builtin_amdgcn_mfma_f32_32x32x16_bf16(afr, bfr, acc[i], 0, 0, 0); }
        if (ks & 1) __builtin_amdgcn_sched_barrier(0); }
}
__device__ __forceinline__ size_t seg_state_off(int g, int seg, int hd) { return ((size_t)(g * NSEG + seg) * 4 + hd) * 8192; }

__device__ __forceinline__ void ssd_pass_a(const Args& a, const Ctx& F) {
    LAS bf16* xT = (LAS bf16*)(F.lds + SQ_XT); LAS bf16* Bt = (LAS bf16*)(F.lds + SQ_BT); const LAS float* cdec = (const LAS float*)(F.lds + SQ_DT) + 1024; const LAS float* wl = (const LAS float*)(F.lds + SQ_W);
    for (int u = F.vcu; u < NGRP * NSEG; u += F.G) {
        const int g = u >> 5, seg = u & 31; const int hd = F.wave >> 1, pt = F.wave & 1, r = F.lane & 31, hh = F.lane >> 5;
        const int cgx = F.tid >> 4, l0x = (F.tid & 15) * 4, cgb = F.tid >> 5, l0b = (F.tid & 31) * 2;
        conv_weights_to_lds(a, F, g);
        f32x16 acc[4];
#pragma unroll
        for (int i = 0; i < 4; ++i)
#pragma unroll
            for (int j = 0; j < 16; ++j) acc[i][j] = 0.f;
        float totsum = 0.f;
        const int t0 = seg * SEGC * CHK;
        const unsigned char* wsb = PWS;
        unsigned ox = (unsigned)(WS_XBC + ((size_t)(t0 + l0x) * XBCD + g * 256 + cgx * 8) * 2 - 3 * XBCD * 2);
        unsigned ob = (unsigned)(WS_XBC + ((size_t)(t0 + l0b) * XBCD + 2048 + g * 128 + cgb * 8) * 2 - 3 * XBCD * 2);
        unsigned odt = (unsigned)(WS_DT + ((size_t)(t0 + F.lane) * 32 + 4 * g + (F.wave & 3)) * 4);
        v4u rx[7];
        rows_load<7>(wsb, ox, t0 + l0x - 3, rx);
        float dtv = *(const float*)(wsb + odt);
#pragma unroll 1
        for (int k = 0; k < SEGC; ++k) {
            v4u rb[5];
            rows_load<5>(wsb, ob, t0 + k * CHK + l0b - 3, rb);
            totsum += seq_dt_setup(a, F, g, dtv, k & 1);
            { const int hx = cgx >> 3, p0 = (cgx & 7) * 8;
              conv_xs_to_lds<false>(wl, cgx * 8, rx, xT + (hx * 64 + p0) * 72 + l0x, (f32x4){1.f, 1.f, 1.f, 1.f});
              conv_bc_to_lds<false, true>(wl, 256 + cgb * 8, rb, Bt, Bt + (cgb * 8) * 72 + l0b); }
            ox += CHK * XBCD * 2; ob += CHK * XBCD * 2; odt += CHK * 32 * 4;
            if (k + 1 < SEGC) { rows_load<7>(wsb, ox, 0, rx); dtv = *(const float*)(wsb + odt); }
            __syncthreads();
            seq_state_update(F, acc, hd, pt, cdec[(k & 1) * 4 + hd]);
            __syncthreads();
        }
        bf16* st = (bf16*)(PWS + WS_ST) + seg_state_off(g, seg, hd); const int p = 32 * pt + r;
#pragma unroll
        for (int i = 0; i < 4; ++i)
#pragma unroll
            for (int q = 0; q < 4; ++q) { v2u w; w.x = pk2(acc[i][4 * q], acc[i][4 * q + 1]); w.y = pk2(acc[i][4 * q + 2], acc[i][4 * q + 3]); *(v2u*)(st + ((4 * i + q) * 64 + p) * 8 + 4 * hh) = w; }
        if (F.wave < 4 && F.lane == 63) ((float*)(PWS + WS_MISC + 768 * 1024))[(g * NSEG + seg) * 4 + F.wave] = __expf(totsum);
        __syncthreads();
    }
}

__device__ __forceinline__ void ssd_pass_b(const Args& a, const Ctx& F) {
    LAS bf16* xT = (LAS bf16*)(F.lds + SQ_XT); LAS bf16* Bc = (LAS bf16*)(F.lds + SQ_BC); LAS bf16* Bt = (LAS bf16*)(F.lds + SQ_BT); LAS bf16* Cc = (LAS bf16*)(F.lds + SQ_CC);
    LAS float* dts = (LAS float*)(F.lds + SQ_DT); LAS float* acs = dts + 256; LAS float* eacs = dts + 768; const LAS float* cdec = dts + 1024; LAS bf16* yb = (LAS bf16*)(F.lds + SQ_Y); const LAS float* wl = (const LAS float*)(F.lds + SQ_W);
    for (int u = F.vcu; u < NGRP * NSEG; u += F.G) {
        const int g = u >> 5, seg = u & 31; const int hd = F.wave >> 1, pt = F.wave & 1, r = F.lane & 31, hh = F.lane >> 5, head = 4 * g + hd;
        const int cgx = F.tid >> 4, l0x = (F.tid & 15) * 4, cgb = F.tid >> 5, l0b = (F.tid & 31) * 2;
        conv_weights_to_lds(a, F, g);
        f32x16 acc[4];
        { const bf16* st = (const bf16*)(PWS + WS_ST) + seg_state_off(g, seg, hd); const int p = 32 * pt + r;
#pragma unroll
          for (int i = 0; i < 4; ++i)
#pragma unroll
              for (int q = 0; q < 4; ++q) { const v2u w = *(const v2u*)(st + ((4 * i + q) * 64 + p) * 8 + 4 * hh); acc[i][4 * q] = bflo(w.x); acc[i][4 * q + 1] = bfhi(w.x); acc[i][4 * q + 2] = bflo(w.y); acc[i][4 * q + 3] = bfhi(w.y); } }
        const float dsk = PIN(I_DSSD)[head];
        const int t0 = seg * SEGC * CHK;
        unsigned char* wsb = PWS;
        unsigned ox = (unsigned)(WS_XBC + ((size_t)(t0 + l0x) * XBCD + g * 256 + cgx * 8) * 2 - 3 * XBCD * 2);
        unsigned ob = (unsigned)(WS_XBC + ((size_t)(t0 + l0b) * XBCD + 2048 + g * 128 + cgb * 8) * 2 - 3 * XBCD * 2);
        unsigned odt = (unsigned)(WS_DT + ((size_t)(t0 + F.lane) * 32 + 4 * g + (F.wave & 3)) * 4);
        const int gcx = F.tid & 31;
        unsigned oz = (unsigned)(WS_YV + ((size_t)(t0 + (F.tid >> 5) * 4) * YVP + g * 256 + gcx * 8) * 2);
        unsigned oss = (unsigned)(WS_MISC + ((size_t)(t0 + (F.tid >> 5) * 4) * 8 + g) * 4);
#pragma unroll 1
        for (int k = 0; k < SEGC; ++k) {
            v4u rx[7], rb[5], rc[5];
            const float dtv = *(const float*)(wsb + odt);
            rows_load<7>(wsb, ox, t0 + k * CHK + l0x - 3, rx); rows_load<5>(wsb, ob, t0 + k * CHK + l0b - 3, rb); rows_load<5>(wsb, ob + 2048, t0 + k * CHK + l0b - 3, rc);
            (void)seq_dt_setup(a, F, g, dtv, k & 1);
            { const int hx = cgx >> 3, p0 = (cgx & 7) * 8;
              conv_xs_to_lds<false>(wl, cgx * 8, rx, xT + (hx * 64 + p0) * 72 + l0x, (f32x4){1.f, 1.f, 1.f, 1.f});
              conv_bc_to_lds<true, true>(wl, 256 + cgb * 8, rb, Bc + l0b * 136 + cgb * 8, Bt + (cgb * 8) * 72 + l0b);
              conv_bc_to_lds<true, false>(wl, 384 + cgb * 8, rc, Cc + l0b * 136 + cgb * 8, Cc); }
            __syncthreads();
            {
                const LAS bf16* xrow = xT + (hd * 64 + 32 * pt + r) * 72; const int pcol = hd * 64 + 32 * pt + r;
#pragma unroll
                for (int lt = 0; lt < 2; ++lt) {
                    f32x16 y;
#pragma unroll
                    for (int j = 0; j < 16; ++j) y[j] = 0.f;
#pragma unroll
                    for (int i = 0; i < 4; ++i)
#pragma unroll
                        for (int kk = 0; kk < 2; ++kk) { const bf16x8 bs = pack_frag(acc[i], kk); const int nb = 32 * i + 16 * kk + 4 * hh;
                            const v2u lo = *(const LAS v2u*)(Cc + (32 * lt + r) * 136 + nb), hi = *(const LAS v2u*)(Cc + (32 * lt + r) * 136 + nb + 8); const v4u c0 = (v4u){lo.x, lo.y, hi.x, hi.y};
                            y = __builtin_amdgcn_mfma_f32_32x32x16_bf16(__builtin_bit_cast(bf16x8, c0), bs, y, 0, 0, 0); }
#pragma unroll
                    for (int q = 0; q < 4; ++q) { const f32x4 e0 = *(const LAS f32x4*)(eacs + hd * 64 + 32 * lt + 8 * q + 4 * hh);
#pragma unroll
                        for (int i = 0; i < 4; ++i) y[4 * q + i] *= e0[i]; }
                    __builtin_amdgcn_sched_barrier(0);
                    const float al = acs[hd * 64 + 32 * lt + r];
#pragma unroll
                    for (int st = 0; st <= lt; ++st) {
                        f32x16 X;
#pragma unroll
                        for (int j = 0; j < 16; ++j) X[j] = 0.f;
#pragma unroll
                        for (int ks = 0; ks < 8; ++ks) { const int ko = 16 * ks + 8 * hh;
                            const bf16x8 a0 = *(const LAS bf16x8*)(Bc + (32 * st + r) * 136 + ko), b0 = *(const LAS bf16x8*)(Cc + (32 * lt + r) * 136 + ko);
                            X = __builtin_amdgcn_mfma_f32_32x32x16_bf16(a0, b0, X, 0, 0, 0); }
#pragma unroll
                        for (int q = 0; q < 4; ++q) { const int sb = 8 * q + 4 * hh;
                            const f32x4 as0 = *(const LAS f32x4*)(acs + hd * 64 + 32 * st + sb), ds0 = *(const LAS f32x4*)(dts + hd * 64 + 32 * st + sb);
#pragma unroll
                            for (int i = 0; i < 4; ++i) { const int j = 4 * q + i; const float v = X[j] * __expf(al - as0[i]) * ds0[i]; X[j] = (st < lt || r >= sb + i) ? v : 0.f; } }
#pragma unroll
                        for (int kk = 0; kk < 2; ++kk) { const int sb = 32 * st + 16 * kk + 4 * hh;
                            const v2u lo = *(const LAS v2u*)(xrow + sb), hi = *(const LAS v2u*)(xrow + sb + 8); const v4u wa = (v4u){lo.x, lo.y, hi.x, hi.y};
                            y = __builtin_amdgcn_mfma_f32_32x32x16_bf16(pack_frag(X, kk), __builtin_bit_cast(bf16x8, wa), y, 0, 0, 0); }
                        __builtin_amdgcn_sched_barrier(0);
                    }
#pragma unroll
                    for (int q = 0; q < 4; ++q) { const int lb = 32 * lt + 8 * q + 4 * hh;
                        const v2u xa = *(const LAS v2u*)(xrow + lb); const float xa4[4] = {bflo(xa.x), bfhi(xa.x), bflo(xa.y), bfhi(xa.y)};
#pragma unroll
                        for (int i = 0; i < 4; ++i) yb[(lb + i) * 264 + pcol] = (bf16)f2bf(y[4 * q + i] + dsk * xa4[i]); }
                    __builtin_amdgcn_sched_barrier(0);
                }
                seq_state_update(F, acc, hd, pt, cdec[(k & 1) * 4 + hd]);
            }
            ox += CHK * XBCD * 2; ob += CHK * XBCD * 2; odt += CHK * 32 * 4;
            v4u zq[4];
#pragma unroll
            for (int i = 0; i < 4; ++i) zq[i] = *(const v4u*)(wsb + (size_t)(oz + (unsigned)i * (YVP * 2)));
            __syncthreads();
            { const float* nw = PIN(I_NSW) + g * 256 + gcx * 8; const f32x4 n0 = *(const f32x4*)nw, n1 = *(const f32x4*)(nw + 4);
#pragma unroll
              for (int i = 0; i < 4; ++i) { const int l = (F.tid >> 5) * 4 + i;
                  float zz[8], yy[8]; unpack8(zq[i], zz); unpack8(*(const LAS v4u*)(yb + l * 264 + gcx * 8), yy);
                  f32x4 g0, g1; float sq = 0.f;
#pragma unroll
                  for (int j = 0; j < 4; ++j) { g0[j] = yy[j] * zz[j]; g1[j] = yy[4 + j] * zz[4 + j]; sq += g0[j] * g0[j] + g1[j] * g1[j]; }
                  *(v4u*)(wsb + (size_t)(oz + (unsigned)i * (YVP * 2))) = pack8(g0 * n0, g1 * n1);
#pragma unroll
                  for (int o = 1; o < 32; o <<= 1) sq += __shfl_xor(sq, o);
                  if (gcx == 0) *(float*)(wsb + (size_t)(oss + (unsigned)i * 32)) = sq; } }
            oz += CHK * YVP * 2; oss += CHK * 8 * 4;
        }
        __syncthreads();
    }
}

__device__ __forceinline__ void seg_scan(const Args& a, const Ctx& F) {
    for (int it = F.vcu * NWAVES + F.wave; it < 2048; it += F.G * NWAVES) { const int gh = it >> 6, sl = it & 63, g = gh >> 2, hd = gh & 3;
        bf16* base = (bf16*)(PWS + WS_ST) + seg_state_off(g, 0, hd) + sl * 128 + F.lane * 2; const float* cd = (const float*)(PWS + WS_MISC + 768 * 1024) + (size_t)g * NSEG * 4 + hd; constexpr size_t CS = (size_t)4 * 8192;
        unsigned v[NSEG]; float d[NSEG];
#pragma unroll
        for (int j = 0; j < NSEG; ++j) { v[j] = *(const unsigned*)(base + (size_t)j * CS); d[j] = cd[j * 4]; }
        float c0 = 0.f, c1 = 0.f;
#pragma unroll
        for (int j = 0; j < NSEG; ++j) { *(unsigned*)(base + (size_t)j * CS) = pk2(c0, c1); c0 = c0 * d[j] + bflo(v[j]); c1 = c1 * d[j] + bfhi(v[j]); } }
}

__device__ __forceinline__ void scans(const Args& a, const Ctx& F) {
    if (F.vcu < S5G) {
        const int g = F.vcu, n = F.lane; const float dt = expf(PIN(I_LOGDT)[g]), lr = PIN(I_LRE)[g * 64 + n], li = PIN(I_LIM)[g * 64 + n];
        const float mag = expf(16.f * lr * dt), ang = 16.f * li * dt, ar = mag * cosf(ang), ai = mag * sinf(ang);
        const float* SLp = (const float*)(PWS + WS_SL) + ((size_t)g * S5NC + 128 * F.wave) * 128 + n; bf16* AP = (bf16*)(PWS + WS_AP) + ((size_t)g * S5NC + 128 * F.wave) * APK + 256 + n;
        LAS float* ex = (LAS float*)F.lds;
        float sr = 0.f, si = 0.f;
        for (int cb = 0; cb < 128; cb += 32) { float ra[32], ia[32];
#pragma unroll
            for (int j = 0; j < 32; ++j) { ra[j] = SLp[(size_t)(cb + j) * 128]; ia[j] = SLp[(size_t)(cb + j) * 128 + 64]; }
#pragma unroll
            for (int j = 0; j < 32; ++j) { const float nr = ar * sr - ai * si + ra[j], ni = ar * si + ai * sr + ia[j]; sr = nr; si = ni; } }
        ex[F.wave * 128 + n] = sr; ex[F.wave * 128 + 64 + n] = si;
        __syncthreads();
        float pr = ar, pi = ai;
#pragma unroll
        for (int q = 0; q < 7; ++q) { const float t = pr * pr - pi * pi; pi = 2.f * pr * pi; pr = t; }
        sr = 0.f; si = 0.f;
        for (int w = 0; w < F.wave; ++w) { const float er = ex[w * 128 + n], ei = ex[w * 128 + 64 + n]; const float nr = pr * sr - pi * si + er, ni = pr * si + pi * sr + ei; sr = nr; si = ni; }
        for (int cb = 0; cb < 128; cb += 32) { float ra[32], ia[32];
#pragma unroll
            for (int j = 0; j < 32; ++j) { ra[j] = SLp[(size_t)(cb + j) * 128]; ia[j] = SLp[(size_t)(cb + j) * 128 + 64]; }
#pragma unroll
            for (int j = 0; j < 32; ++j) { AP[(size_t)(cb + j) * APK] = (bf16)f2bf(sr); AP[(size_t)(cb + j) * APK + 64] = (bf16)f2bf(si);
                const float nr = ar * sr - ai * si + ra[j], ni = ar * si + ai * sr + ia[j]; sr = nr; si = ni; } }
        __syncthreads();
    }
    seg_scan(a, F);
}

__device__ __forceinline__ void route_unit(const Args& a, const Ctx& F, int unit, LAS float* lg  ) {
    const int t0 = unit * 16, row = F.lane & 15, kq = F.lane >> 4;
    const float* xr = PIN(I_X) + (size_t)(t0 + row) * D + 8 * kq; const bf16* xd = (const bf16*)(PWS + WS_XD) + (size_t)(t0 + row) * D + 8 * kq; unsigned char* h2 = PWS + WS_H + (size_t)(t0 + row) * D + 8 * kq;
    const float* nf = PIN(I_NFW) + 8 * kq; const bf16* wt = (const bf16*)(PWS + WS_RT) + (size_t)row * D + 8 * kq;
    f32x4 acc0 = {0.f, 0.f, 0.f, 0.f}, acc1 = acc0, acc2 = acc0; float ssq = 0.f;
#pragma unroll 4
    for (int ks = 0; ks < 64; ++ks) { const int k = 32 * ks;
        const f32x4 x0 = *(const f32x4*)(xr + k), x1 = *(const f32x4*)(xr + k + 4), g0 = *(const f32x4*)(nf + k), g1 = *(const f32x4*)(nf + k + 4); float dd[8]; unpack8(*(const v4u*)(xd + k), dd);
        f32x4 m0, m1;
#pragma unroll
        for (int j = 0; j < 4; ++j) { m0[j] = x0[j] + dd[j]; m1[j] = x1[j] + dd[4 + j]; ssq += m0[j] * m0[j] + m1[j] * m1[j]; }
        const f32x4 hq0 = m0 * g0, hq1 = m1 * g1; const v4u hv = pack8(hq0, hq1); { v2u o8; o8.x = pk4_fp8(hq0[0], hq0[1], hq0[2], hq0[3]); o8.y = pk4_fp8(hq1[0], hq1[1], hq1[2], hq1[3]); *(v2u*)(h2 + k) = o8; } const bf16x8 af = __builtin_bit_cast(bf16x8, hv);
        const bf16x8 b0h = *(const bf16x8*)(wt + k), b1h = *(const bf16x8*)(wt + (size_t)16 * D + k), b2h = *(const bf16x8*)(wt + (size_t)32 * D + k);
        const bf16x8 b0l = *(const bf16x8*)(wt + (size_t)48 * D + k), b1l = *(const bf16x8*)(wt + (size_t)64 * D + k), b2l = *(const bf16x8*)(wt + (size_t)80 * D + k);
        acc0 = __builtin_amdgcn_mfma_f32_16x16x32_bf16(af, b0h, acc0, 0, 0, 0); acc1 = __builtin_amdgcn_mfma_f32_16x16x32_bf16(af, b1h, acc1, 0, 0, 0); acc2 = __builtin_amdgcn_mfma_f32_16x16x32_bf16(af, b2h, acc2, 0, 0, 0);
        acc0 = __builtin_amdgcn_mfma_f32_16x16x32_bf16(af, b0l, acc0, 0, 0, 0); acc1 = __builtin_amdgcn_mfma_f32_16x16x32_bf16(af, b1l, acc1, 0, 0, 0); acc2 = __builtin_amdgcn_mfma_f32_16x16x32_bf16(af, b2l, acc2, 0, 0, 0); }
    ssq += __shfl_xor(ssq, 16); ssq += __shfl_xor(ssq, 32);
    const float rstd = 1.0f / sqrtf(ssq * (1.f / D) + EPS);
    if (kq == 0) ((float*)(PWS + WS_MISC + 800 * 1024))[t0 + row] = rstd;
#pragma unroll
    for (int reg = 0; reg < 4; ++reg) { const int tok = 4 * kq + reg; const float rs = __shfl(rstd, tok);
        lg[tok * 48 + row] = rs * acc0[reg]; lg[tok * 48 + 16 + row] = rs * acc1[reg]; lg[tok * 48 + 32 + row] = rs * acc2[reg]; }
    LDS_WAIT(); asm volatile("" ::: "memory");
    if (F.lane < 16) { const int tok = F.lane; const LAS float* lq = lg + tok * 48;
        unsigned* cnt = (unsigned*)(PWS + WS_CTL) + CW_CNT + a.bar_region * 4096; unsigned* list_tok = (unsigned*)(PWS + WS_LST); float* list_w = (float*)(PWS + WS_LST + 2 * MiB);
        float g4[4]; int grp = 0; float gmax;
#pragma unroll
        for (int j = 0; j < 4; ++j) g4[j] = lq[j] + PIN(I_BRG)[j];
        gmax = g4[0];
#pragma unroll
        for (int j = 1; j < 4; ++j) if (g4[j] > gmax) { gmax = g4[j]; grp = j; }
        float den = 0.f;
#pragma unroll
        for (int j = 0; j < 4; ++j) den += expf(g4[j] - gmax);
        const float pg = 1.0f / den;
        float v1 = -INFINITY, v2 = -INFINITY; int i1 = 0, i2 = 0;
        for (int j = 0; j < 8; ++j) { const float le = lq[16 + grp * 8 + j] + PIN(I_BRE2)[grp * 8 + j];
            if (le > v1) { v2 = v1; i2 = i1; v1 = le; i1 = j; } else if (le > v2) { v2 = le; i2 = j; } }
        const float e2 = expf(v2 - v1), w1 = pg / (1.0f + e2), w2 = pg * e2 / (1.0f + e2);
        const int ea = grp * 8 + i1, eb = grp * 8 + i2; const unsigned tk = (unsigned)(t0 + tok);
        float* list_r = (float*)(PWS + WS_LR); unsigned* tokslot = (unsigned*)(PWS + WS_LR + 2 * MiB);
        const unsigned s1 = atomicAdd(cnt + 64 * ea, 1u); list_tok[(size_t)ea * CAPL + s1] = tk * 2u; list_w[(size_t)ea * CAPL + s1] = w1; list_r[(size_t)ea * CAPL + s1] = rstd; tokslot[tk * 2u] = (unsigned)ea * CAPL + s1;
        const unsigned s2 = atomicAdd(cnt + 64 * eb, 1u); list_tok[(size_t)eb * CAPL + s2] = tk * 2u + 1u; list_w[(size_t)eb * CAPL + s2] = w2; list_r[(size_t)eb * CAPL + s2] = rstd; tokslot[tk * 2u + 1u] = (unsigned)eb * CAPL + s2; }
    LDS_WAIT(); asm volatile("" ::: "memory");
}
template <class Dec>
__device__ __forceinline__ void transpose_jobs_dyn(volatile LAS unsigned* ctr, int cu, int ncu, int nitems, const Dec dec, LAS float* scr, int lane) {
    auto grab = [&]() -> int { unsigned j = 0; if (lane == 0) j = __hip_atomic_fetch_add((LAS unsigned*)ctr, 1u, __ATOMIC_RELAXED, __HIP_MEMORY_SCOPE_WORKGROUP); j = __builtin_amdgcn_readfirstlane(j); return cu + (int)j * ncu; };
    int it = grab(); if (it >= nitems) return;
    TJob cur; f32x4 v[8]; dec(it, cur); tj_load(cur, lane, v);
    for (;;) { const int nx = grab(); const bool hn = nx < nitems; TJob nj = cur; f32x4 nv[8];
        if (hn) { dec(nx, nj); tj_load(nj, lane, nv); }
        tj_store(cur, lane, v, scr);
        if (!hn) break;
        cur = nj;
#pragma unroll
        for (int i = 0; i < 8; ++i) v[i] = nv[i]; }
}
template <class Dec>
__device__ __forceinline__ void transpose_jobs_queue(unsigned* gctr, int first_item, int nbatches, const Dec dec, LAS float* scr, int lane) {
    unsigned bv = 0u; if (lane == 0) bv = __hip_atomic_fetch_add(gctr, 1u, __ATOMIC_RELAXED, __HIP_MEMORY_SCOPE_AGENT);
    int b = (int)__builtin_amdgcn_readfirstlane(bv);
    while (b < nbatches) {
        unsigned nv = 0u; if (lane == 0) nv = __hip_atomic_fetch_add(gctr, 1u, __ATOMIC_RELAXED, __HIP_MEMORY_SCOPE_AGENT);
        transpose_jobs<Dec>(first_item + 8 * b, 1, first_item + 8 * b + 8, dec, scr, lane);
        b = (int)__builtin_amdgcn_readfirstlane(nv); }
}
__device__ __forceinline__ void route_phase(const Args& a, const Ctx& F) {
    if (F.wave < 4) { LAS float* lg = (LAS float*)(F.lds + 8 * 16384) + F.wave * 768;
        for (int unit = F.vcu * 4 + F.wave; unit < T / 16; unit += F.G * 4) route_unit(a, F, unit, lg); }
    { LAS float* scr = (LAS float*)(F.lds + F.wave * 16384);
      DecExp dec{PIN(I_WEG), PIN(I_WEU), PIN(I_WED), PWS};
      transpose_jobs_dyn<DecExp>(F.ctl + 76, F.vcu, F.G, 2 * DecExp::I_GU, dec, scr, F.lane); }
}
__device__ __forceinline__ void moe_tables(const Args& a, const Ctx& F) {
    if (F.tid == 0) { const unsigned* cnt = (const unsigned*)(PWS + WS_CTL) + CW_CNT + a.bar_region * 4096; unsigned rb = 0, nt = 0;
        for (int e = 0; e < NE; ++e) { const unsigned c = __hip_atomic_load(cnt + 64 * e, __ATOMIC_RELAXED, __HIP_MEMORY_SCOPE_AGENT); const unsigned tiles = (c + 255u) >> 8; F.ctl[8 + e] = c; F.ctl[40 + e] = rb;
            for (unsigned i = 0; i < tiles && nt < 160u; ++i) F.ctl[80 + nt++] = (unsigned)e; rb += tiles * 256u; }
        F.ctl[72] = nt; }
    __syncthreads();
}
__device__ __forceinline__ void final_phase(const Args& a, const Ctx& F) {
    const int lane = (int)__builtin_amdgcn_mbcnt_hi(~0u, __builtin_amdgcn_mbcnt_lo(~0u, 0u));
    const int gw = F.vcu * NWAVES + F.wave, NGW = F.G * NWAVES; const unsigned char* Y = PWS + WS_XBC; const bf16* XD = (const bf16*)(PWS + WS_XD); const unsigned* tokslot = (const unsigned*)(PWS + WS_LR + 2 * MiB);
    for (int m = gw; m < T; m += NGW) { float* orow = POUT + (size_t)m * D; const f32x4* x4 = (const f32x4*)(PIN(I_X) + (size_t)m * D) + lane; const v2u* xd = (const v2u*)(XD + (size_t)m * D) + lane;
        const unsigned ts0 = tokslot[2 * m], ts1 = tokslot[2 * m + 1];
        const size_t r0 = (size_t)F.ctl[40 + (ts0 >> 14)] + (ts0 & 16383u), r1 = (size_t)F.ctl[40 + (ts1 >> 14)] + (ts1 & 16383u);
        const unsigned* y0 = (const unsigned*)(Y + r0 * D) + lane; const unsigned* y1 = (const unsigned*)(Y + r1 * D) + lane;
        const f32x4* w4 = (const f32x4*)PIN(I_NFINAL) + lane; f32x4 v[8]; float s = 0.f;
#pragma unroll
        for (int j = 0; j < 8; ++j) { const f32x4 x = x4[64 * j]; const unsigned p = y0[64 * j], q = y1[64 * j]; const v2u d2 = xd[64 * j];
            const f32x2 p0 = __builtin_amdgcn_cvt_pk_f32_fp8((int)p, false), p1 = __builtin_amdgcn_cvt_pk_f32_fp8((int)p, true), q0 = __builtin_amdgcn_cvt_pk_f32_fp8((int)q, false), q1 = __builtin_amdgcn_cvt_pk_f32_fp8((int)q, true);
            constexpr float ys = 1.0f / Y_SCALE;
            v[j] = (f32x4){x.x + bflo(d2.x) + ys * (p0[0] + q0[0]), x.y + bfhi(d2.x) + ys * (p0[1] + q0[1]), x.z + bflo(d2.y) + ys * (p1[0] + q1[0]), x.w + bfhi(d2.y) + ys * (p1[1] + q1[1])};
            s += (v[j].x * v[j].x + v[j].y * v[j].y) + (v[j].z * v[j].z + v[j].w * v[j].w); }
        const float rstd = 1.0f / sqrtf(wave_sum(s) * (1.f / D) + EPS);
#pragma unroll
        for (int j = 0; j < 8; ++j) { const f32x4 g = w4[64 * j]; ((f32x4*)orow + lane)[64 * j] = (f32x4){v[j].x * rstd * g.x, v[j].y * rstd * g.y, v[j].z * rstd * g.z, v[j].w * rstd * g.w}; } }
}

constexpr int N_PHASES = 12;
template <int VARIANT>
__global__ void __launch_bounds__(NWAVES * 64, 2) hybrid_fwd(Args args) {
    extern __shared__ __attribute__((aligned(16))) unsigned char lds_raw[];
    Ctx F; F.lds = (LAS unsigned char*)lds_raw; F.ctl = (volatile LAS unsigned*)(F.lds + LDSCTL_OFF);
    F.tid = threadIdx.x; F.lane = F.tid & 63; F.wave = __builtin_amdgcn_readfirstlane(F.tid >> 6);
    F.G = gridDim.x; { const int bx = blockIdx.x; F.vcu = (F.G % 8 == 0) ? (bx % 8) * (F.G / 8) + bx / 8 : bx; }
    for (int u = F.tid; u < (LDS_BYTES - LDSCTL_OFF) / 4; u += NWAVES * 64) ((LAS unsigned*)(F.lds + LDSCTL_OFF))[u] = 0u;
    __syncthreads();
    if (F.tid == 0) { LAS unsigned long long* pt = (LAS unsigned long long*)(F.lds + PTAB_OFF);
        pt[0] = (unsigned long long)args.in[0];
        pt[1] = (unsigned long long)args.in[1];
        pt[2] = (unsigned long long)args.in[2];
        pt[3] = (unsigned long long)args.in[3];
        pt[4] = (unsigned long long)args.in[4];
        pt[5] = (unsigned long long)args.in[5];
        pt[6] = (unsigned long long)args.in[6];
        pt[7] = (unsigned long long)args.in[7];
        pt[8] = (unsigned long long)args.in[8];
        pt[9] = (unsigned long long)args.in[9];
        pt[10] = (unsigned long long)args.in[10];
        pt[11] = (unsigned long long)args.in[11];
        pt[12] = (unsigned long long)args.in[12];
        pt[13] = (unsigned long long)args.in[13];
        pt[14] = (unsigned long long)args.in[14];
        pt[15] = (unsigned long long)args.in[15];
        pt[16] = (unsigned long long)args.in[16];
        pt[17] = (unsigned long long)args.in[17];
        pt[18] = (unsigned long long)args.in[18];
        pt[19] = (unsigned long long)args.in[19];
        pt[20] = (unsigned long long)args.in[20];
        pt[21] = (unsigned long long)args.in[21];
        pt[22] = (unsigned long long)args.in[22];
        pt[23] = (unsigned long long)args.in[23];
        pt[24] = (unsigned long long)args.in[24];
        pt[25] = (unsigned long long)args.in[25];
        pt[26] = (unsigned long long)args.in[26];
        pt[27] = (unsigned long long)args.in[27];
        pt[28] = (unsigned long long)args.in[28];
        pt[29] = (unsigned long long)args.in[29];
        pt[30] = (unsigned long long)args.in[30];
        pt[31] = (unsigned long long)args.out; pt[32] = (unsigned long long)args.ws; }
    __syncthreads();
    const unsigned mask = args.mask; const int lastp = 31 - __builtin_clz(mask | 1u);
    if (__builtin_popcount(mask) > 1) (void)xcd_barrier_post((unsigned*)(PWS + WS_CTL) + CW_BAR + args.bar_region * XCD_BAR_WORDS, F.ctl);
#define IN(k) (((mask >> (k)) & 1u) && (F.lane = (int)__builtin_amdgcn_mbcnt_hi(~0u, __builtin_amdgcn_mbcnt_lo(~0u, 0u)), F.tid = F.wave * 64 + F.lane, true))
#define SEAM(k) do { if (IN(k) && (k) != lastp) { XcdBarrier bar_; bar_.bar = (unsigned*)(PWS + WS_CTL) + CW_BAR + args.bar_region * XCD_BAR_WORDS; bar_.x = xb_xcc_id(); bar_.st = F.ctl; xcd_barrier(bar_); } } while (0)
    unsigned char* ws = PWS;
    if (IN(0)) { p0_prologue(args, F); } SEAM(0);
    if (IN(1)) { SchedDense S; S.so.init(T / 256, 28, F.G, (int)blockIdx.x); S.A = (const char*)(ws + WS_H); S.B = (const char*)(ws + WS_WIN); S.lda = D * 2; S.ldb = D * 2;
        Epi1a E{(bf16*)(ws + WS_YV), (bf16*)(ws + WS_XBC), (bf16*)(ws + WS_AP)};
        pg8::gemm_phase<Epi1a, SchedDense, false>(F.lds, D, D * 2, D * 2, S, E, (VARIANT & 1) != 0);
        dt_gemm(args, F); } SEAM(1);
    if (IN(2)) { ssd_pass_a(args, F);
        SchedS5 S{(const char*)(ws + WS_AP), (const char*)(ws + WS_S5WS), 512u, F.G, F.vcu}; EpiS5a E{(float*)(ws + WS_SL)};
        pg8::gemm_phase<EpiS5a, SchedS5, false>(F.lds, 256, APK * 2, 512, S, E, (VARIANT & 1) != 0); } SEAM(2);
    if (IN(3)) { scans(args, F); } SEAM(3);
    if (IN(4)) { ssd_pass_b(args, F);
        SchedS5 S{(const char*)(ws + WS_AP), (const char*)(ws + WS_S5TW), (unsigned)(APK * 2), F.G, F.vcu}; EpiS5b E{(bf16*)(ws + WS_SL)};
        pg8::gemm_phase<EpiS5b, SchedS5, false>(F.lds, APK, APK * 2, APK * 2, S, E, (VARIANT & 1) != 0); } SEAM(4);
    if (IN(5)) { { SchedDense S; S.so.init(T / 256, 16, F.G, (int)blockIdx.x); S.A = (const char*)(ws + WS_H8); S.B = (const char*)(ws + WS_WIN) + (size_t)7168 * D * 2; S.lda = D; S.ldb = D;
          Epi1b E{(bf16*)(ws + WS_XBC), PIN(I_GATEB), (const float*)(ws + WS_MISC)};
          pg8::gemm_phase<Epi1b, SchedDense, false, true, 0, true, 127, 122>(F.lds, D, D, D, S, E, (VARIANT & 1) != 0); }
        { SchedDense S; S.so.init(T / 256, 4, F.G, (int)blockIdx.x); S.A = (const char*)(ws + WS_SL); S.B = (const char*)(ws + WS_WGLU); S.lda = S5W * 2; S.ldb = S5W * 2;
          EpiGlu E{(const bf16*)(ws + WS_SL), (bf16*)(ws + WS_YV)};
          pg8::gemm_phase<EpiGlu, SchedDense, false>(F.lds, S5W, S5W * 2, S5W * 2, S, E, (VARIANT & 1) != 0); } } SEAM(5);
    if (IN(6)) { SchedDense S; S.so.init(T / 256, 8, F.G, (int)blockIdx.x); S.A = (const char*)(ws + WS_YV); S.B = (const char*)(ws + WS_WAB); S.lda = YVP * 2; S.ldb = YVP * 2;
        EpiAB E{(const bf16*)(ws + WS_XBC), (bf16*)(ws + WS_ST)};
        pg8::gemm_phase<EpiAB, SchedDense, false, true, 32>(F.lds, YVP, YVP * 2, YVP * 2, S, E, (VARIANT & 1) != 0); } SEAM(6);
    if (IN(8)) { SchedDense S; S.so.init(T / 256, 8, F.G, (int)blockIdx.x); S.A = (const char*)(ws + WS_ST); S.B = (const char*)(ws + WS_WOUT); S.lda = D * 2; S.ldb = D * 2;
        EpiOut E{(bf16*)(ws + WS_XD)};
        pg8::gemm_phase<EpiOut, SchedDense, false>(F.lds, D, D * 2, D * 2, S, E, (VARIANT & 1) != 0); } SEAM(8);
    if (IN(9)) { route_phase(args, F); } SEAM(9);
    if (IN(10)) { moe_tables(args, F);
        SchedMoE S{F.ctl, (const char*)(ws + WS_H), (const char*)(ws + WS_ST), (const unsigned*)(ws + WS_LST), (unsigned)D, (size_t)1024 * D, (unsigned)D, 4, F.G, F.vcu, true};
        EpiGU E{(bf16*)(ws + WS_AP), (const unsigned*)(ws + WS_LST), (const float*)(ws + WS_LR)};
        pg8::gemm_phase<EpiGU, SchedMoE, true, true, 0, true, 127, 121>(F.lds, D, D, D, S, E, (VARIANT & 1) != 0);
        { LAS float* scr = (LAS float*)(F.lds + F.wave * 16384); DecExp dec{PIN(I_WEG), PIN(I_WEU), PIN(I_WED), PWS};
          transpose_jobs_queue<DecExp>((unsigned*)(ws + WS_CTL) + CW_CNT + args.bar_region * 4096 + 2560, 2 * DecExp::I_GU, DecExp::I_GU / 8, dec, scr, F.lane); } } SEAM(10);
    if (IN(11)) { moe_tables(args, F);
        SchedMoE S{F.ctl, (const char*)(ws + WS_AP), (const char*)(ws + WS_YV), (const unsigned*)(ws + WS_LST), (unsigned)FF, (size_t)D * FF, (unsigned)FF, 8, F.G, F.vcu, false};
        EpiDn E{(const float*)(ws + WS_LST + 2 * MiB), ws + WS_XBC};
        pg8::gemm_phase<EpiDn, SchedMoE, false, true, 0, true, 125, 122>(F.lds, FF, FF, FF, S, E, (VARIANT & 1) != 0); } SEAM(11);
    if (IN(12)) { moe_tables(args, F); final_phase(args, F); }
#undef IN
#undef SEAM
}

extern "C" void kernel_launch(void* const* d_in, const int* in_sizes, int n_in, void* d_out, int out_size, void* d_ws, size_t ws_size, hipStream_t stream) {
    static int grid = 0;
    if (grid == 0) {
        if (n_in != 31 || in_sizes[0] != T * D || out_size != T * D || ws_size < WS_END) { fprintf(stderr, "kernel_launch: unexpected shapes / workspace (n_in %d, ws %zu, need %zu)\n", n_in, ws_size, (size_t)WS_END); grid = -1; return; }
        int dev = 0, cus = 0;
        if (hipGetDevice(&dev) != hipSuccess || hipDeviceGetAttribute(&cus, hipDeviceAttributeMultiprocessorCount, dev) != hipSuccess) { grid = -1; return; }
        if (hipFuncSetAttribute((const void*)hybrid_fwd<0>, hipFuncAttributeMaxDynamicSharedMemorySize, LDS_BYTES) != hipSuccess) { fprintf(stderr, "kernel_launch: hipFuncSetAttribute failed\n"); grid = -1; return; }
#if defined(EXP_MASK)
        (void)hipFuncSetAttribute((const void*)hybrid_fwd<EXP_VARIANT>, hipFuncAttributeMaxDynamicSharedMemorySize, LDS_BYTES);
#endif
        int per_cu = 0;
        if (hipOccupancyMaxActiveBlocksPerMultiprocessor(&per_cu, (const void*)hybrid_fwd<0>, NWAVES * 64, LDS_BYTES) != hipSuccess || per_cu < 1) fprintf(stderr, "kernel_launch: occupancy query reports %d\n", per_cu);
        (void)hipGetLastError();
        grid = cus;
    }
    if (grid < 0) return;
    (void)hipMemsetAsync((char*)d_ws + WS_CTL, 0, CTL_ZERO_BYTES, stream);
    Args a{};
    for (int i = 0; i < 31; ++i) a.in[i] = (const float*)d_in[i];
    a.out = (float*)d_out; a.ws = (unsigned char*)d_ws;
#if defined(EXP_MASK)
    a.mask = EXP_MASK; a.variant = EXP_VARIANT; a.bar_region = 0;
    hipLaunchKernelGGL(hybrid_fwd<EXP_VARIANT>, dim3(grid), dim3(NWAVES * 64), LDS_BYTES, stream, a);
    a.mask = ((1u << (N_PHASES + 1)) - 1u) & ~(1u << 7); a.variant = 0; a.bar_region = 1;
    hipLaunchKernelGGL(hybrid_fwd<0>, dim3(grid), dim3(NWAVES * 64), LDS_BYTES, stream, a);
#elif MK_N_LAUNCHES == 1
    a.mask = ((1u << (N_PHASES + 1)) - 1u) & ~(1u << 7); a.variant = 0; a.bar_region = 0;
    hipLaunchKernelGGL(hybrid_fwd<0>, dim3(grid), dim3(NWAVES * 64), LDS_BYTES, stream, a);
#else
    for (int p = 0; p <= N_PHASES; ++p) { if (p == 7) continue; a.mask = 1u << p; a.variant = 0; a.bar_region = 0; hipLaunchKernelGGL(hybrid_fwd<0>, dim3(grid), dim3(NWAVES * 64), LDS_BYTES, stream, a); }
#endif
}
```

```cpp
#include <hip/hip_runtime.h>
#include <cstdio>
#include <cstdint>

#ifndef MK_N_LAUNCHES
#define MK_N_LAUNCHES 1
#endif
#ifndef EXP_VARIANT
#define EXP_VARIANT 0
#endif
#ifndef NAIVE_GEMM
#define NAIVE_GEMM 0
#endif

#define LAS __attribute__((address_space(3)))
#define GAS __attribute__((address_space(1)))
typedef unsigned short bf16;
typedef short bf16x8 __attribute__((ext_vector_type(8)));
typedef float f32x4 __attribute__((ext_vector_type(4)));
typedef float f32x2 __attribute__((ext_vector_type(2)));
typedef float f32x16 __attribute__((ext_vector_type(16)));
typedef unsigned v4u __attribute__((ext_vector_type(4)));
typedef unsigned v2u __attribute__((ext_vector_type(2)));
typedef GAS unsigned gu32;
typedef int v4i_ __attribute__((ext_vector_type(4)));
typedef int v8i_ __attribute__((ext_vector_type(8)));

constexpr int T = 16384, D = 2048;
constexpr int NH = 32, HP = 64, NGRP = 8, NST = 128, CHK = 64, NCHK = T / CHK;
constexpr int XBCD = 4096;
constexpr int S5W = 1024, S5G = 64, S5C = 16, S5N = 64, LS = 16, S5NC = T / LS;
constexpr int APK = 384;
constexpr int NE = 32, EPG = 8, FF = 512, CAPL = 16384;
constexpr int IN_DIM = 11296;
constexpr float EPS = 1e-6f;
constexpr int NWAVES = 8;

constexpr size_t MiB = 1u << 20;
constexpr size_t WS_CTL = 0, CTL_ZERO_BYTES = 1 * MiB;
constexpr size_t WS_WIN = 1 * MiB;
constexpr size_t WS_WAB = 46 * MiB;
constexpr size_t WS_WGLU = 58 * MiB, WS_WOUT = 80 * MiB;
constexpr size_t WS_S5WS = 60 * MiB;
constexpr size_t WS_S5TW = 68 * MiB;
constexpr size_t WS_XD = 1 * MiB;
constexpr size_t WS_H = 88 * MiB;
constexpr int YVP = 3072;
constexpr size_t WS_YV = 152 * MiB;
constexpr size_t WS_XBC = 248 * MiB;
constexpr size_t WS_ST = 376 * MiB;
constexpr size_t WS_AP = 504 * MiB;
constexpr size_t WS_DT = 552 * MiB;
constexpr size_t WS_MISC = 554 * MiB;
constexpr size_t WS_SL = 555 * MiB;
constexpr size_t WS_LST = 587 * MiB;
constexpr size_t WS_RT = 591 * MiB;
constexpr size_t WS_H8 = 592 * MiB;
constexpr size_t WS_LR = 624 * MiB;
constexpr size_t WS_END = 627 * MiB;
constexpr int CW_BAR = 4096;
constexpr int CW_CNT = 16384;

constexpr int LDS_BYTES = 163840;
constexpr int LDSCTL_OFF = 161792;

typedef __bf16 bf16x2_t __attribute__((ext_vector_type(2)));
__device__ __forceinline__ unsigned f2bf(float f) { return (unsigned)__builtin_bit_cast(unsigned short, (__bf16)f); }
__device__ __forceinline__ unsigned pk2(float lo, float hi) { const f32x2 v = {lo, hi}; const bf16x2_t b = __builtin_convertvector(v, bf16x2_t); return __builtin_bit_cast(unsigned, b); }
__device__ __forceinline__ unsigned pk4_fp8(float a, float b, float c, float d) { unsigned w = 0u; w = (unsigned)__builtin_amdgcn_cvt_pk_fp8_f32(a, b, (int)w, false); w = (unsigned)__builtin_amdgcn_cvt_pk_fp8_f32(c, d, (int)w, true); return w; }
__device__ __forceinline__ float bflo(unsigned w) { return __builtin_bit_cast(float, w << 16); }
__device__ __forceinline__ float bfhi(unsigned w) { return __builtin_bit_cast(float, w & 0xffff0000u); }
__device__ __forceinline__ float bf2f(bf16 h) { return __builtin_bit_cast(float, (unsigned)h << 16); }
__device__ __forceinline__ float wave_sum(float v) {
#pragma unroll
    for (int o = 1; o < 64; o <<= 1) v += __shfl_xor(v, o);
    return v;
}
__device__ __forceinline__ float sigmoidf_(float x) { return __builtin_amdgcn_rcpf(1.0f + __builtin_amdgcn_exp2f(-1.4426950408889634f * x)); }
__device__ __forceinline__ float siluf_(float x) { return x * __builtin_amdgcn_rcpf(1.0f + __builtin_amdgcn_exp2f(-1.4426950408889634f * x)); }
__device__ __forceinline__ float gelu_tanh(float x) { const float u = 0.7978845608028654f * (x + 0.044715f * x * x * x); return x * __builtin_amdgcn_rcpf(1.0f + __builtin_amdgcn_exp2f(-2.8853900817779268f * u)); }
#define LDS_WAIT() asm volatile("s_waitcnt lgkmcnt(0)" ::: "memory")
#define VM_WAIT() asm volatile("s_waitcnt vmcnt(0)" ::: "memory")

namespace pg8 {
constexpr int BM = 256, BK = 64, HALF = 128, HTB = HALF * BK * 2, STAGE_BYTES = 8 * HTB, NXCD = 8, WGM = 8;
__host__ __device__ __forceinline__ int lds_byte(int r, int c) { const int st = (r >> 4) * 2 + (c >> 5), rr = r & 15, cc = c & 31, ob = rr * 64 + cc * 2; return st * 1024 + (ob ^ (((ob >> 9) & 1) << 5)); }
__host__ __device__ __forceinline__ void stage_rc(int b, int& R, int& C) { const int st = b / 1024, sb = b % 1024, swz = sb ^ (((sb >> 9) & 1) << 5); R = (st >> 1) * 16 + swz / 64; C = (st & 1) * 32 + (swz % 64) / 2; }
__host__ __device__ __forceinline__ int perm32(int rho) { const int n = rho >> 4, i = rho & 15; return 8 * (i >> 2) + 4 * n + (i & 3); }

struct Unit { const char* A; const char* B; int row0, col0, e, nvalid, slot0; };

struct StaticOrder {
    int nM, nN, nwg, G, c;
    __device__ void init(int nM_, int nN_, int G_, int c_) { nM = nM_; nN = nN_; nwg = nM * nN; G = G_; c = c_; }
    __device__ bool next(int i, int& pm, int& pn) const {
        const long L = (long)i * G + c; if (L >= nwg) return false;
        int wgid = (int)L; { const int q = nwg / NXCD, r = nwg % NXCD, xcd = wgid % NXCD, off = wgid / NXCD; wgid = (xcd < r ? xcd * (q + 1) : r * (q + 1) + (xcd - r) * q) + off; }
        const int nig = WGM * nN, gid = wgid / nig, fm = gid * WGM, gsz = (nM - fm) < WGM ? (nM - fm) : WGM;
        pm = fm + ((wgid % nig) % gsz); pn = (wgid % nig) / gsz; return true;
    }
};

#if !NAIVE_GEMM
template <class Epi, class Sched, bool GATHER, bool SP2 = true, int MIDT = 0, bool FP8 = false, int SCA = 127, int SCB = 127>
__device__ __forceinline__ void gemm_phase(LAS unsigned char* lds, const int K, const unsigned lda, const unsigned ldb, const Sched& S, const Epi& E, const bool noepi = false) {
    const int tid = threadIdx.x, wid = __builtin_amdgcn_readfirstlane(tid >> 6), lane = tid & 63, wr = wid >> 2, wc = wid & 3, fr = lane & 15, fq = lane >> 4;
    const int nt = FP8 ? K / 128 : K / BK;
    unsigned voffA[2], voffB[2]; int gC0 = 0;
#pragma unroll
    for (int i = 0; i < 2; ++i) { int R, C; stage_rc(tid * 16 + i * 8192, R, C); const int Rb = (R & ~31) + perm32(R & 31);
        voffA[i] = (unsigned)R * lda + (unsigned)C * 2u; voffB[i] = (unsigned)Rb * ldb + (unsigned)C * 2u; if (i == 0) gC0 = C * 2; }
    const size_t kstep = (size_t)(BK * 2);
    const size_t hstepA = (size_t)HALF * lda, hstepB = (size_t)HALF * ldb;
    const unsigned ldsw = (unsigned)wid * 1024u;
    const int aoff = FP8 ? lds_byte(wr * 64 + fr, fq * 16) : lds_byte(wr * 64 + fr, fq * 8), boff = FP8 ? lds_byte(wc * 32 + fr, fq * 16) : lds_byte(wc * 32 + fr, fq * 8);
    constexpr int PIECE1 = FP8 ? 16 : 1024;
    unsigned gcur[2], gnxt[2];
    int scav = SCA, scbv = SCB;
    if constexpr (FP8) { asm volatile("" : "+v"(scav), "+v"(scbv)); }
#define PG8_SA(b, h) (((b) * 2 + (h)) * HTB)
#define PG8_SB(b, h) ((4 + (b) * 2 + (h)) * HTB)
#define PG8_GLDS(gptr, bufoff, i) __builtin_amdgcn_global_load_lds((const unsigned*)(gptr), (LAS unsigned*)(lds + (bufoff) + ldsw + (i) * 8192), 16, 0, 0)
#define PG8_STAGEB(bufoff, gbase) do { _Pragma("unroll") for (int _i = 0; _i < 2; ++_i) PG8_GLDS((const char*)(gbase) + voffB[0] + (size_t)(_i * 64) * ldb, bufoff, _i); } while (0)
#define PG8_STAGEA(bufoff, gbase, h, nx) do { _Pragma("unroll") for (int _i = 0; _i < 2; ++_i) { \
        const unsigned _pk = (nx) ? gnxt[h] : gcur[h]; const size_t _o = GATHER ? (size_t)((_i ? (_pk >> 16) : (_pk & 0xffffu)) * lda + (unsigned)gC0) : (size_t)voffA[0] + (size_t)(_i * 64) * lda + (size_t)(h) * hstepA; PG8_GLDS((const char*)(gbase) + _o, bufoff, _i); } } while (0)
#define PG8_LD16(off) (*(const LAS v4i_*)(lds + (off)))
#define PG8_LDA(dst, b, h) do { _Pragma("unroll") for (int m = 0; m < 4; ++m) { const v4i_ _lo = PG8_LD16(PG8_SA(b, h) + aoff + m * 2048), _hi = PG8_LD16(PG8_SA(b, h) + aoff + PIECE1 + m * 2048); \
        if constexpr (FP8) dst##8[m] = __builtin_shufflevector(_lo, _hi, 0, 1, 2, 3, 4, 5, 6, 7); else { dst##4[m][0] = _lo; dst##4[m][1] = _hi; } } } while (0)
#define PG8_LDB(dst, b, h) do { _Pragma("unroll") for (int n = 0; n < 2; ++n) { const v4i_ _lo = PG8_LD16(PG8_SB(b, h) + boff + n * 2048), _hi = PG8_LD16(PG8_SB(b, h) + boff + PIECE1 + n * 2048); \
        if constexpr (FP8) dst##8[n] = __builtin_shufflevector(_lo, _hi, 0, 1, 2, 3, 4, 5, 6, 7); else { dst##4[n][0] = _lo; dst##4[n][1] = _hi; } } } while (0)
#define PG8_MMA(ai, bj, At, Bt) do { __builtin_amdgcn_s_setprio(1); _Pragma("unroll") for (int m = 0; m < 4; ++m) _Pragma("unroll") for (int n = 0; n < 2; ++n) { \
        if constexpr (FP8) { asm volatile("v_mfma_scale_f32_16x16x128_f8f6f4 %0, %1, %2, %0, %3, %4 op_sel_hi:[0,0,0]" : "+v"(acc[ai][bj][m][n]) : "v"(Bt##8[n]), "v"(At##8[m]), "v"(scbv), "v"(scav)); } \
        else { _Pragma("unroll") for (int k = 0; k < 2; ++k) acc[ai][bj][m][n] = __builtin_amdgcn_mfma_f32_16x16x32_bf16(__builtin_bit_cast(bf16x8, Bt##4[n][k]), __builtin_bit_cast(bf16x8, At##4[m][k]), acc[ai][bj][m][n], 0, 0, 0); } } \
        __builtin_amdgcn_s_setprio(0); } while (0)
#define PG8_WAIT_V(n) asm volatile("s_waitcnt vmcnt(" #n ")" ::: "memory")
#define PG8_WAIT_L(n) asm volatile("s_waitcnt lgkmcnt(" #n ")" ::: "memory")
#define PG8_BAR __builtin_amdgcn_s_barrier()
#define PG8_SCHED __builtin_amdgcn_sched_barrier(0)
#define PG8_GOFFS(dst, u) do { if constexpr (GATHER) { int _r0, _r1, _c; stage_rc(tid * 16, _r0, _c); stage_rc(tid * 16 + 8192, _r1, _c); _Pragma("unroll") for (int _h = 0; _h < 2; ++_h) dst[_h] = S.row_idx(u, _h * HALF + _r0) | (S.row_idx(u, _h * HALF + _r1) << 16); } } while (0)
    Unit cur, nxt; int ui = 0;
    if (!S.next(0, cur)) return;
    f32x4 acc[2][2][4][2];
#pragma unroll
    for (int a = 0; a < 2; ++a)
#pragma unroll
        for (int b = 0; b < 2; ++b)
#pragma unroll
            for (int m = 0; m < 4; ++m)
#pragma unroll
                for (int n = 0; n < 2; ++n) acc[a][b][m][n] = (f32x4){0.f, 0.f, 0.f, 0.f};
    v8i_ At8[4], B08[2], B18[2]; v4i_ At4[4][2], B04[2][2], B14[2][2];
    const char* cA = cur.A; const char* cB = cur.B;
#pragma unroll
    for (int h = 0; h < 2; ++h) { gcur[h] = 0u; gnxt[h] = 0u; }
    PG8_GOFFS(gcur, cur);
    if constexpr (SP2) {
    PG8_STAGEB(PG8_SB(0, 0), cB); PG8_STAGEB(PG8_SB(0, 1), cB + hstepB); PG8_STAGEA(PG8_SA(0, 0), cA, 0, false); PG8_STAGEA(PG8_SA(0, 1), cA, 1, false);
    if (wr == 1) PG8_BAR;
    PG8_WAIT_V(2); PG8_BAR;
    PG8_STAGEB(PG8_SB(1, 0), cB + kstep); PG8_STAGEA(PG8_SA(1, 0), cA + kstep, 0, false); PG8_STAGEB(PG8_SB(1, 1), cB + hstepB + kstep);
    PG8_WAIT_V(6); PG8_BAR;
    } else {
    PG8_STAGEB(PG8_SB(0, 0), cB); PG8_STAGEA(PG8_SA(0, 0), cA, 0, false); PG8_STAGEB(PG8_SB(0, 1), cB + hstepB); PG8_STAGEA(PG8_SA(0, 1), cA, 1, false);
    if (wr == 1) PG8_BAR;
    PG8_WAIT_V(4); PG8_BAR;
    PG8_STAGEB(PG8_SB(1, 0), cB + kstep); PG8_STAGEA(PG8_SA(1, 0), cA + kstep, 0, false); PG8_STAGEB(PG8_SB(1, 1), cB + hstepB + kstep);
    PG8_WAIT_V(6); PG8_BAR;
    }
    for (;;) {
        const bool has_next = S.next(ui + 1, nxt);
        const char* nA = has_next ? nxt.A : cA; const char* nB = has_next ? nxt.B : cB;
        if constexpr (GATHER) { if (has_next) { PG8_GOFFS(gnxt, nxt); } else {
            gnxt[0] = gcur[0]; gnxt[1] = gcur[1]; } }
        asm volatile(".p2align 8" ::: "memory");
#pragma unroll 1
        for (int t = 0; t < nt; t += 2) {
            const bool last = (t == nt - 2);
            if constexpr (MIDT > 0) { if (t == MIDT) E.mid(acc, cur, wr, wc, fr, fq); }
            const char* a1 = cA + (size_t)(t + 1) * kstep;
            const char* a2 = last ? nA : cA + (size_t)(t + 2) * kstep; const char* b2 = last ? nB : cB + (size_t)(t + 2) * kstep;
            const char* a3 = a2 + kstep; const char* b3 = b2 + kstep;
            if constexpr (SP2) {
            PG8_LDB(B0, 0, 0); PG8_LDB(B1, 0, 1); PG8_SCHED; PG8_LDA(At, 0, 0); PG8_STAGEA(PG8_SA(1, 1), a1, 1, false);
            PG8_WAIT_V(8); PG8_WAIT_L(0); PG8_BAR; PG8_MMA(0, 0, At, B0); PG8_MMA(0, 1, At, B1); PG8_BAR; PG8_SCHED;
            PG8_LDA(At, 0, 1); PG8_STAGEB(PG8_SB(0, 0), b2); PG8_STAGEB(PG8_SB(0, 1), b2 + hstepB); PG8_STAGEA(PG8_SA(0, 0), a2, 0, last);
            PG8_WAIT_V(8); PG8_WAIT_L(0); PG8_BAR; PG8_MMA(1, 0, At, B0); PG8_MMA(1, 1, At, B1); PG8_BAR; PG8_SCHED;
            PG8_LDB(B0, 1, 0); PG8_LDB(B1, 1, 1); PG8_SCHED; PG8_LDA(At, 1, 0); PG8_STAGEA(PG8_SA(0, 1), a2, 1, last);
            PG8_WAIT_V(8); PG8_WAIT_L(0); PG8_BAR; PG8_MMA(0, 0, At, B0); PG8_MMA(0, 1, At, B1); PG8_BAR; PG8_SCHED;
            PG8_LDA(At, 1, 1); PG8_STAGEB(PG8_SB(1, 0), b3); PG8_STAGEB(PG8_SB(1, 1), b3 + hstepB); PG8_STAGEA(PG8_SA(1, 0), a3, 0, last);
            PG8_WAIT_V(8); PG8_WAIT_L(0); PG8_BAR; PG8_MMA(1, 0, At, B0); PG8_MMA(1, 1, At, B1); PG8_BAR; PG8_SCHED;
            } else {
            PG8_LDB(B0, 0, 0); PG8_SCHED; PG8_LDA(At, 0, 0); PG8_STAGEA(PG8_SA(1, 1), a1, 1, false);
            PG8_WAIT_L(8); PG8_BAR; PG8_WAIT_L(0); PG8_MMA(0, 0, At, B0); PG8_BAR; PG8_SCHED;
            PG8_LDB(B1, 0, 1); PG8_STAGEB(PG8_SB(0, 0), b2);
            PG8_BAR; PG8_WAIT_L(0); PG8_MMA(0, 1, At, B1); PG8_BAR;
            PG8_LDA(At, 0, 1); PG8_STAGEA(PG8_SA(0, 0), a2, 0, last);
            PG8_BAR; PG8_WAIT_L(0); PG8_MMA(1, 0, At, B0); PG8_BAR; PG8_SCHED;
            PG8_STAGEB(PG8_SB(0, 1), b2 + hstepB);
            PG8_WAIT_V(6); PG8_BAR; PG8_MMA(1, 1, At, B1); PG8_BAR;
            PG8_LDB(B0, 1, 0); PG8_SCHED; PG8_LDA(At, 1, 0); PG8_STAGEA(PG8_SA(0, 1), a2, 1, last);
            PG8_WAIT_L(8); PG8_BAR; PG8_WAIT_L(0); PG8_MMA(0, 0, At, B0); PG8_BAR; PG8_SCHED;
            PG8_LDB(B1, 1, 1); PG8_STAGEB(PG8_SB(1, 0), b3);
            PG8_BAR; PG8_WAIT_L(0); PG8_MMA(0, 1, At, B1); PG8_BAR;
            PG8_LDA(At, 1, 1); PG8_STAGEA(PG8_SA(1, 0), a3, 0, last);
            PG8_BAR; PG8_WAIT_L(0); PG8_MMA(1, 0, At, B0); PG8_BAR; PG8_SCHED;
            PG8_STAGEB(PG8_SB(1, 1), b3 + hstepB);
            PG8_WAIT_V(6); PG8_BAR; PG8_MMA(1, 1, At, B1); PG8_BAR;
            }
        }
        if constexpr (FP8) { asm volatile("s_nop 15\n\ts_nop 15" ::: "memory"); }
        if (wr == 0) PG8_BAR;
        if (!noepi) E(acc, cur, wr, wc, fr, fq);
        else {
#pragma unroll
            for (int a = 0; a < 2; ++a)
#pragma unroll
                for (int b = 0; b < 2; ++b)
#pragma unroll
                    for (int m = 0; m < 4; ++m)
#pragma unroll
                        for (int n = 0; n < 2; ++n) asm volatile("" :: "v"(acc[a][b][m][n])); }
        if (!has_next) break;
#pragma unroll
        for (int a = 0; a < 2; ++a)
#pragma unroll
            for (int b = 0; b < 2; ++b)
#pragma unroll
                for (int m = 0; m < 4; ++m)
#pragma unroll
                    for (int n = 0; n < 2; ++n) acc[a][b][m][n] = (f32x4){0.f, 0.f, 0.f, 0.f};
        cur = nxt; cA = nA; cB = nB; ++ui;
        if constexpr (GATHER) {
            gcur[0] = gnxt[0]; gcur[1] = gnxt[1]; }
        if (wr == 1) PG8_BAR;
    }
    PG8_WAIT_V(0);
    PG8_BAR;
#undef PG8_SA
#undef PG8_SB
#undef PG8_GLDS
#undef PG8_STAGEA
#undef PG8_STAGEB
#undef PG8_LDA
#undef PG8_LDB
#undef PG8_MMA
#undef PG8_WAIT_V
#undef PG8_WAIT_L
#undef PG8_BAR
#undef PG8_SCHED
#undef PG8_GOFFS
}
#else
template <class Epi, class Sched, bool GATHER>
__device__ __forceinline__ void gemm_phase(LAS unsigned char* lds, const int K, const unsigned lda, const unsigned ldb, const Sched& S, const Epi& E, const bool noepi = false) {
    const int tid = threadIdx.x, wid = __builtin_amdgcn_readfirstlane(tid >> 6), lane = tid & 63, wr = wid >> 2, wc = wid & 3, fr = lane & 15, fq = lane >> 4;
    Unit cur;
    for (int ui = 0; S.next(ui, cur); ++ui) {
        f32x4 acc[2][2][4][2];
#pragma unroll
        for (int a = 0; a < 2; ++a)
#pragma unroll
            for (int b = 0; b < 2; ++b)
#pragma unroll
                for (int m = 0; m < 4; ++m)
#pragma unroll
                    for (int n = 0; n < 2; ++n) acc[a][b][m][n] = (f32x4){0.f, 0.f, 0.f, 0.f};
        for (int k = 0; k < K; k += 8) {
            v4u av[2][4];
#pragma unroll
            for (int ai = 0; ai < 2; ++ai)
#pragma unroll
                for (int m = 0; m < 4; ++m) { const int r = ai * 128 + wr * 64 + m * 16 + fr; const size_t ro = GATHER ? (size_t)S.row_idx(cur, r) * lda : (size_t)r * lda; av[ai][m] = *(const v4u*)(cur.A + ro + (size_t)k * 2); }
#pragma unroll
            for (int bj = 0; bj < 2; ++bj)
#pragma unroll
                for (int n = 0; n < 2; ++n)
#pragma unroll
                    for (int j = 0; j < 4; ++j) { const int c = bj * 128 + wc * 32 + 8 * fq + 4 * n + j; const v4u bv = *(const v4u*)(cur.B + (size_t)c * ldb + (size_t)k * 2);
#pragma unroll
                        for (int ai = 0; ai < 2; ++ai)
#pragma unroll
                            for (int m = 0; m < 4; ++m) { const v4u a = av[ai][m]; float s = acc[ai][bj][m][n][j];
                                s += bflo(a.x) * bflo(bv.x) + bfhi(a.x) * bfhi(bv.x); s += bflo(a.y) * bflo(bv.y) + bfhi(a.y) * bfhi(bv.y);
                                s += bflo(a.z) * bflo(bv.z) + bfhi(a.z) * bfhi(bv.z); s += bflo(a.w) * bflo(bv.w) + bfhi(a.w) * bfhi(bv.w); acc[ai][bj][m][n][j] = s; } }
        }
        E(acc, cur, wr, wc, fr, fq);
    }
    __syncthreads();
}
#endif
}
using pg8::Unit;

#define XB_TMO      128
#define XB_XCNT(j)  (256  + 64 * (j))
#define XB_XSUB(j)  (1280 + 64 * (j))
#define XB_XGEN(j)  (2304 + 64 * (j))
#define XB_TOP      3328
#define XB_TOPGEN   3392
#define XCD_BAR_WORDS 3456
#define XB_SPIN_CAP (1u << 22)
__device__ __forceinline__ unsigned xb_ld(unsigned* p)              { return __hip_atomic_load(p, __ATOMIC_RELAXED, __HIP_MEMORY_SCOPE_AGENT); }
__device__ __forceinline__ unsigned xb_add(unsigned* p, unsigned v) { return __hip_atomic_fetch_add(p, v, __ATOMIC_RELAXED, __HIP_MEMORY_SCOPE_AGENT); }
__device__ __forceinline__ unsigned xb_xcc_id() { return (unsigned)__builtin_amdgcn_s_getreg((3 << 11) | 20) & 0xFu; }
#define XB_SPIN(cond, bar) do { unsigned _sp = 0; while (cond) { __builtin_amdgcn_s_sleep(1); \
    if ((++_sp & 255u) == 0u) { if (xb_ld(&(bar)[XB_TMO])) break; if (_sp > XB_SPIN_CAP) { atomicAdd(&(bar)[XB_TMO], 1u); break; } } } } while (0)
struct XcdBarrier { unsigned* bar; unsigned x; volatile LAS unsigned* st; };
__device__ __forceinline__ XcdBarrier xcd_barrier_post(unsigned* bar, volatile LAS unsigned* st) {
    XcdBarrier b; b.bar = bar; b.x = xb_xcc_id(); b.st = st;
    if (threadIdx.x == 0) (void)xb_add(&bar[XB_XCNT(b.x)], 1u);
    return b;
}
__device__ __forceinline__ void xcd_barrier_complete(unsigned* bar, unsigned x, unsigned& nloc, unsigned& nx) {
    const unsigned G = gridDim.x * gridDim.y * gridDim.z;
    unsigned sum, cnt, mine, sp = 0u;
    for (;;) {
        sum = 0u; cnt = 0u; mine = 0u;
#pragma unroll
        for (unsigned j = 0; j < 16; ++j) { const unsigned c = xb_ld(&bar[XB_XCNT(j)]); sum += c; cnt += (c > 0u) ? 1u : 0u; mine = (j == x) ? c : mine; }
        if (sum == G) break;
        __builtin_amdgcn_s_sleep(1);
        if ((++sp & 255u) == 0u) { if (xb_ld(&bar[XB_TMO])) break; if (sp > XB_SPIN_CAP) { atomicAdd(&bar[XB_TMO], 1u); break; } }
    }
    nloc = mine > 0u ? mine : 1u; nx = cnt > 0u ? cnt : 1u;
}
__device__ __forceinline__ void xcd_barrier(const XcdBarrier& b) {
    asm volatile("s_waitcnt vmcnt(0)" ::: "memory");
    __syncthreads();
    if (threadIdx.x == 0) {
        unsigned* bar = b.bar;
        __builtin_amdgcn_s_waitcnt(0);
        unsigned nloc = b.st[0], nx = b.st[1];
        if (nloc == 0u) { xcd_barrier_complete(bar, b.x, nloc, nx); b.st[0] = nloc; b.st[1] = nx; }
        const unsigned old = xb_add(&bar[XB_XSUB(b.x)], 1u);
        const unsigned gen = old / nloc;
        if (old + 1u == (gen + 1u) * nloc) {
            __builtin_amdgcn_fence(__ATOMIC_RELEASE, "agent");
            asm volatile("s_waitcnt vmcnt(0)" ::: "memory");
            const unsigned og = xb_add(&bar[XB_TOP], 1u);
            const unsigned tg = og / nx;
            if (og + 1u == (tg + 1u) * nx) xb_add(&bar[XB_TOPGEN], 1u);
            else XB_SPIN(xb_ld(&bar[XB_TOPGEN]) == tg, bar);
            __builtin_amdgcn_fence(__ATOMIC_ACQUIRE, "agent");
            xb_add(&bar[XB_XGEN(b.x)], 1u);
            asm volatile("s_waitcnt vmcnt(0)" ::: "memory");
        } else {
            XB_SPIN(xb_ld(&bar[XB_XGEN(b.x)]) == gen, bar);
            __builtin_amdgcn_fence(__ATOMIC_ACQUIRE, "agent");
            asm volatile("s_waitcnt vmcnt(0)" ::: "memory");
        }
    }
    __syncthreads();
}

struct Args { const float* in[31]; float* out; unsigned char* ws; unsigned mask; int variant, bar_region, pad; };
enum { I_X = 0, I_NMW, I_WIN, I_CONVW, I_CONVB, I_DTB, I_ALOG, I_DSSD, I_NSW, I_WAUP, I_LRE, I_LIM, I_LOGDT, I_BRE, I_BIM, I_CRE, I_CIM, I_S5D,
       I_WGLU, I_WBUP, I_GATEB, I_WOUT, I_NFW, I_WRG, I_BRG, I_WRE, I_BRE2, I_WEG, I_WEU, I_WED, I_NFINAL };
struct Ctx { LAS unsigned char* lds; volatile LAS unsigned* ctl; int tid, lane, wave, vcu, G; };
constexpr int PTAB_OFF = LDSCTL_OFF + 1024;
__device__ __forceinline__ unsigned long long ptab_get(LAS unsigned char* lds, int i) {
    const LAS unsigned* p = (const LAS unsigned*)(lds + PTAB_OFF + 8 * i); const unsigned lo = __builtin_amdgcn_readfirstlane(p[0]), hi = __builtin_amdgcn_readfirstlane(p[1]); return ((unsigned long long)hi << 32) | lo; }
#define PIN(i) ((const float*)ptab_get(F.lds, (i)))
#define POUT ((float*)ptab_get(F.lds, 31))
#define PWS ((unsigned char*)ptab_get(F.lds, 32))

struct TJob { const float* src; unsigned char* dst; int N, K; float scale; int fp8; };
__device__ __forceinline__ void tj_load(const TJob& j, int lane, f32x4 (&v)[8]) {
    const float* p = j.src + (size_t)(lane >> 3) * j.N + (lane & 7) * 4;
#pragma unroll
    for (int i = 0; i < 8; ++i) v[i] = __builtin_nontemporal_load((const f32x4*)(p + (size_t)(8 * i) * j.N));
}
__device__ __forceinline__ void tj_store(const TJob& j, int lane, const f32x4 (&v)[8], LAS float* scr) {
    LAS float* w = scr + (lane >> 3) * 33 + (lane & 7) * 4;
#pragma unroll
    for (int i = 0; i < 8; ++i) { w[i * 264 + 0] = v[i][0]; w[i * 264 + 1] = v[i][1]; w[i * 264 + 2] = v[i][2]; w[i * 264 + 3] = v[i][3]; }
    LDS_WAIT(); asm volatile("" ::: "memory");
    const int c = lane & 7;
#pragma unroll
    for (int jj = 0; jj < 4; ++jj) { const int n = (lane >> 3) + 8 * jj; const LAS float* s = scr + (8 * c) * 33 + n;
        if (j.fp8) { const float q = j.scale; v2u o; o.x = pk4_fp8(s[0 * 33] * q, s[1 * 33] * q, s[2 * 33] * q, s[3 * 33] * q); o.y = pk4_fp8(s[4 * 33] * q, s[5 * 33] * q, s[6 * 33] * q, s[7 * 33] * q);
            *(v2u*)(j.dst + (size_t)n * j.K + 8 * c) = o; }
        else { v4u o; o.x = pk2(s[0 * 33], s[1 * 33]); o.y = pk2(s[2 * 33], s[3 * 33]); o.z = pk2(s[4 * 33], s[5 * 33]); o.w = pk2(s[6 * 33], s[7 * 33]);
            *(v4u*)(j.dst + ((size_t)n * j.K + 8 * c) * 2) = o; } }
    LDS_WAIT(); asm volatile("" ::: "memory");
}
template <class Dec>
__device__ __forceinline__ void transpose_jobs(int first, int stride, int nitems, const Dec dec, LAS float* scr, int lane) {
    int it = first; if (it >= nitems) return;
    TJob cur; f32x4 v[8]; dec(it, cur); tj_load(cur, lane, v);
    for (;;) { const int nx = it + stride; const bool hn = nx < nitems; TJob nj = cur; f32x4 nv[8];
        if (hn) { dec(nx, nj); tj_load(nj, lane, nv); }
        tj_store(cur, lane, v, scr);
        if (!hn) break;
        cur = nj; it = nx;
#pragma unroll
        for (int i = 0; i < 8; ++i) v[i] = nv[i]; }
}
struct DecP0 {
    static constexpr int I_IN = 32 * (IN_DIM / 32), I_A = 32 * 64, I_G = 16 * 32, I_B = 16 * 64, I_O = 32 * 64, NITEMS = I_IN + I_A + I_G + I_B + I_O;
    const float *win, *wa, *wg, *wb, *wo; unsigned char* ws;
    __device__ __forceinline__ void operator()(int r, TJob& j) const {
        if (r < I_IN) { const int nb = r % (IN_DIM / 32), kb = r / (IN_DIM / 32); const int dr = 32 * nb; int sc; if (dr < 6144) sc = dr; else if (dr < 7168) sc = dr + 32; else if (dr < 11264) { const int rel = dr - 7168, within = rel & 255; sc = 7200 + (within >> 7) * 2048 + (rel >> 8) * 128 + (within & 127); } else sc = dr - 11264 + 6144;
            j.src = win + (size_t)(64 * kb) * IN_DIM + sc; if (dr >= 7168 && dr < 11264) { j.dst = ws + WS_WIN + (size_t)7168 * D * 2 + (size_t)(dr - 7168) * D + 64 * kb; j.scale = 32.f; j.fp8 = 1; } else { j.dst = ws + WS_WIN + ((size_t)dr * D + 64 * kb) * 2; j.scale = 1.f; j.fp8 = 0; } j.N = IN_DIM; j.K = D; return; } r -= I_IN;
        if (r < I_A) { j.src = wa + (size_t)(64 * (r / 64)) * D + 32 * (r % 64); j.dst = ws + WS_WAB + ((size_t)(32 * (r % 64)) * YVP + 64 * (r / 64)) * 2; j.scale = 1.f; j.fp8 = 0; j.N = D; j.K = YVP; return; } r -= I_A;
        if (r < I_G) { j.src = wg + (size_t)(64 * (r / 32)) * S5W + 32 * (r % 32); j.dst = ws + WS_WGLU + ((size_t)(32 * (r % 32)) * S5W + 64 * (r / 32)) * 2; j.scale = 1.f; j.fp8 = 0; j.N = S5W; j.K = S5W; return; } r -= I_G;
        if (r < I_B) { j.src = wb + (size_t)(64 * (r / 64)) * D + 32 * (r % 64); j.dst = ws + WS_WAB + ((size_t)(32 * (r % 64)) * YVP + 2048 + 64 * (r / 64)) * 2; j.scale = 1.f; j.fp8 = 0; j.N = D; j.K = YVP; return; } r -= I_B;
        j.src = wo + (size_t)(64 * (r / 64)) * D + 32 * (r % 64); j.dst = ws + WS_WOUT + ((size_t)(32 * (r % 64)) * D + 64 * (r / 64)) * 2; j.scale = 1.f; j.fp8 = 0; j.N = D; j.K = D; }
};
constexpr float WGU_SCALE = 64.f, WD_SCALE = 32.f, HID_SCALE = 4.f;
struct DecExp {
    static constexpr int I_GU = NE * 32 * 16, NITEMS = 3 * I_GU;
    const float *wg, *wu, *wd; unsigned char* ws;
    __device__ __forceinline__ void operator()(int it, TJob& j) const {
        if (it < 2 * I_GU) { const int which = it / I_GU, r = it % I_GU, e = r / 512, q = r % 512, kb = q / 16, nb = q % 16; const int j0 = 32 * nb;
            const int drow = (j0 >> 7) * 256 + which * 128 + (j0 & 127);
            j.src = (which ? wu : wg) + (size_t)e * D * FF + (size_t)(64 * kb) * FF + j0; j.dst = ws + WS_ST + ((size_t)e * 1024 + drow) * D + 64 * kb; j.N = FF; j.K = D; j.scale = WGU_SCALE; j.fp8 = 1; }
        else { const int r = it - 2 * I_GU, e = r / 512, q = r % 512, kb = q / 64, nb = q % 64;
            j.src = wd + (size_t)e * FF * D + (size_t)(64 * kb) * D + 32 * nb; j.dst = ws + WS_YV + ((size_t)e * D + 32 * nb) * FF + 64 * kb; j.N = D; j.K = FF; j.scale = WD_SCALE; j.fp8 = 1; }
    }
};
__device__ __forceinline__ void rms_row_to_bf16(const float* xrow, const float* w, bf16* orow, unsigned char* orow8, int lane) {
    const f32x4* xr = (const f32x4*)xrow + lane; const f32x4* wr4 = (const f32x4*)w + lane;
    f32x4 v[8]; float s = 0.f;
#pragma unroll
    for (int j = 0; j < 8; ++j) { v[j] = xr[64 * j]; s += (v[j].x * v[j].x + v[j].y * v[j].y) + (v[j].z * v[j].z + v[j].w * v[j].w); }
    const float rstd = 1.0f / sqrtf(wave_sum(s) * (1.f / D) + EPS);
    v2u* o8 = (v2u*)orow + lane; unsigned* q8 = (unsigned*)orow8 + lane;
#pragma unroll
    for (int j = 0; j < 8; ++j) { const f32x4 g = wr4[64 * j]; const f32x4 hv = {v[j].x * rstd * g.x, v[j].y * rstd * g.y, v[j].z * rstd * g.z, v[j].w * rstd * g.w};
        v2u o; o.x = pk2(hv.x, hv.y); o.y = pk2(hv.z, hv.w); o8[64 * j] = o; q8[64 * j] = pk4_fp8(hv.x, hv.y, hv.z, hv.w); }
}

__device__ __forceinline__ void s5_mats_group(const Args& a, const Ctx& F, int g) {
    LAS float* L = (LAS float*)F.lds;
    LAS float* apr = L; LAS float* api = L + 17 * 64; LAS float* bbr = L + 2 * 17 * 64; LAS float* bbi = bbr + 1024; LAS float* cr = bbi + 1024; LAS float* ci = cr + 1024; LAS float* kt = ci + 1024;
    LAS float* cof = kt + 4096;
    const float dt = expf(PIN(I_LOGDT)[g]);
    if (F.tid < 64) { const int n = F.tid; const float lr = PIN(I_LRE)[g * 64 + n], li = PIN(I_LIM)[g * 64 + n];
        for (int m = 0; m <= 16; ++m) { const float mag = expf((float)m * lr * dt), ang = (float)m * li * dt; apr[m * 64 + n] = mag * cosf(ang); api[m * 64 + n] = mag * sinf(ang); }
        const float ar = expf(lr * dt) * cosf(li * dt), ai = expf(lr * dt) * sinf(li * dt);
        const float den = lr * lr + li * li, nr = ar - 1.0f, ni = ai;
        cof[n] = (nr * lr + ni * li) / den; cof[64 + n] = (ni * lr - nr * li) / den; }
    for (int i = F.tid; i < 1024; i += 512) { const int co = i >> 6, n = i & 63; cr[i] = PIN(I_CRE)[(size_t)g * 1024 + co * 64 + n]; ci[i] = PIN(I_CIM)[(size_t)g * 1024 + co * 64 + n]; }
    __syncthreads();
    for (int i = F.tid; i < 1024; i += 512) { const int n = i >> 4; const float br = PIN(I_BRE)[(size_t)g * 1024 + i], bi = PIN(I_BIM)[(size_t)g * 1024 + i]; const float c0 = cof[n], c1 = cof[64 + n];
        bbr[i] = c0 * br - c1 * bi; bbi[i] = c0 * bi + c1 * br; }
    __syncthreads();
    for (int i = F.tid; i < 4096; i += 512) { const int lag = i >> 8, co = (i >> 4) & 15, cin = i & 15; float s = 0.f;
        for (int n = 0; n < 64; ++n) { const float wr_ = apr[lag * 64 + n] * bbr[n * 16 + cin] - api[lag * 64 + n] * bbi[n * 16 + cin], wi_ = apr[lag * 64 + n] * bbi[n * 16 + cin] + api[lag * 64 + n] * bbr[n * 16 + cin];
            s += cr[co * 64 + n] * wr_ - ci[co * 64 + n] * wi_; }
        kt[i] = s; }
    __syncthreads();
    bf16* TW = (bf16*)(PWS + WS_S5TW) + (size_t)g * 256 * APK;
    for (int i = F.tid; i < 256 * APK / 2; i += 512) { const int row = (2 * i) / APK, k0 = (2 * i) % APK; const int l = row >> 4, co = row & 15; float v[2];
#pragma unroll
        for (int q = 0; q < 2; ++q) { const int k = k0 + q; float val;
            if (k < 256) { const int j = k >> 4, cin = k & 15; val = (l >= j) ? kt[(l - j) * 256 + co * 16 + cin] : 0.f; if (l == j && cin == co) val += PIN(I_S5D)[g * 16 + co]; }
            else if (k < 320) { const int n = k - 256; val = cr[co * 64 + n] * apr[(l + 1) * 64 + n] - ci[co * 64 + n] * api[(l + 1) * 64 + n]; }
            else { const int n = k - 320; val = -(cr[co * 64 + n] * api[(l + 1) * 64 + n] + ci[co * 64 + n] * apr[(l + 1) * 64 + n]); }
            v[q] = val; }
        *(unsigned*)(TW + 2 * i) = pk2(v[0], v[1]); }
    bf16* WS = (bf16*)(PWS + WS_S5WS) + (size_t)g * 256 * 256;
    for (int i = F.tid; i < 256 * 256 / 2; i += 512) { const int row = (2 * i) >> 8, k0 = (2 * i) & 255; float v[2];
#pragma unroll
        for (int q = 0; q < 2; ++q) { const int k = k0 + q, j = k >> 4, cin = k & 15; float val = 0.f;
            if (row < 64) { const int n = row; val = apr[(15 - j) * 64 + n] * bbr[n * 16 + cin] - api[(15 - j) * 64 + n] * bbi[n * 16 + cin]; }
            else if (row < 128) { const int n = row - 64; val = apr[(15 - j) * 64 + n] * bbi[n * 16 + cin] + api[(15 - j) * 64 + n] * bbr[n * 16 + cin]; }
            v[q] = val; }
        *(unsigned*)(WS + 2 * i) = pk2(v[0], v[1]); }
    __syncthreads();
}

__device__ __forceinline__ void p0_prologue(const Args& a, const Ctx& F) {
    if (F.vcu < S5G) s5_mats_group(a, F, F.vcu);
    LAS float* scr = (LAS float*)(F.lds + F.wave * 16384);
    const int gw = F.vcu * NWAVES + F.wave, NGW = F.G * NWAVES;
    { DecP0 dec{PIN(I_WIN), PIN(I_WAUP), PIN(I_WGLU), PIN(I_WBUP), PIN(I_WOUT), PWS};
      transpose_jobs<DecP0>(gw, NGW, DecP0::NITEMS, dec, scr, F.lane); }
    {
        unsigned* gctr = (unsigned*)(PWS + WS_CTL) + CW_CNT + a.bar_region * 4096 + 2624; const float* X = PIN(I_X); const float* nmw = PIN(I_NMW); unsigned char* wsb = PWS;
        unsigned bv = 0u; if (F.lane == 0) bv = __hip_atomic_fetch_add(gctr, 1u, __ATOMIC_RELAXED, __HIP_MEMORY_SCOPE_AGENT);
        int b = (int)__builtin_amdgcn_readfirstlane(bv);
        while (b < T / 8) { unsigned nv = 0u; if (F.lane == 0) nv = __hip_atomic_fetch_add(gctr, 1u, __ATOMIC_RELAXED, __HIP_MEMORY_SCOPE_AGENT);
            for (int m = 8 * b; m < 8 * b + 8; ++m) rms_row_to_bf16(X + (size_t)m * D, nmw, (bf16*)(wsb + WS_H) + (size_t)m * D, wsb + WS_H8 + (size_t)m * D, F.lane);
            b = (int)__builtin_amdgcn_readfirstlane(nv); } }
    for (int i = gw * 64 + F.lane; i < 48 * D; i += NGW * 64) { const int col = i / D, k = i % D; float w = 0.f;
        if (col < 4) w = PIN(I_WRG)[k * 4 + col]; else if (col >= 16) w = PIN(I_WRE)[k * 32 + (col - 16)];
        const unsigned hi = f2bf(w); const float lo = w - bf2f((bf16)hi);
        ((bf16*)(PWS + WS_RT))[i] = (bf16)hi; ((bf16*)(PWS + WS_RT))[48 * D + i] = (bf16)f2bf(lo); }
}

struct SchedDense {
    pg8::StaticOrder so; const char* A; const char* B; unsigned lda, ldb;
    __device__ __forceinline__ bool next(int i, Unit& u) const { int pm, pn; if (!so.next(i, pm, pn)) return false;
        u.A = A + (size_t)pm * 256 * lda; u.B = B + (size_t)pn * 256 * ldb; u.row0 = pm * 256; u.col0 = pn * 256; u.e = 0; u.nvalid = 256; return true; }
    __device__ __forceinline__ unsigned row_idx(const Unit&, int) const { return 0u; }
};
struct SchedS5 {
    const char* A; const char* B; unsigned ldb; int G, c;
    __device__ __forceinline__ bool next(int i, Unit& u) const { const int idx = i * G + c; if (idx >= 256) return false; const int g = idx >> 2, mt = idx & 3;
        u.A = A + (size_t)(g * 1024 + mt * 256) * (APK * 2); u.B = B + (size_t)g * 256 * ldb; u.row0 = g * 1024 + mt * 256; u.col0 = 0; u.e = g; u.nvalid = 256; return true; }
    __device__ __forceinline__ unsigned row_idx(const Unit&, int) const { return 0u; }
};
struct SchedMoE {
    volatile LAS unsigned* ctl; const char* A; const char* B; const unsigned* list_tok; unsigned lda; size_t bstride_e; unsigned ldb; int NN, G, c; bool gather;
    __device__ __forceinline__ bool next(int i, Unit& u) const { const int idx = i * G + c; const int NT = (int)ctl[72]; if (idx >= NT * NN) return false;
        const int mtg = idx / NN, pn = idx % NN; const int e = (int)ctl[80 + mtg]; const int rb = (int)ctl[40 + e]; const int mtl = mtg - (rb >> 8); const int cnt = (int)ctl[8 + e];
        u.e = e; u.nvalid = cnt - mtl * 256; u.slot0 = mtl * 256; u.B = B + (size_t)e * bstride_e + (size_t)pn * 256 * ldb;
        if (gather) { u.A = A; u.row0 = rb + mtl * 256; u.col0 = pn * 128; }
        else { u.A = A + (size_t)(rb + mtl * 256) * lda; u.row0 = rb + mtl * 256; u.col0 = pn * 256; }
        return true; }
    __device__ __forceinline__ unsigned row_idx(const Unit& u, int r) const {
        const unsigned tokk = (r < u.nvalid) ? list_tok[(size_t)u.e * CAPL + u.slot0 + r] : 0u; return tokk >> 1; }
};

#define EPI_BEGIN _Pragma("unroll") for (int ai = 0; ai < 2; ++ai) _Pragma("unroll") for (int m = 0; m < 4; ++m) { const int r = ai * 128 + wr * 64 + m * 16 + fr; \
    _Pragma("unroll") for (int bj = 0; bj < 2; ++bj) { const int c = bj * 128 + wc * 32 + 8 * fq; const f32x4 v0 = acc[ai][bj][m][0], v1 = acc[ai][bj][m][1];
#define EPI_END } }
__device__ __forceinline__ v4u pack8(const f32x4 a, const f32x4 b) { v4u w; w.x = pk2(a[0], a[1]); w.y = pk2(a[2], a[3]); w.z = pk2(b[0], b[1]); w.w = pk2(b[2], b[3]); return w; }
__device__ __forceinline__ void unpack8(const v4u w, float (&f)[8]) { f[0] = bflo(w.x); f[1] = bfhi(w.x); f[2] = bflo(w.y); f[3] = bfhi(w.y); f[4] = bflo(w.z); f[5] = bfhi(w.z); f[6] = bflo(w.w); f[7] = bfhi(w.w); }

struct Epi1a {
    bf16* ZS; bf16* XBC; bf16* AP;
    __device__ __forceinline__ void operator()(const f32x4 (&acc)[2][2][4][2], const Unit& u, int wr, int wc, int fr, int fq) const {
        EPI_BEGIN  const int row = u.row0 + r, col = u.col0 + c;
            if (col < 2048) { f32x4 a = v0, b = v1;
#pragma unroll
                for (int j = 0; j < 4; ++j) { a[j] = siluf_(a[j]); b[j] = siluf_(b[j]); }
                *(v4u*)(ZS + (size_t)row * YVP + col) = pack8(a, b); }
            else if (col < 6144) { *(v4u*)(XBC + (size_t)row * XBCD + (col - 2048)) = pack8(v0, v1); }
            else { const int cc = col - 6144, g = cc >> 4, ci0 = cc & 15; *(v4u*)(AP + ((size_t)(g * S5NC + (row >> 4)) * APK + (row & 15) * 16 + ci0)) = pack8(v0, v1); }  EPI_END
    }
};
struct EpiS5a {
    float* SL;
    __device__ __forceinline__ void operator()(const f32x4 (&acc)[2][2][4][2], const Unit& u, int wr, int wc, int fr, int fq) const {
        EPI_BEGIN  if (bj == 0) { float* p = SL + (size_t)(u.row0 + r) * 128 + c; *(f32x4*)p = v0; *(f32x4*)(p + 4) = v1; }  EPI_END
    }
};
struct EpiS5b {
    bf16* V;
    __device__ __forceinline__ void operator()(const f32x4 (&acc)[2][2][4][2], const Unit& u, int wr, int wc, int fr, int fq) const {
        EPI_BEGIN  const int chunk = (u.row0 + r) & 1023, g = u.e, l = c >> 4, co0 = c & 15; f32x4 a = v0, b = v1;
#pragma unroll
            for (int j = 0; j < 4; ++j) { a[j] = gelu_tanh(a[j]); b[j] = gelu_tanh(b[j]); }
            *(v4u*)(V + (size_t)(chunk * 16 + l) * S5W + g * 16 + co0) = pack8(a, b);  EPI_END
    }
};
struct Epi1b {
    bf16* Gt; const float* gb; const float* ssq;
    __device__ __forceinline__ void operator()(const f32x4 (&acc)[2][2][4][2], const Unit& u, int wr, int wc, int fr, int fq) const {
        const int j0 = (u.col0 >> 1) + wc * 32 + 8 * fq;
        const f32x4 ba0 = *(const f32x4*)(gb + j0), ba1 = *(const f32x4*)(gb + j0 + 4), bb0 = *(const f32x4*)(gb + 2048 + j0), bb1 = *(const f32x4*)(gb + 2048 + j0 + 4);
#pragma unroll
        for (int ai = 0; ai < 2; ++ai)
#pragma unroll
            for (int m = 0; m < 4; ++m) { const int row = u.row0 + ai * 128 + wr * 64 + m * 16 + fr; const f32x4 s0 = *(const f32x4*)(ssq + (size_t)row * 8), s1 = *(const f32x4*)(ssq + (size_t)row * 8 + 4);
                const float tot = ((s0[0] + s0[1]) + (s0[2] + s0[3])) + ((s1[0] + s1[1]) + (s1[2] + s1[3])); const float rstd = 1.0f / sqrtf(tot * (1.f / D) + EPS);
                f32x4 r0, r1, g0, g1;
#pragma unroll
                for (int j = 0; j < 4; ++j) { const float a0 = sigmoidf_(acc[ai][0][m][0][j] + ba0[j]), a1 = sigmoidf_(acc[ai][0][m][1][j] + ba1[j]);
                    g0[j] = fmaxf(sigmoidf_(acc[ai][1][m][0][j] + bb0[j]), 1e-20f); g1[j] = fmaxf(sigmoidf_(acc[ai][1][m][1][j] + bb1[j]), 1e-20f);
                    r0[j] = a0 * rstd * __builtin_amdgcn_rcpf(g0[j]); r1[j] = a1 * rstd * __builtin_amdgcn_rcpf(g1[j]); }
                *(v4u*)(Gt + (size_t)row * 4096 + j0) = pack8(r0, r1); *(v4u*)(Gt + (size_t)row * 4096 + 2048 + j0) = pack8(g0, g1); }
    }
};
struct EpiGlu {
    const bf16* V; bf16* YV;
    __device__ __forceinline__ void operator()(const f32x4 (&acc)[2][2][4][2], const Unit& u, int wr, int wc, int fr, int fq) const {
        EPI_BEGIN const size_t o = (size_t)(u.row0 + r) * S5W + u.col0 + c; float vv[8]; unpack8(*(const v4u*)(V + o), vv); f32x4 a, b;
#pragma unroll
            for (int j = 0; j < 4; ++j) { a[j] = vv[j] * sigmoidf_(v0[j]); b[j] = vv[4 + j] * sigmoidf_(v1[j]); }
            *(v4u*)(YV + (size_t)(u.row0 + r) * YVP + 2048 + u.col0 + c) = pack8(a, b); EPI_END
    }
};
struct EpiAB {
    const bf16* Gt; bf16* MG;
    __device__ __forceinline__ void mid(f32x4 (&acc)[2][2][4][2], const Unit& u, int wr, int wc, int fr, int fq) const {
        unsigned base = (unsigned)((u.row0 + wr * 64 + fr) * 4096 + u.col0 + wc * 32 + 8 * fq) * 2u;
        asm volatile("" : "+v"(base));
        const char* gp = (const char*)Gt;
#pragma unroll
        for (int ai = 0; ai < 2; ++ai)
#pragma unroll
            for (int m = 0; m < 4; ++m)
#pragma unroll
                for (int bj = 0; bj < 2; ++bj) { float rr[8]; unpack8(*(const v4u*)(gp + (size_t)(base + (unsigned)((ai * 128 + m * 16) * 4096 + bj * 128) * 2u)), rr);
#pragma unroll
                    for (int j = 0; j < 4; ++j) { acc[ai][bj][m][0][j] *= rr[j]; acc[ai][bj][m][1][j] *= rr[4 + j]; } }
    }
    __device__ __forceinline__ void operator()(const f32x4 (&acc)[2][2][4][2], const Unit& u, int wr, int wc, int fr, int fq) const {
        EPI_BEGIN const int row = u.row0 + r, col = u.col0 + c; float gg[8]; unpack8(*(const v4u*)(Gt + (size_t)row * 4096 + 2048 + col), gg); f32x4 a, b;
#pragma unroll
            for (int j = 0; j < 4; ++j) { a[j] = gg[j] * v0[j]; b[j] = gg[4 + j] * v1[j]; }
            *(v4u*)(MG + (size_t)row * D + col) = pack8(a, b); EPI_END
    }
};
struct EpiOut {
    bf16* XD;
    __device__ __forceinline__ void operator()(const f32x4 (&acc)[2][2][4][2], const Unit& u, int wr, int wc, int fr, int fq) const {
        EPI_BEGIN *(v4u*)(XD + (size_t)(u.row0 + r) * D + u.col0 + c) = pack8(v0, v1); EPI_END
    }
};
struct EpiGU {
    bf16* HID; const unsigned* list_tok; const float* rstd2;
    __device__ __forceinline__ void operator()(const f32x4 (&acc)[2][2][4][2], const Unit& u, int wr, int wc, int fr, int fq) const {
#pragma unroll
        for (int ai = 0; ai < 2; ++ai)
#pragma unroll
            for (int m = 0; m < 4; ++m) { const int r = ai * 128 + wr * 64 + m * 16 + fr; if (r < u.nvalid) { const float sc = rstd2[(size_t)u.e * CAPL + u.slot0 + r]; f32x4 a, b;
#pragma unroll
                for (int j = 0; j < 4; ++j) { a[j] = siluf_(sc * acc[ai][0][m][0][j]) * (sc * acc[ai][1][m][0][j]); b[j] = siluf_(sc * acc[ai][0][m][1][j]) * (sc * acc[ai][1][m][1][j]); }
                { v2u o8; o8.x = pk4_fp8(a[0] * HID_SCALE, a[1] * HID_SCALE, a[2] * HID_SCALE, a[3] * HID_SCALE); o8.y = pk4_fp8(b[0] * HID_SCALE, b[1] * HID_SCALE, b[2] * HID_SCALE, b[3] * HID_SCALE);
                  *(v2u*)((unsigned char*)HID + (size_t)(u.row0 + r) * FF + u.col0 + wc * 32 + 8 * fq) = o8; } } }
    }
};
constexpr float Y_SCALE = 16.f;
struct EpiDn {
    const float* list_w; unsigned char* Y;
    __device__ __forceinline__ void operator()(const f32x4 (&acc)[2][2][4][2], const Unit& u, int wr, int wc, int fr, int fq) const {
        const float* wp = list_w + (unsigned)(u.e * CAPL + u.slot0 + wr * 64 + fr);
#pragma unroll
        for (int ai = 0; ai < 2; ++ai)
#pragma unroll
            for (int m = 0; m < 4; ++m) { const int r = ai * 128 + wr * 64 + m * 16 + fr; const float w = wp[ai * 128 + m * 16] * Y_SCALE;
#pragma unroll
                for (int bj = 0; bj < 2; ++bj) { const int col = u.col0 + bj * 128 + wc * 32 + 8 * fq; const f32x4 a = acc[ai][bj][m][0] * w, b = acc[ai][bj][m][1] * w;
                    v2u o; o.x = pk4_fp8(a[0], a[1], a[2], a[3]); o.y = pk4_fp8(b[0], b[1], b[2], b[3]); if (r < u.nvalid) *(v2u*)(Y + (size_t)(u.row0 + r) * D + col) = o; } }
    }
};

__device__ __forceinline__ void dt_gemm(const Args& a, const Ctx& F) {
    const bf16* Hb = (const bf16*)(PWS + WS_H); const bf16* Wd = (const bf16*)(PWS + WS_WIN) + (size_t)11264 * D; float* DT = (float*)(PWS + WS_DT);
    LAS float* part = (LAS float*)F.lds;
    const int r = F.lane & 31, hh = F.lane >> 5;
    for (int unit = F.vcu; unit < T / 64; unit += F.G) {
        const int r0 = unit * 64; f32x16 acc0, acc1;
#pragma unroll
        for (int j = 0; j < 16; ++j) { acc0[j] = 0.f; acc1[j] = 0.f; }
#pragma unroll 4
        for (int ks = 0; ks < 16; ++ks) { const int k = F.wave * 256 + ks * 16 + hh * 8;
            const bf16x8 a0 = *(const bf16x8*)(Hb + (size_t)(r0 + r) * D + k), a1 = *(const bf16x8*)(Hb + (size_t)(r0 + 32 + r) * D + k), b = *(const bf16x8*)(Wd + (size_t)r * D + k);
            acc0 = __builtin_amdgcn_mfma_f32_32x32x16_bf16(a0, b, acc0, 0, 0, 0); acc1 = __builtin_amdgcn_mfma_f32_32x32x16_bf16(a1, b, acc1, 0, 0, 0); }
#pragma unroll
        for (int j = 0; j < 16; ++j) { part[((F.wave * 2 + 0) * 16 + j) * 64 + F.lane] = acc0[j]; part[((F.wave * 2 + 1) * 16 + j) * 64 + F.lane] = acc1[j]; }
        __syncthreads();
        for (int o = F.tid; o < 2048; o += 512) { const int row = o >> 5, col = o & 31; const int i = row >> 5, rr = row & 31, h2 = (rr >> 2) & 1, reg = (rr & 3) + 4 * (rr >> 3), ln = col + 32 * h2; float s = 0.f;
#pragma unroll
            for (int w = 0; w < 8; ++w) s += part[((w * 2 + i) * 16 + reg) * 64 + ln];
            s += PIN(I_DTB)[col]; DT[(size_t)(r0 + row) * 32 + col] = s > 20.f ? s : log1pf(expf(s)); }
        __syncthreads();
    }
}

constexpr int SEGC = 8, NSEG = NCHK / SEGC;
constexpr int SQ_XT = 0;
constexpr int SQ_BC = 36864;
constexpr int SQ_BT = SQ_BC + 17408;
constexpr int SQ_CC = SQ_BT + 18432;
constexpr int SQ_DT = SQ_CC + 17408;
constexpr int SQ_Y = SQ_DT + 4352;
constexpr int SQ_W = SQ_Y + 33792;
static_assert(SQ_W + 10240 <= LDSCTL_OFF, "SSD (sequential) LDS map");

template <int NTOK>
__device__ __forceinline__ void conv_pair(const LAS float* wl, int lc, const v4u (&rawv)[NTOK + 3], int d, float (&o)[NTOK][2]) {
    f32x2 w[4]; const f32x2 bias = *(const LAS f32x2*)(wl + 4 * 512 + lc);
#pragma unroll
    for (int k = 0; k < 4; ++k) w[k] = *(const LAS f32x2*)(wl + k * 512 + lc);
#pragma unroll
    for (int tt = 0; tt < NTOK; ++tt) { float s0 = bias[0], s1 = bias[1];
#pragma unroll
        for (int k = 0; k < 4; ++k) { const unsigned uu = rawv[tt + k][d]; s0 += w[k][0] * bflo(uu); s1 += w[k][1] * bfhi(uu); }
        o[tt][0] = siluf_(s0); o[tt][1] = siluf_(s1); }
}
template <bool SCALE>
__device__ __forceinline__ void conv_xs_to_lds(const LAS float* wl, int lc, const v4u (&rx)[7], LAS bf16* dst  , const f32x4 sc) {
#pragma unroll
    for (int d = 0; d < 4; ++d) { float o[4][2]; conv_pair<4>(wl, lc + 2 * d, rx, d, o);
        if constexpr (SCALE) {
#pragma unroll
            for (int tt = 0; tt < 4; ++tt) { o[tt][0] *= sc[tt]; o[tt][1] *= sc[tt]; } }
        v2u w0, w1; w0.x = pk2(o[0][0], o[1][0]); w0.y = pk2(o[2][0], o[3][0]); w1.x = pk2(o[0][1], o[1][1]); w1.y = pk2(o[2][1], o[3][1]);
        *(LAS v2u*)(dst + (2 * d) * 72) = w0; *(LAS v2u*)(dst + (2 * d + 1) * 72) = w1; }
}
template <bool NAT, bool TR>
__device__ __forceinline__ void conv_bc_to_lds(const LAS float* wl, int lc, const v4u (&rb)[5], LAS bf16* nat, LAS bf16* tr) {
    v4u n0, n1;
#pragma unroll
    for (int d = 0; d < 4; ++d) { float o[2][2]; conv_pair<2>(wl, lc + 2 * d, rb, d, o);
        if constexpr (NAT) { n0[d] = pk2(o[0][0], o[0][1]); n1[d] = pk2(o[1][0], o[1][1]); }
        if constexpr (TR) { *(LAS unsigned*)(tr + (2 * d) * 72) = pk2(o[0][0], o[1][0]); *(LAS unsigned*)(tr + (2 * d + 1) * 72) = pk2(o[0][1], o[1][1]); } }
    if constexpr (NAT) { *(LAS v4u*)nat = n0; *(LAS v4u*)(nat + 136) = n1; }
}
__device__ __forceinline__ void conv_weights_to_lds(const Args& a, const Ctx& F, int g) {
    LAS float* wl = (LAS float*)(F.lds + SQ_W);
    for (int i = F.tid; i < 5 * 512; i += NWAVES * 64) { const int k = i >> 9, lc = i & 511; const int ch = lc < 256 ? g * 256 + lc : (lc < 384 ? 2048 + g * 128 + (lc - 256) : 3072 + g * 128 + (lc - 384));
        wl[i] = k < 4 ? PIN(I_CONVW)[k * XBCD + ch] : PIN(I_CONVB)[ch]; }
    __syncthreads();
}
template <int NR>
__device__ __forceinline__ void rows_load(const unsigned char* ws, unsigned off, int t0, v4u (&raw)[NR]) {
#pragma unroll
    for (int i = 0; i < NR; ++i) { v4u v = (v4u){0u, 0u, 0u, 0u}; if (t0 + i >= 0) v = *(const v4u*)(ws + (size_t)(off + (unsigned)i * (XBCD * 2))); raw[i] = v; }
}

__device__ __forceinline__ float seq_dt_setup(const Args& a, const Ctx& F, int g, float dtv, int buf) {
    LAS float* dts = (LAS float*)(F.lds + SQ_DT); LAS float* acs = dts + 256; LAS float* wsc = dts + 512; LAS float* eacs = dts + 768; LAS float* cdec = dts + 1024;
    float tot = 0.f;
    if (F.wave < 4) { const int hd = 4 * g + F.wave; const float av = -expf(PIN(I_ALOG)[hd]);
        float s = dtv * av;
#pragma unroll
        for (int o = 1; o < 64; o <<= 1) { const float t = __shfl_up(s, o); if (F.lane >= o) s += t; }
        tot = __shfl(s, 63);
        dts[F.wave * 64 + F.lane] = dtv; acs[F.wave * 64 + F.lane] = s; wsc[F.wave * 64 + F.lane] = dtv * __expf(tot - s); eacs[F.wave * 64 + F.lane] = __expf(s);
        if (F.lane == 63) cdec[buf * 4 + F.wave] = __expf(tot); }
    return tot;
}
__device__ __forceinline__ bf16x8 pack_frag(const f32x16& X, int kk) { v4u w; w.x = pk2(X[8 * kk], X[8 * kk + 1]); w.y = pk2(X[8 * kk + 2], X[8 * kk + 3]); w.z = pk2(X[8 * kk + 4], X[8 * kk + 5]); w.w = pk2(X[8 * kk + 6], X[8 * kk + 7]); return __builtin_bit_cast(bf16x8, w); }
__device__ __forceinline__ void seq_state_update(const Ctx& F, f32x16 (&acc)[4], int hd, int pt, float cd) {
    const LAS bf16* xT = (const LAS bf16*)(F.lds + SQ_XT); const LAS bf16* Bt = (const LAS bf16*)(F.lds + SQ_BT); const LAS float* wsc = (const LAS float*)(F.lds + SQ_DT) + 512;
    const int r = F.lane & 31, hh = F.lane >> 5;
#pragma unroll
    for (int i = 0; i < 4; ++i) acc[i] = acc[i] * cd;
#pragma unroll
    for (int ks = 0; ks < 4; ++ks) { const v4u xw = *(const LAS v4u*)(xT + (hd * 64 + 32 * pt + r) * 72 + 16 * ks + 8 * hh); float xv[8]; unpack8(xw, xv);
        const f32x4 w0 = *(const LAS f32x4*)(wsc + hd * 64 + 16 * ks + 8 * hh), w1 = *(const LAS f32x4*)(wsc + hd * 64 + 16 * ks + 8 * hh + 4);
        v4u sw; sw.x = pk2(xv[0] * w0[0], xv[1] * w0[1]); sw.y = pk2(xv[2] * w0[2], xv[3] * w0[3]); sw.z = pk2(xv[4] * w1[0], xv[5] * w1[1]); sw.w = pk2(xv[6] * w1[2], xv[7] * w1[3]);
        const bf16x8 bfr = __builtin_bit_cast(bf16x8, sw);
#pragma unroll
        for (int i = 0; i < 4; ++i) { const bf16x8 afr = *(const LAS bf16x8*)(Bt + (32 * i + r) * 72 + 16 * ks + 8 * hh); acc[i] = __builtin_amdgcn_mfma_f32_32x32x16_bf16(afr, bfr, acc[i], 0, 0, 0); }
        if (ks & 1) __builtin_amdgcn_sched_barrier(0); }
}
__device__ __forceinline__ size_t seg_state_off(int g, int seg, int hd) { return ((size_t)(g * NSEG + seg) * 4 + hd) * 8192; }

__device__ __forceinline__ void ssd_pass_a(const Args& a, const Ctx& F) {
    LAS bf16* xT = (LAS bf16*)(F.lds + SQ_XT); LAS bf16* Bt = (LAS bf16*)(F.lds + SQ_BT); const LAS float* cdec = (const LAS float*)(F.lds + SQ_DT) + 1024; const LAS float* wl = (const LAS float*)(F.lds + SQ_W);
    for (int u = F.vcu; u < NGRP * NSEG; u += F.G) {
        const int g = u >> 5, seg = u & 31; const int hd = F.wave >> 1, pt = F.wave & 1, r = F.lane & 31, hh = F.lane >> 5;
        const int cgx = F.tid >> 4, l0x = (F.tid & 15) * 4, cgb = F.tid >> 5, l0b = (F.tid & 31) * 2;
        conv_weights_to_lds(a, F, g);
        f32x16 acc[4];
#pragma unroll
        for (int i = 0; i < 4; ++i)
#pragma unroll
            for (int j = 0; j < 16; ++j) acc[i][j] = 0.f;
        float totsum = 0.f;
        const int t0 = seg * SEGC * CHK;
        const unsigned char* wsb = PWS;
        unsigned ox = (unsigned)(WS_XBC + ((size_t)(t0 + l0x) * XBCD + g * 256 + cgx * 8) * 2 - 3 * XBCD * 2);
        unsigned ob = (unsigned)(WS_XBC + ((size_t)(t0 + l0b) * XBCD + 2048 + g * 128 + cgb * 8) * 2 - 3 * XBCD * 2);
        unsigned odt = (unsigned)(WS_DT + ((size_t)(t0 + F.lane) * 32 + 4 * g + (F.wave & 3)) * 4);
        v4u rx[7];
        rows_load<7>(wsb, ox, t0 + l0x - 3, rx);
        float dtv = *(const float*)(wsb + odt);
#pragma unroll 1
        for (int k = 0; k < SEGC; ++k) {
            v4u rb[5];
            rows_load<5>(wsb, ob, t0 + k * CHK + l0b - 3, rb);
            totsum += seq_dt_setup(a, F, g, dtv, k & 1);
            { const int hx = cgx >> 3, p0 = (cgx & 7) * 8;
              conv_xs_to_lds<false>(wl, cgx * 8, rx, xT + (hx * 64 + p0) * 72 + l0x, (f32x4){1.f, 1.f, 1.f, 1.f});
              conv_bc_to_lds<false, true>(wl, 256 + cgb * 8, rb, Bt, Bt + (cgb * 8) * 72 + l0b); }
            ox += CHK * XBCD * 2; ob += CHK * XBCD * 2; odt += CHK * 32 * 4;
            if (k + 1 < SEGC) { rows_load<7>(wsb, ox, 0, rx); dtv = *(const float*)(wsb + odt); }
            __syncthreads();
            seq_state_update(F, acc, hd, pt, cdec[(k & 1) * 4 + hd]);
            __syncthreads();
        }
        bf16* st = (bf16*)(PWS + WS_ST) + seg_state_off(g, seg, hd); const int p = 32 * pt + r;
#pragma unroll
        for (int i = 0; i < 4; ++i)
#pragma unroll
            for (int q = 0; q < 4; ++q) { v2u w; w.x = pk2(acc[i][4 * q], acc[i][4 * q + 1]); w.y = pk2(acc[i][4 * q + 2], acc[i][4 * q + 3]); *(v2u*)(st + ((4 * i + q) * 64 + p) * 8 + 4 * hh) = w; }
        if (F.wave < 4 && F.lane == 63) ((float*)(PWS + WS_MISC + 768 * 1024))[(g * NSEG + seg) * 4 + F.wave] = __expf(totsum);
        __syncthreads();
    }
}

__device__ __forceinline__ void ssd_pass_b(const Args& a, const Ctx& F) {
    LAS bf16* xT = (LAS bf16*)(F.lds + SQ_XT); LAS bf16* Bc = (LAS bf16*)(F.lds + SQ_BC); LAS bf16* Bt = (LAS bf16*)(F.lds + SQ_BT); LAS bf16* Cc = (LAS bf16*)(F.lds + SQ_CC);
    LAS float* dts = (LAS float*)(F.lds + SQ_DT); LAS float* acs = dts + 256; LAS float* eacs = dts + 768; const LAS float* cdec = dts + 1024; LAS bf16* yb = (LAS bf16*)(F.lds + SQ_Y); const LAS float* wl = (const LAS float*)(F.lds + SQ_W);
    for (int u = F.vcu; u < NGRP * NSEG; u += F.G) {
        const int g = u >> 5, seg = u & 31; const int hd = F.wave >> 1, pt = F.wave & 1, r = F.lane & 31, hh = F.lane >> 5, head = 4 * g + hd;
        const int cgx = F.tid >> 4, l0x = (F.tid & 15) * 4, cgb = F.tid >> 5, l0b = (F.tid & 31) * 2;
        conv_weights_to_lds(a, F, g);
        f32x16 acc[4];
        { const bf16* st = (const bf16*)(PWS + WS_ST) + seg_state_off(g, seg, hd); const int p = 32 * pt + r;
#pragma unroll
          for (int i = 0; i < 4; ++i)
#pragma unroll
              for (int q = 0; q < 4; ++q) { const v2u w = *(const v2u*)(st + ((4 * i + q) * 64 + p) * 8 + 4 * hh); acc[i][4 * q] = bflo(w.x); acc[i][4 * q + 1] = bfhi(w.x); acc[i][4 * q + 2] = bflo(w.y); acc[i][4 * q + 3] = bfhi(w.y); } }
        const float dsk = PIN(I_DSSD)[head];
        const int t0 = seg * SEGC * CHK;
        unsigned char* wsb = PWS;
        unsigned ox = (unsigned)(WS_XBC + ((size_t)(t0 + l0x) * XBCD + g * 256 + cgx * 8) * 2 - 3 * XBCD * 2);
        unsigned ob = (unsigned)(WS_XBC + ((size_t)(t0 + l0b) * XBCD + 2048 + g * 128 + cgb * 8) * 2 - 3 * XBCD * 2);
        unsigned odt = (unsigned)(WS_DT + ((size_t)(t0 + F.lane) * 32 + 4 * g + (F.wave & 3)) * 4);
        const int gcx = F.tid & 31;
        unsigned oz = (unsigned)(WS_YV + ((size_t)(t0 + (F.tid >> 5) * 4) * YVP + g * 256 + gcx * 8) * 2);
        unsigned oss = (unsigned)(WS_MISC + ((size_t)(t0 + (F.tid >> 5) * 4) * 8 + g) * 4);
#pragma unroll 1
        for (int k = 0; k < SEGC; ++k) {
            v4u rx[7], rb[5], rc[5];
            const float dtv = *(const float*)(wsb + odt);
            rows_load<7>(wsb, ox, t0 + k * CHK + l0x - 3, rx); rows_load<5>(wsb, ob, t0 + k * CHK + l0b - 3, rb); rows_load<5>(wsb, ob + 2048, t0 + k * CHK + l0b - 3, rc);
            (void)seq_dt_setup(a, F, g, dtv, k & 1);
            { const int hx = cgx >> 3, p0 = (cgx & 7) * 8;
              conv_xs_to_lds<false>(wl, cgx * 8, rx, xT + (hx * 64 + p0) * 72 + l0x, (f32x4){1.f, 1.f, 1.f, 1.f});
              conv_bc_to_lds<true, true>(wl, 256 + cgb * 8, rb, Bc + l0b * 136 + cgb * 8, Bt + (cgb * 8) * 72 + l0b);
              conv_bc_to_lds<true, false>(wl, 384 + cgb * 8, rc, Cc + l0b * 136 + cgb * 8, Cc); }
            __syncthreads();
            {
                const LAS bf16* xrow = xT + (hd * 64 + 32 * pt + r) * 72; const int pcol = hd * 64 + 32 * pt + r;
#pragma unroll
                for (int lt = 0; lt < 2; ++lt) {
                    f32x16 y;
#pragma unroll
                    for (int j = 0; j < 16; ++j) y[j] = 0.f;
#pragma unroll
                    for (int i = 0; i < 4; ++i)
#pragma unroll
                        for (int kk = 0; kk < 2; ++kk) { const bf16x8 bs = pack_frag(acc[i], kk); const int nb = 32 * i + 16 * kk + 4 * hh;
                            const v2u lo = *(const LAS v2u*)(Cc + (32 * lt + r) * 136 + nb), hi = *(const LAS v2u*)(Cc + (32 * lt + r) * 136 + nb + 8); const v4u c0 = (v4u){lo.x, lo.y, hi.x, hi.y};
                            y = __builtin_amdgcn_mfma_f32_32x32x16_bf16(__builtin_bit_cast(bf16x8, c0), bs, y, 0, 0, 0); }
#pragma unroll
                    for (int q = 0; q < 4; ++q) { const f32x4 e0 = *(const LAS f32x4*)(eacs + hd * 64 + 32 * lt + 8 * q + 4 * hh);
#pragma unroll
                        for (int i = 0; i < 4; ++i) y[4 * q + i] *= e0[i]; }
                    __builtin_amdgcn_sched_barrier(0);
                    const float al = acs[hd * 64 + 32 * lt + r];
#pragma unroll
                    for (int st = 0; st <= lt; ++st) {
                        f32x16 X;
#pragma unroll
                        for (int j = 0; j < 16; ++j) X[j] = 0.f;
#pragma unroll
                        for (int ks = 0; ks < 8; ++ks) { const int ko = 16 * ks + 8 * hh;
                            const bf16x8 a0 = *(const LAS bf16x8*)(Bc + (32 * st + r) * 136 + ko), b0 = *(const LAS bf16x8*)(Cc + (32 * lt + r) * 136 + ko);
                            X = __builtin_amdgcn_mfma_f32_32x32x16_bf16(a0, b0, X, 0, 0, 0); }
#pragma unroll
                        for (int q = 0; q < 4; ++q) { const int sb = 8 * q + 4 * hh;
                            const f32x4 as0 = *(const LAS f32x4*)(acs + hd * 64 + 32 * st + sb), ds0 = *(const LAS f32x4*)(dts + hd * 64 + 32 * st + sb);
#pragma unroll
                            for (int i = 0; i < 4; ++i) { const int j = 4 * q + i; const float v = X[j] * __expf(al - as0[i]) * ds0[i]; X[j] = (st < lt || r >= sb + i) ? v : 0.f; } }
#pragma unroll
                        for (int kk = 0; kk < 2; ++kk) { const int sb = 32 * st + 16 * kk + 4 * hh;
                            const v2u lo = *(const LAS v2u*)(xrow + sb), hi = *(const LAS v2u*)(xrow + sb + 8); const v4u wa = (v4u){lo.x, lo.y, hi.x, hi.y};
                            y = __builtin_amdgcn_mfma_f32_32x32x16_bf16(pack_frag(X, kk), __builtin_bit_cast(bf16x8, wa), y, 0, 0, 0); }
                        __builtin_amdgcn_sched_barrier(0);
                    }
#pragma unroll
                    for (int q = 0; q < 4; ++q) { const int lb = 32 * lt + 8 * q + 4 * hh;
                        const v2u xa = *(const LAS v2u*)(xrow + lb); const float xa4[4] = {bflo(xa.x), bfhi(xa.x), bflo(xa.y), bfhi(xa.y)};
#pragma unroll
                        for (int i = 0; i < 4; ++i) yb[(lb + i) * 264 + pcol] = (bf16)f2bf(y[4 * q + i] + dsk * xa4[i]); }
                    __builtin_amdgcn_sched_barrier(0);
                }
                seq_state_update(F, acc, hd, pt, cdec[(k & 1) * 4 + hd]);
            }
            ox += CHK * XBCD * 2; ob += CHK * XBCD * 2; odt += CHK * 32 * 4;
            v4u zq[4];
#pragma unroll
            for (int i = 0; i < 4; ++i) zq[i] = *(const v4u*)(wsb + (size_t)(oz + (unsigned)i * (YVP * 2)));
            __syncthreads();
            { const float* nw = PIN(I_NSW) + g * 256 + gcx * 8; const f32x4 n0 = *(const f32x4*)nw, n1 = *(const f32x4*)(nw + 4);
#pragma unroll
              for (int i = 0; i < 4; ++i) { const int l = (F.tid >> 5) * 4 + i;
                  float zz[8], yy[8]; unpack8(zq[i], zz); unpack8(*(const LAS v4u*)(yb + l * 264 + gcx * 8), yy);
                  f32x4 g0, g1; float sq = 0.f;
#pragma unroll
                  for (int j = 0; j < 4; ++j) { g0[j] = yy[j] * zz[j]; g1[j] = yy[4 + j] * zz[4 + j]; sq += g0[j] * g0[j] + g1[j] * g1[j]; }
                  *(v4u*)(wsb + (size_t)(oz + (unsigned)i * (YVP * 2))) = pack8(g0 * n0, g1 * n1);
#pragma unroll
                  for (int o = 1; o < 32; o <<= 1) sq += __shfl_xor(sq, o);
                  if (gcx == 0) *(float*)(wsb + (size_t)(oss + (unsigned)i * 32)) = sq; } }
            oz += CHK * YVP * 2; oss += CHK * 8 * 4;
        }
        __syncthreads();
    }
}

__device__ __forceinline__ void seg_scan(const Args& a, const Ctx& F) {
    for (int it = F.vcu * NWAVES + F.wave; it < 2048; it += F.G * NWAVES) { const int gh = it >> 6, sl = it & 63, g = gh >> 2, hd = gh & 3;
        bf16* base = (bf16*)(PWS + WS_ST) + seg_state_off(g, 0, hd) + sl * 128 + F.lane * 2; const float* cd = (const float*)(PWS + WS_MISC + 768 * 1024) + (size_t)g * NSEG * 4 + hd; constexpr size_t CS = (size_t)4 * 8192;
        unsigned v[NSEG]; float d[NSEG];
#pragma unroll
        for (int j = 0; j < NSEG; ++j) { v[j] = *(const unsigned*)(base + (size_t)j * CS); d[j] = cd[j * 4]; }
        float c0 = 0.f, c1 = 0.f;
#pragma unroll
        for (int j = 0; j < NSEG; ++j) { *(unsigned*)(base + (size_t)j * CS) = pk2(c0, c1); c0 = c0 * d[j] + bflo(v[j]); c1 = c1 * d[j] + bfhi(v[j]); } }
}

__device__ __forceinline__ void scans(const Args& a, const Ctx& F) {
    if (F.vcu < S5G) {
        const int g = F.vcu, n = F.lane; const float dt = expf(PIN(I_LOGDT)[g]), lr = PIN(I_LRE)[g * 64 + n], li = PIN(I_LIM)[g * 64 + n];
        const float mag = expf(16.f * lr * dt), ang = 16.f * li * dt, ar = mag * cosf(ang), ai = mag * sinf(ang);
        const float* SLp = (const float*)(PWS + WS_SL) + ((size_t)g * S5NC + 128 * F.wave) * 128 + n; bf16* AP = (bf16*)(PWS + WS_AP) + ((size_t)g * S5NC + 128 * F.wave) * APK + 256 + n;
        LAS float* ex = (LAS float*)F.lds;
        float sr = 0.f, si = 0.f;
        for (int cb = 0; cb < 128; cb += 16) { float ra[16], ia[16];
#pragma unroll
            for (int j = 0; j < 16; ++j) { ra[j] = SLp[(size_t)(cb + j) * 128]; ia[j] = SLp[(size_t)(cb + j) * 128 + 64]; }
#pragma unroll
            for (int j = 0; j < 16; ++j) { const float nr = ar * sr - ai * si + ra[j], ni = ar * si + ai * sr + ia[j]; sr = nr; si = ni; } }
        ex[F.wave * 128 + n] = sr; ex[F.wave * 128 + 64 + n] = si;
        __syncthreads();
        float pr = ar, pi = ai;
#pragma unroll
        for (int q = 0; q < 7; ++q) { const float t = pr * pr - pi * pi; pi = 2.f * pr * pi; pr = t; }
        sr = 0.f; si = 0.f;
        for (int w = 0; w < F.wave; ++w) { const float er = ex[w * 128 + n], ei = ex[w * 128 + 64 + n]; const float nr = pr * sr - pi * si + er, ni = pr * si + pi * sr + ei; sr = nr; si = ni; }
        for (int cb = 0; cb < 128; cb += 16) { float ra[16], ia[16];
#pragma unroll
            for (int j = 0; j < 16; ++j) { ra[j] = SLp[(size_t)(cb + j) * 128]; ia[j] = SLp[(size_t)(cb + j) * 128 + 64]; }
#pragma unroll
            for (int j = 0; j < 16; ++j) { AP[(size_t)(cb + j) * APK] = (bf16)f2bf(sr); AP[(size_t)(cb + j) * APK + 64] = (bf16)f2bf(si);
                const float nr = ar * sr - ai * si + ra[j], ni = ar * si + ai * sr + ia[j]; sr = nr; si = ni; } }
        __syncthreads();
    }
    seg_scan(a, F);
}

__device__ __forceinline__ void route_unit(const Args& a, const Ctx& F, int unit, LAS float* lg  ) {
    const int t0 = unit * 16, row = F.lane & 15, kq = F.lane >> 4;
    const float* xr = PIN(I_X) + (size_t)(t0 + row) * D + 8 * kq; const bf16* xd = (const bf16*)(PWS + WS_XD) + (size_t)(t0 + row) * D + 8 * kq; unsigned char* h2 = PWS + WS_H + (size_t)(t0 + row) * D + 8 * kq;
    const float* nf = PIN(I_NFW) + 8 * kq; const bf16* wt = (const bf16*)(PWS + WS_RT) + (size_t)row * D + 8 * kq;
    f32x4 acc0 = {0.f, 0.f, 0.f, 0.f}, acc1 = acc0, acc2 = acc0; float ssq = 0.f;
#pragma unroll 4
    for (int ks = 0; ks < 64; ++ks) { const int k = 32 * ks;
        const f32x4 x0 = *(const f32x4*)(xr + k), x1 = *(const f32x4*)(xr + k + 4), g0 = *(const f32x4*)(nf + k), g1 = *(const f32x4*)(nf + k + 4); float dd[8]; unpack8(*(const v4u*)(xd + k), dd);
        f32x4 m0, m1;
#pragma unroll
        for (int j = 0; j < 4; ++j) { m0[j] = x0[j] + dd[j]; m1[j] = x1[j] + dd[4 + j]; ssq += m0[j] * m0[j] + m1[j] * m1[j]; }
        const f32x4 hq0 = m0 * g0, hq1 = m1 * g1; const v4u hv = pack8(hq0, hq1); { v2u o8; o8.x = pk4_fp8(hq0[0], hq0[1], hq0[2], hq0[3]); o8.y = pk4_fp8(hq1[0], hq1[1], hq1[2], hq1[3]); *(v2u*)(h2 + k) = o8; } const bf16x8 af = __builtin_bit_cast(bf16x8, hv);
        const bf16x8 b0h = *(const bf16x8*)(wt + k), b1h = *(const bf16x8*)(wt + (size_t)16 * D + k), b2h = *(const bf16x8*)(wt + (size_t)32 * D + k);
        const bf16x8 b0l = *(const bf16x8*)(wt + (size_t)48 * D + k), b1l = *(const bf16x8*)(wt + (size_t)64 * D + k), b2l = *(const bf16x8*)(wt + (size_t)80 * D + k);
        acc0 = __builtin_amdgcn_mfma_f32_16x16x32_bf16(af, b0h, acc0, 0, 0, 0); acc1 = __builtin_amdgcn_mfma_f32_16x16x32_bf16(af, b1h, acc1, 0, 0, 0); acc2 = __builtin_amdgcn_mfma_f32_16x16x32_bf16(af, b2h, acc2, 0, 0, 0);
        acc0 = __builtin_amdgcn_mfma_f32_16x16x32_bf16(af, b0l, acc0, 0, 0, 0); acc1 = __builtin_amdgcn_mfma_f32_16x16x32_bf16(af, b1l, acc1, 0, 0, 0); acc2 = __builtin_amdgcn_mfma_f32_16x16x32_bf16(af, b2l, acc2, 0, 0, 0); }
    ssq += __shfl_xor(ssq, 16); ssq += __shfl_xor(ssq, 32);
    const float rstd = 1.0f / sqrtf(ssq * (1.f / D) + EPS);
    if (kq == 0) ((float*)(PWS + WS_MISC + 800 * 1024))[t0 + row] = rstd;
#pragma unroll
    for (int reg = 0; reg < 4; ++reg) { const int tok = 4 * kq + reg; const float rs = __shfl(rstd, tok);
        lg[tok * 48 + row] = rs * acc0[reg]; lg[tok * 48 + 16 + row] = rs * acc1[reg]; lg[tok * 48 + 32 + row] = rs * acc2[reg]; }
    LDS_WAIT(); asm volatile("" ::: "memory");
    if (F.lane < 16) { const int tok = F.lane; const LAS float* lq = lg + tok * 48;
        unsigned* cnt = (unsigned*)(PWS + WS_CTL) + CW_CNT + a.bar_region * 4096; unsigned* list_tok = (unsigned*)(PWS + WS_LST); float* list_w = (float*)(PWS + WS_LST + 2 * MiB);
        float g4[4]; int grp = 0; float gmax;
#pragma unroll
        for (int j = 0; j < 4; ++j) g4[j] = lq[j] + PIN(I_BRG)[j];
        gmax = g4[0];
#pragma unroll
        for (int j = 1; j < 4; ++j) if (g4[j] > gmax) { gmax = g4[j]; grp = j; }
        float den = 0.f;
#pragma unroll
        for (int j = 0; j < 4; ++j) den += expf(g4[j] - gmax);
        const float pg = 1.0f / den;
        float v1 = -INFINITY, v2 = -INFINITY; int i1 = 0, i2 = 0;
        for (int j = 0; j < 8; ++j) { const float le = lq[16 + grp * 8 + j] + PIN(I_BRE2)[grp * 8 + j];
            if (le > v1) { v2 = v1; i2 = i1; v1 = le; i1 = j; } else if (le > v2) { v2 = le; i2 = j; } }
        const float e2 = expf(v2 - v1), w1 = pg / (1.0f + e2), w2 = pg * e2 / (1.0f + e2);
        const int ea = grp * 8 + i1, eb = grp * 8 + i2; const unsigned tk = (unsigned)(t0 + tok);
        float* list_r = (float*)(PWS + WS_LR); unsigned* tokslot = (unsigned*)(PWS + WS_LR + 2 * MiB);
        const unsigned s1 = atomicAdd(cnt + 64 * ea, 1u); list_tok[(size_t)ea * CAPL + s1] = tk * 2u; list_w[(size_t)ea * CAPL + s1] = w1; list_r[(size_t)ea * CAPL + s1] = rstd; tokslot[tk * 2u] = (unsigned)ea * CAPL + s1;
        const unsigned s2 = atomicAdd(cnt + 64 * eb, 1u); list_tok[(size_t)eb * CAPL + s2] = tk * 2u + 1u; list_w[(size_t)eb * CAPL + s2] = w2; list_r[(size_t)eb * CAPL + s2] = rstd; tokslot[tk * 2u + 1u] = (unsigned)eb * CAPL + s2; }
    LDS_WAIT(); asm volatile("" ::: "memory");
}
template <class Dec>
__device__ __forceinline__ void transpose_jobs_dyn(volatile LAS unsigned* ctr, int cu, int ncu, int nitems, const Dec dec, LAS float* scr, int lane) {
    auto grab = [&]() -> int { unsigned j = 0; if (lane == 0) j = __hip_atomic_fetch_add((LAS unsigned*)ctr, 1u, __ATOMIC_RELAXED, __HIP_MEMORY_SCOPE_WORKGROUP); j = __builtin_amdgcn_readfirstlane(j); return cu + (int)j * ncu; };
    int it = grab(); if (it >= nitems) return;
    TJob cur; f32x4 v[8]; dec(it, cur); tj_load(cur, lane, v);
    for (;;) { const int nx = grab(); const bool hn = nx < nitems; TJob nj = cur; f32x4 nv[8];
        if (hn) { dec(nx, nj); tj_load(nj, lane, nv); }
        tj_store(cur, lane, v, scr);
        if (!hn) break;
        cur = nj;
#pragma unroll
        for (int i = 0; i < 8; ++i) v[i] = nv[i]; }
}
template <class Dec>
__device__ __forceinline__ void transpose_jobs_queue(unsigned* gctr, int first_item, int nbatches, const Dec dec, LAS float* scr, int lane) {
    unsigned bv = 0u; if (lane == 0) bv = __hip_atomic_fetch_add(gctr, 1u, __ATOMIC_RELAXED, __HIP_MEMORY_SCOPE_AGENT);
    int b = (int)__builtin_amdgcn_readfirstlane(bv);
    while (b < nbatches) {
        unsigned nv = 0u; if (lane == 0) nv = __hip_atomic_fetch_add(gctr, 1u, __ATOMIC_RELAXED, __HIP_MEMORY_SCOPE_AGENT);
        transpose_jobs<Dec>(first_item + 8 * b, 1, first_item + 8 * b + 8, dec, scr, lane);
        b = (int)__builtin_amdgcn_readfirstlane(nv); }
}
__device__ __forceinline__ void route_phase(const Args& a, const Ctx& F) {
    if (F.wave < 4) { LAS float* lg = (LAS float*)(F.lds + 8 * 16384) + F.wave * 768;
        for (int unit = F.vcu * 4 + F.wave; unit < T / 16; unit += F.G * 4) route_unit(a, F, unit, lg); }
    { LAS float* scr = (LAS float*)(F.lds + F.wave * 16384);
      DecExp dec{PIN(I_WEG), PIN(I_WEU), PIN(I_WED), PWS};
      transpose_jobs_dyn<DecExp>(F.ctl + 76, F.vcu, F.G, 2 * DecExp::I_GU, dec, scr, F.lane); }
}
__device__ __forceinline__ void moe_tables(const Args& a, const Ctx& F) {
    if (F.tid == 0) { const unsigned* cnt = (const unsigned*)(PWS + WS_CTL) + CW_CNT + a.bar_region * 4096; unsigned rb = 0, nt = 0;
        for (int e = 0; e < NE; ++e) { const unsigned c = __hip_atomic_load(cnt + 64 * e, __ATOMIC_RELAXED, __HIP_MEMORY_SCOPE_AGENT); const unsigned tiles = (c + 255u) >> 8; F.ctl[8 + e] = c; F.ctl[40 + e] = rb;
            for (unsigned i = 0; i < tiles && nt < 160u; ++i) F.ctl[80 + nt++] = (unsigned)e; rb += tiles * 256u; }
        F.ctl[72] = nt; }
    __syncthreads();
}
__device__ __forceinline__ void final_phase(const Args& a, const Ctx& F) {
    const int lane = (int)__builtin_amdgcn_mbcnt_hi(~0u, __builtin_amdgcn_mbcnt_lo(~0u, 0u));
    const int gw = F.vcu * NWAVES + F.wave, NGW = F.G * NWAVES; const unsigned char* Y = PWS + WS_XBC; const bf16* XD = (const bf16*)(PWS + WS_XD); const unsigned* tokslot = (const unsigned*)(PWS + WS_LR + 2 * MiB);
    for (int m = gw; m < T; m += NGW) { float* orow = POUT + (size_t)m * D; const f32x4* x4 = (const f32x4*)(PIN(I_X) + (size_t)m * D) + lane; const v2u* xd = (const v2u*)(XD + (size_t)m * D) + lane;
        const unsigned ts0 = tokslot[2 * m], ts1 = tokslot[2 * m + 1];
        const size_t r0 = (size_t)F.ctl[40 + (ts0 >> 14)] + (ts0 & 16383u), r1 = (size_t)F.ctl[40 + (ts1 >> 14)] + (ts1 & 16383u);
        const unsigned* y0 = (const unsigned*)(Y + r0 * D) + lane; const unsigned* y1 = (const unsigned*)(Y + r1 * D) + lane;
        const f32x4* w4 = (const f32x4*)PIN(I_NFINAL) + lane; f32x4 v[8]; float s = 0.f;
#pragma unroll
        for (int j = 0; j < 8; ++j) { const f32x4 x = x4[64 * j]; const unsigned p = y0[64 * j], q = y1[64 * j]; const v2u d2 = xd[64 * j];
            const f32x2 p0 = __builtin_amdgcn_cvt_pk_f32_fp8((int)p, false), p1 = __builtin_amdgcn_cvt_pk_f32_fp8((int)p, true), q0 = __builtin_amdgcn_cvt_pk_f32_fp8((int)q, false), q1 = __builtin_amdgcn_cvt_pk_f32_fp8((int)q, true);
            constexpr float ys = 1.0f / Y_SCALE;
            v[j] = (f32x4){x.x + bflo(d2.x) + ys * (p0[0] + q0[0]), x.y + bfhi(d2.x) + ys * (p0[1] + q0[1]), x.z + bflo(d2.y) + ys * (p1[0] + q1[0]), x.w + bfhi(d2.y) + ys * (p1[1] + q1[1])};
            s += (v[j].x * v[j].x + v[j].y * v[j].y) + (v[j].z * v[j].z + v[j].w * v[j].w); }
        const float rstd = 1.0f / sqrtf(wave_sum(s) * (1.f / D) + EPS);
#pragma unroll
        for (int j = 0; j < 8; ++j) { const f32x4 g = w4[64 * j]; ((f32x4*)orow + lane)[64 * j] = (f32x4){v[j].x * rstd * g.x, v[j].y * rstd * g.y, v[j].z * rstd * g.z, v[j].w * rstd * g.w}; } }
}

constexpr int N_PHASES = 12;
template <int VARIANT>
__global__ void __launch_bounds__(NWAVES * 64, 2) hybrid_fwd(Args args) {
    extern __shared__ __attribute__((aligned(16))) unsigned char lds_raw[];
    Ctx F; F.lds = (LAS unsigned char*)lds_raw; F.ctl = (volatile LAS unsigned*)(F.lds + LDSCTL_OFF);
    F.tid = threadIdx.x; F.lane = F.tid & 63; F.wave = __builtin_amdgcn_readfirstlane(F.tid >> 6);
    F.G = gridDim.x; { const int bx = blockIdx.x; F.vcu = (F.G % 8 == 0) ? (bx % 8) * (F.G / 8) + bx / 8 : bx; }
    for (int u = F.tid; u < (LDS_BYTES - LDSCTL_OFF) / 4; u += NWAVES * 64) ((LAS unsigned*)(F.lds + LDSCTL_OFF))[u] = 0u;
    __syncthreads();
    if (F.tid == 0) { LAS unsigned long long* pt = (LAS unsigned long long*)(F.lds + PTAB_OFF);
        pt[0] = (unsigned long long)args.in[0];
        pt[1] = (unsigned long long)args.in[1];
        pt[2] = (unsigned long long)args.in[2];
        pt[3] = (unsigned long long)args.in[3];
        pt[4] = (unsigned long long)args.in[4];
        pt[5] = (unsigned long long)args.in[5];
        pt[6] = (unsigned long long)args.in[6];
        pt[7] = (unsigned long long)args.in[7];
        pt[8] = (unsigned long long)args.in[8];
        pt[9] = (unsigned long long)args.in[9];
        pt[10] = (unsigned long long)args.in[10];
        pt[11] = (unsigned long long)args.in[11];
        pt[12] = (unsigned long long)args.in[12];
        pt[13] = (unsigned long long)args.in[13];
        pt[14] = (unsigned long long)args.in[14];
        pt[15] = (unsigned long long)args.in[15];
        pt[16] = (unsigned long long)args.in[16];
        pt[17] = (unsigned long long)args.in[17];
        pt[18] = (unsigned long long)args.in[18];
        pt[19] = (unsigned long long)args.in[19];
        pt[20] = (unsigned long long)args.in[20];
        pt[21] = (unsigned long long)args.in[21];
        pt[22] = (unsigned long long)args.in[22];
        pt[23] = (unsigned long long)args.in[23];
        pt[24] = (unsigned long long)args.in[24];
        pt[25] = (unsigned long long)args.in[25];
        pt[26] = (unsigned long long)args.in[26];
        pt[27] = (unsigned long long)args.in[27];
        pt[28] = (unsigned long long)args.in[28];
        pt[29] = (unsigned long long)args.in[29];
        pt[30] = (unsigned long long)args.in[30];
        pt[31] = (unsigned long long)args.out; pt[32] = (unsigned long long)args.ws; }
    __syncthreads();
    const unsigned mask = args.mask; const int lastp = 31 - __builtin_clz(mask | 1u);
    if (__builtin_popcount(mask) > 1) (void)xcd_barrier_post((unsigned*)(PWS + WS_CTL) + CW_BAR + args.bar_region * XCD_BAR_WORDS, F.ctl);
#define IN(k) (((mask >> (k)) & 1u) && (F.lane = (int)__builtin_amdgcn_mbcnt_hi(~0u, __builtin_amdgcn_mbcnt_lo(~0u, 0u)), F.tid = F.wave * 64 + F.lane, true))
#define SEAM(k) do { if (IN(k) && (k) != lastp) { XcdBarrier bar_; bar_.bar = (unsigned*)(PWS + WS_CTL) + CW_BAR + args.bar_region * XCD_BAR_WORDS; bar_.x = xb_xcc_id(); bar_.st = F.ctl; xcd_barrier(bar_); } } while (0)
    unsigned char* ws = PWS;
    if (IN(0)) { p0_prologue(args, F); } SEAM(0);
    if (IN(1)) { SchedDense S; S.so.init(T / 256, 28, F.G, (int)blockIdx.x); S.A = (const char*)(ws + WS_H); S.B = (const char*)(ws + WS_WIN); S.lda = D * 2; S.ldb = D * 2;
        Epi1a E{(bf16*)(ws + WS_YV), (bf16*)(ws + WS_XBC), (bf16*)(ws + WS_AP)};
        pg8::gemm_phase<Epi1a, SchedDense, false>(F.lds, D, D * 2, D * 2, S, E, (VARIANT & 1) != 0);
        dt_gemm(args, F); } SEAM(1);
    if (IN(2)) { ssd_pass_a(args, F);
        SchedS5 S{(const char*)(ws + WS_AP), (const char*)(ws + WS_S5WS), 512u, F.G, F.vcu}; EpiS5a E{(float*)(ws + WS_SL)};
        pg8::gemm_phase<EpiS5a, SchedS5, false>(F.lds, 256, APK * 2, 512, S, E, (VARIANT & 1) != 0); } SEAM(2);
    if (IN(3)) { scans(args, F); } SEAM(3);
    if (IN(4)) { ssd_pass_b(args, F);
        SchedS5 S{(const char*)(ws + WS_AP), (const char*)(ws + WS_S5TW), (unsigned)(APK * 2), F.G, F.vcu}; EpiS5b E{(bf16*)(ws + WS_SL)};
        pg8::gemm_phase<EpiS5b, SchedS5, false>(F.lds, APK, APK * 2, APK * 2, S, E, (VARIANT & 1) != 0); } SEAM(4);
    if (IN(5)) { { SchedDense S; S.so.init(T / 256, 16, F.G, (int)blockIdx.x); S.A = (const char*)(ws + WS_H8); S.B = (const char*)(ws + WS_WIN) + (size_t)7168 * D * 2; S.lda = D; S.ldb = D;
          Epi1b E{(bf16*)(ws + WS_XBC), PIN(I_GATEB), (const float*)(ws + WS_MISC)};
          pg8::gemm_phase<Epi1b, SchedDense, false, true, 0, true, 127, 122>(F.lds, D, D, D, S, E, (VARIANT & 1) != 0); }
        { SchedDense S; S.so.init(T / 256, 4, F.G, (int)blockIdx.x); S.A = (const char*)(ws + WS_SL); S.B = (const char*)(ws + WS_WGLU); S.lda = S5W * 2; S.ldb = S5W * 2;
          EpiGlu E{(const bf16*)(ws + WS_SL), (bf16*)(ws + WS_YV)};
          pg8::gemm_phase<EpiGlu, SchedDense, false>(F.lds, S5W, S5W * 2, S5W * 2, S, E, (VARIANT & 1) != 0); } } SEAM(5);
    if (IN(6)) { SchedDense S; S.so.init(T / 256, 8, F.G, (int)blockIdx.x); S.A = (const char*)(ws + WS_YV); S.B = (const char*)(ws + WS_WAB); S.lda = YVP * 2; S.ldb = YVP * 2;
        EpiAB E{(const bf16*)(ws + WS_XBC), (bf16*)(ws + WS_ST)};
        pg8::gemm_phase<EpiAB, SchedDense, false, true, 32>(F.lds, YVP, YVP * 2, YVP * 2, S, E, (VARIANT & 1) != 0); } SEAM(6);
    if (IN(8)) { SchedDense S; S.so.init(T / 256, 8, F.G, (int)blockIdx.x); S.A = (const char*)(ws + WS_ST); S.B = (const char*)(ws + WS_WOUT); S.lda = D * 2; S.ldb = D * 2;
        EpiOut E{(bf16*)(ws + WS_XD)};
        pg8::gemm_phase<EpiOut, SchedDense, false>(F.lds, D, D * 2, D * 2, S, E, (VARIANT & 1) != 0); } SEAM(8);
    if (IN(9)) { route_phase(args, F); } SEAM(9);
    if (IN(10)) { moe_tables(args, F);
        SchedMoE S{F.ctl, (const char*)(ws + WS_H), (const char*)(ws + WS_ST), (const unsigned*)(ws + WS_LST), (unsigned)D, (size_t)1024 * D, (unsigned)D, 4, F.G, F.vcu, true};
        EpiGU E{(bf16*)(ws + WS_AP), (const unsigned*)(ws + WS_LST), (const float*)(ws + WS_LR)};
        pg8::gemm_phase<EpiGU, SchedMoE, true, true, 0, true, 127, 121>(F.lds, D, D, D, S, E, (VARIANT & 1) != 0);
        { LAS float* scr = (LAS float*)(F.lds + F.wave * 16384); DecExp dec{PIN(I_WEG), PIN(I_WEU), PIN(I_WED), PWS};
          transpose_jobs_queue<DecExp>((unsigned*)(ws + WS_CTL) + CW_CNT + args.bar_region * 4096 + 2560, 2 * DecExp::I_GU, DecExp::I_GU / 8, dec, scr, F.lane); } } SEAM(10);
    if (IN(11)) { moe_tables(args, F);
        SchedMoE S{F.ctl, (const char*)(ws + WS_AP), (const char*)(ws + WS_YV), (const unsigned*)(ws + WS_LST), (unsigned)FF, (size_t)D * FF, (unsigned)FF, 8, F.G, F.vcu, false};
        EpiDn E{(const float*)(ws + WS_LST + 2 * MiB), ws + WS_XBC};
        pg8::gemm_phase<EpiDn, SchedMoE, false, true, 0, true, 125, 122>(F.lds, FF, FF, FF, S, E, (VARIANT & 1) != 0); } SEAM(11);
    if (IN(12)) { moe_tables(args, F); final_phase(args, F); }
#undef IN
#undef SEAM
}

extern "C" void kernel_launch(void* const* d_in, const int* in_sizes, int n_in, void* d_out, int out_size, void* d_ws, size_t ws_size, hipStream_t stream) {
    static int grid = 0;
    if (grid == 0) {
        if (n_in != 31 || in_sizes[0] != T * D || out_size != T * D || ws_size < WS_END) { fprintf(stderr, "kernel_launch: unexpected shapes / workspace (n_in %d, ws %zu, need %zu)\n", n_in, ws_size, (size_t)WS_END); grid = -1; return; }
        int dev = 0, cus = 0;
        if (hipGetDevice(&dev) != hipSuccess || hipDeviceGetAttribute(&cus, hipDeviceAttributeMultiprocessorCount, dev) != hipSuccess) { grid = -1; return; }
        if (hipFuncSetAttribute((const void*)hybrid_fwd<0>, hipFuncAttributeMaxDynamicSharedMemorySize, LDS_BYTES) != hipSuccess) { fprintf(stderr, "kernel_launch: hipFuncSetAttribute failed\n"); grid = -1; return; }
#if defined(EXP_MASK)
        (void)hipFuncSetAttribute((const void*)hybrid_fwd<EXP_VARIANT>, hipFuncAttributeMaxDynamicSharedMemorySize, LDS_BYTES);
#endif
        int per_cu = 0;
        if (hipOccupancyMaxActiveBlocksPerMultiprocessor(&per_cu, (const void*)hybrid_fwd<0>, NWAVES * 64, LDS_BYTES) != hipSuccess || per_cu < 1) fprintf(stderr, "kernel_launch: occupancy query reports %d\n", per_cu);
        (void)hipGetLastError();
        grid = cus;
    }
    if (grid < 0) return;
    (void)hipMemsetAsync((char*)d_ws + WS_CTL, 0, CTL_ZERO_BYTES, stream);
    Args a{};
    for (int i = 0; i < 31; ++i) a.in[i] = (const float*)d_in[i];
    a.out = (float*)d_out; a.ws = (unsigned char*)d_ws;
#if defined(EXP_MASK)
    a.mask = EXP_MASK; a.variant = EXP_VARIANT; a.bar_region = 0;
    hipLaunchKernelGGL(hybrid_fwd<EXP_VARIANT>, dim3(grid), dim3(NWAVES * 64), LDS_BYTES, stream, a);
    a.mask = ((1u << (N_PHASES + 1)) - 1u) & ~(1u << 7); a.variant = 0; a.bar_region = 1;
    hipLaunchKernelGGL(hybrid_fwd<0>, dim3(grid), dim3(NWAVES * 64), LDS_BYTES, stream, a);
#elif MK_N_LAUNCHES == 1
    a.mask = ((1u << (N_PHASES + 1)) - 1u) & ~(1u << 7); a.variant = 0; a.bar_region = 0;
    hipLaunchKernelGGL(hybrid_fwd<0>, dim3(grid), dim3(NWAVES * 64), LDS_BYTES, stream, a);
#else
    for (int p = 0; p <= N_PHASES; ++p) { if (p == 7) continue; a.mask = 1u << p; a.variant = 0; a.bar_region = 0; hipLaunchKernelGGL(hybrid_fwd<0>, dim3(grid), dim3(NWAVES * 64), LDS_BYTES, stream, a); }
#endif
}
```

```cpp
#include <hip/hip_runtime.h>
#include <cstdio>
#include <cstdint>

#ifndef MK_N_LAUNCHES
#define MK_N_LAUNCHES 1
#endif
#ifndef EXP_VARIANT
#define EXP_VARIANT 0
#endif
#ifndef NAIVE_GEMM
#define NAIVE_GEMM 0
#endif

#define LAS __attribute__((address_space(3)))
#define GAS __attribute__((address_space(1)))
typedef unsigned short bf16;
typedef short bf16x8 __attribute__((ext_vector_type(8)));
typedef float f32x4 __attribute__((ext_vector_type(4)));
typedef float f32x2 __attribute__((ext_vector_type(2)));
typedef float f32x16 __attribute__((ext_vector_type(16)));
typedef unsigned v4u __attribute__((ext_vector_type(4)));
typedef unsigned v2u __attribute__((ext_vector_type(2)));
typedef GAS unsigned gu32;
typedef int v4i_ __attribute__((ext_vector_type(4)));
typedef int v8i_ __attribute__((ext_vector_type(8)));

constexpr int T = 16384, D = 2048;
constexpr int NH = 32, HP = 64, NGRP = 8, NST = 128, CHK = 64, NCHK = T / CHK;
constexpr int XBCD = 4096;
constexpr int S5W = 1024, S5G = 64, S5C = 16, S5N = 64, LS = 16, S5NC = T / LS;
constexpr int APK = 384;
constexpr int NE = 32, EPG = 8, FF = 512, CAPL = 16384;
constexpr int IN_DIM = 11296;
constexpr float EPS = 1e-6f;
constexpr int NWAVES = 8;

constexpr size_t MiB = 1u << 20;
constexpr size_t WS_CTL = 0, CTL_ZERO_BYTES = 1 * MiB;
constexpr size_t WS_WIN = 1 * MiB;
constexpr size_t WS_WAB = 46 * MiB;
constexpr size_t WS_WGLU = 58 * MiB, WS_WOUT = 80 * MiB;
constexpr size_t WS_S5WS = 60 * MiB;
constexpr size_t WS_S5TW = 68 * MiB;
constexpr size_t WS_XD = 1 * MiB;
constexpr size_t WS_H = 88 * MiB;
constexpr int YVP = 3072;
constexpr size_t WS_YV = 152 * MiB;
constexpr size_t WS_XBC = 248 * MiB;
constexpr size_t WS_ST = 376 * MiB;
constexpr size_t WS_AP = 504 * MiB;
constexpr size_t WS_DT = 552 * MiB;
constexpr size_t WS_MISC = 554 * MiB;
constexpr size_t WS_SL = 555 * MiB;
constexpr size_t WS_LST = 587 * MiB;
constexpr size_t WS_RT = 591 * MiB;
constexpr size_t WS_H8 = 592 * MiB;
constexpr size_t WS_LR = 624 * MiB;
constexpr size_t WS_END = 627 * MiB;
constexpr int CW_BAR = 4096;
constexpr int CW_CNT = 16384;

constexpr int LDS_BYTES = 163840;
constexpr int LDSCTL_OFF = 161792;

typedef __bf16 bf16x2_t __attribute__((ext_vector_type(2)));
__device__ __forceinline__ unsigned f2bf(float f) { return (unsigned)__builtin_bit_cast(unsigned short, (__bf16)f); }
__device__ __forceinline__ unsigned pk2(float lo, float hi) { const f32x2 v = {lo, hi}; const bf16x2_t b = __builtin_convertvector(v, bf16x2_t); return __builtin_bit_cast(unsigned, b); }
__device__ __forceinline__ unsigned pk4_fp8(float a, float b, float c, float d) { unsigned w = 0u; w = (unsigned)__builtin_amdgcn_cvt_pk_fp8_f32(a, b, (int)w, false); w = (unsigned)__builtin_amdgcn_cvt_pk_fp8_f32(c, d, (int)w, true); return w; }
__device__ __forceinline__ float bflo(unsigned w) { return __builtin_bit_cast(float, w << 16); }
__device__ __forceinline__ float bfhi(unsigned w) { return __builtin_bit_cast(float, w & 0xffff0000u); }
__device__ __forceinline__ float bf2f(bf16 h) { return __builtin_bit_cast(float, (unsigned)h << 16); }
__device__ __forceinline__ float wave_sum(float v) {
#pragma unroll
    for (int o = 1; o < 64; o <<= 1) v += __shfl_xor(v, o);
    return v;
}
__device__ __forceinline__ float sigmoidf_(float x) { return __builtin_amdgcn_rcpf(1.0f + __builtin_amdgcn_exp2f(-1.4426950408889634f * x)); }
__device__ __forceinline__ float siluf_(float x) { return x * __builtin_amdgcn_rcpf(1.0f + __builtin_amdgcn_exp2f(-1.4426950408889634f * x)); }
__device__ __forceinline__ float gelu_tanh(float x) { const float u = 0.7978845608028654f * (x + 0.044715f * x * x * x); return x * __builtin_amdgcn_rcpf(1.0f + __builtin_amdgcn_exp2f(-2.8853900817779268f * u)); }
#define LDS_WAIT() asm volatile("s_waitcnt lgkmcnt(0)" ::: "memory")
#define VM_WAIT() asm volatile("s_waitcnt vmcnt(0)" ::: "memory")

namespace pg8 {
constexpr int BM = 256, BK = 64, HALF = 128, HTB = HALF * BK * 2, STAGE_BYTES = 8 * HTB, NXCD = 8, WGM = 8;
__host__ __device__ __forceinline__ int lds_byte(int r, int c) { const int st = (r >> 4) * 2 + (c >> 5), rr = r & 15, cc = c & 31, ob = rr * 64 + cc * 2; return st * 1024 + (ob ^ (((ob >> 9) & 1) << 5)); }
__host__ __device__ __forceinline__ void stage_rc(int b, int& R, int& C) { const int st = b / 1024, sb = b % 1024, swz = sb ^ (((sb >> 9) & 1) << 5); R = (st >> 1) * 16 + swz / 64; C = (st & 1) * 32 + (swz % 64) / 2; }
__host__ __device__ __forceinline__ int perm32(int rho) { const int n = rho >> 4, i = rho & 15; return 8 * (i >> 2) + 4 * n + (i & 3); }

struct Unit { const char* A; const char* B; int row0, col0, e, nvalid, slot0; };

struct StaticOrder {
    int nM, nN, nwg, G, c;
    __device__ void init(int nM_, int nN_, int G_, int c_) { nM = nM_; nN = nN_; nwg = nM * nN; G = G_; c = c_; }
    __device__ bool next(int i, int& pm, int& pn) const {
        const long L = (long)i * G + c; if (L >= nwg) return false;
        int wgid = (int)L; { const int q = nwg / NXCD, r = nwg % NXCD, xcd = wgid % NXCD, off = wgid / NXCD; wgid = (xcd < r ? xcd * (q + 1) : r * (q + 1) + (xcd - r) * q) + off; }
        const int nig = WGM * nN, gid = wgid / nig, fm = gid * WGM, gsz = (nM - fm) < WGM ? (nM - fm) : WGM;
        pm = fm + ((wgid % nig) % gsz); pn = (wgid % nig) / gsz; return true;
    }
};

#if !NAIVE_GEMM
template <class Epi, class Sched, bool GATHER, bool SP2 = true, int MIDT = 0, bool FP8 = false, int SCA = 127, int SCB = 127>
__device__ __forceinline__ void gemm_phase(LAS unsigned char* lds, const int K, const unsigned lda, const unsigned ldb, const Sched& S, const Epi& E, const bool noepi = false) {
    const int tid = threadIdx.x, wid = __builtin_amdgcn_readfirstlane(tid >> 6), lane = tid & 63, wr = wid >> 2, wc = wid & 3, fr = lane & 15, fq = lane >> 4;
    const int nt = FP8 ? K / 128 : K / BK;
    unsigned voffA[2], voffB[2]; int gC0 = 0;
#pragma unroll
    for (int i = 0; i < 2; ++i) { int R, C; stage_rc(tid * 16 + i * 8192, R, C); const int Rb = (R & ~31) + perm32(R & 31);
        voffA[i] = (unsigned)R * lda + (unsigned)C * 2u; voffB[i] = (unsigned)Rb * ldb + (unsigned)C * 2u; if (i == 0) gC0 = C * 2; }
    const size_t kstep = (size_t)(BK * 2);
    const size_t hstepA = (size_t)HALF * lda, hstepB = (size_t)HALF * ldb;
    const unsigned ldsw = (unsigned)wid * 1024u;
    const int aoff = lds_byte(wr * 64 + fr, fq * 8), boff = lds_byte(wc * 32 + fr, fq * 8);
    constexpr int PIECE1 = 1024;
    unsigned gcur[2], gnxt[2];
    int scav = SCA, scbv = SCB;
    if constexpr (FP8) { asm volatile("" : "+v"(scav), "+v"(scbv)); }
#define PG8_SA(b, h) (((b) * 2 + (h)) * HTB)
#define PG8_SB(b, h) ((4 + (b) * 2 + (h)) * HTB)
#define PG8_GLDS(gptr, bufoff, i) __builtin_amdgcn_global_load_lds((const unsigned*)(gptr), (LAS unsigned*)(lds + (bufoff) + ldsw + (i) * 8192), 16, 0, 0)
#define PG8_STAGEB(bufoff, gbase) do { _Pragma("unroll") for (int _i = 0; _i < 2; ++_i) PG8_GLDS((const char*)(gbase) + voffB[0] + (size_t)(_i * 64) * ldb, bufoff, _i); } while (0)
#define PG8_STAGEA(bufoff, gbase, h, nx) do { _Pragma("unroll") for (int _i = 0; _i < 2; ++_i) { \
        const unsigned _pk = (nx) ? gnxt[h] : gcur[h]; const size_t _o = GATHER ? (size_t)((_i ? (_pk >> 16) : (_pk & 0xffffu)) * lda + (unsigned)gC0) : (size_t)voffA[0] + (size_t)(_i * 64) * lda + (size_t)(h) * hstepA; PG8_GLDS((const char*)(gbase) + _o, bufoff, _i); } } while (0)
#define PG8_LD16(off) (*(const LAS v4i_*)(lds + (off)))
#define PG8_LDA(dst, b, h) do { _Pragma("unroll") for (int m = 0; m < 4; ++m) { const v4i_ _lo = PG8_LD16(PG8_SA(b, h) + aoff + m * 2048), _hi = PG8_LD16(PG8_SA(b, h) + aoff + PIECE1 + m * 2048); \
        if constexpr (FP8) dst##8[m] = __builtin_shufflevector(_lo, _hi, 0, 1, 2, 3, 4, 5, 6, 7); else { dst##4[m][0] = _lo; dst##4[m][1] = _hi; } } } while (0)
#define PG8_LDB(dst, b, h) do { _Pragma("unroll") for (int n = 0; n < 2; ++n) { const v4i_ _lo = PG8_LD16(PG8_SB(b, h) + boff + n * 2048), _hi = PG8_LD16(PG8_SB(b, h) + boff + PIECE1 + n * 2048); \
        if constexpr (FP8) dst##8[n] = __builtin_shufflevector(_lo, _hi, 0, 1, 2, 3, 4, 5, 6, 7); else { dst##4[n][0] = _lo; dst##4[n][1] = _hi; } } } while (0)
#define PG8_MMA(ai, bj, At, Bt) do { __builtin_amdgcn_s_setprio(1); _Pragma("unroll") for (int m = 0; m < 4; ++m) _Pragma("unroll") for (int n = 0; n < 2; ++n) { \
        if constexpr (FP8) { asm volatile("v_mfma_scale_f32_16x16x128_f8f6f4 %0, %1, %2, %0, %3, %4 op_sel_hi:[0,0,0]" : "+v"(acc[ai][bj][m][n]) : "v"(Bt##8[n]), "v"(At##8[m]), "v"(scbv), "v"(scav)); } \
        else { _Pragma("unroll") for (int k = 0; k < 2; ++k) acc[ai][bj][m][n] = __builtin_amdgcn_mfma_f32_16x16x32_bf16(__builtin_bit_cast(bf16x8, Bt##4[n][k]), __builtin_bit_cast(bf16x8, At##4[m][k]), acc[ai][bj][m][n], 0, 0, 0); } } \
        __builtin_amdgcn_s_setprio(0); } while (0)
#define PG8_WAIT_V(n) asm volatile("s_waitcnt vmcnt(" #n ")" ::: "memory")
#define PG8_WAIT_L(n) asm volatile("s_waitcnt lgkmcnt(" #n ")" ::: "memory")
#define PG8_BAR __builtin_amdgcn_s_barrier()
#define PG8_SCHED __builtin_amdgcn_sched_barrier(0)
#define PG8_GOFFS(dst, u) do { if constexpr (GATHER) { int _r0, _r1, _c; stage_rc(tid * 16, _r0, _c); stage_rc(tid * 16 + 8192, _r1, _c); _Pragma("unroll") for (int _h = 0; _h < 2; ++_h) dst[_h] = S.row_idx(u, _h * HALF + _r0) | (S.row_idx(u, _h * HALF + _r1) << 16); } } while (0)
    Unit cur, nxt; int ui = 0;
    if (!S.next(0, cur)) return;
    f32x4 acc[2][2][4][2];
#pragma unroll
    for (int a = 0; a < 2; ++a)
#pragma unroll
        for (int b = 0; b < 2; ++b)
#pragma unroll
            for (int m = 0; m < 4; ++m)
#pragma unroll
                for (int n = 0; n < 2; ++n) acc[a][b][m][n] = (f32x4){0.f, 0.f, 0.f, 0.f};
    v8i_ At8[4], B08[2], B18[2]; v4i_ At4[4][2], B04[2][2], B14[2][2];
    const char* cA = cur.A; const char* cB = cur.B;
#pragma unroll
    for (int h = 0; h < 2; ++h) { gcur[h] = 0u; gnxt[h] = 0u; }
    PG8_GOFFS(gcur, cur);
    if constexpr (SP2) {
    PG8_STAGEB(PG8_SB(0, 0), cB); PG8_STAGEB(PG8_SB(0, 1), cB + hstepB); PG8_STAGEA(PG8_SA(0, 0), cA, 0, false); PG8_STAGEA(PG8_SA(0, 1), cA, 1, false);
    if (wr == 1) PG8_BAR;
    PG8_WAIT_V(2); PG8_BAR;
    PG8_STAGEB(PG8_SB(1, 0), cB + kstep); PG8_STAGEA(PG8_SA(1, 0), cA + kstep, 0, false); PG8_STAGEB(PG8_SB(1, 1), cB + hstepB + kstep);
    PG8_WAIT_V(6); PG8_BAR;
    } else {
    PG8_STAGEB(PG8_SB(0, 0), cB); PG8_STAGEA(PG8_SA(0, 0), cA, 0, false); PG8_STAGEB(PG8_SB(0, 1), cB + hstepB); PG8_STAGEA(PG8_SA(0, 1), cA, 1, false);
    if (wr == 1) PG8_BAR;
    PG8_WAIT_V(4); PG8_BAR;
    PG8_STAGEB(PG8_SB(1, 0), cB + kstep); PG8_STAGEA(PG8_SA(1, 0), cA + kstep, 0, false); PG8_STAGEB(PG8_SB(1, 1), cB + hstepB + kstep);
    PG8_WAIT_V(6); PG8_BAR;
    }
    for (;;) {
        const bool has_next = S.next(ui + 1, nxt);
        const char* nA = has_next ? nxt.A : cA; const char* nB = has_next ? nxt.B : cB;
        if constexpr (GATHER) { if (has_next) { PG8_GOFFS(gnxt, nxt); } else {
            gnxt[0] = gcur[0]; gnxt[1] = gcur[1]; } }
#pragma unroll 1
        for (int t = 0; t < nt; t += 2) {
            const bool last = (t == nt - 2);
            if constexpr (MIDT > 0) { if (t == MIDT) E.mid(acc, cur, wr, wc, fr, fq); }
            const char* a1 = cA + (size_t)(t + 1) * kstep;
            const char* a2 = last ? nA : cA + (size_t)(t + 2) * kstep; const char* b2 = last ? nB : cB + (size_t)(t + 2) * kstep;
            const char* a3 = a2 + kstep; const char* b3 = b2 + kstep;
            if constexpr (SP2) {
            PG8_LDB(B0, 0, 0); PG8_LDB(B1, 0, 1); PG8_SCHED; PG8_LDA(At, 0, 0); PG8_STAGEA(PG8_SA(1, 1), a1, 1, false);
            PG8_WAIT_V(8); PG8_WAIT_L(0); PG8_BAR; PG8_MMA(0, 0, At, B0); PG8_MMA(0, 1, At, B1); PG8_BAR; PG8_SCHED;
            PG8_LDA(At, 0, 1); PG8_STAGEB(PG8_SB(0, 0), b2); PG8_STAGEB(PG8_SB(0, 1), b2 + hstepB); PG8_STAGEA(PG8_SA(0, 0), a2, 0, last);
            PG8_WAIT_V(8); PG8_WAIT_L(0); PG8_BAR; PG8_MMA(1, 0, At, B0); PG8_MMA(1, 1, At, B1); PG8_BAR; PG8_SCHED;
            PG8_LDB(B0, 1, 0); PG8_LDB(B1, 1, 1); PG8_SCHED; PG8_LDA(At, 1, 0); PG8_STAGEA(PG8_SA(0, 1), a2, 1, last);
            PG8_WAIT_V(8); PG8_WAIT_L(0); PG8_BAR; PG8_MMA(0, 0, At, B0); PG8_MMA(0, 1, At, B1); PG8_BAR; PG8_SCHED;
            PG8_LDA(At, 1, 1); PG8_STAGEB(PG8_SB(1, 0), b3); PG8_STAGEB(PG8_SB(1, 1), b3 + hstepB); PG8_STAGEA(PG8_SA(1, 0), a3, 0, last);
            PG8_WAIT_V(8); PG8_WAIT_L(0); PG8_BAR; PG8_MMA(1, 0, At, B0); PG8_MMA(1, 1, At, B1); PG8_BAR; PG8_SCHED;
            } else {
            PG8_LDB(B0, 0, 0); PG8_SCHED; PG8_LDA(At, 0, 0); PG8_STAGEA(PG8_SA(1, 1), a1, 1, false);
            PG8_WAIT_L(8); PG8_BAR; PG8_WAIT_L(0); PG8_MMA(0, 0, At, B0); PG8_BAR; PG8_SCHED;
            PG8_LDB(B1, 0, 1); PG8_STAGEB(PG8_SB(0, 0), b2);
            PG8_BAR; PG8_WAIT_L(0); PG8_MMA(0, 1, At, B1); PG8_BAR;
            PG8_LDA(At, 0, 1); PG8_STAGEA(PG8_SA(0, 0), a2, 0, last);
            PG8_BAR; PG8_WAIT_L(0); PG8_MMA(1, 0, At, B0); PG8_BAR; PG8_SCHED;
            PG8_STAGEB(PG8_SB(0, 1), b2 + hstepB);
            PG8_WAIT_V(6); PG8_BAR; PG8_MMA(1, 1, At, B1); PG8_BAR;
            PG8_LDB(B0, 1, 0); PG8_SCHED; PG8_LDA(At, 1, 0); PG8_STAGEA(PG8_SA(0, 1), a2, 1, last);
            PG8_WAIT_L(8); PG8_BAR; PG8_WAIT_L(0); PG8_MMA(0, 0, At, B0); PG8_BAR; PG8_SCHED;
            PG8_LDB(B1, 1, 1); PG8_STAGEB(PG8_SB(1, 0), b3);
            PG8_BAR; PG8_WAIT_L(0); PG8_MMA(0, 1, At, B1); PG8_BAR;
            PG8_LDA(At, 1, 1); PG8_STAGEA(PG8_SA(1, 0), a3, 0, last);
            PG8_BAR; PG8_WAIT_L(0); PG8_MMA(1, 0, At, B0); PG8_BAR; PG8_SCHED;
            PG8_STAGEB(PG8_SB(1, 1), b3 + hstepB);
            PG8_WAIT_V(6); PG8_BAR; PG8_MMA(1, 1, At, B1); PG8_BAR;
            }
        }
        if constexpr (FP8) { asm volatile("s_nop 15\n\ts_nop 15" ::: "memory"); }
        if (wr == 0) PG8_BAR;
        if (!noepi) E(acc, cur, wr, wc, fr, fq);
        else {
#pragma unroll
            for (int a = 0; a < 2; ++a)
#pragma unroll
                for (int b = 0; b < 2; ++b)
#pragma unroll
                    for (int m = 0; m < 4; ++m)
#pragma unroll
                        for (int n = 0; n < 2; ++n) asm volatile("" :: "v"(acc[a][b][m][n])); }
        if (!has_next) break;
#pragma unroll
        for (int a = 0; a < 2; ++a)
#pragma unroll
            for (int b = 0; b < 2; ++b)
#pragma unroll
                for (int m = 0; m < 4; ++m)
#pragma unroll
                    for (int n = 0; n < 2; ++n) acc[a][b][m][n] = (f32x4){0.f, 0.f, 0.f, 0.f};
        cur = nxt; cA = nA; cB = nB; ++ui;
        if constexpr (GATHER) {
            gcur[0] = gnxt[0]; gcur[1] = gnxt[1]; }
        if (wr == 1) PG8_BAR;
    }
    PG8_WAIT_V(0);
    PG8_BAR;
#undef PG8_SA
#undef PG8_SB
#undef PG8_GLDS
#undef PG8_STAGEA
#undef PG8_STAGEB
#undef PG8_LDA
#undef PG8_LDB
#undef PG8_MMA
#undef PG8_WAIT_V
#undef PG8_WAIT_L
#undef PG8_BAR
#undef PG8_SCHED
#undef PG8_GOFFS
}
#else
template <class Epi, class Sched, bool GATHER>
__device__ __forceinline__ void gemm_phase(LAS unsigned char* lds, const int K, const unsigned lda, const unsigned ldb, const Sched& S, const Epi& E, const bool noepi = false) {
    const int tid = threadIdx.x, wid = __builtin_amdgcn_readfirstlane(tid >> 6), lane = tid & 63, wr = wid >> 2, wc = wid & 3, fr = lane & 15, fq = lane >> 4;
    Unit cur;
    for (int ui = 0; S.next(ui, cur); ++ui) {
        f32x4 acc[2][2][4][2];
#pragma unroll
        for (int a = 0; a < 2; ++a)
#pragma unroll
            for (int b = 0; b < 2; ++b)
#pragma unroll
                for (int m = 0; m < 4; ++m)
#pragma unroll
                    for (int n = 0; n < 2; ++n) acc[a][b][m][n] = (f32x4){0.f, 0.f, 0.f, 0.f};
        for (int k = 0; k < K; k += 8) {
            v4u av[2][4];
#pragma unroll
            for (int ai = 0; ai < 2; ++ai)
#pragma unroll
                for (int m = 0; m < 4; ++m) { const int r = ai * 128 + wr * 64 + m * 16 + fr; const size_t ro = GATHER ? (size_t)S.row_idx(cur, r) * lda : (size_t)r * lda; av[ai][m] = *(const v4u*)(cur.A + ro + (size_t)k * 2); }
#pragma unroll
            for (int bj = 0; bj < 2; ++bj)
#pragma unroll
                for (int n = 0; n < 2; ++n)
#pragma unroll
                    for (int j = 0; j < 4; ++j) { const int c = bj * 128 + wc * 32 + 8 * fq + 4 * n + j; const v4u bv = *(const v4u*)(cur.B + (size_t)c * ldb + (size_t)k * 2);
#pragma unroll
                        for (int ai = 0; ai < 2; ++ai)
#pragma unroll
                            for (int m = 0; m < 4; ++m) { const v4u a = av[ai][m]; float s = acc[ai][bj][m][n][j];
                                s += bflo(a.x) * bflo(bv.x) + bfhi(a.x) * bfhi(bv.x); s += bflo(a.y) * bflo(bv.y) + bfhi(a.y) * bfhi(bv.y);
                                s += bflo(a.z) * bflo(bv.z) + bfhi(a.z) * bfhi(bv.z); s += bflo(a.w) * bflo(bv.w) + bfhi(a.w) * bfhi(bv.w); acc[ai][bj][m][n][j] = s; } }
        }
        E(acc, cur, wr, wc, fr, fq);
    }
    __syncthreads();
}
#endif
}
using pg8::Unit;

#define XB_TMO      128
#define XB_XCNT(j)  (256  + 64 * (j))
#define XB_XSUB(j)  (1280 + 64 * (j))
#define XB_XGEN(j)  (2304 + 64 * (j))
#define XB_TOP      3328
#define XB_TOPGEN   3392
#define XCD_BAR_WORDS 3456
#define XB_SPIN_CAP (1u << 22)
__device__ __forceinline__ unsigned xb_ld(unsigned* p)              { return __hip_atomic_load(p, __ATOMIC_RELAXED, __HIP_MEMORY_SCOPE_AGENT); }
__device__ __forceinline__ unsigned xb_add(unsigned* p, unsigned v) { return __hip_atomic_fetch_add(p, v, __ATOMIC_RELAXED, __HIP_MEMORY_SCOPE_AGENT); }
__device__ __forceinline__ unsigned xb_xcc_id() { return (unsigned)__builtin_amdgcn_s_getreg((3 << 11) | 20) & 0xFu; }
#define XB_SPIN(cond, bar) do { unsigned _sp = 0; while (cond) { __builtin_amdgcn_s_sleep(1); \
    if ((++_sp & 255u) == 0u) { if (xb_ld(&(bar)[XB_TMO])) break; if (_sp > XB_SPIN_CAP) { atomicAdd(&(bar)[XB_TMO], 1u); break; } } } } while (0)
struct XcdBarrier { unsigned* bar; unsigned x; volatile LAS unsigned* st; };
__device__ __forceinline__ XcdBarrier xcd_barrier_post(unsigned* bar, volatile LAS unsigned* st) {
    XcdBarrier b; b.bar = bar; b.x = xb_xcc_id(); b.st = st;
    if (threadIdx.x == 0) (void)xb_add(&bar[XB_XCNT(b.x)], 1u);
    return b;
}
__device__ __forceinline__ void xcd_barrier_complete(unsigned* bar, unsigned x, unsigned& nloc, unsigned& nx) {
    const unsigned G = gridDim.x * gridDim.y * gridDim.z;
    unsigned sum, cnt, mine, sp = 0u;
    for (;;) {
        sum = 0u; cnt = 0u; mine = 0u;
#pragma unroll
        for (unsigned j = 0; j < 16; ++j) { const unsigned c = xb_ld(&bar[XB_XCNT(j)]); sum += c; cnt += (c > 0u) ? 1u : 0u; mine = (j == x) ? c : mine; }
        if (sum == G) break;
        __builtin_amdgcn_s_sleep(1);
        if ((++sp & 255u) == 0u) { if (xb_ld(&bar[XB_TMO])) break; if (sp > XB_SPIN_CAP) { atomicAdd(&bar[XB_TMO], 1u); break; } }
    }
    nloc = mine > 0u ? mine : 1u; nx = cnt > 0u ? cnt : 1u;
}
__device__ __forceinline__ void xcd_barrier(const XcdBarrier& b) {
    asm volatile("s_waitcnt vmcnt(0)" ::: "memory");
    __syncthreads();
    if (threadIdx.x == 0) {
        unsigned* bar = b.bar;
        __builtin_amdgcn_s_waitcnt(0);
        unsigned nloc = b.st[0], nx = b.st[1];
        if (nloc == 0u) { xcd_barrier_complete(bar, b.x, nloc, nx); b.st[0] = nloc; b.st[1] = nx; }
        const unsigned old = xb_add(&bar[XB_XSUB(b.x)], 1u);
        const unsigned gen = old / nloc;
        if (old + 1u == (gen + 1u) * nloc) {
            __builtin_amdgcn_fence(__ATOMIC_RELEASE, "agent");
            asm volatile("s_waitcnt vmcnt(0)" ::: "memory");
            const unsigned og = xb_add(&bar[XB_TOP], 1u);
            const unsigned tg = og / nx;
            if (og + 1u == (tg + 1u) * nx) xb_add(&bar[XB_TOPGEN], 1u);
            else XB_SPIN(xb_ld(&bar[XB_TOPGEN]) == tg, bar);
            __builtin_amdgcn_fence(__ATOMIC_ACQUIRE, "agent");
            xb_add(&bar[XB_XGEN(b.x)], 1u);
            asm volatile("s_waitcnt vmcnt(0)" ::: "memory");
        } else {
            XB_SPIN(xb_ld(&bar[XB_XGEN(b.x)]) == gen, bar);
            __builtin_amdgcn_fence(__ATOMIC_ACQUIRE, "agent");
            asm volatile("s_waitcnt vmcnt(0)" ::: "memory");
        }
    }
    __syncthreads();
}

struct Args { const float* in[31]; float* out; unsigned char* ws; unsigned mask; int variant, bar_region, pad; };
enum { I_X = 0, I_NMW, I_WIN, I_CONVW, I_CONVB, I_DTB, I_ALOG, I_DSSD, I_NSW, I_WAUP, I_LRE, I_LIM, I_LOGDT, I_BRE, I_BIM, I_CRE, I_CIM, I_S5D,
       I_WGLU, I_WBUP, I_GATEB, I_WOUT, I_NFW, I_WRG, I_BRG, I_WRE, I_BRE2, I_WEG, I_WEU, I_WED, I_NFINAL };
struct Ctx { LAS unsigned char* lds; volatile LAS unsigned* ctl; int tid, lane, wave, vcu, G; };
constexpr int PTAB_OFF = LDSCTL_OFF + 1024;
__device__ __forceinline__ unsigned long long ptab_get(LAS unsigned char* lds, int i) {
    const LAS unsigned* p = (const LAS unsigned*)(lds + PTAB_OFF + 8 * i); const unsigned lo = __builtin_amdgcn_readfirstlane(p[0]), hi = __builtin_amdgcn_readfirstlane(p[1]); return ((unsigned long long)hi << 32) | lo; }
#define PIN(i) ((const float*)ptab_get(F.lds, (i)))
#define POUT ((float*)ptab_get(F.lds, 31))
#define PWS ((unsigned char*)ptab_get(F.lds, 32))

struct TJob { const float* src; unsigned char* dst; int N, K; float scale; int fp8; };
__device__ __forceinline__ void tj_load(const TJob& j, int lane, f32x4 (&v)[8]) {
    const float* p = j.src + (size_t)(lane >> 3) * j.N + (lane & 7) * 4;
#pragma unroll
    for (int i = 0; i < 8; ++i) v[i] = __builtin_nontemporal_load((const f32x4*)(p + (size_t)(8 * i) * j.N));
}
__device__ __forceinline__ void tj_store(const TJob& j, int lane, const f32x4 (&v)[8], LAS float* scr) {
    LAS float* w = scr + (lane >> 3) * 33 + (lane & 7) * 4;
#pragma unroll
    for (int i = 0; i < 8; ++i) { w[i * 264 + 0] = v[i][0]; w[i * 264 + 1] = v[i][1]; w[i * 264 + 2] = v[i][2]; w[i * 264 + 3] = v[i][3]; }
    LDS_WAIT(); asm volatile("" ::: "memory");
    const int c = lane & 7;
#pragma unroll
    for (int jj = 0; jj < 4; ++jj) { const int n = (lane >> 3) + 8 * jj; const LAS float* s = scr + (8 * c) * 33 + n;
        if (j.fp8) { const float q = j.scale; v2u o; o.x = pk4_fp8(s[0 * 33] * q, s[1 * 33] * q, s[2 * 33] * q, s[3 * 33] * q); o.y = pk4_fp8(s[4 * 33] * q, s[5 * 33] * q, s[6 * 33] * q, s[7 * 33] * q);
            *(v2u*)(j.dst + (size_t)n * j.K + 8 * c) = o; }
        else { v4u o; o.x = pk2(s[0 * 33], s[1 * 33]); o.y = pk2(s[2 * 33], s[3 * 33]); o.z = pk2(s[4 * 33], s[5 * 33]); o.w = pk2(s[6 * 33], s[7 * 33]);
            *(v4u*)(j.dst + ((size_t)n * j.K + 8 * c) * 2) = o; } }
    LDS_WAIT(); asm volatile("" ::: "memory");
}
template <class Dec>
__device__ __forceinline__ void transpose_jobs(int first, int stride, int nitems, const Dec dec, LAS float* scr, int lane) {
    int it = first; if (it >= nitems) return;
    TJob cur; f32x4 v[8]; dec(it, cur); tj_load(cur, lane, v);
    for (;;) { const int nx = it + stride; const bool hn = nx < nitems; TJob nj = cur; f32x4 nv[8];
        if (hn) { dec(nx, nj); tj_load(nj, lane, nv); }
        tj_store(cur, lane, v, scr);
        if (!hn) break;
        cur = nj; it = nx;
#pragma unroll
        for (int i = 0; i < 8; ++i) v[i] = nv[i]; }
}
struct DecP0 {
    static constexpr int I_IN = 32 * (IN_DIM / 32), I_A = 32 * 64, I_G = 16 * 32, I_B = 16 * 64, I_O = 32 * 64, NITEMS = I_IN + I_A + I_G + I_B + I_O;
    const float *win, *wa, *wg, *wb, *wo; unsigned char* ws;
    __device__ __forceinline__ void operator()(int r, TJob& j) const {
        if (r < I_IN) { const int nb = r % (IN_DIM / 32), kb = r / (IN_DIM / 32); const int dr = 32 * nb; int sc; if (dr < 6144) sc = dr; else if (dr < 7168) sc = dr + 32; else if (dr < 11264) { const int rel = dr - 7168, within = rel & 255; sc = 7200 + (within >> 7) * 2048 + (rel >> 8) * 128 + (within & 127); } else sc = dr - 11264 + 6144;
            j.src = win + (size_t)(64 * kb) * IN_DIM + sc; if (dr >= 7168 && dr < 11264) { j.dst = ws + WS_WIN + (size_t)7168 * D * 2 + (size_t)(dr - 7168) * D + 64 * kb; j.scale = 32.f; j.fp8 = 1; } else { j.dst = ws + WS_WIN + ((size_t)dr * D + 64 * kb) * 2; j.scale = 1.f; j.fp8 = 0; } j.N = IN_DIM; j.K = D; return; } r -= I_IN;
        if (r < I_A) { j.src = wa + (size_t)(64 * (r / 64)) * D + 32 * (r % 64); j.dst = ws + WS_WAB + ((size_t)(32 * (r % 64)) * YVP + 64 * (r / 64)) * 2; j.scale = 1.f; j.fp8 = 0; j.N = D; j.K = YVP; return; } r -= I_A;
        if (r < I_G) { j.src = wg + (size_t)(64 * (r / 32)) * S5W + 32 * (r % 32); j.dst = ws + WS_WGLU + ((size_t)(32 * (r % 32)) * S5W + 64 * (r / 32)) * 2; j.scale = 1.f; j.fp8 = 0; j.N = S5W; j.K = S5W; return; } r -= I_G;
        if (r < I_B) { j.src = wb + (size_t)(64 * (r / 64)) * D + 32 * (r % 64); j.dst = ws + WS_WAB + ((size_t)(32 * (r % 64)) * YVP + 2048 + 64 * (r / 64)) * 2; j.scale = 1.f; j.fp8 = 0; j.N = D; j.K = YVP; return; } r -= I_B;
        j.src = wo + (size_t)(64 * (r / 64)) * D + 32 * (r % 64); j.dst = ws + WS_WOUT + ((size_t)(32 * (r % 64)) * D + 64 * (r / 64)) * 2; j.scale = 1.f; j.fp8 = 0; j.N = D; j.K = D; }
};
constexpr float WGU_SCALE = 64.f, WD_SCALE = 32.f, HID_SCALE = 4.f;
struct DecExp {
    static constexpr int I_GU = NE * 32 * 16, NITEMS = 3 * I_GU;
    const float *wg, *wu, *wd; unsigned char* ws;
    __device__ __forceinline__ void operator()(int it, TJob& j) const {
        if (it < 2 * I_GU) { const int which = it / I_GU, r = it % I_GU, e = r / 512, q = r % 512, kb = q / 16, nb = q % 16; const int j0 = 32 * nb;
            const int drow = (j0 >> 7) * 256 + which * 128 + (j0 & 127);
            j.src = (which ? wu : wg) + (size_t)e * D * FF + (size_t)(64 * kb) * FF + j0; j.dst = ws + WS_ST + ((size_t)e * 1024 + drow) * D + 64 * kb; j.N = FF; j.K = D; j.scale = WGU_SCALE; j.fp8 = 1; }
        else { const int r = it - 2 * I_GU, e = r / 512, q = r % 512, kb = q / 64, nb = q % 64;
            j.src = wd + (size_t)e * FF * D + (size_t)(64 * kb) * D + 32 * nb; j.dst = ws + WS_YV + ((size_t)e * D + 32 * nb) * FF + 64 * kb; j.N = D; j.K = FF; j.scale = WD_SCALE; j.fp8 = 1; }
    }
};
__device__ __forceinline__ void rms_row_to_bf16(const float* xrow, const float* w, bf16* orow, unsigned char* orow8, int lane) {
    const f32x4* xr = (const f32x4*)xrow + lane; const f32x4* wr4 = (const f32x4*)w + lane;
    f32x4 v[8]; float s = 0.f;
#pragma unroll
    for (int j = 0; j < 8; ++j) { v[j] = xr[64 * j]; s += (v[j].x * v[j].x + v[j].y * v[j].y) + (v[j].z * v[j].z + v[j].w * v[j].w); }
    const float rstd = 1.0f / sqrtf(wave_sum(s) * (1.f / D) + EPS);
    v2u* o8 = (v2u*)orow + lane; unsigned* q8 = (unsigned*)orow8 + lane;
#pragma unroll
    for (int j = 0; j < 8; ++j) { const f32x4 g = wr4[64 * j]; const f32x4 hv = {v[j].x * rstd * g.x, v[j].y * rstd * g.y, v[j].z * rstd * g.z, v[j].w * rstd * g.w};
        v2u o; o.x = pk2(hv.x, hv.y); o.y = pk2(hv.z, hv.w); o8[64 * j] = o; q8[64 * j] = pk4_fp8(hv.x, hv.y, hv.z, hv.w); }
}

__device__ __forceinline__ void s5_mats_group(const Args& a, const Ctx& F, int g) {
    LAS float* L = (LAS float*)F.lds;
    LAS float* apr = L; LAS float* api = L + 17 * 64; LAS float* bbr = L + 2 * 17 * 64; LAS float* bbi = bbr + 1024; LAS float* cr = bbi + 1024; LAS float* ci = cr + 1024; LAS float* kt = ci + 1024;
    LAS float* cof = kt + 4096;
    const float dt = expf(PIN(I_LOGDT)[g]);
    if (F.tid < 64) { const int n = F.tid; const float lr = PIN(I_LRE)[g * 64 + n], li = PIN(I_LIM)[g * 64 + n];
        for (int m = 0; m <= 16; ++m) { const float mag = expf((float)m * lr * dt), ang = (float)m * li * dt; apr[m * 64 + n] = mag * cosf(ang); api[m * 64 + n] = mag * sinf(ang); }
        const float ar = expf(lr * dt) * cosf(li * dt), ai = expf(lr * dt) * sinf(li * dt);
        const float den = lr * lr + li * li, nr = ar - 1.0f, ni = ai;
        cof[n] = (nr * lr + ni * li) / den; cof[64 + n] = (ni * lr - nr * li) / den; }
    for (int i = F.tid; i < 1024; i += 512) { const int co = i >> 6, n = i & 63; cr[i] = PIN(I_CRE)[(size_t)g * 1024 + co * 64 + n]; ci[i] = PIN(I_CIM)[(size_t)g * 1024 + co * 64 + n]; }
    __syncthreads();
    for (int i = F.tid; i < 1024; i += 512) { const int n = i >> 4; const float br = PIN(I_BRE)[(size_t)g * 1024 + i], bi = PIN(I_BIM)[(size_t)g * 1024 + i]; const float c0 = cof[n], c1 = cof[64 + n];
        bbr[i] = c0 * br - c1 * bi; bbi[i] = c0 * bi + c1 * br; }
    __syncthreads();
    for (int i = F.tid; i < 4096; i += 512) { const int lag = i >> 8, co = (i >> 4) & 15, cin = i & 15; float s = 0.f;
        for (int n = 0; n < 64; ++n) { const float wr_ = apr[lag * 64 + n] * bbr[n * 16 + cin] - api[lag * 64 + n] * bbi[n * 16 + cin], wi_ = apr[lag * 64 + n] * bbi[n * 16 + cin] + api[lag * 64 + n] * bbr[n * 16 + cin];
            s += cr[co * 64 + n] * wr_ - ci[co * 64 + n] * wi_; }
        kt[i] = s; }
    __syncthreads();
    bf16* TW = (bf16*)(PWS + WS_S5TW) + (size_t)g * 256 * APK;
    for (int i = F.tid; i < 256 * APK / 2; i += 512) { const int row = (2 * i) / APK, k0 = (2 * i) % APK; const int l = row >> 4, co = row & 15; float v[2];
#pragma unroll
        for (int q = 0; q < 2; ++q) { const int k = k0 + q; float val;
            if (k < 256) { const int j = k >> 4, cin = k & 15; val = (l >= j) ? kt[(l - j) * 256 + co * 16 + cin] : 0.f; if (l == j && cin == co) val += PIN(I_S5D)[g * 16 + co]; }
            else if (k < 320) { const int n = k - 256; val = cr[co * 64 + n] * apr[(l + 1) * 64 + n] - ci[co * 64 + n] * api[(l + 1) * 64 + n]; }
            else { const int n = k - 320; val = -(cr[co * 64 + n] * api[(l + 1) * 64 + n] + ci[co * 64 + n] * apr[(l + 1) * 64 + n]); }
            v[q] = val; }
        *(unsigned*)(TW + 2 * i) = pk2(v[0], v[1]); }
    bf16* WS = (bf16*)(PWS + WS_S5WS) + (size_t)g * 256 * 256;
    for (int i = F.tid; i < 256 * 256 / 2; i += 512) { const int row = (2 * i) >> 8, k0 = (2 * i) & 255; float v[2];
#pragma unroll
        for (int q = 0; q < 2; ++q) { const int k = k0 + q, j = k >> 4, cin = k & 15; float val = 0.f;
            if (row < 64) { const int n = row; val = apr[(15 - j) * 64 + n] * bbr[n * 16 + cin] - api[(15 - j) * 64 + n] * bbi[n * 16 + cin]; }
            else if (row < 128) { const int n = row - 64; val = apr[(15 - j) * 64 + n] * bbi[n * 16 + cin] + api[(15 - j) * 64 + n] * bbr[n * 16 + cin]; }
            v[q] = val; }
        *(unsigned*)(WS + 2 * i) = pk2(v[0], v[1]); }
    __syncthreads();
}

__device__ __forceinline__ void p0_prologue(const Args& a, const Ctx& F) {
    if (F.vcu < S5G) s5_mats_group(a, F, F.vcu);
    LAS float* scr = (LAS float*)(F.lds + F.wave * 16384);
    const int gw = F.vcu * NWAVES + F.wave, NGW = F.G * NWAVES;
    { DecP0 dec{PIN(I_WIN), PIN(I_WAUP), PIN(I_WGLU), PIN(I_WBUP), PIN(I_WOUT), PWS};
      transpose_jobs<DecP0>(gw, NGW, DecP0::NITEMS, dec, scr, F.lane); }
    {
        unsigned* gctr = (unsigned*)(PWS + WS_CTL) + CW_CNT + a.bar_region * 4096 + 2624; const float* X = PIN(I_X); const float* nmw = PIN(I_NMW); unsigned char* wsb = PWS;
        unsigned bv = 0u; if (F.lane == 0) bv = __hip_atomic_fetch_add(gctr, 1u, __ATOMIC_RELAXED, __HIP_MEMORY_SCOPE_AGENT);
        int b = (int)__builtin_amdgcn_readfirstlane(bv);
        while (b < T / 8) { unsigned nv = 0u; if (F.lane == 0) nv = __hip_atomic_fetch_add(gctr, 1u, __ATOMIC_RELAXED, __HIP_MEMORY_SCOPE_AGENT);
            for (int m = 8 * b; m < 8 * b + 8; ++m) rms_row_to_bf16(X + (size_t)m * D, nmw, (bf16*)(wsb + WS_H) + (size_t)m * D, wsb + WS_H8 + (size_t)m * D, F.lane);
            b = (int)__builtin_amdgcn_readfirstlane(nv); } }
    for (int i = gw * 64 + F.lane; i < 48 * D; i += NGW * 64) { const int col = i / D, k = i % D; float w = 0.f;
        if (col < 4) w = PIN(I_WRG)[k * 4 + col]; else if (col >= 16) w = PIN(I_WRE)[k * 32 + (col - 16)];
        const unsigned hi = f2bf(w); const float lo = w - bf2f((bf16)hi);
        ((bf16*)(PWS + WS_RT))[i] = (bf16)hi; ((bf16*)(PWS + WS_RT))[48 * D + i] = (bf16)f2bf(lo); }
}

struct SchedDense {
    pg8::StaticOrder so; const char* A; const char* B; unsigned lda, ldb;
    __device__ __forceinline__ bool next(int i, Unit& u) const { int pm, pn; if (!so.next(i, pm, pn)) return false;
        u.A = A + (size_t)pm * 256 * lda; u.B = B + (size_t)pn * 256 * ldb; u.row0 = pm * 256; u.col0 = pn * 256; u.e = 0; u.nvalid = 256; return true; }
    __device__ __forceinline__ unsigned row_idx(const Unit&, int) const { return 0u; }
};
struct SchedS5 {
    const char* A; const char* B; unsigned ldb; int G, c;
    __device__ __forceinline__ bool next(int i, Unit& u) const { const int idx = i * G + c; if (idx >= 256) return false; const int g = idx >> 2, mt = idx & 3;
        u.A = A + (size_t)(g * 1024 + mt * 256) * (APK * 2); u.B = B + (size_t)g * 256 * ldb; u.row0 = g * 1024 + mt * 256; u.col0 = 0; u.e = g; u.nvalid = 256; return true; }
    __device__ __forceinline__ unsigned row_idx(const Unit&, int) const { return 0u; }
};
struct SchedMoE {
    volatile LAS unsigned* ctl; const char* A; const char* B; const unsigned* list_tok; unsigned lda; size_t bstride_e; unsigned ldb; int NN, G, c; bool gather;
    __device__ __forceinline__ bool next(int i, Unit& u) const { const int idx = i * G + c; const int NT = (int)ctl[72]; if (idx >= NT * NN) return false;
        const int mtg = idx / NN, pn = idx % NN; const int e = (int)ctl[80 + mtg]; const int rb = (int)ctl[40 + e]; const int mtl = mtg - (rb >> 8); const int cnt = (int)ctl[8 + e];
        u.e = e; u.nvalid = cnt - mtl * 256; u.slot0 = mtl * 256; u.B = B + (size_t)e * bstride_e + (size_t)pn * 256 * ldb;
        if (gather) { u.A = A; u.row0 = rb + mtl * 256; u.col0 = pn * 128; }
        else { u.A = A + (size_t)(rb + mtl * 256) * lda; u.row0 = rb + mtl * 256; u.col0 = pn * 256; }
        return true; }
    __device__ __forceinline__ unsigned row_idx(const Unit& u, int r) const {
        const unsigned tokk = (r < u.nvalid) ? list_tok[(size_t)u.e * CAPL + u.slot0 + r] : 0u; return tokk >> 1; }
};

#define EPI_BEGIN _Pragma("unroll") for (int ai = 0; ai < 2; ++ai) _Pragma("unroll") for (int m = 0; m < 4; ++m) { const int r = ai * 128 + wr * 64 + m * 16 + fr; \
    _Pragma("unroll") for (int bj = 0; bj < 2; ++bj) { const int c = bj * 128 + wc * 32 + 8 * fq; const f32x4 v0 = acc[ai][bj][m][0], v1 = acc[ai][bj][m][1];
#define EPI_END } }
__device__ __forceinline__ v4u pack8(const f32x4 a, const f32x4 b) { v4u w; w.x = pk2(a[0], a[1]); w.y = pk2(a[2], a[3]); w.z = pk2(b[0], b[1]); w.w = pk2(b[2], b[3]); return w; }
__device__ __forceinline__ void unpack8(const v4u w, float (&f)[8]) { f[0] = bflo(w.x); f[1] = bfhi(w.x); f[2] = bflo(w.y); f[3] = bfhi(w.y); f[4] = bflo(w.z); f[5] = bfhi(w.z); f[6] = bflo(w.w); f[7] = bfhi(w.w); }

struct Epi1a {
    bf16* ZS; bf16* XBC; bf16* AP;
    __device__ __forceinline__ void operator()(const f32x4 (&acc)[2][2][4][2], const Unit& u, int wr, int wc, int fr, int fq) const {
        EPI_BEGIN  const int row = u.row0 + r, col = u.col0 + c;
            if (col < 2048) { f32x4 a = v0, b = v1;
#pragma unroll
                for (int j = 0; j < 4; ++j) { a[j] = siluf_(a[j]); b[j] = siluf_(b[j]); }
                *(v4u*)(ZS + (size_t)row * YVP + col) = pack8(a, b); }
            else if (col < 6144) { *(v4u*)(XBC + (size_t)row * XBCD + (col - 2048)) = pack8(v0, v1); }
            else { const int cc = col - 6144, g = cc >> 4, ci0 = cc & 15; *(v4u*)(AP + ((size_t)(g * S5NC + (row >> 4)) * APK + (row & 15) * 16 + ci0)) = pack8(v0, v1); }  EPI_END
    }
};
struct EpiS5a {
    float* SL;
    __device__ __forceinline__ void operator()(const f32x4 (&acc)[2][2][4][2], const Unit& u, int wr, int wc, int fr, int fq) const {
        EPI_BEGIN  if (bj == 0) { float* p = SL + (size_t)(u.row0 + r) * 128 + c; *(f32x4*)p = v0; *(f32x4*)(p + 4) = v1; }  EPI_END
    }
};
struct EpiS5b {
    bf16* V;
    __device__ __forceinline__ void operator()(const f32x4 (&acc)[2][2][4][2], const Unit& u, int wr, int wc, int fr, int fq) const {
        EPI_BEGIN  const int chunk = (u.row0 + r) & 1023, g = u.e, l = c >> 4, co0 = c & 15; f32x4 a = v0, b = v1;
#pragma unroll
            for (int j = 0; j < 4; ++j) { a[j] = gelu_tanh(a[j]); b[j] = gelu_tanh(b[j]); }
            *(v4u*)(V + (size_t)(chunk * 16 + l) * S5W + g * 16 + co0) = pack8(a, b);  EPI_END
    }
};
struct Epi1b {
    bf16* Gt; const float* gb; const float* ssq;
    __device__ __forceinline__ void operator()(const f32x4 (&acc)[2][2][4][2], const Unit& u, int wr, int wc, int fr, int fq) const {
        const int j0 = (u.col0 >> 1) + wc * 32 + 8 * fq;
        const f32x4 ba0 = *(const f32x4*)(gb + j0), ba1 = *(const f32x4*)(gb + j0 + 4), bb0 = *(const f32x4*)(gb + 2048 + j0), bb1 = *(const f32x4*)(gb + 2048 + j0 + 4);
#pragma unroll
        for (int ai = 0; ai < 2; ++ai)
#pragma unroll
            for (int m = 0; m < 4; ++m) { const int row = u.row0 + ai * 128 + wr * 64 + m * 16 + fr; const f32x4 s0 = *(const f32x4*)(ssq + (size_t)row * 8), s1 = *(const f32x4*)(ssq + (size_t)row * 8 + 4);
                const float tot = ((s0[0] + s0[1]) + (s0[2] + s0[3])) + ((s1[0] + s1[1]) + (s1[2] + s1[3])); const float rstd = 1.0f / sqrtf(tot * (1.f / D) + EPS);
                f32x4 r0, r1, g0, g1;
#pragma unroll
                for (int j = 0; j < 4; ++j) { const float a0 = sigmoidf_(acc[ai][0][m][0][j] + ba0[j]), a1 = sigmoidf_(acc[ai][0][m][1][j] + ba1[j]);
                    g0[j] = fmaxf(sigmoidf_(acc[ai][1][m][0][j] + bb0[j]), 1e-20f); g1[j] = fmaxf(sigmoidf_(acc[ai][1][m][1][j] + bb1[j]), 1e-20f);
                    r0[j] = a0 * rstd * __builtin_amdgcn_rcpf(g0[j]); r1[j] = a1 * rstd * __builtin_amdgcn_rcpf(g1[j]); }
                *(v4u*)(Gt + (size_t)row * 4096 + j0) = pack8(r0, r1); *(v4u*)(Gt + (size_t)row * 4096 + 2048 + j0) = pack8(g0, g1); }
    }
};
struct EpiGlu {
    const bf16* V; bf16* YV;
    __device__ __forceinline__ void operator()(const f32x4 (&acc)[2][2][4][2], const Unit& u, int wr, int wc, int fr, int fq) const {
        EPI_BEGIN const size_t o = (size_t)(u.row0 + r) * S5W + u.col0 + c; float vv[8]; unpack8(*(const v4u*)(V + o), vv); f32x4 a, b;
#pragma unroll
            for (int j = 0; j < 4; ++j) { a[j] = vv[j] * sigmoidf_(v0[j]); b[j] = vv[4 + j] * sigmoidf_(v1[j]); }
            *(v4u*)(YV + (size_t)(u.row0 + r) * YVP + 2048 + u.col0 + c) = pack8(a, b); EPI_END
    }
};
struct EpiAB {
    const bf16* Gt; bf16* MG;
    __device__ __forceinline__ void mid(f32x4 (&acc)[2][2][4][2], const Unit& u, int wr, int wc, int fr, int fq) const {
        unsigned base = (unsigned)((u.row0 + wr * 64 + fr) * 4096 + u.col0 + wc * 32 + 8 * fq) * 2u;
        asm volatile("" : "+v"(base));
        const char* gp = (const char*)Gt;
#pragma unroll
        for (int ai = 0; ai < 2; ++ai)
#pragma unroll
            for (int m = 0; m < 4; ++m)
#pragma unroll
                for (int bj = 0; bj < 2; ++bj) { float rr[8]; unpack8(*(const v4u*)(gp + (size_t)(base + (unsigned)((ai * 128 + m * 16) * 4096 + bj * 128) * 2u)), rr);
#pragma unroll
                    for (int j = 0; j < 4; ++j) { acc[ai][bj][m][0][j] *= rr[j]; acc[ai][bj][m][1][j] *= rr[4 + j]; } }
    }
    __device__ __forceinline__ void operator()(const f32x4 (&acc)[2][2][4][2], const Unit& u, int wr, int wc, int fr, int fq) const {
        EPI_BEGIN const int row = u.row0 + r, col = u.col0 + c; float gg[8]; unpack8(*(const v4u*)(Gt + (size_t)row * 4096 + 2048 + col), gg); f32x4 a, b;
#pragma unroll
            for (int j = 0; j < 4; ++j) { a[j] = gg[j] * v0[j]; b[j] = gg[4 + j] * v1[j]; }
            *(v4u*)(MG + (size_t)row * D + col) = pack8(a, b); EPI_END
    }
};
struct EpiOut {
    bf16* XD;
    __device__ __forceinline__ void operator()(const f32x4 (&acc)[2][2][4][2], const Unit& u, int wr, int wc, int fr, int fq) const {
        EPI_BEGIN *(v4u*)(XD + (size_t)(u.row0 + r) * D + u.col0 + c) = pack8(v0, v1); EPI_END
    }
};
struct EpiGU {
    bf16* HID; const unsigned* list_tok; const float* rstd2;
    __device__ __forceinline__ void operator()(const f32x4 (&acc)[2][2][4][2], const Unit& u, int wr, int wc, int fr, int fq) const {
#pragma unroll
        for (int ai = 0; ai < 2; ++ai)
#pragma unroll
            for (int m = 0; m < 4; ++m) { const int r = ai * 128 + wr * 64 + m * 16 + fr; if (r < u.nvalid) { const float sc = rstd2[(size_t)u.e * CAPL + u.slot0 + r]; f32x4 a, b;
#pragma unroll
                for (int j = 0; j < 4; ++j) { a[j] = siluf_(sc * acc[ai][0][m][0][j]) * (sc * acc[ai][1][m][0][j]); b[j] = siluf_(sc * acc[ai][0][m][1][j]) * (sc * acc[ai][1][m][1][j]); }
                { v2u o8; o8.x = pk4_fp8(a[0] * HID_SCALE, a[1] * HID_SCALE, a[2] * HID_SCALE, a[3] * HID_SCALE); o8.y = pk4_fp8(b[0] * HID_SCALE, b[1] * HID_SCALE, b[2] * HID_SCALE, b[3] * HID_SCALE);
                  *(v2u*)((unsigned char*)HID + (size_t)(u.row0 + r) * FF + u.col0 + wc * 32 + 8 * fq) = o8; } } }
    }
};
constexpr float Y_SCALE = 16.f;
struct EpiDn {
    const float* list_w; unsigned char* Y;
    __device__ __forceinline__ void operator()(const f32x4 (&acc)[2][2][4][2], const Unit& u, int wr, int wc, int fr, int fq) const {
        const float* wp = list_w + (unsigned)(u.e * CAPL + u.slot0 + wr * 64 + fr);
#pragma unroll
        for (int ai = 0; ai < 2; ++ai)
#pragma unroll
            for (int m = 0; m < 4; ++m) { const int r = ai * 128 + wr * 64 + m * 16 + fr; const float w = wp[ai * 128 + m * 16] * Y_SCALE;
#pragma unroll
                for (int bj = 0; bj < 2; ++bj) { const int col = u.col0 + bj * 128 + wc * 32 + 8 * fq; const f32x4 a = acc[ai][bj][m][0] * w, b = acc[ai][bj][m][1] * w;
                    v2u o; o.x = pk4_fp8(a[0], a[1], a[2], a[3]); o.y = pk4_fp8(b[0], b[1], b[2], b[3]); if (r < u.nvalid) *(v2u*)(Y + (size_t)(u.row0 + r) * D + col) = o; } }
    }
};

__device__ __forceinline__ void dt_gemm(const Args& a, const Ctx& F) {
    const bf16* Hb = (const bf16*)(PWS + WS_H); const bf16* Wd = (const bf16*)(PWS + WS_WIN) + (size_t)11264 * D; float* DT = (float*)(PWS + WS_DT);
    LAS float* part = (LAS float*)F.lds;
    const int r = F.lane & 31, hh = F.lane >> 5;
    for (int unit = F.vcu; unit < T / 64; unit += F.G) {
        const int r0 = unit * 64; f32x16 acc0, acc1;
#pragma unroll
        for (int j = 0; j < 16; ++j) { acc0[j] = 0.f; acc1[j] = 0.f; }
#pragma unroll 4
        for (int ks = 0; ks < 16; ++ks) { const int k = F.wave * 256 + ks * 16 + hh * 8;
            const bf16x8 a0 = *(const bf16x8*)(Hb + (size_t)(r0 + r) * D + k), a1 = *(const bf16x8*)(Hb + (size_t)(r0 + 32 + r) * D + k), b = *(const bf16x8*)(Wd + (size_t)r * D + k);
            acc0 = __builtin_amdgcn_mfma_f32_32x32x16_bf16(a0, b, acc0, 0, 0, 0); acc1 = __builtin_amdgcn_mfma_f32_32x32x16_bf16(a1, b, acc1, 0, 0, 0); }
#pragma unroll
        for (int j = 0; j < 16; ++j) { part[((F.wave * 2 + 0) * 16 + j) * 64 + F.lane] = acc0[j]; part[((F.wave * 2 + 1) * 16 + j) * 64 + F.lane] = acc1[j]; }
        __syncthreads();
        for (int o = F.tid; o < 2048; o += 512) { const int row = o >> 5, col = o & 31; const int i = row >> 5, rr = row & 31, h2 = (rr >> 2) & 1, reg = (rr & 3) + 4 * (rr >> 3), ln = col + 32 * h2; float s = 0.f;
#pragma unroll
            for (int w = 0; w < 8; ++w) s += part[((w * 2 + i) * 16 + reg) * 64 + ln];
            s += PIN(I_DTB)[col]; DT[(size_t)(r0 + row) * 32 + col] = s > 20.f ? s : log1pf(expf(s)); }
        __syncthreads();
    }
}

constexpr int SEGC = 8, NSEG = NCHK / SEGC;
constexpr int SQ_XT = 0;
constexpr int SQ_BC = 36864;
constexpr int SQ_BT = SQ_BC + 17408;
constexpr int SQ_CC = SQ_BT + 18432;
constexpr int SQ_DT = SQ_CC + 17408;
constexpr int SQ_Y = SQ_DT + 4352;
constexpr int SQ_W = SQ_Y + 33792;
static_assert(SQ_W + 10240 <= LDSCTL_OFF, "SSD (sequential) LDS map");

template <int NTOK>
__device__ __forceinline__ void conv_pair(const LAS float* wl, int lc, const v4u (&rawv)[NTOK + 3], int d, float (&o)[NTOK][2]) {
    f32x2 w[4]; const f32x2 bias = *(const LAS f32x2*)(wl + 4 * 512 + lc);
#pragma unroll
    for (int k = 0; k < 4; ++k) w[k] = *(const LAS f32x2*)(wl + k * 512 + lc);
#pragma unroll
    for (int tt = 0; tt < NTOK; ++tt) { float s0 = bias[0], s1 = bias[1];
#pragma unroll
        for (int k = 0; k < 4; ++k) { const unsigned uu = rawv[tt + k][d]; s0 += w[k][0] * bflo(uu); s1 += w[k][1] * bfhi(uu); }
        o[tt][0] = siluf_(s0); o[tt][1] = siluf_(s1); }
}
template <bool SCALE>
__device__ __forceinline__ void conv_xs_to_lds(const LAS float* wl, int lc, const v4u (&rx)[7], LAS bf16* dst  , const f32x4 sc) {
#pragma unroll
    for (int d = 0; d < 4; ++d) { float o[4][2]; conv_pair<4>(wl, lc + 2 * d, rx, d, o);
        if constexpr (SCALE) {
#pragma unroll
            for (int tt = 0; tt < 4; ++tt) { o[tt][0] *= sc[tt]; o[tt][1] *= sc[tt]; } }
        v2u w0, w1; w0.x = pk2(o[0][0], o[1][0]); w0.y = pk2(o[2][0], o[3][0]); w1.x = pk2(o[0][1], o[1][1]); w1.y = pk2(o[2][1], o[3][1]);
        *(LAS v2u*)(dst + (2 * d) * 72) = w0; *(LAS v2u*)(dst + (2 * d + 1) * 72) = w1; }
}
template <bool NAT, bool TR>
__device__ __forceinline__ void conv_bc_to_lds(const LAS float* wl, int lc, const v4u (&rb)[5], LAS bf16* nat, LAS bf16* tr) {
    v4u n0, n1;
#pragma unroll
    for (int d = 0; d < 4; ++d) { float o[2][2]; conv_pair<2>(wl, lc + 2 * d, rb, d, o);
        if constexpr (NAT) { n0[d] = pk2(o[0][0], o[0][1]); n1[d] = pk2(o[1][0], o[1][1]); }
        if constexpr (TR) { *(LAS unsigned*)(tr + (2 * d) * 72) = pk2(o[0][0], o[1][0]); *(LAS unsigned*)(tr + (2 * d + 1) * 72) = pk2(o[0][1], o[1][1]); } }
    if constexpr (NAT) { *(LAS v4u*)nat = n0; *(LAS v4u*)(nat + 136) = n1; }
}
__device__ __forceinline__ void conv_weights_to_lds(const Args& a, const Ctx& F, int g) {
    LAS float* wl = (LAS float*)(F.lds + SQ_W);
    for (int i = F.tid; i < 5 * 512; i += NWAVES * 64) { const int k = i >> 9, lc = i & 511; const int ch = lc < 256 ? g * 256 + lc : (lc < 384 ? 2048 + g * 128 + (lc - 256) : 3072 + g * 128 + (lc - 384));
        wl[i] = k < 4 ? PIN(I_CONVW)[k * XBCD + ch] : PIN(I_CONVB)[ch]; }
    __syncthreads();
}
template <int NR>
__device__ __forceinline__ void rows_load(const unsigned char* ws, unsigned off, int t0, v4u (&raw)[NR]) {
#pragma unroll
    for (int i = 0; i < NR; ++i) { v4u v = (v4u){0u, 0u, 0u, 0u}; if (t0 + i >= 0) v = *(const v4u*)(ws + (size_t)(off + (unsigned)i * (XBCD * 2))); raw[i] = v; }
}

__device__ __forceinline__ float seq_dt_setup(const Args& a, const Ctx& F, int g, float dtv, int buf) {
    LAS float* dts = (LAS float*)(F.lds + SQ_DT); LAS float* acs = dts + 256; LAS float* wsc = dts + 512; LAS float* eacs = dts + 768; LAS float* cdec = dts + 1024;
    float tot = 0.f;
    if (F.wave < 4) { const int hd = 4 * g + F.wave; const float av = -expf(PIN(I_ALOG)[hd]);
        float s = dtv * av;
#pragma unroll
        for (int o = 1; o < 64; o <<= 1) { const float t = __shfl_up(s, o); if (F.lane >= o) s += t; }
        tot = __shfl(s, 63);
        dts[F.wave * 64 + F.lane] = dtv; acs[F.wave * 64 + F.lane] = s; wsc[F.wave * 64 + F.lane] = dtv * __expf(tot - s); eacs[F.wave * 64 + F.lane] = __expf(s);
        if (F.lane == 63) cdec[buf * 4 + F.wave] = __expf(tot); }
    return tot;
}
__device__ __forceinline__ bf16x8 pack_frag(const f32x16& X, int kk) { v4u w; w.x = pk2(X[8 * kk], X[8 * kk + 1]); w.y = pk2(X[8 * kk + 2], X[8 * kk + 3]); w.z = pk2(X[8 * kk + 4], X[8 * kk + 5]); w.w = pk2(X[8 * kk + 6], X[8 * kk + 7]); return __builtin_bit_cast(bf16x8, w); }
__device__ __forceinline__ void seq_state_update(const Ctx& F, f32x16 (&acc)[4], int hd, int pt, float cd) {
    const LAS bf16* xT = (const LAS bf16*)(F.lds + SQ_XT); const LAS bf16* Bt = (const LAS bf16*)(F.lds + SQ_BT); const LAS float* wsc = (const LAS float*)(F.lds + SQ_DT) + 512;
    const int r = F.lane & 31, hh = F.lane >> 5;
#pragma unroll
    for (int i = 0; i < 4; ++i) acc[i] = acc[i] * cd;
#pragma unroll
    for (int ks = 0; ks < 4; ++ks) { const v4u xw = *(const LAS v4u*)(xT + (hd * 64 + 32 * pt + r) * 72 + 16 * ks + 8 * hh); float xv[8]; unpack8(xw, xv);
        const f32x4 w0 = *(const LAS f32x4*)(wsc + hd * 64 + 16 * ks + 8 * hh), w1 = *(const LAS f32x4*)(wsc + hd * 64 + 16 * ks + 8 * hh + 4);
        v4u sw; sw.x = pk2(xv[0] * w0[0], xv[1] * w0[1]); sw.y = pk2(xv[2] * w0[2], xv[3] * w0[3]); sw.z = pk2(xv[4] * w1[0], xv[5] * w1[1]); sw.w = pk2(xv[6] * w1[2], xv[7] * w1[3]);
        const bf16x8 bfr = __builtin_bit_cast(bf16x8, sw);
#pragma unroll
        for (int i = 0; i < 4; ++i) { const bf16x8 afr = *(const LAS bf16x8*)(Bt + (32 * i + r) * 72 + 16 * ks + 8 * hh); acc[i] = __builtin_amdgcn_mfma_f32_32x32x16_bf16(afr, bfr, acc[i], 0, 0, 0); }
        if (ks & 1) __builtin_amdgcn_sched_barrier(0); }
}
__device__ __forceinline__ size_t seg_state_off(int g, int seg, int hd) { return ((size_t)(g * NSEG + seg) * 4 + hd) * 8192; }

__device__ __forceinline__ void ssd_pass_a(const Args& a, const Ctx& F) {
    LAS bf16* xT = (LAS bf16*)(F.lds + SQ_XT); LAS bf16* Bt = (LAS bf16*)(F.lds + SQ_BT); const LAS float* cdec = (const LAS float*)(F.lds + SQ_DT) + 1024; const LAS float* wl = (const LAS float*)(F.lds + SQ_W);
    for (int u = F.vcu; u < NGRP * NSEG; u += F.G) {
        const int g = u >> 5, seg = u & 31; const int hd = F.wave >> 1, pt = F.wave & 1, r = F.lane & 31, hh = F.lane >> 5;
        const int cgx = F.tid >> 4, l0x = (F.tid & 15) * 4, cgb = F.tid >> 5, l0b = (F.tid & 31) * 2;
        conv_weights_to_lds(a, F, g);
        f32x16 acc[4];
#pragma unroll
        for (int i = 0; i < 4; ++i)
#pragma unroll
            for (int j = 0; j < 16; ++j) acc[i][j] = 0.f;
        float totsum = 0.f;
        const int t0 = seg * SEGC * CHK;
        const unsigned char* wsb = PWS;
        unsigned ox = (unsigned)(WS_XBC + ((size_t)(t0 + l0x) * XBCD + g * 256 + cgx * 8) * 2 - 3 * XBCD * 2);
        unsigned ob = (unsigned)(WS_XBC + ((size_t)(t0 + l0b) * XBCD + 2048 + g * 128 + cgb * 8) * 2 - 3 * XBCD * 2);
        unsigned odt = (unsigned)(WS_DT + ((size_t)(t0 + F.lane) * 32 + 4 * g + (F.wave & 3)) * 4);
        v4u rx[7];
        rows_load<7>(wsb, ox, t0 + l0x - 3, rx);
        float dtv = *(const float*)(wsb + odt);
#pragma unroll 1
        for (int k = 0; k < SEGC; ++k) {
            v4u rb[5];
            rows_load<5>(wsb, ob, t0 + k * CHK + l0b - 3, rb);
            totsum += seq_dt_setup(a, F, g, dtv, k & 1);
            { const int hx = cgx >> 3, p0 = (cgx & 7) * 8;
              conv_xs_to_lds<false>(wl, cgx * 8, rx, xT + (hx * 64 + p0) * 72 + l0x, (f32x4){1.f, 1.f, 1.f, 1.f});
              conv_bc_to_lds<false, true>(wl, 256 + cgb * 8, rb, Bt, Bt + (cgb * 8) * 72 + l0b); }
            ox += CHK * XBCD * 2; ob += CHK * XBCD * 2; odt += CHK * 32 * 4;
            if (k + 1 < SEGC) { rows_load<7>(wsb, ox, 0, rx); dtv = *(const float*)(wsb + odt); }
            __syncthreads();
            seq_state_update(F, acc, hd, pt, cdec[(k & 1) * 4 + hd]);
            __syncthreads();
        }
        bf16* st = (bf16*)(PWS + WS_ST) + seg_state_off(g, seg, hd); const int p = 32 * pt + r;
#pragma unroll
        for (int i = 0; i < 4; ++i)
#pragma unroll
            for (int q = 0; q < 4; ++q) { v2u w; w.x = pk2(acc[i][4 * q], acc[i][4 * q + 1]); w.y = pk2(acc[i][4 * q + 2], acc[i][4 * q + 3]); *(v2u*)(st + ((4 * i + q) * 64 + p) * 8 + 4 * hh) = w; }
        if (F.wave < 4 && F.lane == 63) ((float*)(PWS + WS_MISC + 768 * 1024))[(g * NSEG + seg) * 4 + F.wave] = __expf(totsum);
        __syncthreads();
    }
}

__device__ __forceinline__ void ssd_pass_b(const Args& a, const Ctx& F) {
    LAS bf16* xT = (LAS bf16*)(F.lds + SQ_XT); LAS bf16* Bc = (LAS bf16*)(F.lds + SQ_BC); LAS bf16* Bt = (LAS bf16*)(F.lds + SQ_BT); LAS bf16* Cc = (LAS bf16*)(F.lds + SQ_CC);
    LAS float* dts = (LAS float*)(F.lds + SQ_DT); LAS float* acs = dts + 256; LAS float* eacs = dts + 768; const LAS float* cdec = dts + 1024; LAS bf16* yb = (LAS bf16*)(F.lds + SQ_Y); const LAS float* wl = (const LAS float*)(F.lds + SQ_W);
    for (int u = F.vcu; u < NGRP * NSEG; u += F.G) {
        const int g = u >> 5, seg = u & 31; const int hd = F.wave >> 1, pt = F.wave & 1, r = F.lane & 31, hh = F.lane >> 5, head = 4 * g + hd;
        const int cgx = F.tid >> 4, l0x = (F.tid & 15) * 4, cgb = F.tid >> 5, l0b = (F.tid & 31) * 2;
        conv_weights_to_lds(a, F, g);
        f32x16 acc[4];
        { const bf16* st = (const bf16*)(PWS + WS_ST) + seg_state_off(g, seg, hd); const int p = 32 * pt + r;
#pragma unroll
          for (int i = 0; i < 4; ++i)
#pragma unroll
              for (int q = 0; q < 4; ++q) { const v2u w = *(const v2u*)(st + ((4 * i + q) * 64 + p) * 8 + 4 * hh); acc[i][4 * q] = bflo(w.x); acc[i][4 * q + 1] = bfhi(w.x); acc[i][4 * q + 2] = bflo(w.y); acc[i][4 * q + 3] = bfhi(w.y); } }
        const float dsk = PIN(I_DSSD)[head];
        const int t0 = seg * SEGC * CHK;
        unsigned char* wsb = PWS;
        unsigned ox = (unsigned)(WS_XBC + ((size_t)(t0 + l0x) * XBCD + g * 256 + cgx * 8) * 2 - 3 * XBCD * 2);
        unsigned ob = (unsigned)(WS_XBC + ((size_t)(t0 + l0b) * XBCD + 2048 + g * 128 + cgb * 8) * 2 - 3 * XBCD * 2);
        unsigned odt = (unsigned)(WS_DT + ((size_t)(t0 + F.lane) * 32 + 4 * g + (F.wave & 3)) * 4);
        const int gcx = F.tid & 31;
        unsigned oz = (unsigned)(WS_YV + ((size_t)(t0 + (F.tid >> 5) * 4) * YVP + g * 256 + gcx * 8) * 2);
        unsigned oss = (unsigned)(WS_MISC + ((size_t)(t0 + (F.tid >> 5) * 4) * 8 + g) * 4);
#pragma unroll 1
        for (int k = 0; k < SEGC; ++k) {
            v4u rx[7], rb[5], rc[5];
            const float dtv = *(const float*)(wsb + odt);
            rows_load<7>(wsb, ox, t0 + k * CHK + l0x - 3, rx); rows_load<5>(wsb, ob, t0 + k * CHK + l0b - 3, rb); rows_load<5>(wsb, ob + 2048, t0 + k * CHK + l0b - 3, rc);
            (void)seq_dt_setup(a, F, g, dtv, k & 1);
            { const int hx = cgx >> 3, p0 = (cgx & 7) * 8;
              conv_xs_to_lds<false>(wl, cgx * 8, rx, xT + (hx * 64 + p0) * 72 + l0x, (f32x4){1.f, 1.f, 1.f, 1.f});
              conv_bc_to_lds<true, true>(wl, 256 + cgb * 8, rb, Bc + l0b * 136 + cgb * 8, Bt + (cgb * 8) * 72 + l0b);
              conv_bc_to_lds<true, false>(wl, 384 + cgb * 8, rc, Cc + l0b * 136 + cgb * 8, Cc); }
            __syncthreads();
            {
                const LAS bf16* xrow = xT + (hd * 64 + 32 * pt + r) * 72; const int pcol = hd * 64 + 32 * pt + r;
#pragma unroll
                for (int lt = 0; lt < 2; ++lt) {
                    f32x16 y;
#pragma unroll
                    for (int j = 0; j < 16; ++j) y[j] = 0.f;
#pragma unroll
                    for (int i = 0; i < 4; ++i)
#pragma unroll
                        for (int kk = 0; kk < 2; ++kk) { const bf16x8 bs = pack_frag(acc[i], kk); const int nb = 32 * i + 16 * kk + 4 * hh;
                            const v2u lo = *(const LAS v2u*)(Cc + (32 * lt + r) * 136 + nb), hi = *(const LAS v2u*)(Cc + (32 * lt + r) * 136 + nb + 8); const v4u c0 = (v4u){lo.x, lo.y, hi.x, hi.y};
                            y = __builtin_amdgcn_mfma_f32_32x32x16_bf16(__builtin_bit_cast(bf16x8, c0), bs, y, 0, 0, 0); }
#pragma unroll
                    for (int q = 0; q < 4; ++q) { const f32x4 e0 = *(const LAS f32x4*)(eacs + hd * 64 + 32 * lt + 8 * q + 4 * hh);
#pragma unroll
                        for (int i = 0; i < 4; ++i) y[4 * q + i] *= e0[i]; }
                    __builtin_amdgcn_sched_barrier(0);
                    const float al = acs[hd * 64 + 32 * lt + r];
#pragma unroll
                    for (int st = 0; st <= lt; ++st) {
                        f32x16 X;
#pragma unroll
                        for (int j = 0; j < 16; ++j) X[j] = 0.f;
#pragma unroll
                        for (int ks = 0; ks < 8; ++ks) { const int ko = 16 * ks + 8 * hh;
                            const bf16x8 a0 = *(const LAS bf16x8*)(Bc + (32 * st + r) * 136 + ko), b0 = *(const LAS bf16x8*)(Cc + (32 * lt + r) * 136 + ko);
                            X = __builtin_amdgcn_mfma_f32_32x32x16_bf16(a0, b0, X, 0, 0, 0); }
#pragma unroll
                        for (int q = 0; q < 4; ++q) { const int sb = 8 * q + 4 * hh;
                            const f32x4 as0 = *(const LAS f32x4*)(acs + hd * 64 + 32 * st + sb), ds0 = *(const LAS f32x4*)(dts + hd * 64 + 32 * st + sb);
#pragma unroll
                            for (int i = 0; i < 4; ++i) { const int j = 4 * q + i; const float v = X[j] * __expf(al - as0[i]) * ds0[i]; X[j] = (st < lt || r >= sb + i) ? v : 0.f; } }
#pragma unroll
                        for (int kk = 0; kk < 2; ++kk) { const int sb = 32 * st + 16 * kk + 4 * hh;
                            const v2u lo = *(const LAS v2u*)(xrow + sb), hi = *(const LAS v2u*)(xrow + sb + 8); const v4u wa = (v4u){lo.x, lo.y, hi.x, hi.y};
                            y = __builtin_amdgcn_mfma_f32_32x32x16_bf16(pack_frag(X, kk), __builtin_bit_cast(bf16x8, wa), y, 0, 0, 0); }
                        __builtin_amdgcn_sched_barrier(0);
                    }
#pragma unroll
                    for (int q = 0; q < 4; ++q) { const int lb = 32 * lt + 8 * q + 4 * hh;
                        const v2u xa = *(const LAS v2u*)(xrow + lb); const float xa4[4] = {bflo(xa.x), bfhi(xa.x), bflo(xa.y), bfhi(xa.y)};
#pragma unroll
                        for (int i = 0; i < 4; ++i) yb[(lb + i) * 264 + pcol] = (bf16)f2bf(y[4 * q + i] + dsk * xa4[i]); }
                    __builtin_amdgcn_sched_barrier(0);
                }
                seq_state_update(F, acc, hd, pt, cdec[(k & 1) * 4 + hd]);
            }
            ox += CHK * XBCD * 2; ob += CHK * XBCD * 2; odt += CHK * 32 * 4;
            v4u zq[4];
#pragma unroll
            for (int i = 0; i < 4; ++i) zq[i] = *(const v4u*)(wsb + (size_t)(oz + (unsigned)i * (YVP * 2)));
            __syncthreads();
            { const float* nw = PIN(I_NSW) + g * 256 + gcx * 8; const f32x4 n0 = *(const f32x4*)nw, n1 = *(const f32x4*)(nw + 4);
#pragma unroll
              for (int i = 0; i < 4; ++i) { const int l = (F.tid >> 5) * 4 + i;
                  float zz[8], yy[8]; unpack8(zq[i], zz); unpack8(*(const LAS v4u*)(yb + l * 264 + gcx * 8), yy);
                  f32x4 g0, g1; float sq = 0.f;
#pragma unroll
                  for (int j = 0; j < 4; ++j) { g0[j] = yy[j] * zz[j]; g1[j] = yy[4 + j] * zz[4 + j]; sq += g0[j] * g0[j] + g1[j] * g1[j]; }
                  *(v4u*)(wsb + (size_t)(oz + (unsigned)i * (YVP * 2))) = pack8(g0 * n0, g1 * n1);
#pragma unroll
                  for (int o = 1; o < 32; o <<= 1) sq += __shfl_xor(sq, o);
                  if (gcx == 0) *(float*)(wsb + (size_t)(oss + (unsigned)i * 32)) = sq; } }
            oz += CHK * YVP * 2; oss += CHK * 8 * 4;
        }
        __syncthreads();
    }
}

__device__ __forceinline__ void seg_scan(const Args& a, const Ctx& F) {
    for (int it = F.vcu * NWAVES + F.wave; it < 2048; it += F.G * NWAVES) { const int gh = it >> 6, sl = it & 63, g = gh >> 2, hd = gh & 3;
        bf16* base = (bf16*)(PWS + WS_ST) + seg_state_off(g, 0, hd) + sl * 128 + F.lane * 2; const float* cd = (const float*)(PWS + WS_MISC + 768 * 1024) + (size_t)g * NSEG * 4 + hd; constexpr size_t CS = (size_t)4 * 8192;
        unsigned v[NSEG]; float d[NSEG];
#pragma unroll
        for (int j = 0; j < NSEG; ++j) { v[j] = *(const unsigned*)(base + (size_t)j * CS); d[j] = cd[j * 4]; }
        float c0 = 0.f, c1 = 0.f;
#pragma unroll
        for (int j = 0; j < NSEG; ++j) { *(unsigned*)(base + (size_t)j * CS) = pk2(c0, c1); c0 = c0 * d[j] + bflo(v[j]); c1 = c1 * d[j] + bfhi(v[j]); } }
}

__device__ __forceinline__ void scans(const Args& a, const Ctx& F) {
    if (F.vcu < S5G) {
        const int g = F.vcu, n = F.lane; const float dt = expf(PIN(I_LOGDT)[g]), lr = PIN(I_LRE)[g * 64 + n], li = PIN(I_LIM)[g * 64 + n];
        const float mag = expf(16.f * lr * dt), ang = 16.f * li * dt, ar = mag * cosf(ang), ai = mag * sinf(ang);
        const float* SLp = (const float*)(PWS + WS_SL) + ((size_t)g * S5NC + 128 * F.wave) * 128 + n; bf16* AP = (bf16*)(PWS + WS_AP) + ((size_t)g * S5NC + 128 * F.wave) * APK + 256 + n;
        LAS float* ex = (LAS float*)F.lds;
        float sr = 0.f, si = 0.f;
        for (int cb = 0; cb < 128; cb += 16) { float ra[16], ia[16];
#pragma unroll
            for (int j = 0; j < 16; ++j) { ra[j] = SLp[(size_t)(cb + j) * 128]; ia[j] = SLp[(size_t)(cb + j) * 128 + 64]; }
#pragma unroll
            for (int j = 0; j < 16; ++j) { const float nr = ar * sr - ai * si + ra[j], ni = ar * si + ai * sr + ia[j]; sr = nr; si = ni; } }
        ex[F.wave * 128 + n] = sr; ex[F.wave * 128 + 64 + n] = si;
        __syncthreads();
        float pr = ar, pi = ai;
#pragma unroll
        for (int q = 0; q < 7; ++q) { const float t = pr * pr - pi * pi; pi = 2.f * pr * pi; pr = t; }
        sr = 0.f; si = 0.f;
        for (int w = 0; w < F.wave; ++w) { const float er = ex[w * 128 + n], ei = ex[w * 128 + 64 + n]; const float nr = pr * sr - pi * si + er, ni = pr * si + pi * sr + ei; sr = nr; si = ni; }
        for (int cb = 0; cb < 128; cb += 16) { float ra[16], ia[16];
#pragma unroll
            for (int j = 0; j < 16; ++j) { ra[j] = SLp[(size_t)(cb + j) * 128]; ia[j] = SLp[(size_t)(cb + j) * 128 + 64]; }
#pragma unroll
            for (int j = 0; j < 16; ++j) { AP[(size_t)(cb + j) * APK] = (bf16)f2bf(sr); AP[(size_t)(cb + j) * APK + 64] = (bf16)f2bf(si);
                const float nr = ar * sr - ai * si + ra[j], ni = ar * si + ai * sr + ia[j]; sr = nr; si = ni; } }
        __syncthreads();
    }
    seg_scan(a, F);
}

__device__ __forceinline__ void route_unit(const Args& a, const Ctx& F, int unit, LAS float* lg  ) {
    const int t0 = unit * 16, row = F.lane & 15, kq = F.lane >> 4;
    const float* xr = PIN(I_X) + (size_t)(t0 + row) * D + 8 * kq; const bf16* xd = (const bf16*)(PWS + WS_XD) + (size_t)(t0 + row) * D + 8 * kq; unsigned char* h2 = PWS + WS_H + (size_t)(t0 + row) * D + 8 * kq;
    const float* nf = PIN(I_NFW) + 8 * kq; const bf16* wt = (const bf16*)(PWS + WS_RT) + (size_t)row * D + 8 * kq;
    f32x4 acc0 = {0.f, 0.f, 0.f, 0.f}, acc1 = acc0, acc2 = acc0; float ssq = 0.f;
#pragma unroll 4
    for (int ks = 0; ks < 64; ++ks) { const int k = 32 * ks;
        const f32x4 x0 = *(const f32x4*)(xr + k), x1 = *(const f32x4*)(xr + k + 4), g0 = *(const f32x4*)(nf + k), g1 = *(const f32x4*)(nf + k + 4); float dd[8]; unpack8(*(const v4u*)(xd + k), dd);
        f32x4 m0, m1;
#pragma unroll
        for (int j = 0; j < 4; ++j) { m0[j] = x0[j] + dd[j]; m1[j] = x1[j] + dd[4 + j]; ssq += m0[j] * m0[j] + m1[j] * m1[j]; }
        const f32x4 hq0 = m0 * g0, hq1 = m1 * g1; const v4u hv = pack8(hq0, hq1); { v2u o8; o8.x = pk4_fp8(hq0[0], hq0[1], hq0[2], hq0[3]); o8.y = pk4_fp8(hq1[0], hq1[1], hq1[2], hq1[3]); *(v2u*)(h2 + k) = o8; } const bf16x8 af = __builtin_bit_cast(bf16x8, hv);
        const bf16x8 b0h = *(const bf16x8*)(wt + k), b1h = *(const bf16x8*)(wt + (size_t)16 * D + k), b2h = *(const bf16x8*)(wt + (size_t)32 * D + k);
        const bf16x8 b0l = *(const bf16x8*)(wt + (size_t)48 * D + k), b1l = *(const bf16x8*)(wt + (size_t)64 * D + k), b2l = *(const bf16x8*)(wt + (size_t)80 * D + k);
        acc0 = __builtin_amdgcn_mfma_f32_16x16x32_bf16(af, b0h, acc0, 0, 0, 0); acc1 = __builtin_amdgcn_mfma_f32_16x16x32_bf16(af, b1h, acc1, 0, 0, 0); acc2 = __builtin_amdgcn_mfma_f32_16x16x32_bf16(af, b2h, acc2, 0, 0, 0);
        acc0 = __builtin_amdgcn_mfma_f32_16x16x32_bf16(af, b0l, acc0, 0, 0, 0); acc1 = __builtin_amdgcn_mfma_f32_16x16x32_bf16(af, b1l, acc1, 0, 0, 0); acc2 = __builtin_amdgcn_mfma_f32_16x16x32_bf16(af, b2l, acc2, 0, 0, 0); }
    ssq += __shfl_xor(ssq, 16); ssq += __shfl_xor(ssq, 32);
    const float rstd = 1.0f / sqrtf(ssq * (1.f / D) + EPS);
    if (kq == 0) ((float*)(PWS + WS_MISC + 800 * 1024))[t0 + row] = rstd;
#pragma unroll
    for (int reg = 0; reg < 4; ++reg) { const int tok = 4 * kq + reg; const float rs = __shfl(rstd, tok);
        lg[tok * 48 + row] = rs * acc0[reg]; lg[tok * 48 + 16 + row] = rs * acc1[reg]; lg[tok * 48 + 32 + row] = rs * acc2[reg]; }
    LDS_WAIT(); asm volatile("" ::: "memory");
    if (F.lane < 16) { const int tok = F.lane; const LAS float* lq = lg + tok * 48;
        unsigned* cnt = (unsigned*)(PWS + WS_CTL) + CW_CNT + a.bar_region * 4096; unsigned* list_tok = (unsigned*)(PWS + WS_LST); float* list_w = (float*)(PWS + WS_LST + 2 * MiB);
        float g4[4]; int grp = 0; float gmax;
#pragma unroll
        for (int j = 0; j < 4; ++j) g4[j] = lq[j] + PIN(I_BRG)[j];
        gmax = g4[0];
#pragma unroll
        for (int j = 1; j < 4; ++j) if (g4[j] > gmax) { gmax = g4[j]; grp = j; }
        float den = 0.f;
#pragma unroll
        for (int j = 0; j < 4; ++j) den += expf(g4[j] - gmax);
        const float pg = 1.0f / den;
        float v1 = -INFINITY, v2 = -INFINITY; int i1 = 0, i2 = 0;
        for (int j = 0; j < 8; ++j) { const float le = lq[16 + grp * 8 + j] + PIN(I_BRE2)[grp * 8 + j];
            if (le > v1) { v2 = v1; i2 = i1; v1 = le; i1 = j; } else if (le > v2) { v2 = le; i2 = j; } }
        const float e2 = expf(v2 - v1), w1 = pg / (1.0f + e2), w2 = pg * e2 / (1.0f + e2);
        const int ea = grp * 8 + i1, eb = grp * 8 + i2; const unsigned tk = (unsigned)(t0 + tok);
        float* list_r = (float*)(PWS + WS_LR); unsigned* tokslot = (unsigned*)(PWS + WS_LR + 2 * MiB);
        const unsigned s1 = atomicAdd(cnt + 64 * ea, 1u); list_tok[(size_t)ea * CAPL + s1] = tk * 2u; list_w[(size_t)ea * CAPL + s1] = w1; list_r[(size_t)ea * CAPL + s1] = rstd; tokslot[tk * 2u] = (unsigned)ea * CAPL + s1;
        const unsigned s2 = atomicAdd(cnt + 64 * eb, 1u); list_tok[(size_t)eb * CAPL + s2] = tk * 2u + 1u; list_w[(size_t)eb * CAPL + s2] = w2; list_r[(size_t)eb * CAPL + s2] = rstd; tokslot[tk * 2u + 1u] = (unsigned)eb * CAPL + s2; }
    LDS_WAIT(); asm volatile("" ::: "memory");
}
template <class Dec>
__device__ __forceinline__ void transpose_jobs_dyn(volatile LAS unsigned* ctr, int cu, int ncu, int nitems, const Dec dec, LAS float* scr, int lane) {
    auto grab = [&]() -> int { unsigned j = 0; if (lane == 0) j = __hip_atomic_fetch_add((LAS unsigned*)ctr, 1u, __ATOMIC_RELAXED, __HIP_MEMORY_SCOPE_WORKGROUP); j = __builtin_amdgcn_readfirstlane(j); return cu + (int)j * ncu; };
    int it = grab(); if (it >= nitems) return;
    TJob cur; f32x4 v[8]; dec(it, cur); tj_load(cur, lane, v);
    for (;;) { const int nx = grab(); const bool hn = nx < nitems; TJob nj = cur; f32x4 nv[8];
        if (hn) { dec(nx, nj); tj_load(nj, lane, nv); }
        tj_store(cur, lane, v, scr);
        if (!hn) break;
        cur = nj;
#pragma unroll
        for (int i = 0; i < 8; ++i) v[i] = nv[i]; }
}
template <class Dec>
__device__ __forceinline__ void transpose_jobs_queue(unsigned* gctr, int first_item, int nbatches, const Dec dec, LAS float* scr, int lane) {
    unsigned bv = 0u; if (lane == 0) bv = __hip_atomic_fetch_add(gctr, 1u, __ATOMIC_RELAXED, __HIP_MEMORY_SCOPE_AGENT);
    int b = (int)__builtin_amdgcn_readfirstlane(bv);
    while (b < nbatches) {
        unsigned nv = 0u; if (lane == 0) nv = __hip_atomic_fetch_add(gctr, 1u, __ATOMIC_RELAXED, __HIP_MEMORY_SCOPE_AGENT);
        transpose_jobs<Dec>(first_item + 8 * b, 1, first_item + 8 * b + 8, dec, scr, lane);
        b = (int)__builtin_amdgcn_readfirstlane(nv); }
}
__device__ __forceinline__ void route_phase(const Args& a, const Ctx& F) {
    if (F.wave < 4) { LAS float* lg = (LAS float*)(F.lds + 8 * 16384) + F.wave * 768;
        for (int unit = F.vcu * 4 + F.wave; unit < T / 16; unit += F.G * 4) route_unit(a, F, unit, lg); }
    { LAS float* scr = (LAS float*)(F.lds + F.wave * 16384);
      DecExp dec{PIN(I_WEG), PIN(I_WEU), PIN(I_WED), PWS};
      transpose_jobs_dyn<DecExp>(F.ctl + 76, F.vcu, F.G, 2 * DecExp::I_GU, dec, scr, F.lane); }
}
__device__ __forceinline__ void moe_tables(const Args& a, const Ctx& F) {
    if (F.tid == 0) { const unsigned* cnt = (const unsigned*)(PWS + WS_CTL) + CW_CNT + a.bar_region * 4096; unsigned rb = 0, nt = 0;
        for (int e = 0; e < NE; ++e) { const unsigned c = __hip_atomic_load(cnt + 64 * e, __ATOMIC_RELAXED, __HIP_MEMORY_SCOPE_AGENT); const unsigned tiles = (c + 255u) >> 8; F.ctl[8 + e] = c; F.ctl[40 + e] = rb;
            for (unsigned i = 0; i < tiles && nt < 160u; ++i) F.ctl[80 + nt++] = (unsigned)e; rb += tiles * 256u; }
        F.ctl[72] = nt; }
    __syncthreads();
}
__device__ __forceinline__ void final_phase(const Args& a, const Ctx& F) {
    const int lane = (int)__builtin_amdgcn_mbcnt_hi(~0u, __builtin_amdgcn_mbcnt_lo(~0u, 0u));
    const int gw = F.vcu * NWAVES + F.wave, NGW = F.G * NWAVES; const unsigned char* Y = PWS + WS_XBC; const bf16* XD = (const bf16*)(PWS + WS_XD); const unsigned* tokslot = (const unsigned*)(PWS + WS_LR + 2 * MiB);
    for (int m = gw; m < T; m += NGW) { float* orow = POUT + (size_t)m * D; const f32x4* x4 = (const f32x4*)(PIN(I_X) + (size_t)m * D) + lane; const v2u* xd = (const v2u*)(XD + (size_t)m * D) + lane;
        const unsigned ts0 = tokslot[2 * m], ts1 = tokslot[2 * m + 1];
        const size_t r0 = (size_t)F.ctl[40 + (ts0 >> 14)] + (ts0 & 16383u), r1 = (size_t)F.ctl[40 + (ts1 >> 14)] + (ts1 & 16383u);
        const unsigned* y0 = (const unsigned*)(Y + r0 * D) + lane; const unsigned* y1 = (const unsigned*)(Y + r1 * D) + lane;
        const f32x4* w4 = (const f32x4*)PIN(I_NFINAL) + lane; f32x4 v[8]; float s = 0.f;
#pragma unroll
        for (int j = 0; j < 8; ++j) { const f32x4 x = x4[64 * j]; const unsigned p = y0[64 * j], q = y1[64 * j]; const v2u d2 = xd[64 * j];
            const f32x2 p0 = __builtin_amdgcn_cvt_pk_f32_fp8((int)p, false), p1 = __builtin_amdgcn_cvt_pk_f32_fp8((int)p, true), q0 = __builtin_amdgcn_cvt_pk_f32_fp8((int)q, false), q1 = __builtin_amdgcn_cvt_pk_f32_fp8((int)q, true);
            constexpr float ys = 1.0f / Y_SCALE;
            v[j] = (f32x4){x.x + bflo(d2.x) + ys * (p0[0] + q0[0]), x.y + bfhi(d2.x) + ys * (p0[1] + q0[1]), x.z + bflo(d2.y) + ys * (p1[0] + q1[0]), x.w + bfhi(d2.y) + ys * (p1[1] + q1[1])};
            s += (v[j].x * v[j].x + v[j].y * v[j].y) + (v[j].z * v[j].z + v[j].w * v[j].w); }
        const float rstd = 1.0f / sqrtf(wave_sum(s) * (1.f / D) + EPS);
#pragma unroll
        for (int j = 0; j < 8; ++j) { const f32x4 g = w4[64 * j]; ((f32x4*)orow + lane)[64 * j] = (f32x4){v[j].x * rstd * g.x, v[j].y * rstd * g.y, v[j].z * rstd * g.z, v[j].w * rstd * g.w}; } }
}

constexpr int N_PHASES = 12;
template <int VARIANT>
__global__ void __launch_bounds__(NWAVES * 64, 2) hybrid_fwd(Args args) {
    extern __shared__ __attribute__((aligned(16))) unsigned char lds_raw[];
    Ctx F; F.lds = (LAS unsigned char*)lds_raw; F.ctl = (volatile LAS unsigned*)(F.lds + LDSCTL_OFF);
    F.tid = threadIdx.x; F.lane = F.tid & 63; F.wave = __builtin_amdgcn_readfirstlane(F.tid >> 6);
    F.G = gridDim.x; { const int bx = blockIdx.x; F.vcu = (F.G % 8 == 0) ? (bx % 8) * (F.G / 8) + bx / 8 : bx; }
    for (int u = F.tid; u < (LDS_BYTES - LDSCTL_OFF) / 4; u += NWAVES * 64) ((LAS unsigned*)(F.lds + LDSCTL_OFF))[u] = 0u;
    __syncthreads();
    if (F.tid == 0) { LAS unsigned long long* pt = (LAS unsigned long long*)(F.lds + PTAB_OFF);
        pt[0] = (unsigned long long)args.in[0];
        pt[1] = (unsigned long long)args.in[1];
        pt[2] = (unsigned long long)args.in[2];
        pt[3] = (unsigned long long)args.in[3];
        pt[4] = (unsigned long long)args.in[4];
        pt[5] = (unsigned long long)args.in[5];
        pt[6] = (unsigned long long)args.in[6];
        pt[7] = (unsigned long long)args.in[7];
        pt[8] = (unsigned long long)args.in[8];
        pt[9] = (unsigned long long)args.in[9];
        pt[10] = (unsigned long long)args.in[10];
        pt[11] = (unsigned long long)args.in[11];
        pt[12] = (unsigned long long)args.in[12];
        pt[13] = (unsigned long long)args.in[13];
        pt[14] = (unsigned long long)args.in[14];
        pt[15] = (unsigned long long)args.in[15];
        pt[16] = (unsigned long long)args.in[16];
        pt[17] = (unsigned long long)args.in[17];
        pt[18] = (unsigned long long)args.in[18];
        pt[19] = (unsigned long long)args.in[19];
        pt[20] = (unsigned long long)args.in[20];
        pt[21] = (unsigned long long)args.in[21];
        pt[22] = (unsigned long long)args.in[22];
        pt[23] = (unsigned long long)args.in[23];
        pt[24] = (unsigned long long)args.in[24];
        pt[25] = (unsigned long long)args.in[25];
        pt[26] = (unsigned long long)args.in[26];
        pt[27] = (unsigned long long)args.in[27];
        pt[28] = (unsigned long long)args.in[28];
        pt[29] = (unsigned long long)args.in[29];
        pt[30] = (unsigned long long)args.in[30];
        pt[31] = (unsigned long long)args.out; pt[32] = (unsigned long long)args.ws; }
    __syncthreads();
    const unsigned mask = args.mask; const int lastp = 31 - __builtin_clz(mask | 1u);
    if (__builtin_popcount(mask) > 1) (void)xcd_barrier_post((unsigned*)(PWS + WS_CTL) + CW_BAR + args.bar_region * XCD_BAR_WORDS, F.ctl);
#define IN(k) (((mask >> (k)) & 1u) && (F.lane = (int)__builtin_amdgcn_mbcnt_hi(~0u, __builtin_amdgcn_mbcnt_lo(~0u, 0u)), F.tid = F.wave * 64 + F.lane, true))
#define SEAM(k) do { if (IN(k) && (k) != lastp) { XcdBarrier bar_; bar_.bar = (unsigned*)(PWS + WS_CTL) + CW_BAR + args.bar_region * XCD_BAR_WORDS; bar_.x = xb_xcc_id(); bar_.st = F.ctl; xcd_barrier(bar_); } } while (0)
    unsigned char* ws = PWS;
    if (IN(0)) { p0_prologue(args, F); } SEAM(0);
    if (IN(1)) { SchedDense S; S.so.init(T / 256, 28, F.G, (int)blockIdx.x); S.A = (const char*)(ws + WS_H); S.B = (const char*)(ws + WS_WIN); S.lda = D * 2; S.ldb = D * 2;
        Epi1a E{(bf16*)(ws + WS_YV), (bf16*)(ws + WS_XBC), (bf16*)(ws + WS_AP)};
        pg8::gemm_phase<Epi1a, SchedDense, false>(F.lds, D, D * 2, D * 2, S, E, (VARIANT & 1) != 0);
        dt_gemm(args, F); } SEAM(1);
    if (IN(2)) { ssd_pass_a(args, F);
        SchedS5 S{(const char*)(ws + WS_AP), (const char*)(ws + WS_S5WS), 512u, F.G, F.vcu}; EpiS5a E{(float*)(ws + WS_SL)};
        pg8::gemm_phase<EpiS5a, SchedS5, false>(F.lds, 256, APK * 2, 512, S, E, (VARIANT & 1) != 0); } SEAM(2);
    if (IN(3)) { scans(args, F); } SEAM(3);
    if (IN(4)) { ssd_pass_b(args, F);
        SchedS5 S{(const char*)(ws + WS_AP), (const char*)(ws + WS_S5TW), (unsigned)(APK * 2), F.G, F.vcu}; EpiS5b E{(bf16*)(ws + WS_SL)};
        pg8::gemm_phase<EpiS5b, SchedS5, false>(F.lds, APK, APK * 2, APK * 2, S, E, (VARIANT & 1) != 0); } SEAM(4);
    if (IN(5)) { { SchedDense S; S.so.init(T / 256, 16, F.G, (int)blockIdx.x); S.A = (const char*)(ws + WS_H8); S.B = (const char*)(ws + WS_WIN) + (size_t)7168 * D * 2; S.lda = D; S.ldb = D;
          Epi1b E{(bf16*)(ws + WS_XBC), PIN(I_GATEB), (const float*)(ws + WS_MISC)};
          pg8::gemm_phase<Epi1b, SchedDense, false, true, 0, true, 127, 122>(F.lds, D, D, D, S, E, (VARIANT & 1) != 0); }
        { SchedDense S; S.so.init(T / 256, 4, F.G, (int)blockIdx.x); S.A = (const char*)(ws + WS_SL); S.B = (const char*)(ws + WS_WGLU); S.lda = S5W * 2; S.ldb = S5W * 2;
          EpiGlu E{(const bf16*)(ws + WS_SL), (bf16*)(ws + WS_YV)};
          pg8::gemm_phase<EpiGlu, SchedDense, false>(F.lds, S5W, S5W * 2, S5W * 2, S, E, (VARIANT & 1) != 0); } } SEAM(5);
    if (IN(6)) { SchedDense S; S.so.init(T / 256, 8, F.G, (int)blockIdx.x); S.A = (const char*)(ws + WS_YV); S.B = (const char*)(ws + WS_WAB); S.lda = YVP * 2; S.ldb = YVP * 2;
        EpiAB E{(const bf16*)(ws + WS_XBC), (bf16*)(ws + WS_ST)};
        pg8::gemm_phase<EpiAB, SchedDense, false, true, 32>(F.lds, YVP, YVP * 2, YVP * 2, S, E, (VARIANT & 1) != 0); } SEAM(6);
    if (IN(8)) { SchedDense S; S.so.init(T / 256, 8, F.G, (int)blockIdx.x); S.A = (const char*)(ws + WS_ST); S.B = (const char*)(ws + WS_WOUT); S.lda = D * 2; S.ldb = D * 2;
        EpiOut E{(bf16*)(ws + WS_XD)};
        pg8::gemm_phase<EpiOut, SchedDense, false>(F.lds, D, D * 2, D * 2, S, E, (VARIANT & 1) != 0); } SEAM(8);
    if (IN(9)) { route_phase(args, F); } SEAM(9);
    if (IN(10)) { moe_tables(args, F);
        SchedMoE S{F.ctl, (const char*)(ws + WS_H), (const char*)(ws + WS_ST), (const unsigned*)(ws + WS_LST), (unsigned)D, (size_t)1024 * D, (unsigned)D, 4, F.G, F.vcu, true};
        EpiGU E{(bf16*)(ws + WS_AP), (const unsigned*)(ws + WS_LST), (const float*)(ws + WS_LR)};
        pg8::gemm_phase<EpiGU, SchedMoE, true, true, 0, true, 127, 121>(F.lds, D, D, D, S, E, (VARIANT & 1) != 0);
        { LAS float* scr = (LAS float*)(F.lds + F.wave * 16384); DecExp dec{PIN(I_WEG), PIN(I_WEU), PIN(I_WED), PWS};
          transpose_jobs_queue<DecExp>((unsigned*)(ws + WS_CTL) + CW_CNT + args.bar_region * 4096 + 2560, 2 * DecExp::I_GU, DecExp::I_GU / 8, dec, scr, F.lane); } } SEAM(10);
    if (IN(11)) { moe_tables(args, F);
        SchedMoE S{F.ctl, (const char*)(ws + WS_AP), (const char*)(ws + WS_YV), (const unsigned*)(ws + WS_LST), (unsigned)FF, (size_t)D * FF, (unsigned)FF, 8, F.G, F.vcu, false};
        EpiDn E{(const float*)(ws + WS_LST + 2 * MiB), ws + WS_XBC};
        pg8::gemm_phase<EpiDn, SchedMoE, false, true, 0, true, 125, 122>(F.lds, FF, FF, FF, S, E, (VARIANT & 1) != 0); } SEAM(11);
    if (IN(12)) { moe_tables(args, F); final_phase(args, F); }
#undef IN
#undef SEAM
}

extern "C" void kernel_launch(void* const* d_in, const int* in_sizes, int n_in, void* d_out, int out_size, void* d_ws, size_t ws_size, hipStream_t stream) {
    static int grid = 0;
    if (grid == 0) {
        if (n_in != 31 || in_sizes[0] != T * D || out_size != T * D || ws_size < WS_END) { fprintf(stderr, "kernel_launch: unexpected shapes / workspace (n_in %d, ws %zu, need %zu)\n", n_in, ws_size, (size_t)WS_END); grid = -1; return; }
        int dev = 0, cus = 0;
        if (hipGetDevice(&dev) != hipSuccess || hipDeviceGetAttribute(&cus, hipDeviceAttributeMultiprocessorCount, dev) != hipSuccess) { grid = -1; return; }
        if (hipFuncSetAttribute((const void*)hybrid_fwd<0>, hipFuncAttributeMaxDynamicSharedMemorySize, LDS_BYTES) != hipSuccess) { fprintf(stderr, "kernel_launch: hipFuncSetAttribute failed\n"); grid = -1; return; }
#if defined(EXP_MASK)
        (void)hipFuncSetAttribute((const void*)hybrid_fwd<EXP_VARIANT>, hipFuncAttributeMaxDynamicSharedMemorySize, LDS_BYTES);
#endif
        int per_cu = 0;
        if (hipOccupancyMaxActiveBlocksPerMultiprocessor(&per_cu, (const void*)hybrid_fwd<0>, NWAVES * 64, LDS_BYTES) != hipSuccess || per_cu < 1) fprintf(stderr, "kernel_launch: occupancy query reports %d\n", per_cu);
        (void)hipGetLastError();
        grid = cus;
    }
    if (grid < 0) return;
    (void)hipMemsetAsync((char*)d_ws + WS_CTL, 0, CTL_ZERO_BYTES, stream);
    Args a{};
    for (int i = 0; i < 31; ++i) a.in[i] = (const float*)d_in[i];
    a.out = (float*)d_out; a.ws = (unsigned char*)d_ws;
#if defined(EXP_MASK)
    a.mask = EXP_MASK; a.variant = EXP_VARIANT; a.bar_region = 0;
    hipLaunchKernelGGL(hybrid_fwd<EXP_VARIANT>, dim3(grid), dim3(NWAVES * 64), LDS_BYTES, stream, a);
    a.mask = ((1u << (N_PHASES + 1)) - 1u) & ~(1u << 7); a.variant = 0; a.bar_region = 1;
    hipLaunchKernelGGL(hybrid_fwd<0>, dim3(grid), dim3(NWAVES * 64), LDS_BYTES, stream, a);
#elif MK_N_LAUNCHES == 1
    a.mask = ((1u << (N_PHASES + 1)) - 1u) & ~(1u << 7); a.variant = 0; a.bar_region = 0;
    hipLaunchKernelGGL(hybrid_fwd<0>, dim3(grid), dim3(NWAVES * 64), LDS_BYTES, stream, a);
#else
    for (int p = 0; p <= N_PHASES; ++p) { if (p == 7) continue; a.mask = 1u << p; a.variant = 0; a.bar_region = 0; hipLaunchKernelGGL(hybrid_fwd<0>, dim3(grid), dim3(NWAVES * 64), LDS_BYTES, stream, a); }
#endif
}
```

```cpp
#include <hip/hip_runtime.h>
#include <cstdio>
#include <cstdint>

#ifndef MK_N_LAUNCHES
#define MK_N_LAUNCHES 1
#endif
#ifndef EXP_VARIANT
#define EXP_VARIANT 0
#endif
#ifndef NAIVE_GEMM
#define NAIVE_GEMM 0
#endif

#define LAS __attribute__((address_space(3)))
#define GAS __attribute__((address_space(1)))
typedef unsigned short bf16;
typedef short bf16x8 __attribute__((ext_vector_type(8)));
typedef float f32x4 __attribute__((ext_vector_type(4)));
typedef float f32x2 __attribute__((ext_vector_type(2)));
typedef float f32x16 __attribute__((ext_vector_type(16)));
typedef unsigned v4u __attribute__((ext_vector_type(4)));
typedef unsigned v2u __attribute__((ext_vector_type(2)));
typedef GAS unsigned gu32;
typedef int v4i_ __attribute__((ext_vector_type(4)));
typedef int v8i_ __attribute__((ext_vector_type(8)));

constexpr int T = 16384, D = 2048;
constexpr int NH = 32, HP = 64, NGRP = 8, NST = 128, CHK = 64, NCHK = T / CHK;
constexpr int XBCD = 4096;
constexpr int S5W = 1024, S5G = 64, S5C = 16, S5N = 64, LS = 16, S5NC = T / LS;
constexpr int APK = 384;
constexpr int NE = 32, EPG = 8, FF = 512, CAPL = 16384;
constexpr int IN_DIM = 11296;
constexpr float EPS = 1e-6f;
constexpr int NWAVES = 8;

constexpr size_t MiB = 1u << 20;
constexpr size_t WS_CTL = 0, CTL_ZERO_BYTES = 1 * MiB;
constexpr size_t WS_WIN = 1 * MiB;
constexpr size_t WS_WAB = 46 * MiB;
constexpr size_t WS_WGLU = 58 * MiB, WS_WOUT = 80 * MiB;
constexpr size_t WS_S5WS = 60 * MiB;
constexpr size_t WS_S5TW = 68 * MiB;
constexpr size_t WS_XD = 1 * MiB;
constexpr size_t WS_H = 88 * MiB;
constexpr int YVP = 3072;
constexpr size_t WS_YV = 152 * MiB;
constexpr size_t WS_XBC = 248 * MiB;
constexpr size_t WS_ST = 376 * MiB;
constexpr size_t WS_AP = 504 * MiB;
constexpr size_t WS_DT = 552 * MiB;
constexpr size_t WS_MISC = 554 * MiB;
constexpr size_t WS_SL = 555 * MiB;
constexpr size_t WS_LST = 587 * MiB;
constexpr size_t WS_RT = 591 * MiB;
constexpr size_t WS_H8 = 592 * MiB;
constexpr size_t WS_LR = 624 * MiB;
constexpr size_t WS_END = 627 * MiB;
constexpr int CW_BAR = 4096;
constexpr int CW_CNT = 16384;

constexpr int LDS_BYTES = 163840;
constexpr int LDSCTL_OFF = 161792;

typedef __bf16 bf16x2_t __attribute__((ext_vector_type(2)));
__device__ __forceinline__ unsigned f2bf(float f) { return (unsigned)__builtin_bit_cast(unsigned short, (__bf16)f); }
__device__ __forceinline__ unsigned pk2(float lo, float hi) { const f32x2 v = {lo, hi}; const bf16x2_t b = __builtin_convertvector(v, bf16x2_t); return __builtin_bit_cast(unsigned, b); }
__device__ __forceinline__ unsigned pk4_fp8(float a, float b, float c, float d) { unsigned w = 0u; w = (unsigned)__builtin_amdgcn_cvt_pk_fp8_f32(a, b, (int)w, false); w = (unsigned)__builtin_amdgcn_cvt_pk_fp8_f32(c, d, (int)w, true); return w; }
__device__ __forceinline__ float bflo(unsigned w) { return __builtin_bit_cast(float, w << 16); }
__device__ __forceinline__ float bfhi(unsigned w) { return __builtin_bit_cast(float, w & 0xffff0000u); }
__device__ __forceinline__ float bf2f(bf16 h) { return __builtin_bit_cast(float, (unsigned)h << 16); }
__device__ __forceinline__ float wave_sum(float v) {
#pragma unroll
    for (int o = 1; o < 64; o <<= 1) v += __shfl_xor(v, o);
    return v;
}
__device__ __forceinline__ float sigmoidf_(float x) { return __builtin_amdgcn_rcpf(1.0f + __builtin_amdgcn_exp2f(-1.4426950408889634f * x)); }
__device__ __forceinline__ float siluf_(float x) { return x * __builtin_amdgcn_rcpf(1.0f + __builtin_amdgcn_exp2f(-1.4426950408889634f * x)); }
__device__ __forceinline__ float gelu_tanh(float x) { const float u = 0.7978845608028654f * (x + 0.044715f * x * x * x); return x * __builtin_amdgcn_rcpf(1.0f + __builtin_amdgcn_exp2f(-2.8853900817779268f * u)); }
#define LDS_WAIT() asm volatile("s_waitcnt lgkmcnt(0)" ::: "memory")
#define VM_WAIT() asm volatile("s_waitcnt vmcnt(0)" ::: "memory")

namespace pg8 {
constexpr int BM = 256, BK = 64, HALF = 128, HTB = HALF * BK * 2, STAGE_BYTES = 8 * HTB, NXCD = 8, WGM = 8;
__host__ __device__ __forceinline__ int lds_byte(int r, int c) { const int st = (r >> 4) * 2 + (c >> 5), rr = r & 15, cc = c & 31, ob = rr * 64 + cc * 2; return st * 1024 + (ob ^ (((ob >> 9) & 1) << 5)); }
__host__ __device__ __forceinline__ void stage_rc(int b, int& R, int& C) { const int st = b / 1024, sb = b % 1024, swz = sb ^ (((sb >> 9) & 1) << 5); R = (st >> 1) * 16 + swz / 64; C = (st & 1) * 32 + (swz % 64) / 2; }
__host__ __device__ __forceinline__ int perm32(int rho) { const int n = rho >> 4, i = rho & 15; return 8 * (i >> 2) + 4 * n + (i & 3); }

struct Unit { const char* A; const char* B; int row0, col0, e, nvalid, slot0; };

struct StaticOrder {
    int nM, nN, nwg, G, c;
    __device__ void init(int nM_, int nN_, int G_, int c_) { nM = nM_; nN = nN_; nwg = nM * nN; G = G_; c = c_; }
    __device__ bool next(int i, int& pm, int& pn) const {
        const long L = (long)i * G + c; if (L >= nwg) return false;
        int wgid = (int)L; { const int q = nwg / NXCD, r = nwg % NXCD, xcd = wgid % NXCD, off = wgid / NXCD; wgid = (xcd < r ? xcd * (q + 1) : r * (q + 1) + (xcd - r) * q) + off; }
        const int nig = WGM * nN, gid = wgid / nig, fm = gid * WGM, gsz = (nM - fm) < WGM ? (nM - fm) : WGM;
        pm = fm + ((wgid % nig) % gsz); pn = (wgid % nig) / gsz; return true;
    }
};

#if !NAIVE_GEMM
template <class Epi, class Sched, bool GATHER, bool SP2 = true, int MIDT = 0, bool FP8 = false, int SCA = 127, int SCB = 127, bool INIT = false>
__device__ __forceinline__ void gemm_phase(LAS unsigned char* lds, const int K, const unsigned lda, const unsigned ldb, const Sched& S, const Epi& E, const bool noepi = false) {
    const int tid = threadIdx.x, wid = __builtin_amdgcn_readfirstlane(tid >> 6), lane = tid & 63, wr = wid >> 2, wc = wid & 3, fr = lane & 15, fq = lane >> 4;
    const int nt = FP8 ? K / 128 : K / BK;
    unsigned voffA[2], voffB[2]; int gC0 = 0;
#pragma unroll
    for (int i = 0; i < 2; ++i) { int R, C; stage_rc(tid * 16 + i * 8192, R, C); const int Rb = (R & ~31) + perm32(R & 31);
        voffA[i] = (unsigned)R * lda + (unsigned)C * 2u; voffB[i] = (unsigned)Rb * ldb + (unsigned)C * 2u; if (i == 0) gC0 = C * 2; }
    const size_t kstep = (size_t)(BK * 2);
    const size_t hstepA = (size_t)HALF * lda, hstepB = (size_t)HALF * ldb;
    const unsigned ldsw = (unsigned)wid * 1024u;
    const int aoff = FP8 ? lds_byte(wr * 64 + fr, fq * 16) : lds_byte(wr * 64 + fr, fq * 8), boff = FP8 ? lds_byte(wc * 32 + fr, fq * 16) : lds_byte(wc * 32 + fr, fq * 8);
    constexpr int PIECE1 = FP8 ? 16 : 1024;
    unsigned gcur[2], gnxt[2];
    int scav = SCA, scbv = SCB;
    if constexpr (FP8) { asm volatile("" : "+v"(scav), "+v"(scbv)); }
#define PG8_SA(b, h) (((b) * 2 + (h)) * HTB)
#define PG8_SB(b, h) ((4 + (b) * 2 + (h)) * HTB)
#define PG8_GLDS(gptr, bufoff, i) __builtin_amdgcn_global_load_lds((const unsigned*)(gptr), (LAS unsigned*)(lds + (bufoff) + ldsw + (i) * 8192), 16, 0, 0)
#define PG8_STAGEB(bufoff, gbase) do { _Pragma("unroll") for (int _i = 0; _i < 2; ++_i) PG8_GLDS((const char*)(gbase) + voffB[0] + (size_t)(_i * 64) * ldb, bufoff, _i); } while (0)
#define PG8_STAGEA(bufoff, gbase, h, nx) do { _Pragma("unroll") for (int _i = 0; _i < 2; ++_i) { \
        const unsigned _pk = (nx) ? gnxt[h] : gcur[h]; const size_t _o = GATHER ? (size_t)((_i ? (_pk >> 16) : (_pk & 0xffffu)) * lda + (unsigned)gC0) : (size_t)voffA[0] + (size_t)(_i * 64) * lda + (size_t)(h) * hstepA; PG8_GLDS((const char*)(gbase) + _o, bufoff, _i); } } while (0)
#define PG8_LD16(off) (*(const LAS v4i_*)(lds + (off)))
#define PG8_LDA(dst, b, h) do { _Pragma("unroll") for (int m = 0; m < 4; ++m) { const v4i_ _lo = PG8_LD16(PG8_SA(b, h) + aoff + m * 2048), _hi = PG8_LD16(PG8_SA(b, h) + aoff + PIECE1 + m * 2048); \
        if constexpr (FP8) dst##8[m] = __builtin_shufflevector(_lo, _hi, 0, 1, 2, 3, 4, 5, 6, 7); else { dst##4[m][0] = _lo; dst##4[m][1] = _hi; } } } while (0)
#define PG8_LDB(dst, b, h) do { _Pragma("unroll") for (int n = 0; n < 2; ++n) { const v4i_ _lo = PG8_LD16(PG8_SB(b, h) + boff + n * 2048), _hi = PG8_LD16(PG8_SB(b, h) + boff + PIECE1 + n * 2048); \
        if constexpr (FP8) dst##8[n] = __builtin_shufflevector(_lo, _hi, 0, 1, 2, 3, 4, 5, 6, 7); else { dst##4[n][0] = _lo; dst##4[n][1] = _hi; } } } while (0)
#define PG8_MMA(ai, bj, At, Bt) do { __builtin_amdgcn_s_setprio(1); _Pragma("unroll") for (int m = 0; m < 4; ++m) _Pragma("unroll") for (int n = 0; n < 2; ++n) { \
        if constexpr (FP8) { asm volatile("v_mfma_scale_f32_16x16x128_f8f6f4 %0, %1, %2, %0, %3, %4 op_sel_hi:[0,0,0]" : "+v"(acc[ai][bj][m][n]) : "v"(Bt##8[n]), "v"(At##8[m]), "v"(scbv), "v"(scav)); } \
        else { _Pragma("unroll") for (int k = 0; k < 2; ++k) acc[ai][bj][m][n] = __builtin_amdgcn_mfma_f32_16x16x32_bf16(__builtin_bit_cast(bf16x8, Bt##4[n][k]), __builtin_bit_cast(bf16x8, At##4[m][k]), acc[ai][bj][m][n], 0, 0, 0); } } \
        __builtin_amdgcn_s_setprio(0); } while (0)
#define PG8_WAIT_V(n) asm volatile("s_waitcnt vmcnt(" #n ")" ::: "memory")
#define PG8_WAIT_L(n) asm volatile("s_waitcnt lgkmcnt(" #n ")" ::: "memory")
#define PG8_BAR __builtin_amdgcn_s_barrier()
#define PG8_SCHED __builtin_amdgcn_sched_barrier(0)
#define PG8_GOFFS(dst, u) do { if constexpr (GATHER) { int _r0, _r1, _c; stage_rc(tid * 16, _r0, _c); stage_rc(tid * 16 + 8192, _r1, _c); _Pragma("unroll") for (int _h = 0; _h < 2; ++_h) dst[_h] = S.row_idx(u, _h * HALF + _r0) | (S.row_idx(u, _h * HALF + _r1) << 16); } } while (0)
    Unit cur, nxt; int ui = 0;
    if (!S.next(0, cur)) return;
    f32x4 acc[2][2][4][2];
#define PG8_ACC_ALL(stmt) do { _Pragma("unroll") for (int a = 0; a < 2; ++a) _Pragma("unroll") for (int b = 0; b < 2; ++b) _Pragma("unroll") for (int m = 0; m < 4; ++m) _Pragma("unroll") for (int n = 0; n < 2; ++n) { stmt; } } while (0)
    if constexpr (INIT) E.init(acc, cur, wr, wc, fr, fq);
    else PG8_ACC_ALL(acc[a][b][m][n] = ((f32x4){0.f, 0.f, 0.f, 0.f}));
    v8i_ At8[4], B08[2], B18[2]; v4i_ At4[4][2], B04[2][2], B14[2][2];
    const char* cA = cur.A; const char* cB = cur.B;
#pragma unroll
    for (int h = 0; h < 2; ++h) { gcur[h] = 0u; gnxt[h] = 0u; }
    PG8_GOFFS(gcur, cur);
    if constexpr (SP2) {
    PG8_STAGEB(PG8_SB(0, 0), cB); PG8_STAGEB(PG8_SB(0, 1), cB + hstepB); PG8_STAGEA(PG8_SA(0, 0), cA, 0, false); PG8_STAGEA(PG8_SA(0, 1), cA, 1, false);
    if (wr == 1) PG8_BAR;
    PG8_WAIT_V(2); PG8_BAR;
    PG8_STAGEB(PG8_SB(1, 0), cB + kstep); PG8_STAGEA(PG8_SA(1, 0), cA + kstep, 0, false); PG8_STAGEB(PG8_SB(1, 1), cB + hstepB + kstep);
    PG8_WAIT_V(6); PG8_BAR;
    } else {
    PG8_STAGEB(PG8_SB(0, 0), cB); PG8_STAGEA(PG8_SA(0, 0), cA, 0, false); PG8_STAGEB(PG8_SB(0, 1), cB + hstepB); PG8_STAGEA(PG8_SA(0, 1), cA, 1, false);
    if (wr == 1) PG8_BAR;
    PG8_WAIT_V(4); PG8_BAR;
    PG8_STAGEB(PG8_SB(1, 0), cB + kstep); PG8_STAGEA(PG8_SA(1, 0), cA + kstep, 0, false); PG8_STAGEB(PG8_SB(1, 1), cB + hstepB + kstep);
    PG8_WAIT_V(6); PG8_BAR;
    }
    if constexpr (INIT) PG8_ACC_ALL(asm volatile("" : "+v"(acc[a][b][m][n])));
    for (;;) {
        const bool has_next = S.next(ui + 1, nxt);
        const char* nA = has_next ? nxt.A : cA; const char* nB = has_next ? nxt.B : cB;
        if constexpr (GATHER) { if (has_next) { PG8_GOFFS(gnxt, nxt); } else {
            gnxt[0] = gcur[0]; gnxt[1] = gcur[1]; } }
#pragma unroll 1
        for (int t = 0; t < nt; t += 2) {
            const bool last = (t == nt - 2);
            if constexpr (MIDT > 0) { if (t == MIDT) E.mid(acc, cur, wr, wc, fr, fq); }
            const char* a1 = cA + (size_t)(t + 1) * kstep;
            const char* a2 = last ? nA : cA + (size_t)(t + 2) * kstep; const char* b2 = last ? nB : cB + (size_t)(t + 2) * kstep;
            const char* a3 = a2 + kstep; const char* b3 = b2 + kstep;
            if constexpr (SP2) {
            PG8_LDB(B0, 0, 0); PG8_LDB(B1, 0, 1); PG8_SCHED; PG8_LDA(At, 0, 0); PG8_STAGEA(PG8_SA(1, 1), a1, 1, false);
            PG8_WAIT_V(8); PG8_WAIT_L(0); PG8_BAR; PG8_MMA(0, 0, At, B0); PG8_MMA(0, 1, At, B1); PG8_BAR; PG8_SCHED;
            PG8_LDA(At, 0, 1); PG8_STAGEB(PG8_SB(0, 0), b2); PG8_STAGEB(PG8_SB(0, 1), b2 + hstepB); PG8_STAGEA(PG8_SA(0, 0), a2, 0, last);
            PG8_WAIT_V(8); PG8_WAIT_L(0); PG8_BAR; PG8_MMA(1, 0, At, B0); PG8_MMA(1, 1, At, B1); PG8_BAR; PG8_SCHED;
            PG8_LDB(B0, 1, 0); PG8_LDB(B1, 1, 1); PG8_SCHED; PG8_LDA(At, 1, 0); PG8_STAGEA(PG8_SA(0, 1), a2, 1, last);
            PG8_WAIT_V(8); PG8_WAIT_L(0); PG8_BAR; PG8_MMA(0, 0, At, B0); PG8_MMA(0, 1, At, B1); PG8_BAR; PG8_SCHED;
            PG8_LDA(At, 1, 1); PG8_STAGEB(PG8_SB(1, 0), b3); PG8_STAGEB(PG8_SB(1, 1), b3 + hstepB); PG8_STAGEA(PG8_SA(1, 0), a3, 0, last);
            PG8_WAIT_V(8); PG8_WAIT_L(0); PG8_BAR; PG8_MMA(1, 0, At, B0); PG8_MMA(1, 1, At, B1); PG8_BAR; PG8_SCHED;
            } else {
            PG8_LDB(B0, 0, 0); PG8_SCHED; PG8_LDA(At, 0, 0); PG8_STAGEA(PG8_SA(1, 1), a1, 1, false);
            PG8_WAIT_L(8); PG8_BAR; PG8_WAIT_L(0); PG8_MMA(0, 0, At, B0); PG8_BAR; PG8_SCHED;
            PG8_LDB(B1, 0, 1); PG8_STAGEB(PG8_SB(0, 0), b2);
            PG8_BAR; PG8_WAIT_L(0); PG8_MMA(0, 1, At, B1); PG8_BAR;
            PG8_LDA(At, 0, 1); PG8_STAGEA(PG8_SA(0, 0), a2, 0, last);
            PG8_BAR; PG8_WAIT_L(0); PG8_MMA(1, 0, At, B0); PG8_BAR; PG8_SCHED;
            PG8_STAGEB(PG8_SB(0, 1), b2 + hstepB);
            PG8_WAIT_V(6); PG8_BAR; PG8_MMA(1, 1, At, B1); PG8_BAR;
            PG8_LDB(B0, 1, 0); PG8_SCHED; PG8_LDA(At, 1, 0); PG8_STAGEA(PG8_SA(0, 1), a2, 1, last);
            PG8_WAIT_L(8); PG8_BAR; PG8_WAIT_L(0); PG8_MMA(0, 0, At, B0); PG8_BAR; PG8_SCHED;
            PG8_LDB(B1, 1, 1); PG8_STAGEB(PG8_SB(1, 0), b3);
            PG8_BAR; PG8_WAIT_L(0); PG8_MMA(0, 1, At, B1); PG8_BAR;
            PG8_LDA(At, 1, 1); PG8_STAGEA(PG8_SA(1, 0), a3, 0, last);
            PG8_BAR; PG8_WAIT_L(0); PG8_MMA(1, 0, At, B0); PG8_BAR; PG8_SCHED;
            PG8_STAGEB(PG8_SB(1, 1), b3 + hstepB);
            PG8_WAIT_V(6); PG8_BAR; PG8_MMA(1, 1, At, B1); PG8_BAR;
            }
        }
        if constexpr (FP8) { asm volatile("s_nop 15\n\ts_nop 15" ::: "memory"); }
        if (wr == 0) PG8_BAR;
        if (!noepi) E(acc, cur, wr, wc, fr, fq);
        else {
#pragma unroll
            for (int a = 0; a < 2; ++a)
#pragma unroll
                for (int b = 0; b < 2; ++b)
#pragma unroll
                    for (int m = 0; m < 4; ++m)
#pragma unroll
                        for (int n = 0; n < 2; ++n) asm volatile("" :: "v"(acc[a][b][m][n])); }
        if (!has_next) break;
        if constexpr (INIT) { E.init(acc, nxt, wr, wc, fr, fq); PG8_ACC_ALL(asm volatile("" : "+v"(acc[a][b][m][n]))); }
        else PG8_ACC_ALL(acc[a][b][m][n] = ((f32x4){0.f, 0.f, 0.f, 0.f}));
        cur = nxt; cA = nA; cB = nB; ++ui;
        if constexpr (GATHER) {
            gcur[0] = gnxt[0]; gcur[1] = gnxt[1]; }
        if (wr == 1) PG8_BAR;
    }
    PG8_WAIT_V(0);
    PG8_BAR;
#undef PG8_SA
#undef PG8_SB
#undef PG8_GLDS
#undef PG8_STAGEA
#undef PG8_STAGEB
#undef PG8_LDA
#undef PG8_LDB
#undef PG8_MMA
#undef PG8_WAIT_V
#undef PG8_WAIT_L
#undef PG8_BAR
#undef PG8_SCHED
#undef PG8_GOFFS
#undef PG8_ACC_ALL
}
#else
template <class Epi, class Sched, bool GATHER>
__device__ __forceinline__ void gemm_phase(LAS unsigned char* lds, const int K, const unsigned lda, const unsigned ldb, const Sched& S, const Epi& E, const bool noepi = false) {
    const int tid = threadIdx.x, wid = __builtin_amdgcn_readfirstlane(tid >> 6), lane = tid & 63, wr = wid >> 2, wc = wid & 3, fr = lane & 15, fq = lane >> 4;
    Unit cur;
    for (int ui = 0; S.next(ui, cur); ++ui) {
        f32x4 acc[2][2][4][2];
#pragma unroll
        for (int a = 0; a < 2; ++a)
#pragma unroll
            for (int b = 0; b < 2; ++b)
#pragma unroll
                for (int m = 0; m < 4; ++m)
#pragma unroll
                    for (int n = 0; n < 2; ++n) acc[a][b][m][n] = (f32x4){0.f, 0.f, 0.f, 0.f};
        for (int k = 0; k < K; k += 8) {
            v4u av[2][4];
#pragma unroll
            for (int ai = 0; ai < 2; ++ai)
#pragma unroll
                for (int m = 0; m < 4; ++m) { const int r = ai * 128 + wr * 64 + m * 16 + fr; const size_t ro = GATHER ? (size_t)S.row_idx(cur, r) * lda : (size_t)r * lda; av[ai][m] = *(const v4u*)(cur.A + ro + (size_t)k * 2); }
#pragma unroll
            for (int bj = 0; bj < 2; ++bj)
#pragma unroll
                for (int n = 0; n < 2; ++n)
#pragma unroll
                    for (int j = 0; j < 4; ++j) { const int c = bj * 128 + wc * 32 + 8 * fq + 4 * n + j; const v4u bv = *(const v4u*)(cur.B + (size_t)c * ldb + (size_t)k * 2);
#pragma unroll
                        for (int ai = 0; ai < 2; ++ai)
#pragma unroll
                            for (int m = 0; m < 4; ++m) { const v4u a = av[ai][m]; float s = acc[ai][bj][m][n][j];
                                s += bflo(a.x) * bflo(bv.x) + bfhi(a.x) * bfhi(bv.x); s += bflo(a.y) * bflo(bv.y) + bfhi(a.y) * bfhi(bv.y);
                                s += bflo(a.z) * bflo(bv.z) + bfhi(a.z) * bfhi(bv.z); s += bflo(a.w) * bflo(bv.w) + bfhi(a.w) * bfhi(bv.w); acc[ai][bj][m][n][j] = s; } }
        }
        E(acc, cur, wr, wc, fr, fq);
    }
    __syncthreads();
}
#endif
}
using pg8::Unit;

#define XB_TMO      128
#define XB_XCNT(j)  (256  + 64 * (j))
#define XB_XSUB(j)  (1280 + 64 * (j))
#define XB_XGEN(j)  (2304 + 64 * (j))
#define XB_TOP      3328
#define XB_TOPGEN   3392
#define XCD_BAR_WORDS 3456
#define XB_SPIN_CAP (1u << 22)
__device__ __forceinline__ unsigned xb_ld(unsigned* p)              { return __hip_atomic_load(p, __ATOMIC_RELAXED, __HIP_MEMORY_SCOPE_AGENT); }
__device__ __forceinline__ unsigned xb_add(unsigned* p, unsigned v) { return __hip_atomic_fetch_add(p, v, __ATOMIC_RELAXED, __HIP_MEMORY_SCOPE_AGENT); }
__device__ __forceinline__ unsigned xb_xcc_id() { return (unsigned)__builtin_amdgcn_s_getreg((3 << 11) | 20) & 0xFu; }
#define XB_SPIN(cond, bar) do { unsigned _sp = 0; while (cond) { __builtin_amdgcn_s_sleep(1); \
    if ((++_sp & 255u) == 0u) { if (xb_ld(&(bar)[XB_TMO])) break; if (_sp > XB_SPIN_CAP) { atomicAdd(&(bar)[XB_TMO], 1u); break; } } } } while (0)
struct XcdBarrier { unsigned* bar; unsigned x; volatile LAS unsigned* st; };
__device__ __forceinline__ XcdBarrier xcd_barrier_post(unsigned* bar, volatile LAS unsigned* st) {
    XcdBarrier b; b.bar = bar; b.x = xb_xcc_id(); b.st = st;
    if (threadIdx.x == 0) (void)xb_add(&bar[XB_XCNT(b.x)], 1u);
    return b;
}
__device__ __forceinline__ void xcd_barrier_complete(unsigned* bar, unsigned x, unsigned& nloc, unsigned& nx) {
    const unsigned G = gridDim.x * gridDim.y * gridDim.z;
    unsigned sum, cnt, mine, sp = 0u;
    for (;;) {
        sum = 0u; cnt = 0u; mine = 0u;
#pragma unroll
        for (unsigned j = 0; j < 16; ++j) { const unsigned c = xb_ld(&bar[XB_XCNT(j)]); sum += c; cnt += (c > 0u) ? 1u : 0u; mine = (j == x) ? c : mine; }
        if (sum == G) break;
        __builtin_amdgcn_s_sleep(1);
        if ((++sp & 255u) == 0u) { if (xb_ld(&bar[XB_TMO])) break; if (sp > XB_SPIN_CAP) { atomicAdd(&bar[XB_TMO], 1u); break; } }
    }
    nloc = mine > 0u ? mine : 1u; nx = cnt > 0u ? cnt : 1u;
}
__device__ __forceinline__ void xcd_barrier(const XcdBarrier& b) {
    asm volatile("s_waitcnt vmcnt(0)" ::: "memory");
    __syncthreads();
    if (threadIdx.x == 0) {
        unsigned* bar = b.bar;
        __builtin_amdgcn_s_waitcnt(0);
        unsigned nloc = b.st[0], nx = b.st[1];
        if (nloc == 0u) { xcd_barrier_complete(bar, b.x, nloc, nx); b.st[0] = nloc; b.st[1] = nx; }
        const unsigned old = xb_add(&bar[XB_XSUB(b.x)], 1u);
        const unsigned gen = old / nloc;
        if (old + 1u == (gen + 1u) * nloc) {
            __builtin_amdgcn_fence(__ATOMIC_RELEASE, "agent");
            asm volatile("s_waitcnt vmcnt(0)" ::: "memory");
            const unsigned og = xb_add(&bar[XB_TOP], 1u);
            const unsigned tg = og / nx;
            if (og + 1u == (tg + 1u) * nx) xb_add(&bar[XB_TOPGEN], 1u);
            else XB_SPIN(xb_ld(&bar[XB_TOPGEN]) == tg, bar);
            __builtin_amdgcn_fence(__ATOMIC_ACQUIRE, "agent");
            xb_add(&bar[XB_XGEN(b.x)], 1u);
            asm volatile("s_waitcnt vmcnt(0)" ::: "memory");
        } else {
            XB_SPIN(xb_ld(&bar[XB_XGEN(b.x)]) == gen, bar);
            __builtin_amdgcn_fence(__ATOMIC_ACQUIRE, "agent");
            asm volatile("s_waitcnt vmcnt(0)" ::: "memory");
        }
    }
    __syncthreads();
}

struct Args { const float* in[31]; float* out; unsigned char* ws; unsigned mask; int variant, bar_region, pad; };
enum { I_X = 0, I_NMW, I_WIN, I_CONVW, I_CONVB, I_DTB, I_ALOG, I_DSSD, I_NSW, I_WAUP, I_LRE, I_LIM, I_LOGDT, I_BRE, I_BIM, I_CRE, I_CIM, I_S5D,
       I_WGLU, I_WBUP, I_GATEB, I_WOUT, I_NFW, I_WRG, I_BRG, I_WRE, I_BRE2, I_WEG, I_WEU, I_WED, I_NFINAL };
struct Ctx { LAS unsigned char* lds; volatile LAS unsigned* ctl; int tid, lane, wave, vcu, G; };
constexpr int PTAB_OFF = LDSCTL_OFF + 1024;
__device__ __forceinline__ unsigned long long ptab_get(LAS unsigned char* lds, int i) {
    const LAS unsigned* p = (const LAS unsigned*)(lds + PTAB_OFF + 8 * i); const unsigned lo = __builtin_amdgcn_readfirstlane(p[0]), hi = __builtin_amdgcn_readfirstlane(p[1]); return ((unsigned long long)hi << 32) | lo; }
#define PIN(i) ((const float*)ptab_get(F.lds, (i)))
#define POUT ((float*)ptab_get(F.lds, 31))
#define PWS ((unsigned char*)ptab_get(F.lds, 32))

struct TJob { const float* src; unsigned char* dst; int N, K; float scale; int fp8; };
__device__ __forceinline__ void tj_load(const TJob& j, int lane, f32x4 (&v)[8]) {
    const float* p = j.src + (size_t)(lane >> 3) * j.N + (lane & 7) * 4;
#pragma unroll
    for (int i = 0; i < 8; ++i) v[i] = __builtin_nontemporal_load((const f32x4*)(p + (size_t)(8 * i) * j.N));
}
__device__ __forceinline__ void tj_store(const TJob& j, int lane, const f32x4 (&v)[8], LAS float* scr) {
    LAS float* w = scr + (lane >> 3) * 33 + (lane & 7) * 4;
#pragma unroll
    for (int i = 0; i < 8; ++i) { w[i * 264 + 0] = v[i][0]; w[i * 264 + 1] = v[i][1]; w[i * 264 + 2] = v[i][2]; w[i * 264 + 3] = v[i][3]; }
    LDS_WAIT(); asm volatile("" ::: "memory");
    const int c = lane & 7;
#pragma unroll
    for (int jj = 0; jj < 4; ++jj) { const int n = (lane >> 3) + 8 * jj; const LAS float* s = scr + (8 * c) * 33 + n;
        if (j.fp8) { const float q = j.scale; v2u o; o.x = pk4_fp8(s[0 * 33] * q, s[1 * 33] * q, s[2 * 33] * q, s[3 * 33] * q); o.y = pk4_fp8(s[4 * 33] * q, s[5 * 33] * q, s[6 * 33] * q, s[7 * 33] * q);
            *(v2u*)(j.dst + (size_t)n * j.K + 8 * c) = o; }
        else { v4u o; o.x = pk2(s[0 * 33], s[1 * 33]); o.y = pk2(s[2 * 33], s[3 * 33]); o.z = pk2(s[4 * 33], s[5 * 33]); o.w = pk2(s[6 * 33], s[7 * 33]);
            *(v4u*)(j.dst + ((size_t)n * j.K + 8 * c) * 2) = o; } }
    LDS_WAIT(); asm volatile("" ::: "memory");
}
template <class Dec>
__device__ __forceinline__ void transpose_jobs(int first, int stride, int nitems, const Dec dec, LAS float* scr, int lane) {
    int it = first; if (it >= nitems) return;
    TJob cur; f32x4 v[8]; dec(it, cur); tj_load(cur, lane, v);
    for (;;) { const int nx = it + stride; const bool hn = nx < nitems; TJob nj = cur; f32x4 nv[8];
        if (hn) { dec(nx, nj); tj_load(nj, lane, nv); }
        tj_store(cur, lane, v, scr);
        if (!hn) break;
        cur = nj; it = nx;
#pragma unroll
        for (int i = 0; i < 8; ++i) v[i] = nv[i]; }
}
struct DecP0 {
    static constexpr int I_IN = 32 * (IN_DIM / 32), I_A = 32 * 64, I_G = 16 * 32, I_B = 16 * 64, I_O = 32 * 64, NITEMS = I_IN + I_A + I_G + I_B + I_O;
    const float *win, *wa, *wg, *wb, *wo; unsigned char* ws;
    __device__ __forceinline__ void operator()(int r, TJob& j) const {
        if (r < I_IN) { const int nb = r % (IN_DIM / 32), kb = r / (IN_DIM / 32); const int dr = 32 * nb; int sc; if (dr < 6144) sc = dr; else if (dr < 7168) sc = dr + 32; else if (dr < 11264) { const int rel = dr - 7168, within = rel & 255; sc = 7200 + (within >> 7) * 2048 + (rel >> 8) * 128 + (within & 127); } else sc = dr - 11264 + 6144;
            j.src = win + (size_t)(64 * kb) * IN_DIM + sc; if (dr >= 7168 && dr < 11264) { j.dst = ws + WS_WIN + (size_t)7168 * D * 2 + (size_t)(dr - 7168) * D + 64 * kb; j.scale = 32.f; j.fp8 = 1; } else { j.dst = ws + WS_WIN + ((size_t)dr * D + 64 * kb) * 2; j.scale = 1.f; j.fp8 = 0; } j.N = IN_DIM; j.K = D; return; } r -= I_IN;
        if (r < I_A) { j.src = wa + (size_t)(64 * (r / 64)) * D + 32 * (r % 64); j.dst = ws + WS_WAB + ((size_t)(32 * (r % 64)) * YVP + 64 * (r / 64)) * 2; j.scale = 1.f; j.fp8 = 0; j.N = D; j.K = YVP; return; } r -= I_A;
        if (r < I_G) { j.src = wg + (size_t)(64 * (r / 32)) * S5W + 32 * (r % 32); j.dst = ws + WS_WGLU + ((size_t)(32 * (r % 32)) * S5W + 64 * (r / 32)) * 2; j.scale = 1.f; j.fp8 = 0; j.N = S5W; j.K = S5W; return; } r -= I_G;
        if (r < I_B) { j.src = wb + (size_t)(64 * (r / 64)) * D + 32 * (r % 64); j.dst = ws + WS_WAB + ((size_t)(32 * (r % 64)) * YVP + 2048 + 64 * (r / 64)) * 2; j.scale = 1.f; j.fp8 = 0; j.N = D; j.K = YVP; return; } r -= I_B;
        j.src = wo + (size_t)(64 * (r / 64)) * D + 32 * (r % 64); j.dst = ws + WS_WOUT + ((size_t)(32 * (r % 64)) * D + 64 * (r / 64)) * 2; j.scale = 1.f; j.fp8 = 0; j.N = D; j.K = D; }
};
constexpr float WGU_SCALE = 64.f, WD_SCALE = 32.f, HID_SCALE = 4.f;
struct DecExp {
    static constexpr int I_GU = NE * 32 * 16, NITEMS = 3 * I_GU;
    const float *wg, *wu, *wd; unsigned char* ws;
    __device__ __forceinline__ void operator()(int it, TJob& j) const {
        if (it < 2 * I_GU) { const int which = it / I_GU, r = it % I_GU, e = r / 512, q = r % 512, kb = q / 16, nb = q % 16; const int j0 = 32 * nb;
            const int drow = (j0 >> 7) * 256 + which * 128 + (j0 & 127);
            j.src = (which ? wu : wg) + (size_t)e * D * FF + (size_t)(64 * kb) * FF + j0; j.dst = ws + WS_ST + ((size_t)e * 1024 + drow) * D + 64 * kb; j.N = FF; j.K = D; j.scale = WGU_SCALE; j.fp8 = 1; }
        else { const int r = it - 2 * I_GU, e = r / 512, q = r % 512, kb = q / 64, nb = q % 64;
            j.src = wd + (size_t)e * FF * D + (size_t)(64 * kb) * D + 32 * nb; j.dst = ws + WS_YV + ((size_t)e * D + 32 * nb) * FF + 64 * kb; j.N = D; j.K = FF; j.scale = WD_SCALE; j.fp8 = 1; }
    }
};
__device__ __forceinline__ void rms_row_to_bf16(const float* xrow, const float* w, bf16* orow, unsigned char* orow8, int lane) {
    const f32x4* xr = (const f32x4*)xrow + lane; const f32x4* wr4 = (const f32x4*)w + lane;
    f32x4 v[8]; float s = 0.f;
#pragma unroll
    for (int j = 0; j < 8; ++j) { v[j] = xr[64 * j]; s += (v[j].x * v[j].x + v[j].y * v[j].y) + (v[j].z * v[j].z + v[j].w * v[j].w); }
    const float rstd = 1.0f / sqrtf(wave_sum(s) * (1.f / D) + EPS);
    v2u* o8 = (v2u*)orow + lane; unsigned* q8 = (unsigned*)orow8 + lane;
#pragma unroll
    for (int j = 0; j < 8; ++j) { const f32x4 g = wr4[64 * j]; const f32x4 hv = {v[j].x * rstd * g.x, v[j].y * rstd * g.y, v[j].z * rstd * g.z, v[j].w * rstd * g.w};
        v2u o; o.x = pk2(hv.x, hv.y); o.y = pk2(hv.z, hv.w); o8[64 * j] = o; q8[64 * j] = pk4_fp8(hv.x, hv.y, hv.z, hv.w); }
}

__device__ __forceinline__ void s5_mats_group(const Args& a, const Ctx& F, int g) {
    LAS float* L = (LAS float*)F.lds;
    LAS float* apr = L; LAS float* api = L + 17 * 64; LAS float* bbr = L + 2 * 17 * 64; LAS float* bbi = bbr + 1024; LAS float* cr = bbi + 1024; LAS float* ci = cr + 1024; LAS float* kt = ci + 1024;
    LAS float* cof = kt + 4096;
    const float dt = expf(PIN(I_LOGDT)[g]);
    if (F.tid < 64) { const int n = F.tid; const float lr = PIN(I_LRE)[g * 64 + n], li = PIN(I_LIM)[g * 64 + n];
        for (int m = 0; m <= 16; ++m) { const float mag = expf((float)m * lr * dt), ang = (float)m * li * dt; apr[m * 64 + n] = mag * cosf(ang); api[m * 64 + n] = mag * sinf(ang); }
        const float ar = expf(lr * dt) * cosf(li * dt), ai = expf(lr * dt) * sinf(li * dt);
        const float den = lr * lr + li * li, nr = ar - 1.0f, ni = ai;
        cof[n] = (nr * lr + ni * li) / den; cof[64 + n] = (ni * lr - nr * li) / den; }
    for (int i = F.tid; i < 1024; i += 512) { const int co = i >> 6, n = i & 63; cr[i] = PIN(I_CRE)[(size_t)g * 1024 + co * 64 + n]; ci[i] = PIN(I_CIM)[(size_t)g * 1024 + co * 64 + n]; }
    __syncthreads();
    for (int i = F.tid; i < 1024; i += 512) { const int n = i >> 4; const float br = PIN(I_BRE)[(size_t)g * 1024 + i], bi = PIN(I_BIM)[(size_t)g * 1024 + i]; const float c0 = cof[n], c1 = cof[64 + n];
        bbr[i] = c0 * br - c1 * bi; bbi[i] = c0 * bi + c1 * br; }
    __syncthreads();
    for (int i = F.tid; i < 4096; i += 512) { const int lag = i >> 8, co = (i >> 4) & 15, cin = i & 15; float s = 0.f;
        for (int n = 0; n < 64; ++n) { const float wr_ = apr[lag * 64 + n] * bbr[n * 16 + cin] - api[lag * 64 + n] * bbi[n * 16 + cin], wi_ = apr[lag * 64 + n] * bbi[n * 16 + cin] + api[lag * 64 + n] * bbr[n * 16 + cin];
            s += cr[co * 64 + n] * wr_ - ci[co * 64 + n] * wi_; }
        kt[i] = s; }
    __syncthreads();
    bf16* TW = (bf16*)(PWS + WS_S5TW) + (size_t)g * 256 * APK;
    for (int i = F.tid; i < 256 * APK / 2; i += 512) { const int row = (2 * i) / APK, k0 = (2 * i) % APK; const int l = row >> 4, co = row & 15; float v[2];
#pragma unroll
        for (int q = 0; q < 2; ++q) { const int k = k0 + q; float val;
            if (k < 256) { const int j = k >> 4, cin = k & 15; val = (l >= j) ? kt[(l - j) * 256 + co * 16 + cin] : 0.f; if (l == j && cin == co) val += PIN(I_S5D)[g * 16 + co]; }
            else if (k < 320) { const int n = k - 256; val = cr[co * 64 + n] * apr[(l + 1) * 64 + n] - ci[co * 64 + n] * api[(l + 1) * 64 + n]; }
            else { const int n = k - 320; val = -(cr[co * 64 + n] * api[(l + 1) * 64 + n] + ci[co * 64 + n] * apr[(l + 1) * 64 + n]); }
            v[q] = val; }
        *(unsigned*)(TW + 2 * i) = pk2(v[0], v[1]); }
    bf16* WS = (bf16*)(PWS + WS_S5WS) + (size_t)g * 256 * 256;
    for (int i = F.tid; i < 256 * 256 / 2; i += 512) { const int row = (2 * i) >> 8, k0 = (2 * i) & 255; float v[2];
#pragma unroll
        for (int q = 0; q < 2; ++q) { const int k = k0 + q, j = k >> 4, cin = k & 15; float val = 0.f;
            if (row < 64) { const int n = row; val = apr[(15 - j) * 64 + n] * bbr[n * 16 + cin] - api[(15 - j) * 64 + n] * bbi[n * 16 + cin]; }
            else if (row < 128) { const int n = row - 64; val = apr[(15 - j) * 64 + n] * bbi[n * 16 + cin] + api[(15 - j) * 64 + n] * bbr[n * 16 + cin]; }
            v[q] = val; }
        *(unsigned*)(WS + 2 * i) = pk2(v[0], v[1]); }
    __syncthreads();
}

__device__ __forceinline__ void p0_prologue(const Args& a, const Ctx& F) {
    if (F.vcu < S5G) s5_mats_group(a, F, F.vcu);
    LAS float* scr = (LAS float*)(F.lds + F.wave * 16384);
    const int gw = F.vcu * NWAVES + F.wave, NGW = F.G * NWAVES;
    { DecP0 dec{PIN(I_WIN), PIN(I_WAUP), PIN(I_WGLU), PIN(I_WBUP), PIN(I_WOUT), PWS};
      transpose_jobs<DecP0>(gw, NGW, DecP0::NITEMS, dec, scr, F.lane); }
    {
        unsigned* gctr = (unsigned*)(PWS + WS_CTL) + CW_CNT + a.bar_region * 4096 + 2624; const float* X = PIN(I_X); const float* nmw = PIN(I_NMW); unsigned char* wsb = PWS;
        unsigned bv = 0u; if (F.lane == 0) bv = __hip_atomic_fetch_add(gctr, 1u, __ATOMIC_RELAXED, __HIP_MEMORY_SCOPE_AGENT);
        int b = (int)__builtin_amdgcn_readfirstlane(bv);
        while (b < T / 8) { unsigned nv = 0u; if (F.lane == 0) nv = __hip_atomic_fetch_add(gctr, 1u, __ATOMIC_RELAXED, __HIP_MEMORY_SCOPE_AGENT);
            for (int m = 8 * b; m < 8 * b + 8; ++m) rms_row_to_bf16(X + (size_t)m * D, nmw, (bf16*)(wsb + WS_H) + (size_t)m * D, wsb + WS_H8 + (size_t)m * D, F.lane);
            b = (int)__builtin_amdgcn_readfirstlane(nv); } }
    for (int i = gw * 64 + F.lane; i < 48 * D; i += NGW * 64) { const int col = i / D, k = i % D; float w = 0.f;
        if (col < 4) w = PIN(I_WRG)[k * 4 + col]; else if (col >= 16) w = PIN(I_WRE)[k * 32 + (col - 16)];
        const unsigned hi = f2bf(w); const float lo = w - bf2f((bf16)hi);
        ((bf16*)(PWS + WS_RT))[i] = (bf16)hi; ((bf16*)(PWS + WS_RT))[48 * D + i] = (bf16)f2bf(lo); }
}

struct SchedDense {
    pg8::StaticOrder so; const char* A; const char* B; unsigned lda, ldb;
    __device__ __forceinline__ bool next(int i, Unit& u) const { int pm, pn; if (!so.next(i, pm, pn)) return false;
        u.A = A + (size_t)pm * 256 * lda; u.B = B + (size_t)pn * 256 * ldb; u.row0 = pm * 256; u.col0 = pn * 256; u.e = 0; u.nvalid = 256; return true; }
    __device__ __forceinline__ unsigned row_idx(const Unit&, int) const { return 0u; }
};
struct SchedS5 {
    const char* A; const char* B; unsigned ldb; int G, c;
    __device__ __forceinline__ bool next(int i, Unit& u) const { const int idx = i * G + c; if (idx >= 256) return false; const int g = idx >> 2, mt = idx & 3;
        u.A = A + (size_t)(g * 1024 + mt * 256) * (APK * 2); u.B = B + (size_t)g * 256 * ldb; u.row0 = g * 1024 + mt * 256; u.col0 = 0; u.e = g; u.nvalid = 256; return true; }
    __device__ __forceinline__ unsigned row_idx(const Unit&, int) const { return 0u; }
};
struct SchedMoE {
    volatile LAS unsigned* ctl; const char* A; const char* B; const unsigned* list_tok; unsigned lda; size_t bstride_e; unsigned ldb; int NN, G, c; bool gather;
    __device__ __forceinline__ bool next(int i, Unit& u) const { const int idx = i * G + c; const int NT = (int)ctl[72]; if (idx >= NT * NN) return false;
        const int mtg = idx / NN, pn = idx % NN; const int e = (int)ctl[80 + mtg]; const int rb = (int)ctl[40 + e]; const int mtl = mtg - (rb >> 8); const int cnt = (int)ctl[8 + e];
        u.e = e; u.nvalid = cnt - mtl * 256; u.slot0 = mtl * 256; u.B = B + (size_t)e * bstride_e + (size_t)pn * 256 * ldb;
        if (gather) { u.A = A; u.row0 = rb + mtl * 256; u.col0 = pn * 128; }
        else { u.A = A + (size_t)(rb + mtl * 256) * lda; u.row0 = rb + mtl * 256; u.col0 = pn * 256; }
        return true; }
    __device__ __forceinline__ unsigned row_idx(const Unit& u, int r) const {
        const unsigned tokk = (r < u.nvalid) ? list_tok[(size_t)u.e * CAPL + u.slot0 + r] : 0u; return tokk >> 1; }
};

#define EPI_BEGIN _Pragma("unroll") for (int ai = 0; ai < 2; ++ai) _Pragma("unroll") for (int m = 0; m < 4; ++m) { const int r = ai * 128 + wr * 64 + m * 16 + fr; \
    _Pragma("unroll") for (int bj = 0; bj < 2; ++bj) { const int c = bj * 128 + wc * 32 + 8 * fq; const f32x4 v0 = acc[ai][bj][m][0], v1 = acc[ai][bj][m][1];
#define EPI_END } }
__device__ __forceinline__ v4u pack8(const f32x4 a, const f32x4 b) { v4u w; w.x = pk2(a[0], a[1]); w.y = pk2(a[2], a[3]); w.z = pk2(b[0], b[1]); w.w = pk2(b[2], b[3]); return w; }
__device__ __forceinline__ void unpack8(const v4u w, float (&f)[8]) { f[0] = bflo(w.x); f[1] = bfhi(w.x); f[2] = bflo(w.y); f[3] = bfhi(w.y); f[4] = bflo(w.z); f[5] = bfhi(w.z); f[6] = bflo(w.w); f[7] = bfhi(w.w); }

struct Epi1a {
    bf16* ZS; bf16* XBC; bf16* AP;
    __device__ __forceinline__ void operator()(const f32x4 (&acc)[2][2][4][2], const Unit& u, int wr, int wc, int fr, int fq) const {
        EPI_BEGIN  const int row = u.row0 + r, col = u.col0 + c;
            if (col < 2048) { f32x4 a = v0, b = v1;
#pragma unroll
                for (int j = 0; j < 4; ++j) { a[j] = siluf_(a[j]); b[j] = siluf_(b[j]); }
                *(v4u*)(ZS + (size_t)row * YVP + col) = pack8(a, b); }
            else if (col < 6144) { *(v4u*)(XBC + (size_t)row * XBCD + (col - 2048)) = pack8(v0, v1); }
            else { const int cc = col - 6144, g = cc >> 4, ci0 = cc & 15; *(v4u*)(AP + ((size_t)(g * S5NC + (row >> 4)) * APK + (row & 15) * 16 + ci0)) = pack8(v0, v1); }  EPI_END
    }
};
struct EpiS5a {
    float* SL;
    __device__ __forceinline__ void operator()(const f32x4 (&acc)[2][2][4][2], const Unit& u, int wr, int wc, int fr, int fq) const {
        EPI_BEGIN  if (bj == 0) { float* p = SL + (size_t)(u.row0 + r) * 128 + c; *(f32x4*)p = v0; *(f32x4*)(p + 4) = v1; }  EPI_END
    }
};
struct EpiS5b {
    bf16* V;
    __device__ __forceinline__ void operator()(const f32x4 (&acc)[2][2][4][2], const Unit& u, int wr, int wc, int fr, int fq) const {
        EPI_BEGIN  const int chunk = (u.row0 + r) & 1023, g = u.e, l = c >> 4, co0 = c & 15; f32x4 a = v0, b = v1;
#pragma unroll
            for (int j = 0; j < 4; ++j) { a[j] = gelu_tanh(a[j]); b[j] = gelu_tanh(b[j]); }
            *(v4u*)(V + (size_t)(chunk * 16 + l) * S5W + g * 16 + co0) = pack8(a, b);  EPI_END
    }
};
struct Epi1b {
    bf16* Gt; const float* gb; const float* ssq;
    __device__ __forceinline__ void operator()(const f32x4 (&acc)[2][2][4][2], const Unit& u, int wr, int wc, int fr, int fq) const {
        const int j0 = (u.col0 >> 1) + wc * 32 + 8 * fq;
        const f32x4 ba0 = *(const f32x4*)(gb + j0), ba1 = *(const f32x4*)(gb + j0 + 4), bb0 = *(const f32x4*)(gb + 2048 + j0), bb1 = *(const f32x4*)(gb + 2048 + j0 + 4);
#pragma unroll
        for (int ai = 0; ai < 2; ++ai)
#pragma unroll
            for (int m = 0; m < 4; ++m) { const int row = u.row0 + ai * 128 + wr * 64 + m * 16 + fr; const f32x4 s0 = *(const f32x4*)(ssq + (size_t)row * 8), s1 = *(const f32x4*)(ssq + (size_t)row * 8 + 4);
                const float tot = ((s0[0] + s0[1]) + (s0[2] + s0[3])) + ((s1[0] + s1[1]) + (s1[2] + s1[3])); const float rstd = 1.0f / sqrtf(tot * (1.f / D) + EPS);
                f32x4 r0, r1, g0, g1;
#pragma unroll
                for (int j = 0; j < 4; ++j) { const float a0 = sigmoidf_(acc[ai][0][m][0][j] + ba0[j]), a1 = sigmoidf_(acc[ai][0][m][1][j] + ba1[j]);
                    g0[j] = fmaxf(sigmoidf_(acc[ai][1][m][0][j] + bb0[j]), 1e-20f); g1[j] = fmaxf(sigmoidf_(acc[ai][1][m][1][j] + bb1[j]), 1e-20f);
                    r0[j] = a0 * rstd * __builtin_amdgcn_rcpf(g0[j]); r1[j] = a1 * rstd * __builtin_amdgcn_rcpf(g1[j]); }
                *(v4u*)(Gt + (size_t)row * 4096 + j0) = pack8(r0, r1); *(v4u*)(Gt + (size_t)row * 4096 + 2048 + j0) = pack8(g0, g1); }
    }
};
struct EpiGlu {
    const bf16* V; bf16* YV;
    __device__ __forceinline__ void operator()(const f32x4 (&acc)[2][2][4][2], const Unit& u, int wr, int wc, int fr, int fq) const {
        EPI_BEGIN const size_t o = (size_t)(u.row0 + r) * S5W + u.col0 + c; float vv[8]; unpack8(*(const v4u*)(V + o), vv); f32x4 a, b;
#pragma unroll
            for (int j = 0; j < 4; ++j) { a[j] = vv[j] * sigmoidf_(v0[j]); b[j] = vv[4 + j] * sigmoidf_(v1[j]); }
            *(v4u*)(YV + (size_t)(u.row0 + r) * YVP + 2048 + u.col0 + c) = pack8(a, b); EPI_END
    }
};
struct EpiAB {
    const bf16* Gt; bf16* MG;
    __device__ __forceinline__ void mid(f32x4 (&acc)[2][2][4][2], const Unit& u, int wr, int wc, int fr, int fq) const {
        unsigned base = (unsigned)((u.row0 + wr * 64 + fr) * 4096 + u.col0 + wc * 32 + 8 * fq) * 2u;
        asm volatile("" : "+v"(base));
        const char* gp = (const char*)Gt;
#pragma unroll
        for (int ai = 0; ai < 2; ++ai)
#pragma unroll
            for (int m = 0; m < 4; ++m)
#pragma unroll
                for (int bj = 0; bj < 2; ++bj) { float rr[8]; unpack8(*(const v4u*)(gp + (size_t)(base + (unsigned)((ai * 128 + m * 16) * 4096 + bj * 128) * 2u)), rr);
#pragma unroll
                    for (int j = 0; j < 4; ++j) { acc[ai][bj][m][0][j] *= rr[j]; acc[ai][bj][m][1][j] *= rr[4 + j]; } }
    }
    __device__ __forceinline__ void operator()(const f32x4 (&acc)[2][2][4][2], const Unit& u, int wr, int wc, int fr, int fq) const {
        EPI_BEGIN const int row = u.row0 + r, col = u.col0 + c; float gg[8]; unpack8(*(const v4u*)(Gt + (size_t)row * 4096 + 2048 + col), gg); f32x4 a, b;
#pragma unroll
            for (int j = 0; j < 4; ++j) { a[j] = gg[j] * v0[j]; b[j] = gg[4 + j] * v1[j]; }
            *(v4u*)(MG + (size_t)row * D + col) = pack8(a, b); EPI_END
    }
};
typedef __amdgpu_buffer_rsrc_t rsrc_t;
struct EpiOut {
    bf16* XD; const float* X;
    __device__ __forceinline__ void init(f32x4 (&acc)[2][2][4][2], const Unit& u, int wr, int wc, int fr, int fq) const {
        const rsrc_t rx = __builtin_amdgcn_make_buffer_rsrc((void*)X, 0, T * D * 4, 0x00020000);
        const unsigned base = (unsigned)((u.row0 + wr * 64 + fr) * D + u.col0 + wc * 32 + 8 * fq) * 4u;
#pragma unroll
        for (int ai = 0; ai < 2; ++ai)
#pragma unroll
            for (int m = 0; m < 4; ++m)
#pragma unroll
                for (int bj = 0; bj < 2; ++bj)
#pragma unroll
                    for (int n = 0; n < 2; ++n) acc[ai][bj][m][n] = __builtin_bit_cast(f32x4, __builtin_amdgcn_raw_buffer_load_b128(rx, (int)(base + (unsigned)((ai * 128 + m * 16) * D + bj * 128 + n * 4) * 4u), 0, 0));
    }
    __device__ __forceinline__ void operator()(const f32x4 (&acc)[2][2][4][2], const Unit& u, int wr, int wc, int fr, int fq) const {
        EPI_BEGIN *(v4u*)(XD + (size_t)(u.row0 + r) * D + u.col0 + c) = pack8(v0, v1); EPI_END
    }
};
struct EpiGU {
    bf16* HID; const unsigned* list_tok; const float* rstd2;
    __device__ __forceinline__ void operator()(const f32x4 (&acc)[2][2][4][2], const Unit& u, int wr, int wc, int fr, int fq) const {
#pragma unroll
        for (int ai = 0; ai < 2; ++ai)
#pragma unroll
            for (int m = 0; m < 4; ++m) { const int r = ai * 128 + wr * 64 + m * 16 + fr; if (r < u.nvalid) { const float sc = rstd2[(size_t)u.e * CAPL + u.slot0 + r]; f32x4 a, b;
#pragma unroll
                for (int j = 0; j < 4; ++j) { a[j] = siluf_(sc * acc[ai][0][m][0][j]) * (sc * acc[ai][1][m][0][j]); b[j] = siluf_(sc * acc[ai][0][m][1][j]) * (sc * acc[ai][1][m][1][j]); }
                { v2u o8; o8.x = pk4_fp8(a[0] * HID_SCALE, a[1] * HID_SCALE, a[2] * HID_SCALE, a[3] * HID_SCALE); o8.y = pk4_fp8(b[0] * HID_SCALE, b[1] * HID_SCALE, b[2] * HID_SCALE, b[3] * HID_SCALE);
                  *(v2u*)((unsigned char*)HID + (size_t)(u.row0 + r) * FF + u.col0 + wc * 32 + 8 * fq) = o8; } } }
    }
};
constexpr float Y_SCALE = 16.f;
struct EpiDn {
    const float* list_w; unsigned char* Y;
    __device__ __forceinline__ void operator()(const f32x4 (&acc)[2][2][4][2], const Unit& u, int wr, int wc, int fr, int fq) const {
        const float* wp = list_w + (unsigned)(u.e * CAPL + u.slot0 + wr * 64 + fr);
#pragma unroll
        for (int ai = 0; ai < 2; ++ai)
#pragma unroll
            for (int m = 0; m < 4; ++m) { const int r = ai * 128 + wr * 64 + m * 16 + fr; const float w = wp[ai * 128 + m * 16] * Y_SCALE;
#pragma unroll
                for (int bj = 0; bj < 2; ++bj) { const int col = u.col0 + bj * 128 + wc * 32 + 8 * fq; const f32x4 a = acc[ai][bj][m][0] * w, b = acc[ai][bj][m][1] * w;
                    v2u o; o.x = pk4_fp8(a[0], a[1], a[2], a[3]); o.y = pk4_fp8(b[0], b[1], b[2], b[3]); if (r < u.nvalid) *(v2u*)(Y + (size_t)(u.row0 + r) * D + col) = o; } }
    }
};

__device__ __forceinline__ void dt_gemm(const Args& a, const Ctx& F) {
    const bf16* Hb = (const bf16*)(PWS + WS_H); const bf16* Wd = (const bf16*)(PWS + WS_WIN) + (size_t)11264 * D; float* DT = (float*)(PWS + WS_DT);
    LAS float* part = (LAS float*)F.lds;
    const int r = F.lane & 31, hh = F.lane >> 5;
    for (int unit = F.vcu; unit < T / 64; unit += F.G) {
        const int r0 = unit * 64; f32x16 acc0, acc1;
#pragma unroll
        for (int j = 0; j < 16; ++j) { acc0[j] = 0.f; acc1[j] = 0.f; }
#pragma unroll 4
        for (int ks = 0; ks < 16; ++ks) { const int k = F.wave * 256 + ks * 16 + hh * 8;
            const bf16x8 a0 = *(const bf16x8*)(Hb + (size_t)(r0 + r) * D + k), a1 = *(const bf16x8*)(Hb + (size_t)(r0 + 32 + r) * D + k), b = *(const bf16x8*)(Wd + (size_t)r * D + k);
            acc0 = __builtin_amdgcn_mfma_f32_32x32x16_bf16(a0, b, acc0, 0, 0, 0); acc1 = __builtin_amdgcn_mfma_f32_32x32x16_bf16(a1, b, acc1, 0, 0, 0); }
#pragma unroll
        for (int j = 0; j < 16; ++j) { part[((F.wave * 2 + 0) * 16 + j) * 64 + F.lane] = acc0[j]; part[((F.wave * 2 + 1) * 16 + j) * 64 + F.lane] = acc1[j]; }
        __syncthreads();
        for (int o = F.tid; o < 2048; o += 512) { const int row = o >> 5, col = o & 31; const int i = row >> 5, rr = row & 31, h2 = (rr >> 2) & 1, reg = (rr & 3) + 4 * (rr >> 3), ln = col + 32 * h2; float s = 0.f;
#pragma unroll
            for (int w = 0; w < 8; ++w) s += part[((w * 2 + i) * 16 + reg) * 64 + ln];
            s += PIN(I_DTB)[col]; DT[(size_t)(r0 + row) * 32 + col] = s > 20.f ? s : log1pf(expf(s)); }
        __syncthreads();
    }
}

constexpr int SEGC = 8, NSEG = NCHK / SEGC;
constexpr int SQ_XT = 0;
constexpr int SQ_BC = 36864;
constexpr int SQ_BT = SQ_BC + 17408;
constexpr int SQ_CC = SQ_BT + 18432;
constexpr int SQ_DT = SQ_CC + 17408;
constexpr int SQ_Y = SQ_DT + 4352;
constexpr int SQ_W = SQ_Y + 33792;
static_assert(SQ_W + 10240 <= LDSCTL_OFF, "SSD (sequential) LDS map");

template <int NTOK>
__device__ __forceinline__ void conv_pair(const LAS float* wl, int lc, const v4u (&rawv)[NTOK + 3], int d, float (&o)[NTOK][2]) {
    f32x2 w[4]; const f32x2 bias = *(const LAS f32x2*)(wl + 4 * 512 + lc);
#pragma unroll
    for (int k = 0; k < 4; ++k) w[k] = *(const LAS f32x2*)(wl + k * 512 + lc);
#pragma unroll
    for (int tt = 0; tt < NTOK; ++tt) { float s0 = bias[0], s1 = bias[1];
#pragma unroll
        for (int k = 0; k < 4; ++k) { const unsigned uu = rawv[tt + k][d]; s0 += w[k][0] * bflo(uu); s1 += w[k][1] * bfhi(uu); }
        o[tt][0] = siluf_(s0); o[tt][1] = siluf_(s1); }
}
template <bool SCALE>
__device__ __forceinline__ void conv_xs_to_lds(const LAS float* wl, int lc, const v4u (&rx)[7], LAS bf16* dst  , const f32x4 sc) {
#pragma unroll
    for (int d = 0; d < 4; ++d) { float o[4][2]; conv_pair<4>(wl, lc + 2 * d, rx, d, o);
        if constexpr (SCALE) {
#pragma unroll
            for (int tt = 0; tt < 4; ++tt) { o[tt][0] *= sc[tt]; o[tt][1] *= sc[tt]; } }
        v2u w0, w1; w0.x = pk2(o[0][0], o[1][0]); w0.y = pk2(o[2][0], o[3][0]); w1.x = pk2(o[0][1], o[1][1]); w1.y = pk2(o[2][1], o[3][1]);
        *(LAS v2u*)(dst + (2 * d) * 72) = w0; *(LAS v2u*)(dst + (2 * d + 1) * 72) = w1; }
}
template <bool NAT, bool TR>
__device__ __forceinline__ void conv_bc_to_lds(const LAS float* wl, int lc, const v4u (&rb)[5], LAS bf16* nat, LAS bf16* tr) {
    v4u n0, n1;
#pragma unroll
    for (int d = 0; d < 4; ++d) { float o[2][2]; conv_pair<2>(wl, lc + 2 * d, rb, d, o);
        if constexpr (NAT) { n0[d] = pk2(o[0][0], o[0][1]); n1[d] = pk2(o[1][0], o[1][1]); }
        if constexpr (TR) { *(LAS unsigned*)(tr + (2 * d) * 72) = pk2(o[0][0], o[1][0]); *(LAS unsigned*)(tr + (2 * d + 1) * 72) = pk2(o[0][1], o[1][1]); } }
    if constexpr (NAT) { *(LAS v4u*)nat = n0; *(LAS v4u*)(nat + 136) = n1; }
}
__device__ __forceinline__ void conv_weights_to_lds(const Args& a, const Ctx& F, int g) {
    LAS float* wl = (LAS float*)(F.lds + SQ_W);
    for (int i = F.tid; i < 5 * 512; i += NWAVES * 64) { const int k = i >> 9, lc = i & 511; const int ch = lc < 256 ? g * 256 + lc : (lc < 384 ? 2048 + g * 128 + (lc - 256) : 3072 + g * 128 + (lc - 384));
        wl[i] = k < 4 ? PIN(I_CONVW)[k * XBCD + ch] : PIN(I_CONVB)[ch]; }
    __syncthreads();
}
template <int NR>
__device__ __forceinline__ void rows_load(const unsigned char* ws, unsigned off, int t0, v4u (&raw)[NR]) {
#pragma unroll
    for (int i = 0; i < NR; ++i) { v4u v = (v4u){0u, 0u, 0u, 0u}; if (t0 + i >= 0) v = *(const v4u*)(ws + (size_t)(off + (unsigned)i * (XBCD * 2))); raw[i] = v; }
}

__device__ __forceinline__ float seq_dt_setup(const Args& a, const Ctx& F, int g, float dtv, int buf) {
    LAS float* dts = (LAS float*)(F.lds + SQ_DT); LAS float* acs = dts + 256; LAS float* wsc = dts + 512; LAS float* eacs = dts + 768; LAS float* cdec = dts + 1024;
    float tot = 0.f;
    if (F.wave < 4) { const int hd = 4 * g + F.wave; const float av = -expf(PIN(I_ALOG)[hd]);
        float s = dtv * av;
#pragma unroll
        for (int o = 1; o < 64; o <<= 1) { const float t = __shfl_up(s, o); if (F.lane >= o) s += t; }
        tot = __shfl(s, 63);
        dts[F.wave * 64 + F.lane] = dtv; acs[F.wave * 64 + F.lane] = s; wsc[F.wave * 64 + F.lane] = dtv * __expf(tot - s); eacs[F.wave * 64 + F.lane] = __expf(s);
        if (F.lane == 63) cdec[buf * 4 + F.wave] = __expf(tot); }
    return tot;
}
__device__ __forceinline__ bf16x8 pack_frag(const f32x16& X, int kk) { v4u w; w.x = pk2(X[8 * kk], X[8 * kk + 1]); w.y = pk2(X[8 * kk + 2], X[8 * kk + 3]); w.z = pk2(X[8 * kk + 4], X[8 * kk + 5]); w.w = pk2(X[8 * kk + 6], X[8 * kk + 7]); return __builtin_bit_cast(bf16x8, w); }
__device__ __forceinline__ void seq_state_update(const Ctx& F, f32x16 (&acc)[4], int hd, int pt, float cd) {
    const LAS bf16* xT = (const LAS bf16*)(F.lds + SQ_XT); const LAS bf16* Bt = (const LAS bf16*)(F.lds + SQ_BT); const LAS float* wsc = (const LAS float*)(F.lds + SQ_DT) + 512;
    const int r = F.lane & 31, hh = F.lane >> 5;
#pragma unroll
    for (int i = 0; i < 4; ++i) acc[i] = acc[i] * cd;
#pragma unroll
    for (int ks = 0; ks < 4; ++ks) { const v4u xw = *(const LAS v4u*)(xT + (hd * 64 + 32 * pt + r) * 72 + 16 * ks + 8 * hh); float xv[8]; unpack8(xw, xv);
        const f32x4 w0 = *(const LAS f32x4*)(wsc + hd * 64 + 16 * ks + 8 * hh), w1 = *(const LAS f32x4*)(wsc + hd * 64 + 16 * ks + 8 * hh + 4);
        v4u sw; sw.x = pk2(xv[0] * w0[0], xv[1] * w0[1]); sw.y = pk2(xv[2] * w0[2], xv[3] * w0[3]); sw.z = pk2(xv[4] * w1[0], xv[5] * w1[1]); sw.w = pk2(xv[6] * w1[2], xv[7] * w1[3]);
        const bf16x8 bfr = __builtin_bit_cast(bf16x8, sw);
#pragma unroll
        for (int i = 0; i < 4; ++i) { const bf16x8 afr = *(const LAS bf16x8*)(Bt + (32 * i + r) * 72 + 16 * ks + 8 * hh); acc[i] = __builtin_amdgcn_mfma_f32_32x32x16_bf16(afr, bfr, acc[i], 0, 0, 0); }
        if (ks & 1) __builtin_amdgcn_sched_barrier(0); }
}
__device__ __forceinline__ size_t seg_state_off(int g, int seg, int hd) { return ((size_t)(g * NSEG + seg) * 4 + hd) * 8192; }

__device__ __forceinline__ void ssd_pass_a(const Args& a, const Ctx& F) {
    LAS bf16* xT = (LAS bf16*)(F.lds + SQ_XT); LAS bf16* Bt = (LAS bf16*)(F.lds + SQ_BT); const LAS float* cdec = (const LAS float*)(F.lds + SQ_DT) + 1024; const LAS float* wl = (const LAS float*)(F.lds + SQ_W);
    for (int u = F.vcu; u < NGRP * NSEG; u += F.G) {
        const int g = u >> 5, seg = u & 31; const int hd = F.wave >> 1, pt = F.wave & 1, r = F.lane & 31, hh = F.lane >> 5;
        const int cgx = F.tid >> 4, l0x = (F.tid & 15) * 4, cgb = F.tid >> 5, l0b = (F.tid & 31) * 2;
        conv_weights_to_lds(a, F, g);
        f32x16 acc[4];
#pragma unroll
        for (int i = 0; i < 4; ++i)
#pragma unroll
            for (int j = 0; j < 16; ++j) acc[i][j] = 0.f;
        float totsum = 0.f;
        const int t0 = seg * SEGC * CHK;
        const unsigned char* wsb = PWS;
        unsigned ox = (unsigned)(WS_XBC + ((size_t)(t0 + l0x) * XBCD + g * 256 + cgx * 8) * 2 - 3 * XBCD * 2);
        unsigned ob = (unsigned)(WS_XBC + ((size_t)(t0 + l0b) * XBCD + 2048 + g * 128 + cgb * 8) * 2 - 3 * XBCD * 2);
        unsigned odt = (unsigned)(WS_DT + ((size_t)(t0 + F.lane) * 32 + 4 * g + (F.wave & 3)) * 4);
        v4u rx[7];
        rows_load<7>(wsb, ox, t0 + l0x - 3, rx);
        float dtv = *(const float*)(wsb + odt);
#pragma unroll 1
        for (int k = 0; k < SEGC; ++k) {
            v4u rb[5];
            rows_load<5>(wsb, ob, t0 + k * CHK + l0b - 3, rb);
            totsum += seq_dt_setup(a, F, g, dtv, k & 1);
            { const int hx = cgx >> 3, p0 = (cgx & 7) * 8;
              conv_xs_to_lds<false>(wl, cgx * 8, rx, xT + (hx * 64 + p0) * 72 + l0x, (f32x4){1.f, 1.f, 1.f, 1.f});
              conv_bc_to_lds<false, true>(wl, 256 + cgb * 8, rb, Bt, Bt + (cgb * 8) * 72 + l0b); }
            ox += CHK * XBCD * 2; ob += CHK * XBCD * 2; odt += CHK * 32 * 4;
            if (k + 1 < SEGC) { rows_load<7>(wsb, ox, 0, rx); dtv = *(const float*)(wsb + odt); }
            __syncthreads();
            seq_state_update(F, acc, hd, pt, cdec[(k & 1) * 4 + hd]);
            __syncthreads();
        }
        bf16* st = (bf16*)(PWS + WS_ST) + seg_state_off(g, seg, hd); const int p = 32 * pt + r;
#pragma unroll
        for (int i = 0; i < 4; ++i)
#pragma unroll
            for (int q = 0; q < 4; ++q) { v2u w; w.x = pk2(acc[i][4 * q], acc[i][4 * q + 1]); w.y = pk2(acc[i][4 * q + 2], acc[i][4 * q + 3]); *(v2u*)(st + ((4 * i + q) * 64 + p) * 8 + 4 * hh) = w; }
        if (F.wave < 4 && F.lane == 63) ((float*)(PWS + WS_MISC + 768 * 1024))[(g * NSEG + seg) * 4 + F.wave] = __expf(totsum);
        __syncthreads();
    }
}

__device__ __forceinline__ void ssd_pass_b(const Args& a, const Ctx& F) {
    LAS bf16* xT = (LAS bf16*)(F.lds + SQ_XT); LAS bf16* Bc = (LAS bf16*)(F.lds + SQ_BC); LAS bf16* Bt = (LAS bf16*)(F.lds + SQ_BT); LAS bf16* Cc = (LAS bf16*)(F.lds + SQ_CC);
    LAS float* dts = (LAS float*)(F.lds + SQ_DT); LAS float* acs = dts + 256; LAS float* eacs = dts + 768; const LAS float* cdec = dts + 1024; LAS bf16* yb = (LAS bf16*)(F.lds + SQ_Y); const LAS float* wl = (const LAS float*)(F.lds + SQ_W);
    for (int u = F.vcu; u < NGRP * NSEG; u += F.G) {
        const int g = u >> 5, seg = u & 31; const int hd = F.wave >> 1, pt = F.wave & 1, r = F.lane & 31, hh = F.lane >> 5, head = 4 * g + hd;
        const int cgx = F.tid >> 4, l0x = (F.tid & 15) * 4, cgb = F.tid >> 5, l0b = (F.tid & 31) * 2;
        conv_weights_to_lds(a, F, g);
        f32x16 acc[4];
        { const bf16* st = (const bf16*)(PWS + WS_ST) + seg_state_off(g, seg, hd); const int p = 32 * pt + r;
#pragma unroll
          for (int i = 0; i < 4; ++i)
#pragma unroll
              for (int q = 0; q < 4; ++q) { const v2u w = *(const v2u*)(st + ((4 * i + q) * 64 + p) * 8 + 4 * hh); acc[i][4 * q] = bflo(w.x); acc[i][4 * q + 1] = bfhi(w.x); acc[i][4 * q + 2] = bflo(w.y); acc[i][4 * q + 3] = bfhi(w.y); } }
        const float dsk = PIN(I_DSSD)[head];
        const int t0 = seg * SEGC * CHK;
        unsigned char* wsb = PWS;
        unsigned ox = (unsigned)(WS_XBC + ((size_t)(t0 + l0x) * XBCD + g * 256 + cgx * 8) * 2 - 3 * XBCD * 2);
        unsigned ob = (unsigned)(WS_XBC + ((size_t)(t0 + l0b) * XBCD + 2048 + g * 128 + cgb * 8) * 2 - 3 * XBCD * 2);
        unsigned odt = (unsigned)(WS_DT + ((size_t)(t0 + F.lane) * 32 + 4 * g + (F.wave & 3)) * 4);
        const int gcx = F.tid & 31;
        unsigned oz = (unsigned)(WS_YV + ((size_t)(t0 + (F.tid >> 5) * 4) * YVP + g * 256 + gcx * 8) * 2);
        unsigned oss = (unsigned)(WS_MISC + ((size_t)(t0 + (F.tid >> 5) * 4) * 8 + g) * 4);
#pragma unroll 1
        for (int k = 0; k < SEGC; ++k) {
            v4u rx[7], rb[5], rc[5];
            const float dtv = *(const float*)(wsb + odt);
            rows_load<7>(wsb, ox, t0 + k * CHK + l0x - 3, rx); rows_load<5>(wsb, ob, t0 + k * CHK + l0b - 3, rb); rows_load<5>(wsb, ob + 2048, t0 + k * CHK + l0b - 3, rc);
            (void)seq_dt_setup(a, F, g, dtv, k & 1);
            { const int hx = cgx >> 3, p0 = (cgx & 7) * 8;
              conv_xs_to_lds<false>(wl, cgx * 8, rx, xT + (hx * 64 + p0) * 72 + l0x, (f32x4){1.f, 1.f, 1.f, 1.f});
              conv_bc_to_lds<true, true>(wl, 256 + cgb * 8, rb, Bc + l0b * 136 + cgb * 8, Bt + (cgb * 8) * 72 + l0b);
              conv_bc_to_lds<true, false>(wl, 384 + cgb * 8, rc, Cc + l0b * 136 + cgb * 8, Cc); }
            __syncthreads();
            {
                const LAS bf16* xrow = xT + (hd * 64 + 32 * pt + r) * 72; const int pcol = hd * 64 + 32 * pt + r;
#pragma unroll
                for (int lt = 0; lt < 2; ++lt) {
                    f32x16 y;
#pragma unroll
                    for (int j = 0; j < 16; ++j) y[j] = 0.f;
#pragma unroll
                    for (int i = 0; i < 4; ++i)
#pragma unroll
                        for (int kk = 0; kk < 2; ++kk) { const bf16x8 bs = pack_frag(acc[i], kk); const int nb = 32 * i + 16 * kk + 4 * hh;
                            const v2u lo = *(const LAS v2u*)(Cc + (32 * lt + r) * 136 + nb), hi = *(const LAS v2u*)(Cc + (32 * lt + r) * 136 + nb + 8); const v4u c0 = (v4u){lo.x, lo.y, hi.x, hi.y};
                            y = __builtin_amdgcn_mfma_f32_32x32x16_bf16(__builtin_bit_cast(bf16x8, c0), bs, y, 0, 0, 0); }
#pragma unroll
                    for (int q = 0; q < 4; ++q) { const f32x4 e0 = *(const LAS f32x4*)(eacs + hd * 64 + 32 * lt + 8 * q + 4 * hh);
#pragma unroll
                        for (int i = 0; i < 4; ++i) y[4 * q + i] *= e0[i]; }
                    __builtin_amdgcn_sched_barrier(0);
                    const float al = acs[hd * 64 + 32 * lt + r];
#pragma unroll
                    for (int st = 0; st <= lt; ++st) {
                        f32x16 X;
#pragma unroll
                        for (int j = 0; j < 16; ++j) X[j] = 0.f;
#pragma unroll
                        for (int ks = 0; ks < 8; ++ks) { const int ko = 16 * ks + 8 * hh;
                            const bf16x8 a0 = *(const LAS bf16x8*)(Bc + (32 * st + r) * 136 + ko), b0 = *(const LAS bf16x8*)(Cc + (32 * lt + r) * 136 + ko);
                            X = __builtin_amdgcn_mfma_f32_32x32x16_bf16(a0, b0, X, 0, 0, 0); }
#pragma unroll
                        for (int q = 0; q < 4; ++q) { const int sb = 8 * q + 4 * hh;
                            const f32x4 as0 = *(const LAS f32x4*)(acs + hd * 64 + 32 * st + sb), ds0 = *(const LAS f32x4*)(dts + hd * 64 + 32 * st + sb);
#pragma unroll
                            for (int i = 0; i < 4; ++i) { const int j = 4 * q + i; const float v = X[j] * __expf(al - as0[i]) * ds0[i]; X[j] = (st < lt || r >= sb + i) ? v : 0.f; } }
#pragma unroll
                        for (int kk = 0; kk < 2; ++kk) { const int sb = 32 * st + 16 * kk + 4 * hh;
                            const v2u lo = *(const LAS v2u*)(xrow + sb), hi = *(const LAS v2u*)(xrow + sb + 8); const v4u wa = (v4u){lo.x, lo.y, hi.x, hi.y};
                            y = __builtin_amdgcn_mfma_f32_32x32x16_bf16(pack_frag(X, kk), __builtin_bit_cast(bf16x8, wa), y, 0, 0, 0); }
                        __builtin_amdgcn_sched_barrier(0);
                    }
#pragma unroll
                    for (int q = 0; q < 4; ++q) { const int lb = 32 * lt + 8 * q + 4 * hh;
                        const v2u xa = *(const LAS v2u*)(xrow + lb); const float xa4[4] = {bflo(xa.x), bfhi(xa.x), bflo(xa.y), bfhi(xa.y)};
#pragma unroll
                        for (int i = 0; i < 4; ++i) yb[(lb + i) * 264 + pcol] = (bf16)f2bf(y[4 * q + i] + dsk * xa4[i]); }
                    __builtin_amdgcn_sched_barrier(0);
                }
                seq_state_update(F, acc, hd, pt, cdec[(k & 1) * 4 + hd]);
            }
            ox += CHK * XBCD * 2; ob += CHK * XBCD * 2; odt += CHK * 32 * 4;
            v4u zq[4];
#pragma unroll
            for (int i = 0; i < 4; ++i) zq[i] = *(const v4u*)(wsb + (size_t)(oz + (unsigned)i * (YVP * 2)));
            __syncthreads();
            { const float* nw = PIN(I_NSW) + g * 256 + gcx * 8; const f32x4 n0 = *(const f32x4*)nw, n1 = *(const f32x4*)(nw + 4);
#pragma unroll
              for (int i = 0; i < 4; ++i) { const int l = (F.tid >> 5) * 4 + i;
                  float zz[8], yy[8]; unpack8(zq[i], zz); unpack8(*(const LAS v4u*)(yb + l * 264 + gcx * 8), yy);
                  f32x4 g0, g1; float sq = 0.f;
#pragma unroll
                  for (int j = 0; j < 4; ++j) { g0[j] = yy[j] * zz[j]; g1[j] = yy[4 + j] * zz[4 + j]; sq += g0[j] * g0[j] + g1[j] * g1[j]; }
                  *(v4u*)(wsb + (size_t)(oz + (unsigned)i * (YVP * 2))) = pack8(g0 * n0, g1 * n1);
#pragma unroll
                  for (int o = 1; o < 32; o <<= 1) sq += __shfl_xor(sq, o);
                  if (gcx == 0) *(float*)(wsb + (size_t)(oss + (unsigned)i * 32)) = sq; } }
            oz += CHK * YVP * 2; oss += CHK * 8 * 4;
        }
        __syncthreads();
    }
}

__device__ __forceinline__ void seg_scan(const Args& a, const Ctx& F) {
    for (int it = F.vcu * NWAVES + F.wave; it < 2048; it += F.G * NWAVES) { const int gh = it >> 6, sl = it & 63, g = gh >> 2, hd = gh & 3;
        bf16* base = (bf16*)(PWS + WS_ST) + seg_state_off(g, 0, hd) + sl * 128 + F.lane * 2; const float* cd = (const float*)(PWS + WS_MISC + 768 * 1024) + (size_t)g * NSEG * 4 + hd; constexpr size_t CS = (size_t)4 * 8192;
        unsigned v[NSEG]; float d[NSEG];
#pragma unroll
        for (int j = 0; j < NSEG; ++j) { v[j] = *(const unsigned*)(base + (size_t)j * CS); d[j] = cd[j * 4]; }
        float c0 = 0.f, c1 = 0.f;
#pragma unroll
        for (int j = 0; j < NSEG; ++j) { *(unsigned*)(base + (size_t)j * CS) = pk2(c0, c1); c0 = c0 * d[j] + bflo(v[j]); c1 = c1 * d[j] + bfhi(v[j]); } }
}

__device__ __forceinline__ void scans(const Args& a, const Ctx& F) {
    if (F.vcu < S5G) {
        const int g = F.vcu, n = F.lane; const float dt = expf(PIN(I_LOGDT)[g]), lr = PIN(I_LRE)[g * 64 + n], li = PIN(I_LIM)[g * 64 + n];
        const float mag = expf(16.f * lr * dt), ang = 16.f * li * dt, ar = mag * cosf(ang), ai = mag * sinf(ang);
        const float* SLp = (const float*)(PWS + WS_SL) + ((size_t)g * S5NC + 128 * F.wave) * 128 + n; bf16* AP = (bf16*)(PWS + WS_AP) + ((size_t)g * S5NC + 128 * F.wave) * APK + 256 + n;
        LAS float* ex = (LAS float*)F.lds;
        float sr = 0.f, si = 0.f;
        for (int cb = 0; cb < 128; cb += 16) { float ra[16], ia[16];
#pragma unroll
            for (int j = 0; j < 16; ++j) { ra[j] = SLp[(size_t)(cb + j) * 128]; ia[j] = SLp[(size_t)(cb + j) * 128 + 64]; }
#pragma unroll
            for (int j = 0; j < 16; ++j) { const float nr = ar * sr - ai * si + ra[j], ni = ar * si + ai * sr + ia[j]; sr = nr; si = ni; } }
        ex[F.wave * 128 + n] = sr; ex[F.wave * 128 + 64 + n] = si;
        __syncthreads();
        float pr = ar, pi = ai;
#pragma unroll
        for (int q = 0; q < 7; ++q) { const float t = pr * pr - pi * pi; pi = 2.f * pr * pi; pr = t; }
        sr = 0.f; si = 0.f;
        for (int w = 0; w < F.wave; ++w) { const float er = ex[w * 128 + n], ei = ex[w * 128 + 64 + n]; const float nr = pr * sr - pi * si + er, ni = pr * si + pi * sr + ei; sr = nr; si = ni; }
        for (int cb = 0; cb < 128; cb += 16) { float ra[16], ia[16];
#pragma unroll
            for (int j = 0; j < 16; ++j) { ra[j] = SLp[(size_t)(cb + j) * 128]; ia[j] = SLp[(size_t)(cb + j) * 128 + 64]; }
#pragma unroll
            for (int j = 0; j < 16; ++j) { AP[(size_t)(cb + j) * APK] = (bf16)f2bf(sr); AP[(size_t)(cb + j) * APK + 64] = (bf16)f2bf(si);
                const float nr = ar * sr - ai * si + ra[j], ni = ar * si + ai * sr + ia[j]; sr = nr; si = ni; } }
        __syncthreads();
    }
    seg_scan(a, F);
}

__device__ __forceinline__ void route_unit(const Args& a, const Ctx& F, int unit, LAS float* lg  ) {
    const int t0 = unit * 16, row = F.lane & 15, kq = F.lane >> 4;
    const bf16* xd = (const bf16*)(PWS + WS_XD) + (size_t)(t0 + row) * D + 8 * kq; unsigned char* h2 = PWS + WS_H + (size_t)(t0 + row) * D + 8 * kq;
    const float* nf = PIN(I_NFW) + 8 * kq; const bf16* wt = (const bf16*)(PWS + WS_RT) + (size_t)row * D + 8 * kq;
    f32x4 acc0 = {0.f, 0.f, 0.f, 0.f}, acc1 = acc0, acc2 = acc0; float ssq = 0.f;
#pragma unroll 4
    for (int ks = 0; ks < 64; ++ks) { const int k = 32 * ks;
        const f32x4 g0 = *(const f32x4*)(nf + k), g1 = *(const f32x4*)(nf + k + 4); float dd[8]; unpack8(*(const v4u*)(xd + k), dd);
        f32x4 m0, m1;
#pragma unroll
        for (int j = 0; j < 4; ++j) { m0[j] = dd[j]; m1[j] = dd[4 + j]; ssq += m0[j] * m0[j] + m1[j] * m1[j]; }
        const f32x4 hq0 = m0 * g0, hq1 = m1 * g1; const v4u hv = pack8(hq0, hq1); { v2u o8; o8.x = pk4_fp8(hq0[0], hq0[1], hq0[2], hq0[3]); o8.y = pk4_fp8(hq1[0], hq1[1], hq1[2], hq1[3]); *(v2u*)(h2 + k) = o8; } const bf16x8 af = __builtin_bit_cast(bf16x8, hv);
        const bf16x8 b0h = *(const bf16x8*)(wt + k), b1h = *(const bf16x8*)(wt + (size_t)16 * D + k), b2h = *(const bf16x8*)(wt + (size_t)32 * D + k);
        const bf16x8 b0l = *(const bf16x8*)(wt + (size_t)48 * D + k), b1l = *(const bf16x8*)(wt + (size_t)64 * D + k), b2l = *(const bf16x8*)(wt + (size_t)80 * D + k);
        acc0 = __builtin_amdgcn_mfma_f32_16x16x32_bf16(af, b0h, acc0, 0, 0, 0); acc1 = __builtin_amdgcn_mfma_f32_16x16x32_bf16(af, b1h, acc1, 0, 0, 0); acc2 = __builtin_amdgcn_mfma_f32_16x16x32_bf16(af, b2h, acc2, 0, 0, 0);
        acc0 = __builtin_amdgcn_mfma_f32_16x16x32_bf16(af, b0l, acc0, 0, 0, 0); acc1 = __builtin_amdgcn_mfma_f32_16x16x32_bf16(af, b1l, acc1, 0, 0, 0); acc2 = __builtin_amdgcn_mfma_f32_16x16x32_bf16(af, b2l, acc2, 0, 0, 0); }
    ssq += __shfl_xor(ssq, 16); ssq += __shfl_xor(ssq, 32);
    const float rstd = 1.0f / sqrtf(ssq * (1.f / D) + EPS);
    if (kq == 0) ((float*)(PWS + WS_MISC + 800 * 1024))[t0 + row] = rstd;
#pragma unroll
    for (int reg = 0; reg < 4; ++reg) { const int tok = 4 * kq + reg; const float rs = __shfl(rstd, tok);
        lg[tok * 48 + row] = rs * acc0[reg]; lg[tok * 48 + 16 + row] = rs * acc1[reg]; lg[tok * 48 + 32 + row] = rs * acc2[reg]; }
    LDS_WAIT(); asm volatile("" ::: "memory");
    if (F.lane < 16) { const int tok = F.lane; const LAS float* lq = lg + tok * 48;
        unsigned* cnt = (unsigned*)(PWS + WS_CTL) + CW_CNT + a.bar_region * 4096; unsigned* list_tok = (unsigned*)(PWS + WS_LST); float* list_w = (float*)(PWS + WS_LST + 2 * MiB);
        float g4[4]; int grp = 0; float gmax;
#pragma unroll
        for (int j = 0; j < 4; ++j) g4[j] = lq[j] + PIN(I_BRG)[j];
        gmax = g4[0];
#pragma unroll
        for (int j = 1; j < 4; ++j) if (g4[j] > gmax) { gmax = g4[j]; grp = j; }
        float den = 0.f;
#pragma unroll
        for (int j = 0; j < 4; ++j) den += expf(g4[j] - gmax);
        const float pg = 1.0f / den;
        float v1 = -INFINITY, v2 = -INFINITY; int i1 = 0, i2 = 0;
        for (int j = 0; j < 8; ++j) { const float le = lq[16 + grp * 8 + j] + PIN(I_BRE2)[grp * 8 + j];
            if (le > v1) { v2 = v1; i2 = i1; v1 = le; i1 = j; } else if (le > v2) { v2 = le; i2 = j; } }
        const float e2 = expf(v2 - v1), w1 = pg / (1.0f + e2), w2 = pg * e2 / (1.0f + e2);
        const int ea = grp * 8 + i1, eb = grp * 8 + i2; const unsigned tk = (unsigned)(t0 + tok);
        float* list_r = (float*)(PWS + WS_LR); unsigned* tokslot = (unsigned*)(PWS + WS_LR + 2 * MiB);
        const unsigned s1 = atomicAdd(cnt + 64 * ea, 1u); list_tok[(size_t)ea * CAPL + s1] = tk * 2u; list_w[(size_t)ea * CAPL + s1] = w1; list_r[(size_t)ea * CAPL + s1] = rstd; tokslot[tk * 2u] = (unsigned)ea * CAPL + s1;
        const unsigned s2 = atomicAdd(cnt + 64 * eb, 1u); list_tok[(size_t)eb * CAPL + s2] = tk * 2u + 1u; list_w[(size_t)eb * CAPL + s2] = w2; list_r[(size_t)eb * CAPL + s2] = rstd; tokslot[tk * 2u + 1u] = (unsigned)eb * CAPL + s2; }
    LDS_WAIT(); asm volatile("" ::: "memory");
}
template <class Dec>
__device__ __forceinline__ void transpose_jobs_dyn(volatile LAS unsigned* ctr, int cu, int ncu, int nitems, const Dec dec, LAS float* scr, int lane) {
    auto grab = [&]() -> int { unsigned j = 0; if (lane == 0) j = __hip_atomic_fetch_add((LAS unsigned*)ctr, 1u, __ATOMIC_RELAXED, __HIP_MEMORY_SCOPE_WORKGROUP); j = __builtin_amdgcn_readfirstlane(j); return cu + (int)j * ncu; };
    int it = grab(); if (it >= nitems) return;
    TJob cur; f32x4 v[8]; dec(it, cur); tj_load(cur, lane, v);
    for (;;) { const int nx = grab(); const bool hn = nx < nitems; TJob nj = cur; f32x4 nv[8];
        if (hn) { dec(nx, nj); tj_load(nj, lane, nv); }
        tj_store(cur, lane, v, scr);
        if (!hn) break;
        cur = nj;
#pragma unroll
        for (int i = 0; i < 8; ++i) v[i] = nv[i]; }
}
template <class Dec>
__device__ __forceinline__ void transpose_jobs_queue(unsigned* gctr, int first_item, int nbatches, const Dec dec, LAS float* scr, int lane) {
    unsigned bv = 0u; if (lane == 0) bv = __hip_atomic_fetch_add(gctr, 1u, __ATOMIC_RELAXED, __HIP_MEMORY_SCOPE_AGENT);
    int b = (int)__builtin_amdgcn_readfirstlane(bv);
    while (b < nbatches) {
        unsigned nv = 0u; if (lane == 0) nv = __hip_atomic_fetch_add(gctr, 1u, __ATOMIC_RELAXED, __HIP_MEMORY_SCOPE_AGENT);
        transpose_jobs<Dec>(first_item + 8 * b, 1, first_item + 8 * b + 8, dec, scr, lane);
        b = (int)__builtin_amdgcn_readfirstlane(nv); }
}
__device__ __forceinline__ void route_phase(const Args& a, const Ctx& F) {
    if (F.wave < 4) { LAS float* lg = (LAS float*)(F.lds + 8 * 16384) + F.wave * 768;
        for (int unit = F.vcu * 4 + F.wave; unit < T / 16; unit += F.G * 4) route_unit(a, F, unit, lg); }
    { LAS float* scr = (LAS float*)(F.lds + F.wave * 16384);
      DecExp dec{PIN(I_WEG), PIN(I_WEU), PIN(I_WED), PWS};
      transpose_jobs_dyn<DecExp>(F.ctl + 76, F.vcu, F.G, 2 * DecExp::I_GU, dec, scr, F.lane); }
}
__device__ __forceinline__ void moe_tables(const Args& a, const Ctx& F) {
    if (F.tid == 0) { const unsigned* cnt = (const unsigned*)(PWS + WS_CTL) + CW_CNT + a.bar_region * 4096; unsigned rb = 0, nt = 0;
        for (int e = 0; e < NE; ++e) { const unsigned c = __hip_atomic_load(cnt + 64 * e, __ATOMIC_RELAXED, __HIP_MEMORY_SCOPE_AGENT); const unsigned tiles = (c + 255u) >> 8; F.ctl[8 + e] = c; F.ctl[40 + e] = rb;
            for (unsigned i = 0; i < tiles && nt < 160u; ++i) F.ctl[80 + nt++] = (unsigned)e; rb += tiles * 256u; }
        F.ctl[72] = nt; }
    __syncthreads();
}
__device__ __forceinline__ void final_phase(const Args& a, const Ctx& F) {
    const int lane = (int)__builtin_amdgcn_mbcnt_hi(~0u, __builtin_amdgcn_mbcnt_lo(~0u, 0u));
    const int gw = F.vcu * NWAVES + F.wave, NGW = F.G * NWAVES; const unsigned char* Y = PWS + WS_XBC; const bf16* XD = (const bf16*)(PWS + WS_XD); const unsigned* tokslot = (const unsigned*)(PWS + WS_LR + 2 * MiB);
    for (int m = gw; m < T; m += NGW) { float* orow = POUT + (size_t)m * D; const v2u* xd = (const v2u*)(XD + (size_t)m * D) + lane;
        const unsigned ts0 = tokslot[2 * m], ts1 = tokslot[2 * m + 1];
        const size_t r0 = (size_t)F.ctl[40 + (ts0 >> 14)] + (ts0 & 16383u), r1 = (size_t)F.ctl[40 + (ts1 >> 14)] + (ts1 & 16383u);
        const unsigned* y0 = (const unsigned*)(Y + r0 * D) + lane; const unsigned* y1 = (const unsigned*)(Y + r1 * D) + lane;
        const f32x4* w4 = (const f32x4*)PIN(I_NFINAL) + lane; f32x4 v[8]; float s = 0.f;
#pragma unroll
        for (int j = 0; j < 8; ++j) { const unsigned p = y0[64 * j], q = y1[64 * j]; const v2u d2 = xd[64 * j];
            const f32x2 p0 = __builtin_amdgcn_cvt_pk_f32_fp8((int)p, false), p1 = __builtin_amdgcn_cvt_pk_f32_fp8((int)p, true), q0 = __builtin_amdgcn_cvt_pk_f32_fp8((int)q, false), q1 = __builtin_amdgcn_cvt_pk_f32_fp8((int)q, true);
            constexpr float ys = 1.0f / Y_SCALE;
            v[j] = (f32x4){bflo(d2.x) + ys * (p0[0] + q0[0]), bfhi(d2.x) + ys * (p0[1] + q0[1]), bflo(d2.y) + ys * (p1[0] + q1[0]), bfhi(d2.y) + ys * (p1[1] + q1[1])};
            s += (v[j].x * v[j].x + v[j].y * v[j].y) + (v[j].z * v[j].z + v[j].w * v[j].w); }
        const float rstd = 1.0f / sqrtf(wave_sum(s) * (1.f / D) + EPS);
#pragma unroll
        for (int j = 0; j < 8; ++j) { const f32x4 g = w4[64 * j]; ((f32x4*)orow + lane)[64 * j] = (f32x4){v[j].x * rstd * g.x, v[j].y * rstd * g.y, v[j].z * rstd * g.z, v[j].w * rstd * g.w}; } }
}

constexpr int N_PHASES = 12;
template <int VARIANT>
__global__ void __launch_bounds__(NWAVES * 64, 2) hybrid_fwd(Args args) {
    extern __shared__ __attribute__((aligned(16))) unsigned char lds_raw[];
    Ctx F; F.lds = (LAS unsigned char*)lds_raw; F.ctl = (volatile LAS unsigned*)(F.lds + LDSCTL_OFF);
    F.tid = threadIdx.x; F.lane = F.tid & 63; F.wave = __builtin_amdgcn_readfirstlane(F.tid >> 6);
    F.G = gridDim.x; { const int bx = blockIdx.x; F.vcu = (F.G % 8 == 0) ? (bx % 8) * (F.G / 8) + bx / 8 : bx; }
    for (int u = F.tid; u < (LDS_BYTES - LDSCTL_OFF) / 4; u += NWAVES * 64) ((LAS unsigned*)(F.lds + LDSCTL_OFF))[u] = 0u;
    __syncthreads();
    if (F.tid == 0) { LAS unsigned long long* pt = (LAS unsigned long long*)(F.lds + PTAB_OFF);
        pt[0] = (unsigned long long)args.in[0];
        pt[1] = (unsigned long long)args.in[1];
        pt[2] = (unsigned long long)args.in[2];
        pt[3] = (unsigned long long)args.in[3];
        pt[4] = (unsigned long long)args.in[4];
        pt[5] = (unsigned long long)args.in[5];
        pt[6] = (unsigned long long)args.in[6];
        pt[7] = (unsigned long long)args.in[7];
        pt[8] = (unsigned long long)args.in[8];
        pt[9] = (unsigned long long)args.in[9];
        pt[10] = (unsigned long long)args.in[10];
        pt[11] = (unsigned long long)args.in[11];
        pt[12] = (unsigned long long)args.in[12];
        pt[13] = (unsigned long long)args.in[13];
        pt[14] = (unsigned long long)args.in[14];
        pt[15] = (unsigned long long)args.in[15];
        pt[16] = (unsigned long long)args.in[16];
        pt[17] = (unsigned long long)args.in[17];
        pt[18] = (unsigned long long)args.in[18];
        pt[19] = (unsigned long long)args.in[19];
        pt[20] = (unsigned long long)args.in[20];
        pt[21] = (unsigned long long)args.in[21];
        pt[22] = (unsigned long long)args.in[22];
        pt[23] = (unsigned long long)args.in[23];
        pt[24] = (unsigned long long)args.in[24];
        pt[25] = (unsigned long long)args.in[25];
        pt[26] = (unsigned long long)args.in[26];
        pt[27] = (unsigned long long)args.in[27];
        pt[28] = (unsigned long long)args.in[28];
        pt[29] = (unsigned long long)args.in[29];
        pt[30] = (unsigned long long)args.in[30];
        pt[31] = (unsigned long long)args.out; pt[32] = (unsigned long long)args.ws; }
    __syncthreads();
    const unsigned mask = args.mask; const int lastp = 31 - __builtin_clz(mask | 1u);
    if (__builtin_popcount(mask) > 1) (void)xcd_barrier_post((unsigned*)(PWS + WS_CTL) + CW_BAR + args.bar_region * XCD_BAR_WORDS, F.ctl);
#define IN(k) (((mask >> (k)) & 1u) && (F.lane = (int)__builtin_amdgcn_mbcnt_hi(~0u, __builtin_amdgcn_mbcnt_lo(~0u, 0u)), F.tid = F.wave * 64 + F.lane, true))
#define SEAM(k) do { if (IN(k) && (k) != lastp) { XcdBarrier bar_; bar_.bar = (unsigned*)(PWS + WS_CTL) + CW_BAR + args.bar_region * XCD_BAR_WORDS; bar_.x = xb_xcc_id(); bar_.st = F.ctl; xcd_barrier(bar_); } } while (0)
    unsigned char* ws = PWS;
    if (IN(0)) { p0_prologue(args, F); } SEAM(0);
    if (IN(1)) { SchedDense S; S.so.init(T / 256, 28, F.G, (int)blockIdx.x); S.A = (const char*)(ws + WS_H); S.B = (const char*)(ws + WS_WIN); S.lda = D * 2; S.ldb = D * 2;
        Epi1a E{(bf16*)(ws + WS_YV), (bf16*)(ws + WS_XBC), (bf16*)(ws + WS_AP)};
        pg8::gemm_phase<Epi1a, SchedDense, false>(F.lds, D, D * 2, D * 2, S, E, (VARIANT & 1) != 0);
        dt_gemm(args, F); } SEAM(1);
    if (IN(2)) { ssd_pass_a(args, F);
        SchedS5 S{(const char*)(ws + WS_AP), (const char*)(ws + WS_S5WS), 512u, F.G, F.vcu}; EpiS5a E{(float*)(ws + WS_SL)};
        pg8::gemm_phase<EpiS5a, SchedS5, false>(F.lds, 256, APK * 2, 512, S, E, (VARIANT & 1) != 0); } SEAM(2);
    if (IN(3)) { scans(args, F); } SEAM(3);
    if (IN(4)) { ssd_pass_b(args, F);
        SchedS5 S{(const char*)(ws + WS_AP), (const char*)(ws + WS_S5TW), (unsigned)(APK * 2), F.G, F.vcu}; EpiS5b E{(bf16*)(ws + WS_SL)};
        pg8::gemm_phase<EpiS5b, SchedS5, false>(F.lds, APK, APK * 2, APK * 2, S, E, (VARIANT & 1) != 0); } SEAM(4);
    if (IN(5)) { { SchedDense S; S.so.init(T / 256, 16, F.G, (int)blockIdx.x); S.A = (const char*)(ws + WS_H8); S.B = (const char*)(ws + WS_WIN) + (size_t)7168 * D * 2; S.lda = D; S.ldb = D;
          Epi1b E{(bf16*)(ws + WS_XBC), PIN(I_GATEB), (const float*)(ws + WS_MISC)};
          pg8::gemm_phase<Epi1b, SchedDense, false, true, 0, true, 127, 122>(F.lds, D, D, D, S, E, (VARIANT & 1) != 0); }
        { SchedDense S; S.so.init(T / 256, 4, F.G, (int)blockIdx.x); S.A = (const char*)(ws + WS_SL); S.B = (const char*)(ws + WS_WGLU); S.lda = S5W * 2; S.ldb = S5W * 2;
          EpiGlu E{(const bf16*)(ws + WS_SL), (bf16*)(ws + WS_YV)};
          pg8::gemm_phase<EpiGlu, SchedDense, false>(F.lds, S5W, S5W * 2, S5W * 2, S, E, (VARIANT & 1) != 0); } } SEAM(5);
    if (IN(6)) { SchedDense S; S.so.init(T / 256, 8, F.G, (int)blockIdx.x); S.A = (const char*)(ws + WS_YV); S.B = (const char*)(ws + WS_WAB); S.lda = YVP * 2; S.ldb = YVP * 2;
        EpiAB E{(const bf16*)(ws + WS_XBC), (bf16*)(ws + WS_ST)};
        pg8::gemm_phase<EpiAB, SchedDense, false, true, 32>(F.lds, YVP, YVP * 2, YVP * 2, S, E, (VARIANT & 1) != 0); } SEAM(6);
    if (IN(8)) { SchedDense S; S.so.init(T / 256, 8, F.G, (int)blockIdx.x); S.A = (const char*)(ws + WS_ST); S.B = (const char*)(ws + WS_WOUT); S.lda = D * 2; S.ldb = D * 2;
        EpiOut E{(bf16*)(ws + WS_XD), PIN(I_X)};
        pg8::gemm_phase<EpiOut, SchedDense, false, true, 0, false, 127, 127, true>(F.lds, D, D * 2, D * 2, S, E, (VARIANT & 1) != 0); } SEAM(8);
    if (IN(9)) { route_phase(args, F); } SEAM(9);
    if (IN(10)) { moe_tables(args, F);
        SchedMoE S{F.ctl, (const char*)(ws + WS_H), (const char*)(ws + WS_ST), (const unsigned*)(ws + WS_LST), (unsigned)D, (size_t)1024 * D, (unsigned)D, 4, F.G, F.vcu, true};
        EpiGU E{(bf16*)(ws + WS_AP), (const unsigned*)(ws + WS_LST), (const float*)(ws + WS_LR)};
        pg8::gemm_phase<EpiGU, SchedMoE, true, true, 0, true, 127, 121>(F.lds, D, D, D, S, E, (VARIANT & 1) != 0);
        { LAS float* scr = (LAS float*)(F.lds + F.wave * 16384); DecExp dec{PIN(I_WEG), PIN(I_WEU), PIN(I_WED), PWS};
          transpose_jobs_queue<DecExp>((unsigned*)(ws + WS_CTL) + CW_CNT + args.bar_region * 4096 + 2560, 2 * DecExp::I_GU, DecExp::I_GU / 8, dec, scr, F.lane); } } SEAM(10);
    if (IN(11)) { moe_tables(args, F);
        SchedMoE S{F.ctl, (const char*)(ws + WS_AP), (const char*)(ws + WS_YV), (const unsigned*)(ws + WS_LST), (unsigned)FF, (size_t)D * FF, (unsigned)FF, 8, F.G, F.vcu, false};
        EpiDn E{(const float*)(ws + WS_LST + 2 * MiB), ws + WS_XBC};
        pg8::gemm_phase<EpiDn, SchedMoE, false, true, 0, true, 125, 122>(F.lds, FF, FF, FF, S, E, (VARIANT & 1) != 0); } SEAM(11);
    if (IN(12)) { moe_tables(args, F); final_phase(args, F); }
#undef IN
#undef SEAM
}

extern "C" void kernel_launch(void* const* d_in, const int* in_sizes, int n_in, void* d_out, int out_size, void* d_ws, size_t ws_size, hipStream_t stream) {
    static int grid = 0;
    if (grid == 0) {
        if (n_in != 31 || in_sizes[0] != T * D || out_size != T * D || ws_size < WS_END) { fprintf(stderr, "kernel_launch: unexpected shapes / workspace (n_in %d, ws %zu, need %zu)\n", n_in, ws_size, (size_t)WS_END); grid = -1; return; }
        int dev = 0, cus = 0;
        if (hipGetDevice(&dev) != hipSuccess || hipDeviceGetAttribute(&cus, hipDeviceAttributeMultiprocessorCount, dev) != hipSuccess) { grid = -1; return; }
        if (hipFuncSetAttribute((const void*)hybrid_fwd<0>, hipFuncAttributeMaxDynamicSharedMemorySize, LDS_BYTES) != hipSuccess) { fprintf(stderr, "kernel_launch: hipFuncSetAttribute failed\n"); grid = -1; return; }
#if defined(EXP_MASK)
        (void)hipFuncSetAttribute((const void*)hybrid_fwd<EXP_VARIANT>, hipFuncAttributeMaxDynamicSharedMemorySize, LDS_BYTES);
#endif
        int per_cu = 0;
        if (hipOccupancyMaxActiveBlocksPerMultiprocessor(&per_cu, (const void*)hybrid_fwd<0>, NWAVES * 64, LDS_BYTES) != hipSuccess || per_cu < 1) fprintf(stderr, "kernel_launch: occupancy query reports %d\n", per_cu);
        (void)hipGetLastError();
        grid = cus;
    }
    if (grid < 0) return;
    (void)hipMemsetAsync((char*)d_ws + WS_CTL, 0, CTL_ZERO_BYTES, stream);
    Args a{};
    for (int i = 0; i < 31; ++i) a.in[i] = (const float*)d_in[i];
    a.out = (float*)d_out; a.ws = (unsigned char*)d_ws;
#if defined(EXP_MASK)
    a.mask = EXP_MASK; a.variant = EXP_VARIANT; a.bar_region = 0;
    hipLaunchKernelGGL(hybrid_fwd<EXP_VARIANT>, dim3(grid), dim3(NWAVES * 64), LDS_BYTES, stream, a);
    a.mask = ((1u << (N_PHASES + 1)) - 1u) & ~(1u << 7); a.variant = 0; a.bar_region = 1;
    hipLaunchKernelGGL(hybrid_fwd<0>, dim3(grid), dim3(NWAVES * 64), LDS_BYTES, stream, a);
#elif MK_N_LAUNCHES == 1
    a.mask = ((1u << (N_PHASES + 1)) - 1u) & ~(1u << 7); a.variant = 0; a.bar_region = 0;
    hipLaunchKernelGGL(hybrid_fwd<0>, dim3(grid), dim3(NWAVES * 64), LDS_BYTES, stream, a);
#else
    for (int p = 0; p <= N_PHASES; ++p) { if (p == 7) continue; a.mask = 1u << p; a.variant = 0; a.bar_region = 0; hipLaunchKernelGGL(hybrid_fwd<0>, dim3(grid), dim3(NWAVES * 64), LDS_BYTES, stream, a); }
#endif
}
```

```cpp
#include <hip/hip_runtime.h>
#include <cstdio>
#include <cstdint>

#ifndef MK_N_LAUNCHES
#define MK_N_LAUNCHES 1
#endif
#ifndef EXP_VARIANT
#define EXP_VARIANT 0
#endif
#ifndef NAIVE_GEMM
#define NAIVE_GEMM 0
#endif

#define LAS __attribute__((address_space(3)))
#define GAS __attribute__((address_space(1)))
typedef unsigned short bf16;
typedef short bf16x8 __attribute__((ext_vector_type(8)));
typedef float f32x4 __attribute__((ext_vector_type(4)));
typedef float f32x2 __attribute__((ext_vector_type(2)));
typedef float f32x16 __attribute__((ext_vector_type(16)));
typedef unsigned v4u __attribute__((ext_vector_type(4)));
typedef unsigned v2u __attribute__((ext_vector_type(2)));
typedef GAS unsigned gu32;
typedef int v4i_ __attribute__((ext_vector_type(4)));
typedef int v8i_ __attribute__((ext_vector_type(8)));

constexpr int T = 16384, D = 2048;
constexpr int NH = 32, HP = 64, NGRP = 8, NST = 128, CHK = 64, NCHK = T / CHK;
constexpr int XBCD = 4096;
constexpr int S5W = 1024, S5G = 64, S5C = 16, S5N = 64, LS = 16, S5NC = T / LS;
constexpr int APK = 384;
constexpr int NE = 32, EPG = 8, FF = 512, CAPL = 16384;
constexpr int IN_DIM = 11296;
constexpr float EPS = 1e-6f;
constexpr int NWAVES = 8;

constexpr size_t MiB = 1u << 20;
constexpr size_t WS_CTL = 0, CTL_ZERO_BYTES = 1 * MiB;
constexpr size_t WS_WIN = 1 * MiB;
constexpr size_t WS_WAB = 46 * MiB;
constexpr size_t WS_WGLU = 58 * MiB, WS_WOUT = 80 * MiB;
constexpr size_t WS_S5WS = 60 * MiB;
constexpr size_t WS_S5TW = 68 * MiB;
constexpr size_t WS_XD = 1 * MiB;
constexpr size_t WS_H = 88 * MiB;
constexpr int YVP = 3072;
constexpr size_t WS_YV = 152 * MiB;
constexpr size_t WS_XBC = 248 * MiB;
constexpr size_t WS_ST = 376 * MiB;
constexpr size_t WS_AP = 504 * MiB;
constexpr size_t WS_DT = 552 * MiB;
constexpr size_t WS_MISC = 554 * MiB;
constexpr size_t WS_SL = 555 * MiB;
constexpr size_t WS_LST = 587 * MiB;
constexpr size_t WS_RT = 591 * MiB;
constexpr size_t WS_H8 = 592 * MiB;
constexpr size_t WS_LR = 624 * MiB;
constexpr size_t WS_END = 627 * MiB;
constexpr int CW_BAR = 4096;
constexpr int CW_CNT = 16384;

constexpr int LDS_BYTES = 163840;
constexpr int LDSCTL_OFF = 161792;

typedef __bf16 bf16x2_t __attribute__((ext_vector_type(2)));
__device__ __forceinline__ unsigned f2bf(float f) { return (unsigned)__builtin_bit_cast(unsigned short, (__bf16)f); }
__device__ __forceinline__ unsigned pk2(float lo, float hi) { const f32x2 v = {lo, hi}; const bf16x2_t b = __builtin_convertvector(v, bf16x2_t); return __builtin_bit_cast(unsigned, b); }
__device__ __forceinline__ unsigned pk4_fp8(float a, float b, float c, float d) { unsigned w = 0u; w = (unsigned)__builtin_amdgcn_cvt_pk_fp8_f32(a, b, (int)w, false); w = (unsigned)__builtin_amdgcn_cvt_pk_fp8_f32(c, d, (int)w, true); return w; }
__device__ __forceinline__ float bflo(unsigned w) { return __builtin_bit_cast(float, w << 16); }
__device__ __forceinline__ float bfhi(unsigned w) { return __builtin_bit_cast(float, w & 0xffff0000u); }
__device__ __forceinline__ float bf2f(bf16 h) { return __builtin_bit_cast(float, (unsigned)h << 16); }
__device__ __forceinline__ float wave_sum(float v) {
#pragma unroll
    for (int o = 1; o < 64; o <<= 1) v += __shfl_xor(v, o);
    return v;
}
__device__ __forceinline__ float sigmoidf_(float x) { return __builtin_amdgcn_rcpf(1.0f + __builtin_amdgcn_exp2f(-1.4426950408889634f * x)); }
__device__ __forceinline__ float siluf_(float x) { return x * __builtin_amdgcn_rcpf(1.0f + __builtin_amdgcn_exp2f(-1.4426950408889634f * x)); }
__device__ __forceinline__ float gelu_tanh(float x) { const float u = 0.7978845608028654f * (x + 0.044715f * x * x * x); return x * __builtin_amdgcn_rcpf(1.0f + __builtin_amdgcn_exp2f(-2.8853900817779268f * u)); }
#define LDS_WAIT() asm volatile("s_waitcnt lgkmcnt(0)" ::: "memory")
#define VM_WAIT() asm volatile("s_waitcnt vmcnt(0)" ::: "memory")

namespace pg8 {
constexpr int BM = 256, BK = 64, HALF = 128, HTB = HALF * BK * 2, STAGE_BYTES = 8 * HTB, NXCD = 8, WGM = 8;
__host__ __device__ __forceinline__ int lds_byte(int r, int c) { const int st = (r >> 4) * 2 + (c >> 5), rr = r & 15, cc = c & 31, ob = rr * 64 + cc * 2; return st * 1024 + (ob ^ (((ob >> 9) & 1) << 5)); }
__host__ __device__ __forceinline__ void stage_rc(int b, int& R, int& C) { const int st = b / 1024, sb = b % 1024, swz = sb ^ (((sb >> 9) & 1) << 5); R = (st >> 1) * 16 + swz / 64; C = (st & 1) * 32 + (swz % 64) / 2; }
__host__ __device__ __forceinline__ int perm32(int rho) { const int n = rho >> 4, i = rho & 15; return 8 * (i >> 2) + 4 * n + (i & 3); }

struct Unit { const char* A; const char* B; int row0, col0, e, nvalid, slot0; };

struct StaticOrder {
    int nM, nN, nwg, G, c;
    __device__ void init(int nM_, int nN_, int G_, int c_) { nM = nM_; nN = nN_; nwg = nM * nN; G = G_; c = c_; }
    __device__ bool next(int i, int& pm, int& pn) const {
        const long L = (long)i * G + c; if (L >= nwg) return false;
        int wgid = (int)L; { const int q = nwg / NXCD, r = nwg % NXCD, xcd = wgid % NXCD, off = wgid / NXCD; wgid = (xcd < r ? xcd * (q + 1) : r * (q + 1) + (xcd - r) * q) + off; }
        const int nig = WGM * nN, gid = wgid / nig, fm = gid * WGM, gsz = (nM - fm) < WGM ? (nM - fm) : WGM;
        pm = fm + ((wgid % nig) % gsz); pn = (wgid % nig) / gsz; return true;
    }
};

#if !NAIVE_GEMM
template <class Epi, class Sched, bool GATHER, bool SP2 = true, int MIDT = 0, bool FP8 = false, int SCA = 127, int SCB = 127, bool XADD = false>
__device__ __forceinline__ void gemm_phase(LAS unsigned char* lds, const int K, const unsigned lda, const unsigned ldb, const Sched& S, const Epi& E, const bool noepi = false) {
    const int tid = threadIdx.x, wid = __builtin_amdgcn_readfirstlane(tid >> 6), lane = tid & 63, wr = wid >> 2, wc = wid & 3, fr = lane & 15, fq = lane >> 4;
    const int nt = FP8 ? K / 128 : K / BK;
    unsigned voffA[2], voffB[2]; int gC0 = 0;
#pragma unroll
    for (int i = 0; i < 2; ++i) { int R, C; stage_rc(tid * 16 + i * 8192, R, C); const int Rb = (R & ~31) + perm32(R & 31);
        voffA[i] = (unsigned)R * lda + (unsigned)C * 2u; voffB[i] = (unsigned)Rb * ldb + (unsigned)C * 2u; if (i == 0) gC0 = C * 2; }
    const size_t kstep = (size_t)(BK * 2);
    const size_t hstepA = (size_t)HALF * lda, hstepB = (size_t)HALF * ldb;
    const unsigned ldsw = (unsigned)wid * 1024u;
    const int aoff = FP8 ? lds_byte(wr * 64 + fr, fq * 16) : lds_byte(wr * 64 + fr, fq * 8), boff = FP8 ? lds_byte(wc * 32 + fr, fq * 16) : lds_byte(wc * 32 + fr, fq * 8);
    constexpr int PIECE1 = FP8 ? 16 : 1024;
    unsigned gcur[2], gnxt[2];
    int scav = SCA, scbv = SCB;
    if constexpr (FP8) { asm volatile("" : "+v"(scav), "+v"(scbv)); }
#define PG8_SA(b, h) (((b) * 2 + (h)) * HTB)
#define PG8_SB(b, h) ((4 + (b) * 2 + (h)) * HTB)
#define PG8_GLDS(gptr, bufoff, i) __builtin_amdgcn_global_load_lds((const unsigned*)(gptr), (LAS unsigned*)(lds + (bufoff) + ldsw + (i) * 8192), 16, 0, 0)
#define PG8_STAGEB(bufoff, gbase) do { _Pragma("unroll") for (int _i = 0; _i < 2; ++_i) PG8_GLDS((const char*)(gbase) + voffB[0] + (size_t)(_i * 64) * ldb, bufoff, _i); } while (0)
#define PG8_STAGEA(bufoff, gbase, h, nx) do { _Pragma("unroll") for (int _i = 0; _i < 2; ++_i) { \
        const unsigned _pk = (nx) ? gnxt[h] : gcur[h]; const size_t _o = GATHER ? (size_t)((_i ? (_pk >> 16) : (_pk & 0xffffu)) * lda + (unsigned)gC0) : (size_t)voffA[0] + (size_t)(_i * 64) * lda + (size_t)(h) * hstepA; PG8_GLDS((const char*)(gbase) + _o, bufoff, _i); } } while (0)
#define PG8_LD16(off) (*(const LAS v4i_*)(lds + (off)))
#define PG8_LDA(dst, b, h) do { _Pragma("unroll") for (int m = 0; m < 4; ++m) { const v4i_ _lo = PG8_LD16(PG8_SA(b, h) + aoff + m * 2048), _hi = PG8_LD16(PG8_SA(b, h) + aoff + PIECE1 + m * 2048); \
        if constexpr (FP8) dst##8[m] = __builtin_shufflevector(_lo, _hi, 0, 1, 2, 3, 4, 5, 6, 7); else { dst##4[m][0] = _lo; dst##4[m][1] = _hi; } } } while (0)
#define PG8_LDB(dst, b, h) do { _Pragma("unroll") for (int n = 0; n < 2; ++n) { const v4i_ _lo = PG8_LD16(PG8_SB(b, h) + boff + n * 2048), _hi = PG8_LD16(PG8_SB(b, h) + boff + PIECE1 + n * 2048); \
        if constexpr (FP8) dst##8[n] = __builtin_shufflevector(_lo, _hi, 0, 1, 2, 3, 4, 5, 6, 7); else { dst##4[n][0] = _lo; dst##4[n][1] = _hi; } } } while (0)
#define PG8_MMA(ai, bj, At, Bt) do { __builtin_amdgcn_s_setprio(1); _Pragma("unroll") for (int m = 0; m < 4; ++m) _Pragma("unroll") for (int n = 0; n < 2; ++n) { \
        if constexpr (FP8) { asm volatile("v_mfma_scale_f32_16x16x128_f8f6f4 %0, %1, %2, %0, %3, %4 op_sel_hi:[0,0,0]" : "+v"(acc[ai][bj][m][n]) : "v"(Bt##8[n]), "v"(At##8[m]), "v"(scbv), "v"(scav)); } \
        else { _Pragma("unroll") for (int k = 0; k < 2; ++k) acc[ai][bj][m][n] = __builtin_amdgcn_mfma_f32_16x16x32_bf16(__builtin_bit_cast(bf16x8, Bt##4[n][k]), __builtin_bit_cast(bf16x8, At##4[m][k]), acc[ai][bj][m][n], 0, 0, 0); } } \
        __builtin_amdgcn_s_setprio(0); } while (0)
#define PG8_WAIT_V(n) asm volatile("s_waitcnt vmcnt(" #n ")" ::: "memory")
#define PG8_WAIT_L(n) asm volatile("s_waitcnt lgkmcnt(" #n ")" ::: "memory")
#define PG8_BAR __builtin_amdgcn_s_barrier()
#define PG8_SCHED __builtin_amdgcn_sched_barrier(0)
#define PG8_GOFFS(dst, u) do { if constexpr (GATHER) { int _r0, _r1, _c; stage_rc(tid * 16, _r0, _c); stage_rc(tid * 16 + 8192, _r1, _c); _Pragma("unroll") for (int _h = 0; _h < 2; ++_h) dst[_h] = S.row_idx(u, _h * HALF + _r0) | (S.row_idx(u, _h * HALF + _r1) << 16); } } while (0)
    Unit cur, nxt; int ui = 0;
    if (!S.next(0, cur)) return;
    f32x4 acc[2][2][4][2];
#define PG8_ACC_ALL(stmt) do { _Pragma("unroll") for (int a = 0; a < 2; ++a) _Pragma("unroll") for (int b = 0; b < 2; ++b) _Pragma("unroll") for (int m = 0; m < 4; ++m) _Pragma("unroll") for (int n = 0; n < 2; ++n) { stmt; } } while (0)
    PG8_ACC_ALL(acc[a][b][m][n] = ((f32x4){0.f, 0.f, 0.f, 0.f}));
    constexpr int XOFF0 = 8 * HTB, XOFF1 = 8 * HTB + 8192;
#define PG8_XISSUE(r0_, c0_, ai_, it_, bufoff) do { const int i_ = (it_); \
        const char* xg_ = (const char*)E.X + ((size_t)((r0_) + (ai_) * 128 + (i_ >> 2) * 16) * D + (size_t)((c0_) + ((i_ >> 1) & 1) * 128 + (i_ & 1) * 4)) * 4 \
            + (size_t)(unsigned)(((((tid >> 8) * 64) + ((tid >> 4) & 15)) * D + (((tid & 15) ^ ((tid >> 4) & 15)) * 8)) * 4); \
        PG8_GLDS(xg_, bufoff, 0); } while (0)
#define PG8_XCASE(AI_, S_) case S_: acc[AI_][((S_) >> 1) & 1][(S_) >> 2][(S_) & 1] += xv_; break;
#define PG8_XCONSUME(AI_, it_, bufoff) do { const f32x4 xv_ = *(const LAS f32x4*)(lds + (bufoff) + (16 * wr + fr) * 256 + (((4 * wc + fq) ^ fr) * 16)); \
        switch (it_) { PG8_XCASE(AI_, 0) PG8_XCASE(AI_, 1) PG8_XCASE(AI_, 2) PG8_XCASE(AI_, 3) PG8_XCASE(AI_, 4) PG8_XCASE(AI_, 5) PG8_XCASE(AI_, 6) PG8_XCASE(AI_, 7) \
                       PG8_XCASE(AI_, 8) PG8_XCASE(AI_, 9) PG8_XCASE(AI_, 10) PG8_XCASE(AI_, 11) PG8_XCASE(AI_, 12) PG8_XCASE(AI_, 13) PG8_XCASE(AI_, 14) PG8_XCASE(AI_, 15) default: break; } } while (0)
    v8i_ At8[4], B08[2], B18[2]; v4i_ At4[4][2], B04[2][2], B14[2][2];
    const char* cA = cur.A; const char* cB = cur.B;
#pragma unroll
    for (int h = 0; h < 2; ++h) { gcur[h] = 0u; gnxt[h] = 0u; }
    PG8_GOFFS(gcur, cur);
    if constexpr (SP2) {
    PG8_STAGEB(PG8_SB(0, 0), cB); PG8_STAGEB(PG8_SB(0, 1), cB + hstepB); PG8_STAGEA(PG8_SA(0, 0), cA, 0, false); PG8_STAGEA(PG8_SA(0, 1), cA, 1, false);
    if (wr == 1) PG8_BAR;
    PG8_WAIT_V(2); PG8_BAR;
    if constexpr (XADD) PG8_XISSUE(cur.row0, cur.col0, 0, 0, XOFF0);
    PG8_STAGEB(PG8_SB(1, 0), cB + kstep); PG8_STAGEA(PG8_SA(1, 0), cA + kstep, 0, false); PG8_STAGEB(PG8_SB(1, 1), cB + hstepB + kstep);
    if constexpr (XADD) PG8_WAIT_V(7); else PG8_WAIT_V(6);
    PG8_BAR;
    } else {
    PG8_STAGEB(PG8_SB(0, 0), cB); PG8_STAGEA(PG8_SA(0, 0), cA, 0, false); PG8_STAGEB(PG8_SB(0, 1), cB + hstepB); PG8_STAGEA(PG8_SA(0, 1), cA, 1, false);
    if (wr == 1) PG8_BAR;
    PG8_WAIT_V(4); PG8_BAR;
    PG8_STAGEB(PG8_SB(1, 0), cB + kstep); PG8_STAGEA(PG8_SA(1, 0), cA + kstep, 0, false); PG8_STAGEB(PG8_SB(1, 1), cB + hstepB + kstep);
    PG8_WAIT_V(6); PG8_BAR;
    }
    for (;;) {
        const bool has_next = S.next(ui + 1, nxt);
        const char* nA = has_next ? nxt.A : cA; const char* nB = has_next ? nxt.B : cB;
        if constexpr (GATHER) { if (has_next) { PG8_GOFFS(gnxt, nxt); } else {
            gnxt[0] = gcur[0]; gnxt[1] = gcur[1]; } }
#pragma unroll 1
        for (int t = 0; t < nt; t += 2) {
            const bool last = (t == nt - 2);
            if constexpr (MIDT > 0) { if (t == MIDT) E.mid(acc, cur, wr, wc, fr, fq); }
            const char* a1 = cA + (size_t)(t + 1) * kstep;
            const char* a2 = last ? nA : cA + (size_t)(t + 2) * kstep; const char* b2 = last ? nB : cB + (size_t)(t + 2) * kstep;
            const char* a3 = a2 + kstep; const char* b3 = b2 + kstep;
            if constexpr (SP2) {
            if constexpr (XADD) PG8_XISSUE(cur.row0, cur.col0, 1, t >> 1, XOFF1);
            PG8_LDB(B0, 0, 0); PG8_LDB(B1, 0, 1); PG8_SCHED; PG8_LDA(At, 0, 0); PG8_STAGEA(PG8_SA(1, 1), a1, 1, false);
            if constexpr (XADD) PG8_WAIT_V(10); else PG8_WAIT_V(8);
            PG8_WAIT_L(0); PG8_BAR; PG8_MMA(0, 0, At, B0); PG8_MMA(0, 1, At, B1); PG8_BAR; PG8_SCHED;
            PG8_LDA(At, 0, 1); PG8_STAGEB(PG8_SB(0, 0), b2); PG8_STAGEB(PG8_SB(0, 1), b2 + hstepB); PG8_STAGEA(PG8_SA(0, 0), a2, 0, last);
            if constexpr (XADD) PG8_WAIT_V(9); else PG8_WAIT_V(8);
            PG8_WAIT_L(0); PG8_BAR; PG8_MMA(1, 0, At, B0); PG8_MMA(1, 1, At, B1); PG8_BAR; PG8_SCHED;
            if constexpr (XADD) { PG8_XCONSUME(0, t >> 1, XOFF0); PG8_SCHED; }
            PG8_LDB(B0, 1, 0); PG8_LDB(B1, 1, 1); PG8_SCHED; PG8_LDA(At, 1, 0); PG8_STAGEA(PG8_SA(0, 1), a2, 1, last);
            PG8_WAIT_V(8); PG8_WAIT_L(0); PG8_BAR; PG8_MMA(0, 0, At, B0); PG8_MMA(0, 1, At, B1); PG8_BAR; PG8_SCHED;
            if constexpr (XADD) { PG8_XCONSUME(1, t >> 1, XOFF1); PG8_SCHED;
                const bool nn = last && has_next; PG8_XISSUE(nn ? nxt.row0 : cur.row0, nn ? nxt.col0 : cur.col0, 0, last ? 0 : (t >> 1) + 1, XOFF0); }
            PG8_LDA(At, 1, 1); PG8_STAGEB(PG8_SB(1, 0), b3); PG8_STAGEB(PG8_SB(1, 1), b3 + hstepB); PG8_STAGEA(PG8_SA(1, 0), a3, 0, last);
            if constexpr (XADD) PG8_WAIT_V(9); else PG8_WAIT_V(8);
            PG8_WAIT_L(0); PG8_BAR; PG8_MMA(1, 0, At, B0); PG8_MMA(1, 1, At, B1); PG8_BAR; PG8_SCHED;
            } else {
            PG8_LDB(B0, 0, 0); PG8_SCHED; PG8_LDA(At, 0, 0); PG8_STAGEA(PG8_SA(1, 1), a1, 1, false);
            PG8_WAIT_L(8); PG8_BAR; PG8_WAIT_L(0); PG8_MMA(0, 0, At, B0); PG8_BAR; PG8_SCHED;
            PG8_LDB(B1, 0, 1); PG8_STAGEB(PG8_SB(0, 0), b2);
            PG8_BAR; PG8_WAIT_L(0); PG8_MMA(0, 1, At, B1); PG8_BAR;
            PG8_LDA(At, 0, 1); PG8_STAGEA(PG8_SA(0, 0), a2, 0, last);
            PG8_BAR; PG8_WAIT_L(0); PG8_MMA(1, 0, At, B0); PG8_BAR; PG8_SCHED;
            PG8_STAGEB(PG8_SB(0, 1), b2 + hstepB);
            PG8_WAIT_V(6); PG8_BAR; PG8_MMA(1, 1, At, B1); PG8_BAR;
            PG8_LDB(B0, 1, 0); PG8_SCHED; PG8_LDA(At, 1, 0); PG8_STAGEA(PG8_SA(0, 1), a2, 1, last);
            PG8_WAIT_L(8); PG8_BAR; PG8_WAIT_L(0); PG8_MMA(0, 0, At, B0); PG8_BAR; PG8_SCHED;
            PG8_LDB(B1, 1, 1); PG8_STAGEB(PG8_SB(1, 0), b3);
            PG8_BAR; PG8_WAIT_L(0); PG8_MMA(0, 1, At, B1); PG8_BAR;
            PG8_LDA(At, 1, 1); PG8_STAGEA(PG8_SA(1, 0), a3, 0, last);
            PG8_BAR; PG8_WAIT_L(0); PG8_MMA(1, 0, At, B0); PG8_BAR; PG8_SCHED;
            PG8_STAGEB(PG8_SB(1, 1), b3 + hstepB);
            PG8_WAIT_V(6); PG8_BAR; PG8_MMA(1, 1, At, B1); PG8_BAR;
            }
        }
        if constexpr (FP8) { asm volatile("s_nop 15\n\ts_nop 15" ::: "memory"); }
        if (wr == 0) PG8_BAR;
        if (!noepi) E(acc, cur, wr, wc, fr, fq);
        else {
#pragma unroll
            for (int a = 0; a < 2; ++a)
#pragma unroll
                for (int b = 0; b < 2; ++b)
#pragma unroll
                    for (int m = 0; m < 4; ++m)
#pragma unroll
                        for (int n = 0; n < 2; ++n) asm volatile("" :: "v"(acc[a][b][m][n])); }
        if (!has_next) break;
        PG8_ACC_ALL(acc[a][b][m][n] = ((f32x4){0.f, 0.f, 0.f, 0.f}));
        cur = nxt; cA = nA; cB = nB; ++ui;
        if constexpr (GATHER) {
            gcur[0] = gnxt[0]; gcur[1] = gnxt[1]; }
        if (wr == 1) PG8_BAR;
    }
    PG8_WAIT_V(0);
    PG8_BAR;
#undef PG8_SA
#undef PG8_SB
#undef PG8_GLDS
#undef PG8_STAGEA
#undef PG8_STAGEB
#undef PG8_LDA
#undef PG8_LDB
#undef PG8_MMA
#undef PG8_WAIT_V
#undef PG8_WAIT_L
#undef PG8_BAR
#undef PG8_SCHED
#undef PG8_GOFFS
#undef PG8_ACC_ALL
#undef PG8_XISSUE
#undef PG8_XCASE
#undef PG8_XCONSUME
}
#else
template <class Epi, class Sched, bool GATHER>
__device__ __forceinline__ void gemm_phase(LAS unsigned char* lds, const int K, const unsigned lda, const unsigned ldb, const Sched& S, const Epi& E, const bool noepi = false) {
    const int tid = threadIdx.x, wid = __builtin_amdgcn_readfirstlane(tid >> 6), lane = tid & 63, wr = wid >> 2, wc = wid & 3, fr = lane & 15, fq = lane >> 4;
    Unit cur;
    for (int ui = 0; S.next(ui, cur); ++ui) {
        f32x4 acc[2][2][4][2];
#pragma unroll
        for (int a = 0; a < 2; ++a)
#pragma unroll
            for (int b = 0; b < 2; ++b)
#pragma unroll
                for (int m = 0; m < 4; ++m)
#pragma unroll
                    for (int n = 0; n < 2; ++n) acc[a][b][m][n] = (f32x4){0.f, 0.f, 0.f, 0.f};
        for (int k = 0; k < K; k += 8) {
            v4u av[2][4];
#pragma unroll
            for (int ai = 0; ai < 2; ++ai)
#pragma unroll
                for (int m = 0; m < 4; ++m) { const int r = ai * 128 + wr * 64 + m * 16 + fr; const size_t ro = GATHER ? (size_t)S.row_idx(cur, r) * lda : (size_t)r * lda; av[ai][m] = *(const v4u*)(cur.A + ro + (size_t)k * 2); }
#pragma unroll
            for (int bj = 0; bj < 2; ++bj)
#pragma unroll
                for (int n = 0; n < 2; ++n)
#pragma unroll
                    for (int j = 0; j < 4; ++j) { const int c = bj * 128 + wc * 32 + 8 * fq + 4 * n + j; const v4u bv = *(const v4u*)(cur.B + (size_t)c * ldb + (size_t)k * 2);
#pragma unroll
                        for (int ai = 0; ai < 2; ++ai)
#pragma unroll
                            for (int m = 0; m < 4; ++m) { const v4u a = av[ai][m]; float s = acc[ai][bj][m][n][j];
                                s += bflo(a.x) * bflo(bv.x) + bfhi(a.x) * bfhi(bv.x); s += bflo(a.y) * bflo(bv.y) + bfhi(a.y) * bfhi(bv.y);
                                s += bflo(a.z) * bflo(bv.z) + bfhi(a.z) * bfhi(bv.z); s += bflo(a.w) * bflo(bv.w) + bfhi(a.w) * bfhi(bv.w); acc[ai][bj][m][n][j] = s; } }
        }
        E(acc, cur, wr, wc, fr, fq);
    }
    __syncthreads();
}
#endif
}
using pg8::Unit;

#define XB_TMO      128
#define XB_XCNT(j)  (256  + 64 * (j))
#define XB_XSUB(j)  (1280 + 64 * (j))
#define XB_XGEN(j)  (2304 + 64 * (j))
#define XB_TOP      3328
#define XB_TOPGEN   3392
#define XCD_BAR_WORDS 3456
#define XB_SPIN_CAP (1u << 22)
__device__ __forceinline__ unsigned xb_ld(unsigned* p)              { return __hip_atomic_load(p, __ATOMIC_RELAXED, __HIP_MEMORY_SCOPE_AGENT); }
__device__ __forceinline__ unsigned xb_add(unsigned* p, unsigned v) { return __hip_atomic_fetch_add(p, v, __ATOMIC_RELAXED, __HIP_MEMORY_SCOPE_AGENT); }
__device__ __forceinline__ unsigned xb_xcc_id() { return (unsigned)__builtin_amdgcn_s_getreg((3 << 11) | 20) & 0xFu; }
#define XB_SPIN(cond, bar) do { unsigned _sp = 0; while (cond) { __builtin_amdgcn_s_sleep(1); \
    if ((++_sp & 255u) == 0u) { if (xb_ld(&(bar)[XB_TMO])) break; if (_sp > XB_SPIN_CAP) { atomicAdd(&(bar)[XB_TMO], 1u); break; } } } } while (0)
struct XcdBarrier { unsigned* bar; unsigned x; volatile LAS unsigned* st; };
__device__ __forceinline__ XcdBarrier xcd_barrier_post(unsigned* bar, volatile LAS unsigned* st) {
    XcdBarrier b; b.bar = bar; b.x = xb_xcc_id(); b.st = st;
    if (threadIdx.x == 0) (void)xb_add(&bar[XB_XCNT(b.x)], 1u);
    return b;
}
__device__ __forceinline__ void xcd_barrier_complete(unsigned* bar, unsigned x, unsigned& nloc, unsigned& nx) {
    const unsigned G = gridDim.x * gridDim.y * gridDim.z;
    unsigned sum, cnt, mine, sp = 0u;
    for (;;) {
        sum = 0u; cnt = 0u; mine = 0u;
#pragma unroll
        for (unsigned j = 0; j < 16; ++j) { const unsigned c = xb_ld(&bar[XB_XCNT(j)]); sum += c; cnt += (c > 0u) ? 1u : 0u; mine = (j == x) ? c : mine; }
        if (sum == G) break;
        __builtin_amdgcn_s_sleep(1);
        if ((++sp & 255u) == 0u) { if (xb_ld(&bar[XB_TMO])) break; if (sp > XB_SPIN_CAP) { atomicAdd(&bar[XB_TMO], 1u); break; } }
    }
    nloc = mine > 0u ? mine : 1u; nx = cnt > 0u ? cnt : 1u;
}
__device__ __forceinline__ void xcd_barrier(const XcdBarrier& b) {
    asm volatile("s_waitcnt vmcnt(0)" ::: "memory");
    __syncthreads();
    if (threadIdx.x == 0) {
        unsigned* bar = b.bar;
        __builtin_amdgcn_s_waitcnt(0);
        unsigned nloc = b.st[0], nx = b.st[1];
        if (nloc == 0u) { xcd_barrier_complete(bar, b.x, nloc, nx); b.st[0] = nloc; b.st[1] = nx; }
        const unsigned old = xb_add(&bar[XB_XSUB(b.x)], 1u);
        const unsigned gen = old / nloc;
        if (old + 1u == (gen + 1u) * nloc) {
            __builtin_amdgcn_fence(__ATOMIC_RELEASE, "agent");
            asm volatile("s_waitcnt vmcnt(0)" ::: "memory");
            const unsigned og = xb_add(&bar[XB_TOP], 1u);
            const unsigned tg = og / nx;
            if (og + 1u == (tg + 1u) * nx) xb_add(&bar[XB_TOPGEN], 1u);
            else XB_SPIN(xb_ld(&bar[XB_TOPGEN]) == tg, bar);
            __builtin_amdgcn_fence(__ATOMIC_ACQUIRE, "agent");
            xb_add(&bar[XB_XGEN(b.x)], 1u);
            asm volatile("s_waitcnt vmcnt(0)" ::: "memory");
        } else {
            XB_SPIN(xb_ld(&bar[XB_XGEN(b.x)]) == gen, bar);
            __builtin_amdgcn_fence(__ATOMIC_ACQUIRE, "agent");
            asm volatile("s_waitcnt vmcnt(0)" ::: "memory");
        }
    }
    __syncthreads();
}

struct Args { const float* in[31]; float* out; unsigned char* ws; unsigned mask; int variant, bar_region, pad; };
enum { I_X = 0, I_NMW, I_WIN, I_CONVW, I_CONVB, I_DTB, I_ALOG, I_DSSD, I_NSW, I_WAUP, I_LRE, I_LIM, I_LOGDT, I_BRE, I_BIM, I_CRE, I_CIM, I_S5D,
       I_WGLU, I_WBUP, I_GATEB, I_WOUT, I_NFW, I_WRG, I_BRG, I_WRE, I_BRE2, I_WEG, I_WEU, I_WED, I_NFINAL };
struct Ctx { LAS unsigned char* lds; volatile LAS unsigned* ctl; int tid, lane, wave, vcu, G; };
constexpr int PTAB_OFF = LDSCTL_OFF + 1024;
__device__ __forceinline__ unsigned long long ptab_get(LAS unsigned char* lds, int i) {
    const LAS unsigned* p = (const LAS unsigned*)(lds + PTAB_OFF + 8 * i); const unsigned lo = __builtin_amdgcn_readfirstlane(p[0]), hi = __builtin_amdgcn_readfirstlane(p[1]); return ((unsigned long long)hi << 32) | lo; }
#define PIN(i) ((const float*)ptab_get(F.lds, (i)))
#define POUT ((float*)ptab_get(F.lds, 31))
#define PWS ((unsigned char*)ptab_get(F.lds, 32))

struct TJob { const float* src; unsigned char* dst; int N, K; float scale; int fp8; };
__device__ __forceinline__ void tj_load(const TJob& j, int lane, f32x4 (&v)[8]) {
    const float* p = j.src + (size_t)(lane >> 3) * j.N + (lane & 7) * 4;
#pragma unroll
    for (int i = 0; i < 8; ++i) v[i] = __builtin_nontemporal_load((const f32x4*)(p + (size_t)(8 * i) * j.N));
}
__device__ __forceinline__ void tj_store(const TJob& j, int lane, const f32x4 (&v)[8], LAS float* scr) {
    LAS float* w = scr + (lane >> 3) * 33 + (lane & 7) * 4;
#pragma unroll
    for (int i = 0; i < 8; ++i) { w[i * 264 + 0] = v[i][0]; w[i * 264 + 1] = v[i][1]; w[i * 264 + 2] = v[i][2]; w[i * 264 + 3] = v[i][3]; }
    LDS_WAIT(); asm volatile("" ::: "memory");
    const int c = lane & 7;
#pragma unroll
    for (int jj = 0; jj < 4; ++jj) { const int n = (lane >> 3) + 8 * jj; const LAS float* s = scr + (8 * c) * 33 + n;
        if (j.fp8) { const float q = j.scale; v2u o; o.x = pk4_fp8(s[0 * 33] * q, s[1 * 33] * q, s[2 * 33] * q, s[3 * 33] * q); o.y = pk4_fp8(s[4 * 33] * q, s[5 * 33] * q, s[6 * 33] * q, s[7 * 33] * q);
            *(v2u*)(j.dst + (size_t)n * j.K + 8 * c) = o; }
        else { v4u o; o.x = pk2(s[0 * 33], s[1 * 33]); o.y = pk2(s[2 * 33], s[3 * 33]); o.z = pk2(s[4 * 33], s[5 * 33]); o.w = pk2(s[6 * 33], s[7 * 33]);
            *(v4u*)(j.dst + ((size_t)n * j.K + 8 * c) * 2) = o; } }
    LDS_WAIT(); asm volatile("" ::: "memory");
}
template <class Dec>
__device__ __forceinline__ void transpose_jobs(int first, int stride, int nitems, const Dec dec, LAS float* scr, int lane) {
    int it = first; if (it >= nitems) return;
    TJob cur; f32x4 v[8]; dec(it, cur); tj_load(cur, lane, v);
    for (;;) { const int nx = it + stride; const bool hn = nx < nitems; TJob nj = cur; f32x4 nv[8];
        if (hn) { dec(nx, nj); tj_load(nj, lane, nv); }
        tj_store(cur, lane, v, scr);
        if (!hn) break;
        cur = nj; it = nx;
#pragma unroll
        for (int i = 0; i < 8; ++i) v[i] = nv[i]; }
}
struct DecP0 {
    static constexpr int I_IN = 32 * (IN_DIM / 32), I_A = 32 * 64, I_G = 16 * 32, I_B = 16 * 64, I_O = 32 * 64, NITEMS = I_IN + I_A + I_G + I_B + I_O;
    const float *win, *wa, *wg, *wb, *wo; unsigned char* ws;
    __device__ __forceinline__ void operator()(int r, TJob& j) const {
        if (r < I_IN) { const int nb = r % (IN_DIM / 32), kb = r / (IN_DIM / 32); const int dr = 32 * nb; int sc; if (dr < 6144) sc = dr; else if (dr < 7168) sc = dr + 32; else if (dr < 11264) { const int rel = dr - 7168, within = rel & 255; sc = 7200 + (within >> 7) * 2048 + (rel >> 8) * 128 + (within & 127); } else sc = dr - 11264 + 6144;
            j.src = win + (size_t)(64 * kb) * IN_DIM + sc; if (dr >= 7168 && dr < 11264) { j.dst = ws + WS_WIN + (size_t)7168 * D * 2 + (size_t)(dr - 7168) * D + 64 * kb; j.scale = 32.f; j.fp8 = 1; } else { j.dst = ws + WS_WIN + ((size_t)dr * D + 64 * kb) * 2; j.scale = 1.f; j.fp8 = 0; } j.N = IN_DIM; j.K = D; return; } r -= I_IN;
        if (r < I_A) { j.src = wa + (size_t)(64 * (r / 64)) * D + 32 * (r % 64); j.dst = ws + WS_WAB + ((size_t)(32 * (r % 64)) * YVP + 64 * (r / 64)) * 2; j.scale = 1.f; j.fp8 = 0; j.N = D; j.K = YVP; return; } r -= I_A;
        if (r < I_G) { j.src = wg + (size_t)(64 * (r / 32)) * S5W + 32 * (r % 32); j.dst = ws + WS_WGLU + ((size_t)(32 * (r % 32)) * S5W + 64 * (r / 32)) * 2; j.scale = 1.f; j.fp8 = 0; j.N = S5W; j.K = S5W; return; } r -= I_G;
        if (r < I_B) { j.src = wb + (size_t)(64 * (r / 64)) * D + 32 * (r % 64); j.dst = ws + WS_WAB + ((size_t)(32 * (r % 64)) * YVP + 2048 + 64 * (r / 64)) * 2; j.scale = 1.f; j.fp8 = 0; j.N = D; j.K = YVP; return; } r -= I_B;
        j.src = wo + (size_t)(64 * (r / 64)) * D + 32 * (r % 64); j.dst = ws + WS_WOUT + ((size_t)(32 * (r % 64)) * D + 64 * (r / 64)) * 2; j.scale = 1.f; j.fp8 = 0; j.N = D; j.K = D; }
};
constexpr float WGU_SCALE = 64.f, WD_SCALE = 32.f, HID_SCALE = 4.f;
struct DecExp {
    static constexpr int I_GU = NE * 32 * 16, NITEMS = 3 * I_GU;
    const float *wg, *wu, *wd; unsigned char* ws;
    __device__ __forceinline__ void operator()(int it, TJob& j) const {
        if (it < 2 * I_GU) { const int which = it / I_GU, r = it % I_GU, e = r / 512, q = r % 512, kb = q / 16, nb = q % 16; const int j0 = 32 * nb;
            const int drow = (j0 >> 7) * 256 + which * 128 + (j0 & 127);
            j.src = (which ? wu : wg) + (size_t)e * D * FF + (size_t)(64 * kb) * FF + j0; j.dst = ws + WS_ST + ((size_t)e * 1024 + drow) * D + 64 * kb; j.N = FF; j.K = D; j.scale = WGU_SCALE; j.fp8 = 1; }
        else { const int r = it - 2 * I_GU, e = r / 512, q = r % 512, kb = q / 64, nb = q % 64;
            j.src = wd + (size_t)e * FF * D + (size_t)(64 * kb) * D + 32 * nb; j.dst = ws + WS_YV + ((size_t)e * D + 32 * nb) * FF + 64 * kb; j.N = D; j.K = FF; j.scale = WD_SCALE; j.fp8 = 1; }
    }
};
__device__ __forceinline__ void rms_row_to_bf16(const float* xrow, const float* w, bf16* orow, unsigned char* orow8, int lane) {
    const f32x4* xr = (const f32x4*)xrow + lane; const f32x4* wr4 = (const f32x4*)w + lane;
    f32x4 v[8]; float s = 0.f;
#pragma unroll
    for (int j = 0; j < 8; ++j) { v[j] = xr[64 * j]; s += (v[j].x * v[j].x + v[j].y * v[j].y) + (v[j].z * v[j].z + v[j].w * v[j].w); }
    const float rstd = 1.0f / sqrtf(wave_sum(s) * (1.f / D) + EPS);
    v2u* o8 = (v2u*)orow + lane; unsigned* q8 = (unsigned*)orow8 + lane;
#pragma unroll
    for (int j = 0; j < 8; ++j) { const f32x4 g = wr4[64 * j]; const f32x4 hv = {v[j].x * rstd * g.x, v[j].y * rstd * g.y, v[j].z * rstd * g.z, v[j].w * rstd * g.w};
        v2u o; o.x = pk2(hv.x, hv.y); o.y = pk2(hv.z, hv.w); o8[64 * j] = o; q8[64 * j] = pk4_fp8(hv.x, hv.y, hv.z, hv.w); }
}

__device__ __forceinline__ void s5_mats_group(const Args& a, const Ctx& F, int g) {
    LAS float* L = (LAS float*)F.lds;
    LAS float* apr = L; LAS float* api = L + 17 * 64; LAS float* bbr = L + 2 * 17 * 64; LAS float* bbi = bbr + 1024; LAS float* cr = bbi + 1024; LAS float* ci = cr + 1024; LAS float* kt = ci + 1024;
    LAS float* cof = kt + 4096;
    const float dt = expf(PIN(I_LOGDT)[g]);
    if (F.tid < 64) { const int n = F.tid; const float lr = PIN(I_LRE)[g * 64 + n], li = PIN(I_LIM)[g * 64 + n];
        for (int m = 0; m <= 16; ++m) { const float mag = expf((float)m * lr * dt), ang = (float)m * li * dt; apr[m * 64 + n] = mag * cosf(ang); api[m * 64 + n] = mag * sinf(ang); }
        const float ar = expf(lr * dt) * cosf(li * dt), ai = expf(lr * dt) * sinf(li * dt);
        const float den = lr * lr + li * li, nr = ar - 1.0f, ni = ai;
        cof[n] = (nr * lr + ni * li) / den; cof[64 + n] = (ni * lr - nr * li) / den; }
    for (int i = F.tid; i < 1024; i += 512) { const int co = i >> 6, n = i & 63; cr[i] = PIN(I_CRE)[(size_t)g * 1024 + co * 64 + n]; ci[i] = PIN(I_CIM)[(size_t)g * 1024 + co * 64 + n]; }
    __syncthreads();
    for (int i = F.tid; i < 1024; i += 512) { const int n = i >> 4; const float br = PIN(I_BRE)[(size_t)g * 1024 + i], bi = PIN(I_BIM)[(size_t)g * 1024 + i]; const float c0 = cof[n], c1 = cof[64 + n];
        bbr[i] = c0 * br - c1 * bi; bbi[i] = c0 * bi + c1 * br; }
    __syncthreads();
    for (int i = F.tid; i < 4096; i += 512) { const int lag = i >> 8, co = (i >> 4) & 15, cin = i & 15; float s = 0.f;
        for (int n = 0; n < 64; ++n) { const float wr_ = apr[lag * 64 + n] * bbr[n * 16 + cin] - api[lag * 64 + n] * bbi[n * 16 + cin], wi_ = apr[lag * 64 + n] * bbi[n * 16 + cin] + api[lag * 64 + n] * bbr[n * 16 + cin];
            s += cr[co * 64 + n] * wr_ - ci[co * 64 + n] * wi_; }
        kt[i] = s; }
    __syncthreads();
    bf16* TW = (bf16*)(PWS + WS_S5TW) + (size_t)g * 256 * APK;
    for (int i = F.tid; i < 256 * APK / 2; i += 512) { const int row = (2 * i) / APK, k0 = (2 * i) % APK; const int l = row >> 4, co = row & 15; float v[2];
#pragma unroll
        for (int q = 0; q < 2; ++q) { const int k = k0 + q; float val;
            if (k < 256) { const int j = k >> 4, cin = k & 15; val = (l >= j) ? kt[(l - j) * 256 + co * 16 + cin] : 0.f; if (l == j && cin == co) val += PIN(I_S5D)[g * 16 + co]; }
            else if (k < 320) { const int n = k - 256; val = cr[co * 64 + n] * apr[(l + 1) * 64 + n] - ci[co * 64 + n] * api[(l + 1) * 64 + n]; }
            else { const int n = k - 320; val = -(cr[co * 64 + n] * api[(l + 1) * 64 + n] + ci[co * 64 + n] * apr[(l + 1) * 64 + n]); }
            v[q] = val; }
        *(unsigned*)(TW + 2 * i) = pk2(v[0], v[1]); }
    bf16* WS = (bf16*)(PWS + WS_S5WS) + (size_t)g * 256 * 256;
    for (int i = F.tid; i < 256 * 256 / 2; i += 512) { const int row = (2 * i) >> 8, k0 = (2 * i) & 255; float v[2];
#pragma unroll
        for (int q = 0; q < 2; ++q) { const int k = k0 + q, j = k >> 4, cin = k & 15; float val = 0.f;
            if (row < 64) { const int n = row; val = apr[(15 - j) * 64 + n] * bbr[n * 16 + cin] - api[(15 - j) * 64 + n] * bbi[n * 16 + cin]; }
            else if (row < 128) { const int n = row - 64; val = apr[(15 - j) * 64 + n] * bbi[n * 16 + cin] + api[(15 - j) * 64 + n] * bbr[n * 16 + cin]; }
            v[q] = val; }
        *(unsigned*)(WS + 2 * i) = pk2(v[0], v[1]); }
    __syncthreads();
}

__device__ __forceinline__ void p0_prologue(const Args& a, const Ctx& F) {
    if (F.vcu < S5G) s5_mats_group(a, F, F.vcu);
    LAS float* scr = (LAS float*)(F.lds + F.wave * 16384);
    const int gw = F.vcu * NWAVES + F.wave, NGW = F.G * NWAVES;
    { DecP0 dec{PIN(I_WIN), PIN(I_WAUP), PIN(I_WGLU), PIN(I_WBUP), PIN(I_WOUT), PWS};
      transpose_jobs<DecP0>(gw, NGW, DecP0::NITEMS, dec, scr, F.lane); }
    {
        unsigned* gctr = (unsigned*)(PWS + WS_CTL) + CW_CNT + a.bar_region * 4096 + 2624; const float* X = PIN(I_X); const float* nmw = PIN(I_NMW); unsigned char* wsb = PWS;
        unsigned bv = 0u; if (F.lane == 0) bv = __hip_atomic_fetch_add(gctr, 1u, __ATOMIC_RELAXED, __HIP_MEMORY_SCOPE_AGENT);
        int b = (int)__builtin_amdgcn_readfirstlane(bv);
        while (b < T / 8) { unsigned nv = 0u; if (F.lane == 0) nv = __hip_atomic_fetch_add(gctr, 1u, __ATOMIC_RELAXED, __HIP_MEMORY_SCOPE_AGENT);
            for (int m = 8 * b; m < 8 * b + 8; ++m) rms_row_to_bf16(X + (size_t)m * D, nmw, (bf16*)(wsb + WS_H) + (size_t)m * D, wsb + WS_H8 + (size_t)m * D, F.lane);
            b = (int)__builtin_amdgcn_readfirstlane(nv); } }
    for (int i = gw * 64 + F.lane; i < 48 * D; i += NGW * 64) { const int col = i / D, k = i % D; float w = 0.f;
        if (col < 4) w = PIN(I_WRG)[k * 4 + col]; else if (col >= 16) w = PIN(I_WRE)[k * 32 + (col - 16)];
        const unsigned hi = f2bf(w); const float lo = w - bf2f((bf16)hi);
        ((bf16*)(PWS + WS_RT))[i] = (bf16)hi; ((bf16*)(PWS + WS_RT))[48 * D + i] = (bf16)f2bf(lo); }
}

struct SchedDense {
    pg8::StaticOrder so; const char* A; const char* B; unsigned lda, ldb;
    __device__ __forceinline__ bool next(int i, Unit& u) const { int pm, pn; if (!so.next(i, pm, pn)) return false;
        u.A = A + (size_t)pm * 256 * lda; u.B = B + (size_t)pn * 256 * ldb; u.row0 = pm * 256; u.col0 = pn * 256; u.e = 0; u.nvalid = 256; return true; }
    __device__ __forceinline__ unsigned row_idx(const Unit&, int) const { return 0u; }
};
struct SchedS5 {
    const char* A; const char* B; unsigned ldb; int G, c;
    __device__ __forceinline__ bool next(int i, Unit& u) const { const int idx = i * G + c; if (idx >= 256) return false; const int g = idx >> 2, mt = idx & 3;
        u.A = A + (size_t)(g * 1024 + mt * 256) * (APK * 2); u.B = B + (size_t)g * 256 * ldb; u.row0 = g * 1024 + mt * 256; u.col0 = 0; u.e = g; u.nvalid = 256; return true; }
    __device__ __forceinline__ unsigned row_idx(const Unit&, int) const { return 0u; }
};
struct SchedMoE {
    volatile LAS unsigned* ctl; const char* A; const char* B; const unsigned* list_tok; unsigned lda; size_t bstride_e; unsigned ldb; int NN, G, c; bool gather;
    __device__ __forceinline__ bool next(int i, Unit& u) const { const int idx = i * G + c; const int NT = (int)ctl[72]; if (idx >= NT * NN) return false;
        const int mtg = idx / NN, pn = idx % NN; const int e = (int)ctl[80 + mtg]; const int rb = (int)ctl[40 + e]; const int mtl = mtg - (rb >> 8); const int cnt = (int)ctl[8 + e];
        u.e = e; u.nvalid = cnt - mtl * 256; u.slot0 = mtl * 256; u.B = B + (size_t)e * bstride_e + (size_t)pn * 256 * ldb;
        if (gather) { u.A = A; u.row0 = rb + mtl * 256; u.col0 = pn * 128; }
        else { u.A = A + (size_t)(rb + mtl * 256) * lda; u.row0 = rb + mtl * 256; u.col0 = pn * 256; }
        return true; }
    __device__ __forceinline__ unsigned row_idx(const Unit& u, int r) const {
        const unsigned tokk = (r < u.nvalid) ? list_tok[(size_t)u.e * CAPL + u.slot0 + r] : 0u; return tokk >> 1; }
};

#define EPI_BEGIN _Pragma("unroll") for (int ai = 0; ai < 2; ++ai) _Pragma("unroll") for (int m = 0; m < 4; ++m) { const int r = ai * 128 + wr * 64 + m * 16 + fr; \
    _Pragma("unroll") for (int bj = 0; bj < 2; ++bj) { const int c = bj * 128 + wc * 32 + 8 * fq; const f32x4 v0 = acc[ai][bj][m][0], v1 = acc[ai][bj][m][1];
#define EPI_END } }
__device__ __forceinline__ v4u pack8(const f32x4 a, const f32x4 b) { v4u w; w.x = pk2(a[0], a[1]); w.y = pk2(a[2], a[3]); w.z = pk2(b[0], b[1]); w.w = pk2(b[2], b[3]); return w; }
__device__ __forceinline__ void unpack8(const v4u w, float (&f)[8]) { f[0] = bflo(w.x); f[1] = bfhi(w.x); f[2] = bflo(w.y); f[3] = bfhi(w.y); f[4] = bflo(w.z); f[5] = bfhi(w.z); f[6] = bflo(w.w); f[7] = bfhi(w.w); }

struct Epi1a {
    bf16* ZS; bf16* XBC; bf16* AP;
    __device__ __forceinline__ void operator()(const f32x4 (&acc)[2][2][4][2], const Unit& u, int wr, int wc, int fr, int fq) const {
        EPI_BEGIN  const int row = u.row0 + r, col = u.col0 + c;
            if (col < 2048) { f32x4 a = v0, b = v1;
#pragma unroll
                for (int j = 0; j < 4; ++j) { a[j] = siluf_(a[j]); b[j] = siluf_(b[j]); }
                *(v4u*)(ZS + (size_t)row * YVP + col) = pack8(a, b); }
            else if (col < 6144) { *(v4u*)(XBC + (size_t)row * XBCD + (col - 2048)) = pack8(v0, v1); }
            else { const int cc = col - 6144, g = cc >> 4, ci0 = cc & 15; *(v4u*)(AP + ((size_t)(g * S5NC + (row >> 4)) * APK + (row & 15) * 16 + ci0)) = pack8(v0, v1); }  EPI_END
    }
};
struct EpiS5a {
    float* SL;
    __device__ __forceinline__ void operator()(const f32x4 (&acc)[2][2][4][2], const Unit& u, int wr, int wc, int fr, int fq) const {
        EPI_BEGIN  if (bj == 0) { float* p = SL + (size_t)(u.row0 + r) * 128 + c; *(f32x4*)p = v0; *(f32x4*)(p + 4) = v1; }  EPI_END
    }
};
struct EpiS5b {
    bf16* V;
    __device__ __forceinline__ void operator()(const f32x4 (&acc)[2][2][4][2], const Unit& u, int wr, int wc, int fr, int fq) const {
        EPI_BEGIN  const int chunk = (u.row0 + r) & 1023, g = u.e, l = c >> 4, co0 = c & 15; f32x4 a = v0, b = v1;
#pragma unroll
            for (int j = 0; j < 4; ++j) { a[j] = gelu_tanh(a[j]); b[j] = gelu_tanh(b[j]); }
            *(v4u*)(V + (size_t)(chunk * 16 + l) * S5W + g * 16 + co0) = pack8(a, b);  EPI_END
    }
};
struct Epi1b {
    bf16* Gt; const float* gb; const float* ssq;
    __device__ __forceinline__ void operator()(const f32x4 (&acc)[2][2][4][2], const Unit& u, int wr, int wc, int fr, int fq) const {
        const int j0 = (u.col0 >> 1) + wc * 32 + 8 * fq;
        const f32x4 ba0 = *(const f32x4*)(gb + j0), ba1 = *(const f32x4*)(gb + j0 + 4), bb0 = *(const f32x4*)(gb + 2048 + j0), bb1 = *(const f32x4*)(gb + 2048 + j0 + 4);
#pragma unroll
        for (int ai = 0; ai < 2; ++ai)
#pragma unroll
            for (int m = 0; m < 4; ++m) { const int row = u.row0 + ai * 128 + wr * 64 + m * 16 + fr; const f32x4 s0 = *(const f32x4*)(ssq + (size_t)row * 8), s1 = *(const f32x4*)(ssq + (size_t)row * 8 + 4);
                const float tot = ((s0[0] + s0[1]) + (s0[2] + s0[3])) + ((s1[0] + s1[1]) + (s1[2] + s1[3])); const float rstd = 1.0f / sqrtf(tot * (1.f / D) + EPS);
                f32x4 r0, r1, g0, g1;
#pragma unroll
                for (int j = 0; j < 4; ++j) { const float a0 = sigmoidf_(acc[ai][0][m][0][j] + ba0[j]), a1 = sigmoidf_(acc[ai][0][m][1][j] + ba1[j]);
                    g0[j] = fmaxf(sigmoidf_(acc[ai][1][m][0][j] + bb0[j]), 1e-20f); g1[j] = fmaxf(sigmoidf_(acc[ai][1][m][1][j] + bb1[j]), 1e-20f);
                    r0[j] = a0 * rstd * __builtin_amdgcn_rcpf(g0[j]); r1[j] = a1 * rstd * __builtin_amdgcn_rcpf(g1[j]); }
                *(v4u*)(Gt + (size_t)row * 4096 + j0) = pack8(r0, r1); *(v4u*)(Gt + (size_t)row * 4096 + 2048 + j0) = pack8(g0, g1); }
    }
};
struct EpiGlu {
    const bf16* V; bf16* YV;
    __device__ __forceinline__ void operator()(const f32x4 (&acc)[2][2][4][2], const Unit& u, int wr, int wc, int fr, int fq) const {
        EPI_BEGIN const size_t o = (size_t)(u.row0 + r) * S5W + u.col0 + c; float vv[8]; unpack8(*(const v4u*)(V + o), vv); f32x4 a, b;
#pragma unroll
            for (int j = 0; j < 4; ++j) { a[j] = vv[j] * sigmoidf_(v0[j]); b[j] = vv[4 + j] * sigmoidf_(v1[j]); }
            *(v4u*)(YV + (size_t)(u.row0 + r) * YVP + 2048 + u.col0 + c) = pack8(a, b); EPI_END
    }
};
struct EpiAB {
    const bf16* Gt; bf16* MG;
    __device__ __forceinline__ void mid(f32x4 (&acc)[2][2][4][2], const Unit& u, int wr, int wc, int fr, int fq) const {
        unsigned base = (unsigned)((u.row0 + wr * 64 + fr) * 4096 + u.col0 + wc * 32 + 8 * fq) * 2u;
        asm volatile("" : "+v"(base));
        const char* gp = (const char*)Gt;
#pragma unroll
        for (int ai = 0; ai < 2; ++ai)
#pragma unroll
            for (int m = 0; m < 4; ++m)
#pragma unroll
                for (int bj = 0; bj < 2; ++bj) { float rr[8]; unpack8(*(const v4u*)(gp + (size_t)(base + (unsigned)((ai * 128 + m * 16) * 4096 + bj * 128) * 2u)), rr);
#pragma unroll
                    for (int j = 0; j < 4; ++j) { acc[ai][bj][m][0][j] *= rr[j]; acc[ai][bj][m][1][j] *= rr[4 + j]; } }
    }
    __device__ __forceinline__ void operator()(const f32x4 (&acc)[2][2][4][2], const Unit& u, int wr, int wc, int fr, int fq) const {
        EPI_BEGIN const int row = u.row0 + r, col = u.col0 + c; float gg[8]; unpack8(*(const v4u*)(Gt + (size_t)row * 4096 + 2048 + col), gg); f32x4 a, b;
#pragma unroll
            for (int j = 0; j < 4; ++j) { a[j] = gg[j] * v0[j]; b[j] = gg[4 + j] * v1[j]; }
            *(v4u*)(MG + (size_t)row * D + col) = pack8(a, b); EPI_END
    }
};
struct EpiOut {
    bf16* XD; const float* X;
    __device__ __forceinline__ void operator()(const f32x4 (&acc)[2][2][4][2], const Unit& u, int wr, int wc, int fr, int fq) const {
        EPI_BEGIN *(v4u*)(XD + (size_t)(u.row0 + r) * D + u.col0 + c) = pack8(v0, v1); EPI_END
    }
};
struct EpiGU {
    bf16* HID; const unsigned* list_tok; const float* rstd2;
    __device__ __forceinline__ void operator()(const f32x4 (&acc)[2][2][4][2], const Unit& u, int wr, int wc, int fr, int fq) const {
#pragma unroll
        for (int ai = 0; ai < 2; ++ai)
#pragma unroll
            for (int m = 0; m < 4; ++m) { const int r = ai * 128 + wr * 64 + m * 16 + fr; if (r < u.nvalid) { const float sc = rstd2[(size_t)u.e * CAPL + u.slot0 + r]; f32x4 a, b;
#pragma unroll
                for (int j = 0; j < 4; ++j) { a[j] = siluf_(sc * acc[ai][0][m][0][j]) * (sc * acc[ai][1][m][0][j]); b[j] = siluf_(sc * acc[ai][0][m][1][j]) * (sc * acc[ai][1][m][1][j]); }
                { v2u o8; o8.x = pk4_fp8(a[0] * HID_SCALE, a[1] * HID_SCALE, a[2] * HID_SCALE, a[3] * HID_SCALE); o8.y = pk4_fp8(b[0] * HID_SCALE, b[1] * HID_SCALE, b[2] * HID_SCALE, b[3] * HID_SCALE);
                  *(v2u*)((unsigned char*)HID + (size_t)(u.row0 + r) * FF + u.col0 + wc * 32 + 8 * fq) = o8; } } }
    }
};
constexpr float Y_SCALE = 16.f;
struct EpiDn {
    const float* list_w; unsigned char* Y;
    __device__ __forceinline__ void operator()(const f32x4 (&acc)[2][2][4][2], const Unit& u, int wr, int wc, int fr, int fq) const {
        const float* wp = list_w + (unsigned)(u.e * CAPL + u.slot0 + wr * 64 + fr);
#pragma unroll
        for (int ai = 0; ai < 2; ++ai)
#pragma unroll
            for (int m = 0; m < 4; ++m) { const int r = ai * 128 + wr * 64 + m * 16 + fr; const float w = wp[ai * 128 + m * 16] * Y_SCALE;
#pragma unroll
                for (int bj = 0; bj < 2; ++bj) { const int col = u.col0 + bj * 128 + wc * 32 + 8 * fq; const f32x4 a = acc[ai][bj][m][0] * w, b = acc[ai][bj][m][1] * w;
                    v2u o; o.x = pk4_fp8(a[0], a[1], a[2], a[3]); o.y = pk4_fp8(b[0], b[1], b[2], b[3]); if (r < u.nvalid) *(v2u*)(Y + (size_t)(u.row0 + r) * D + col) = o; } }
    }
};

__device__ __forceinline__ void dt_gemm(const Args& a, const Ctx& F) {
    const bf16* Hb = (const bf16*)(PWS + WS_H); const bf16* Wd = (const bf16*)(PWS + WS_WIN) + (size_t)11264 * D; float* DT = (float*)(PWS + WS_DT);
    LAS float* part = (LAS float*)F.lds;
    const int r = F.lane & 31, hh = F.lane >> 5;
    for (int unit = F.vcu; unit < T / 64; unit += F.G) {
        const int r0 = unit * 64; f32x16 acc0, acc1;
#pragma unroll
        for (int j = 0; j < 16; ++j) { acc0[j] = 0.f; acc1[j] = 0.f; }
#pragma unroll 4
        for (int ks = 0; ks < 16; ++ks) { const int k = F.wave * 256 + ks * 16 + hh * 8;
            const bf16x8 a0 = *(const bf16x8*)(Hb + (size_t)(r0 + r) * D + k), a1 = *(const bf16x8*)(Hb + (size_t)(r0 + 32 + r) * D + k), b = *(const bf16x8*)(Wd + (size_t)r * D + k);
            acc0 = __builtin_amdgcn_mfma_f32_32x32x16_bf16(a0, b, acc0, 0, 0, 0); acc1 = __builtin_amdgcn_mfma_f32_32x32x16_bf16(a1, b, acc1, 0, 0, 0); }
#pragma unroll
        for (int j = 0; j < 16; ++j) { part[((F.wave * 2 + 0) * 16 + j) * 64 + F.lane] = acc0[j]; part[((F.wave * 2 + 1) * 16 + j) * 64 + F.lane] = acc1[j]; }
        __syncthreads();
        for (int o = F.tid; o < 2048; o += 512) { const int row = o >> 5, col = o & 31; const int i = row >> 5, rr = row & 31, h2 = (rr >> 2) & 1, reg = (rr & 3) + 4 * (rr >> 3), ln = col + 32 * h2; float s = 0.f;
#pragma unroll
            for (int w = 0; w < 8; ++w) s += part[((w * 2 + i) * 16 + reg) * 64 + ln];
            s += PIN(I_DTB)[col]; DT[(size_t)(r0 + row) * 32 + col] = s > 20.f ? s : log1pf(expf(s)); }
        __syncthreads();
    }
}

constexpr int SEGC = 8, NSEG = NCHK / SEGC;
constexpr int SQ_XT = 0;
constexpr int SQ_BC = 36864;
constexpr int SQ_BT = SQ_BC + 17408;
constexpr int SQ_CC = SQ_BT + 18432;
constexpr int SQ_DT = SQ_CC + 17408;
constexpr int SQ_Y = SQ_DT + 4352;
constexpr int SQ_W = SQ_Y + 33792;
static_assert(SQ_W + 10240 <= LDSCTL_OFF, "SSD (sequential) LDS map");

template <int NTOK>
__device__ __forceinline__ void conv_pair(const LAS float* wl, int lc, const v4u (&rawv)[NTOK + 3], int d, float (&o)[NTOK][2]) {
    f32x2 w[4]; const f32x2 bias = *(const LAS f32x2*)(wl + 4 * 512 + lc);
#pragma unroll
    for (int k = 0; k < 4; ++k) w[k] = *(const LAS f32x2*)(wl + k * 512 + lc);
#pragma unroll
    for (int tt = 0; tt < NTOK; ++tt) { float s0 = bias[0], s1 = bias[1];
#pragma unroll
        for (int k = 0; k < 4; ++k) { const unsigned uu = rawv[tt + k][d]; s0 += w[k][0] * bflo(uu); s1 += w[k][1] * bfhi(uu); }
        o[tt][0] = siluf_(s0); o[tt][1] = siluf_(s1); }
}
template <bool SCALE>
__device__ __forceinline__ void conv_xs_to_lds(const LAS float* wl, int lc, const v4u (&rx)[7], LAS bf16* dst  , const f32x4 sc) {
#pragma unroll
    for (int d = 0; d < 4; ++d) { float o[4][2]; conv_pair<4>(wl, lc + 2 * d, rx, d, o);
        if constexpr (SCALE) {
#pragma unroll
            for (int tt = 0; tt < 4; ++tt) { o[tt][0] *= sc[tt]; o[tt][1] *= sc[tt]; } }
        v2u w0, w1; w0.x = pk2(o[0][0], o[1][0]); w0.y = pk2(o[2][0], o[3][0]); w1.x = pk2(o[0][1], o[1][1]); w1.y = pk2(o[2][1], o[3][1]);
        *(LAS v2u*)(dst + (2 * d) * 72) = w0; *(LAS v2u*)(dst + (2 * d + 1) * 72) = w1; }
}
template <bool NAT, bool TR>
__device__ __forceinline__ void conv_bc_to_lds(const LAS float* wl, int lc, const v4u (&rb)[5], LAS bf16* nat, LAS bf16* tr) {
    v4u n0, n1;
#pragma unroll
    for (int d = 0; d < 4; ++d) { float o[2][2]; conv_pair<2>(wl, lc + 2 * d, rb, d, o);
        if constexpr (NAT) { n0[d] = pk2(o[0][0], o[0][1]); n1[d] = pk2(o[1][0], o[1][1]); }
        if constexpr (TR) { *(LAS unsigned*)(tr + (2 * d) * 72) = pk2(o[0][0], o[1][0]); *(LAS unsigned*)(tr + (2 * d + 1) * 72) = pk2(o[0][1], o[1][1]); } }
    if constexpr (NAT) { *(LAS v4u*)nat = n0; *(LAS v4u*)(nat + 136) = n1; }
}
__device__ __forceinline__ void conv_weights_to_lds(const Args& a, const Ctx& F, int g) {
    LAS float* wl = (LAS float*)(F.lds + SQ_W);
    for (int i = F.tid; i < 5 * 512; i += NWAVES * 64) { const int k = i >> 9, lc = i & 511; const int ch = lc < 256 ? g * 256 + lc : (lc < 384 ? 2048 + g * 128 + (lc - 256) : 3072 + g * 128 + (lc - 384));
        wl[i] = k < 4 ? PIN(I_CONVW)[k * XBCD + ch] : PIN(I_CONVB)[ch]; }
    __syncthreads();
}
template <int NR>
__device__ __forceinline__ void rows_load(const unsigned char* ws, unsigned off, int t0, v4u (&raw)[NR]) {
#pragma unroll
    for (int i = 0; i < NR; ++i) { v4u v = (v4u){0u, 0u, 0u, 0u}; if (t0 + i >= 0) v = *(const v4u*)(ws + (size_t)(off + (unsigned)i * (XBCD * 2))); raw[i] = v; }
}

__device__ __forceinline__ float seq_dt_setup(const Args& a, const Ctx& F, int g, float dtv, int buf) {
    LAS float* dts = (LAS float*)(F.lds + SQ_DT); LAS float* acs = dts + 256; LAS float* wsc = dts + 512; LAS float* eacs = dts + 768; LAS float* cdec = dts + 1024;
    float tot = 0.f;
    if (F.wave < 4) { const int hd = 4 * g + F.wave; const float av = -expf(PIN(I_ALOG)[hd]);
        float s = dtv * av;
#pragma unroll
        for (int o = 1; o < 64; o <<= 1) { const float t = __shfl_up(s, o); if (F.lane >= o) s += t; }
        tot = __shfl(s, 63);
        dts[F.wave * 64 + F.lane] = dtv; acs[F.wave * 64 + F.lane] = s; wsc[F.wave * 64 + F.lane] = dtv * __expf(tot - s); eacs[F.wave * 64 + F.lane] = __expf(s);
        if (F.lane == 63) cdec[buf * 4 + F.wave] = __expf(tot); }
    return tot;
}
__device__ __forceinline__ bf16x8 pack_frag(const f32x16& X, int kk) { v4u w; w.x = pk2(X[8 * kk], X[8 * kk + 1]); w.y = pk2(X[8 * kk + 2], X[8 * kk + 3]); w.z = pk2(X[8 * kk + 4], X[8 * kk + 5]); w.w = pk2(X[8 * kk + 6], X[8 * kk + 7]); return __builtin_bit_cast(bf16x8, w); }
__device__ __forceinline__ void seq_state_update(const Ctx& F, f32x16 (&acc)[4], int hd, int pt, float cd) {
    const LAS bf16* xT = (const LAS bf16*)(F.lds + SQ_XT); const LAS bf16* Bt = (const LAS bf16*)(F.lds + SQ_BT); const LAS float* wsc = (const LAS float*)(F.lds + SQ_DT) + 512;
    const int r = F.lane & 31, hh = F.lane >> 5;
#pragma unroll
    for (int i = 0; i < 4; ++i) acc[i] = acc[i] * cd;
#pragma unroll
    for (int ks = 0; ks < 4; ++ks) { const v4u xw = *(const LAS v4u*)(xT + (hd * 64 + 32 * pt + r) * 72 + 16 * ks + 8 * hh); float xv[8]; unpack8(xw, xv);
        const f32x4 w0 = *(const LAS f32x4*)(wsc + hd * 64 + 16 * ks + 8 * hh), w1 = *(const LAS f32x4*)(wsc + hd * 64 + 16 * ks + 8 * hh + 4);
        v4u sw; sw.x = pk2(xv[0] * w0[0], xv[1] * w0[1]); sw.y = pk2(xv[2] * w0[2], xv[3] * w0[3]); sw.z = pk2(xv[4] * w1[0], xv[5] * w1[1]); sw.w = pk2(xv[6] * w1[2], xv[7] * w1[3]);
        const bf16x8 bfr = __builtin_bit_cast(bf16x8, sw);
#pragma unroll
        for (int i = 0; i < 4; ++i) { const bf16x8 afr = *(const LAS bf16x8*)(Bt + (32 * i + r) * 72 + 16 * ks + 8 * hh); acc[i] = __builtin_amdgcn_mfma_f32_32x32x16_bf16(afr, bfr, acc[i], 0, 0, 0); }
        if (ks & 1) __builtin_amdgcn_sched_barrier(0); }
}
__device__ __forceinline__ size_t seg_state_off(int g, int seg, int hd) { return ((size_t)(g * NSEG + seg) * 4 + hd) * 8192; }

__device__ __forceinline__ void ssd_pass_a(const Args& a, const Ctx& F) {
    LAS bf16* xT = (LAS bf16*)(F.lds + SQ_XT); LAS bf16* Bt = (LAS bf16*)(F.lds + SQ_BT); const LAS float* cdec = (const LAS float*)(F.lds + SQ_DT) + 1024; const LAS float* wl = (const LAS float*)(F.lds + SQ_W);
    for (int u = F.vcu; u < NGRP * NSEG; u += F.G) {
        const int g = u >> 5, seg = u & 31; const int hd = F.wave >> 1, pt = F.wave & 1, r = F.lane & 31, hh = F.lane >> 5;
        const int cgx = F.tid >> 4, l0x = (F.tid & 15) * 4, cgb = F.tid >> 5, l0b = (F.tid & 31) * 2;
        conv_weights_to_lds(a, F, g);
        f32x16 acc[4];
#pragma unroll
        for (int i = 0; i < 4; ++i)
#pragma unroll
            for (int j = 0; j < 16; ++j) acc[i][j] = 0.f;
        float totsum = 0.f;
        const int t0 = seg * SEGC * CHK;
        const unsigned char* wsb = PWS;
        unsigned ox = (unsigned)(WS_XBC + ((size_t)(t0 + l0x) * XBCD + g * 256 + cgx * 8) * 2 - 3 * XBCD * 2);
        unsigned ob = (unsigned)(WS_XBC + ((size_t)(t0 + l0b) * XBCD + 2048 + g * 128 + cgb * 8) * 2 - 3 * XBCD * 2);
        unsigned odt = (unsigned)(WS_DT + ((size_t)(t0 + F.lane) * 32 + 4 * g + (F.wave & 3)) * 4);
        v4u rx[7];
        rows_load<7>(wsb, ox, t0 + l0x - 3, rx);
        float dtv = *(const float*)(wsb + odt);
#pragma unroll 1
        for (int k = 0; k < SEGC; ++k) {
            v4u rb[5];
            rows_load<5>(wsb, ob, t0 + k * CHK + l0b - 3, rb);
            totsum += seq_dt_setup(a, F, g, dtv, k & 1);
            { const int hx = cgx >> 3, p0 = (cgx & 7) * 8;
              conv_xs_to_lds<false>(wl, cgx * 8, rx, xT + (hx * 64 + p0) * 72 + l0x, (f32x4){1.f, 1.f, 1.f, 1.f});
              conv_bc_to_lds<false, true>(wl, 256 + cgb * 8, rb, Bt, Bt + (cgb * 8) * 72 + l0b); }
            ox += CHK * XBCD * 2; ob += CHK * XBCD * 2; odt += CHK * 32 * 4;
            if (k + 1 < SEGC) { rows_load<7>(wsb, ox, 0, rx); dtv = *(const float*)(wsb + odt); }
            __syncthreads();
            seq_state_update(F, acc, hd, pt, cdec[(k & 1) * 4 + hd]);
            __syncthreads();
        }
        bf16* st = (bf16*)(PWS + WS_ST) + seg_state_off(g, seg, hd); const int p = 32 * pt + r;
#pragma unroll
        for (int i = 0; i < 4; ++i)
#pragma unroll
            for (int q = 0; q < 4; ++q) { v2u w; w.x = pk2(acc[i][4 * q], acc[i][4 * q + 1]); w.y = pk2(acc[i][4 * q + 2], acc[i][4 * q + 3]); *(v2u*)(st + ((4 * i + q) * 64 + p) * 8 + 4 * hh) = w; }
        if (F.wave < 4 && F.lane == 63) ((float*)(PWS + WS_MISC + 768 * 1024))[(g * NSEG + seg) * 4 + F.wave] = __expf(totsum);
        __syncthreads();
    }
}

__device__ __forceinline__ void ssd_pass_b(const Args& a, const Ctx& F) {
    LAS bf16* xT = (LAS bf16*)(F.lds + SQ_XT); LAS bf16* Bc = (LAS bf16*)(F.lds + SQ_BC); LAS bf16* Bt = (LAS bf16*)(F.lds + SQ_BT); LAS bf16* Cc = (LAS bf16*)(F.lds + SQ_CC);
    LAS float* dts = (LAS float*)(F.lds + SQ_DT); LAS float* acs = dts + 256; LAS float* eacs = dts + 768; const LAS float* cdec = dts + 1024; LAS bf16* yb = (LAS bf16*)(F.lds + SQ_Y); const LAS float* wl = (const LAS float*)(F.lds + SQ_W);
    for (int u = F.vcu; u < NGRP * NSEG; u += F.G) {
        const int g = u >> 5, seg = u & 31; const int hd = F.wave >> 1, pt = F.wave & 1, r = F.lane & 31, hh = F.lane >> 5, head = 4 * g + hd;
        const int cgx = F.tid >> 4, l0x = (F.tid & 15) * 4, cgb = F.tid >> 5, l0b = (F.tid & 31) * 2;
        conv_weights_to_lds(a, F, g);
        f32x16 acc[4];
        { const bf16* st = (const bf16*)(PWS + WS_ST) + seg_state_off(g, seg, hd); const int p = 32 * pt + r;
#pragma unroll
          for (int i = 0; i < 4; ++i)
#pragma unroll
              for (int q = 0; q < 4; ++q) { const v2u w = *(const v2u*)(st + ((4 * i + q) * 64 + p) * 8 + 4 * hh); acc[i][4 * q] = bflo(w.x); acc[i][4 * q + 1] = bfhi(w.x); acc[i][4 * q + 2] = bflo(w.y); acc[i][4 * q + 3] = bfhi(w.y); } }
        const float dsk = PIN(I_DSSD)[head];
        const int t0 = seg * SEGC * CHK;
        unsigned char* wsb = PWS;
        unsigned ox = (unsigned)(WS_XBC + ((size_t)(t0 + l0x) * XBCD + g * 256 + cgx * 8) * 2 - 3 * XBCD * 2);
        unsigned ob = (unsigned)(WS_XBC + ((size_t)(t0 + l0b) * XBCD + 2048 + g * 128 + cgb * 8) * 2 - 3 * XBCD * 2);
        unsigned odt = (unsigned)(WS_DT + ((size_t)(t0 + F.lane) * 32 + 4 * g + (F.wave & 3)) * 4);
        const int gcx = F.tid & 31;
        unsigned oz = (unsigned)(WS_YV + ((size_t)(t0 + (F.tid >> 5) * 4) * YVP + g * 256 + gcx * 8) * 2);
        unsigned oss = (unsigned)(WS_MISC + ((size_t)(t0 + (F.tid >> 5) * 4) * 8 + g) * 4);
#pragma unroll 1
        for (int k = 0; k < SEGC; ++k) {
            v4u rx[7], rb[5], rc[5];
            const float dtv = *(const float*)(wsb + odt);
            rows_load<7>(wsb, ox, t0 + k * CHK + l0x - 3, rx); rows_load<5>(wsb, ob, t0 + k * CHK + l0b - 3, rb); rows_load<5>(wsb, ob + 2048, t0 + k * CHK + l0b - 3, rc);
            (void)seq_dt_setup(a, F, g, dtv, k & 1);
            { const int hx = cgx >> 3, p0 = (cgx & 7) * 8;
              conv_xs_to_lds<false>(wl, cgx * 8, rx, xT + (hx * 64 + p0) * 72 + l0x, (f32x4){1.f, 1.f, 1.f, 1.f});
              conv_bc_to_lds<true, true>(wl, 256 + cgb * 8, rb, Bc + l0b * 136 + cgb * 8, Bt + (cgb * 8) * 72 + l0b);
              conv_bc_to_lds<true, false>(wl, 384 + cgb * 8, rc, Cc + l0b * 136 + cgb * 8, Cc); }
            __syncthreads();
            {
                const LAS bf16* xrow = xT + (hd * 64 + 32 * pt + r) * 72; const int pcol = hd * 64 + 32 * pt + r;
#pragma unroll
                for (int lt = 0; lt < 2; ++lt) {
                    f32x16 y;
#pragma unroll
                    for (int j = 0; j < 16; ++j) y[j] = 0.f;
#pragma unroll
                    for (int i = 0; i < 4; ++i)
#pragma unroll
                        for (int kk = 0; kk < 2; ++kk) { const bf16x8 bs = pack_frag(acc[i], kk); const int nb = 32 * i + 16 * kk + 4 * hh;
                            const v2u lo = *(const LAS v2u*)(Cc + (32 * lt + r) * 136 + nb), hi = *(const LAS v2u*)(Cc + (32 * lt + r) * 136 + nb + 8); const v4u c0 = (v4u){lo.x, lo.y, hi.x, hi.y};
                            y = __builtin_amdgcn_mfma_f32_32x32x16_bf16(__builtin_bit_cast(bf16x8, c0), bs, y, 0, 0, 0); }
#pragma unroll
                    for (int q = 0; q < 4; ++q) { const f32x4 e0 = *(const LAS f32x4*)(eacs + hd * 64 + 32 * lt + 8 * q + 4 * hh);
#pragma unroll
                        for (int i = 0; i < 4; ++i) y[4 * q + i] *= e0[i]; }
                    __builtin_amdgcn_sched_barrier(0);
                    const float al = acs[hd * 64 + 32 * lt + r];
#pragma unroll
                    for (int st = 0; st <= lt; ++st) {
                        f32x16 X;
#pragma unroll
                        for (int j = 0; j < 16; ++j) X[j] = 0.f;
#pragma unroll
                        for (int ks = 0; ks < 8; ++ks) { const int ko = 16 * ks + 8 * hh;
                            const bf16x8 a0 = *(const LAS bf16x8*)(Bc + (32 * st + r) * 136 + ko), b0 = *(const LAS bf16x8*)(Cc + (32 * lt + r) * 136 + ko);
                            X = __builtin_amdgcn_mfma_f32_32x32x16_bf16(a0, b0, X, 0, 0, 0); }
#pragma unroll
                        for (int q = 0; q < 4; ++q) { const int sb = 8 * q + 4 * hh;
                            const f32x4 as0 = *(const LAS f32x4*)(acs + hd * 64 + 32 * st + sb), ds0 = *(const LAS f32x4*)(dts + hd * 64 + 32 * st + sb);
#pragma unroll
                            for (int i = 0; i < 4; ++i) { const int j = 4 * q + i; const float v = X[j] * __expf(al - as0[i]) * ds0[i]; X[j] = (st < lt || r >= sb + i) ? v : 0.f; } }
#pragma unroll
                        for (int kk = 0; kk < 2; ++kk) { const int sb = 32 * st + 16 * kk + 4 * hh;
                            const v2u lo = *(const LAS v2u*)(xrow + sb), hi = *(const LAS v2u*)(xrow + sb + 8); const v4u wa = (v4u){lo.x, lo.y, hi.x, hi.y};
                            y = __builtin_amdgcn_mfma_f32_32x32x16_bf16(pack_frag(X, kk), __builtin_bit_cast(bf16x8, wa), y, 0, 0, 0); }
                        __builtin_amdgcn_sched_barrier(0);
                    }
#pragma unroll
                    for (int q = 0; q < 4; ++q) { const int lb = 32 * lt + 8 * q + 4 * hh;
                        const v2u xa = *(const LAS v2u*)(xrow + lb); const float xa4[4] = {bflo(xa.x), bfhi(xa.x), bflo(xa.y), bfhi(xa.y)};
#pragma unroll
                        for (int i = 0; i < 4; ++i) yb[(lb + i) * 264 + pcol] = (bf16)f2bf(y[4 * q + i] + dsk * xa4[i]); }
                    __builtin_amdgcn_sched_barrier(0);
                }
                seq_state_update(F, acc, hd, pt, cdec[(k & 1) * 4 + hd]);
            }
            ox += CHK * XBCD * 2; ob += CHK * XBCD * 2; odt += CHK * 32 * 4;
            v4u zq[4];
#pragma unroll
            for (int i = 0; i < 4; ++i) zq[i] = *(const v4u*)(wsb + (size_t)(oz + (unsigned)i * (YVP * 2)));
            __syncthreads();
            { const float* nw = PIN(I_NSW) + g * 256 + gcx * 8; const f32x4 n0 = *(const f32x4*)nw, n1 = *(const f32x4*)(nw + 4);
#pragma unroll
              for (int i = 0; i < 4; ++i) { const int l = (F.tid >> 5) * 4 + i;
                  float zz[8], yy[8]; unpack8(zq[i], zz); unpack8(*(const LAS v4u*)(yb + l * 264 + gcx * 8), yy);
                  f32x4 g0, g1; float sq = 0.f;
#pragma unroll
                  for (int j = 0; j < 4; ++j) { g0[j] = yy[j] * zz[j]; g1[j] = yy[4 + j] * zz[4 + j]; sq += g0[j] * g0[j] + g1[j] * g1[j]; }
                  *(v4u*)(wsb + (size_t)(oz + (unsigned)i * (YVP * 2))) = pack8(g0 * n0, g1 * n1);
#pragma unroll
                  for (int o = 1; o < 32; o <<= 1) sq += __shfl_xor(sq, o);
                  if (gcx == 0) *(float*)(wsb + (size_t)(oss + (unsigned)i * 32)) = sq; } }
            oz += CHK * YVP * 2; oss += CHK * 8 * 4;
        }
        __syncthreads();
    }
}

__device__ __forceinline__ void seg_scan(const Args& a, const Ctx& F) {
    for (int it = F.vcu * NWAVES + F.wave; it < 2048; it += F.G * NWAVES) { const int gh = it >> 6, sl = it & 63, g = gh >> 2, hd = gh & 3;
        bf16* base = (bf16*)(PWS + WS_ST) + seg_state_off(g, 0, hd) + sl * 128 + F.lane * 2; const float* cd = (const float*)(PWS + WS_MISC + 768 * 1024) + (size_t)g * NSEG * 4 + hd; constexpr size_t CS = (size_t)4 * 8192;
        unsigned v[NSEG]; float d[NSEG];
#pragma unroll
        for (int j = 0; j < NSEG; ++j) { v[j] = *(const unsigned*)(base + (size_t)j * CS); d[j] = cd[j * 4]; }
        float c0 = 0.f, c1 = 0.f;
#pragma unroll
        for (int j = 0; j < NSEG; ++j) { *(unsigned*)(base + (size_t)j * CS) = pk2(c0, c1); c0 = c0 * d[j] + bflo(v[j]); c1 = c1 * d[j] + bfhi(v[j]); } }
}

__device__ __forceinline__ void scans(const Args& a, const Ctx& F) {
    if (F.vcu < S5G) {
        const int g = F.vcu, n = F.lane; const float dt = expf(PIN(I_LOGDT)[g]), lr = PIN(I_LRE)[g * 64 + n], li = PIN(I_LIM)[g * 64 + n];
        const float mag = expf(16.f * lr * dt), ang = 16.f * li * dt, ar = mag * cosf(ang), ai = mag * sinf(ang);
        const float* SLp = (const float*)(PWS + WS_SL) + ((size_t)g * S5NC + 128 * F.wave) * 128 + n; bf16* AP = (bf16*)(PWS + WS_AP) + ((size_t)g * S5NC + 128 * F.wave) * APK + 256 + n;
        LAS float* ex = (LAS float*)F.lds;
        float sr = 0.f, si = 0.f;
        for (int cb = 0; cb < 128; cb += 16) { float ra[16], ia[16];
#pragma unroll
            for (int j = 0; j < 16; ++j) { ra[j] = SLp[(size_t)(cb + j) * 128]; ia[j] = SLp[(size_t)(cb + j) * 128 + 64]; }
#pragma unroll
            for (int j = 0; j < 16; ++j) { const float nr = ar * sr - ai * si + ra[j], ni = ar * si + ai * sr + ia[j]; sr = nr; si = ni; } }
        ex[F.wave * 128 + n] = sr; ex[F.wave * 128 + 64 + n] = si;
        __syncthreads();
        float pr = ar, pi = ai;
#pragma unroll
        for (int q = 0; q < 7; ++q) { const float t = pr * pr - pi * pi; pi = 2.f * pr * pi; pr = t; }
        sr = 0.f; si = 0.f;
        for (int w = 0; w < F.wave; ++w) { const float er = ex[w * 128 + n], ei = ex[w * 128 + 64 + n]; const float nr = pr * sr - pi * si + er, ni = pr * si + pi * sr + ei; sr = nr; si = ni; }
        for (int cb = 0; cb < 128; cb += 16) { float ra[16], ia[16];
#pragma unroll
            for (int j = 0; j < 16; ++j) { ra[j] = SLp[(size_t)(cb + j) * 128]; ia[j] = SLp[(size_t)(cb + j) * 128 + 64]; }
#pragma unroll
            for (int j = 0; j < 16; ++j) { AP[(size_t)(cb + j) * APK] = (bf16)f2bf(sr); AP[(size_t)(cb + j) * APK + 64] = (bf16)f2bf(si);
                const float nr = ar * sr - ai * si + ra[j], ni = ar * si + ai * sr + ia[j]; sr = nr; si = ni; } }
        __syncthreads();
    }
    seg_scan(a, F);
}

__device__ __forceinline__ void route_unit(const Args& a, const Ctx& F, int unit, LAS float* lg  ) {
    const int t0 = unit * 16, row = F.lane & 15, kq = F.lane >> 4;
    const bf16* xd = (const bf16*)(PWS + WS_XD) + (size_t)(t0 + row) * D + 8 * kq; unsigned char* h2 = PWS + WS_H + (size_t)(t0 + row) * D + 8 * kq;
    const float* nf = PIN(I_NFW) + 8 * kq; const bf16* wt = (const bf16*)(PWS + WS_RT) + (size_t)row * D + 8 * kq;
    f32x4 acc0 = {0.f, 0.f, 0.f, 0.f}, acc1 = acc0, acc2 = acc0; float ssq = 0.f;
#pragma unroll 4
    for (int ks = 0; ks < 64; ++ks) { const int k = 32 * ks;
        const f32x4 g0 = *(const f32x4*)(nf + k), g1 = *(const f32x4*)(nf + k + 4); float dd[8]; unpack8(*(const v4u*)(xd + k), dd);
        f32x4 m0, m1;
#pragma unroll
        for (int j = 0; j < 4; ++j) { m0[j] = dd[j]; m1[j] = dd[4 + j]; ssq += m0[j] * m0[j] + m1[j] * m1[j]; }
        const f32x4 hq0 = m0 * g0, hq1 = m1 * g1; const v4u hv = pack8(hq0, hq1); { v2u o8; o8.x = pk4_fp8(hq0[0], hq0[1], hq0[2], hq0[3]); o8.y = pk4_fp8(hq1[0], hq1[1], hq1[2], hq1[3]); *(v2u*)(h2 + k) = o8; } const bf16x8 af = __builtin_bit_cast(bf16x8, hv);
        const bf16x8 b0h = *(const bf16x8*)(wt + k), b1h = *(const bf16x8*)(wt + (size_t)16 * D + k), b2h = *(const bf16x8*)(wt + (size_t)32 * D + k);
        const bf16x8 b0l = *(const bf16x8*)(wt + (size_t)48 * D + k), b1l = *(const bf16x8*)(wt + (size_t)64 * D + k), b2l = *(const bf16x8*)(wt + (size_t)80 * D + k);
        acc0 = __builtin_amdgcn_mfma_f32_16x16x32_bf16(af, b0h, acc0, 0, 0, 0); acc1 = __builtin_amdgcn_mfma_f32_16x16x32_bf16(af, b1h, acc1, 0, 0, 0); acc2 = __builtin_amdgcn_mfma_f32_16x16x32_bf16(af, b2h, acc2, 0, 0, 0);
        acc0 = __builtin_amdgcn_mfma_f32_16x16x32_bf16(af, b0l, acc0, 0, 0, 0); acc1 = __builtin_amdgcn_mfma_f32_16x16x32_bf16(af, b1l, acc1, 0, 0, 0); acc2 = __builtin_amdgcn_mfma_f32_16x16x32_bf16(af, b2l, acc2, 0, 0, 0); }
    ssq += __shfl_xor(ssq, 16); ssq += __shfl_xor(ssq, 32);
    const float rstd = 1.0f / sqrtf(ssq * (1.f / D) + EPS);
    if (kq == 0) ((float*)(PWS + WS_MISC + 800 * 1024))[t0 + row] = rstd;
#pragma unroll
    for (int reg = 0; reg < 4; ++reg) { const int tok = 4 * kq + reg; const float rs = __shfl(rstd, tok);
        lg[tok * 48 + row] = rs * acc0[reg]; lg[tok * 48 + 16 + row] = rs * acc1[reg]; lg[tok * 48 + 32 + row] = rs * acc2[reg]; }
    LDS_WAIT(); asm volatile("" ::: "memory");
    if (F.lane < 16) { const int tok = F.lane; const LAS float* lq = lg + tok * 48;
        unsigned* cnt = (unsigned*)(PWS + WS_CTL) + CW_CNT + a.bar_region * 4096; unsigned* list_tok = (unsigned*)(PWS + WS_LST); float* list_w = (float*)(PWS + WS_LST + 2 * MiB);
        float g4[4]; int grp = 0; float gmax;
#pragma unroll
        for (int j = 0; j < 4; ++j) g4[j] = lq[j] + PIN(I_BRG)[j];
        gmax = g4[0];
#pragma unroll
        for (int j = 1; j < 4; ++j) if (g4[j] > gmax) { gmax = g4[j]; grp = j; }
        float den = 0.f;
#pragma unroll
        for (int j = 0; j < 4; ++j) den += expf(g4[j] - gmax);
        const float pg = 1.0f / den;
        float v1 = -INFINITY, v2 = -INFINITY; int i1 = 0, i2 = 0;
        for (int j = 0; j < 8; ++j) { const float le = lq[16 + grp * 8 + j] + PIN(I_BRE2)[grp * 8 + j];
            if (le > v1) { v2 = v1; i2 = i1; v1 = le; i1 = j; } else if (le > v2) { v2 = le; i2 = j; } }
        const float e2 = expf(v2 - v1), w1 = pg / (1.0f + e2), w2 = pg * e2 / (1.0f + e2);
        const int ea = grp * 8 + i1, eb = grp * 8 + i2; const unsigned tk = (unsigned)(t0 + tok);
        float* list_r = (float*)(PWS + WS_LR); unsigned* tokslot = (unsigned*)(PWS + WS_LR + 2 * MiB);
        const unsigned s1 = atomicAdd(cnt + 64 * ea, 1u); list_tok[(size_t)ea * CAPL + s1] = tk * 2u; list_w[(size_t)ea * CAPL + s1] = w1; list_r[(size_t)ea * CAPL + s1] = rstd; tokslot[tk * 2u] = (unsigned)ea * CAPL + s1;
        const unsigned s2 = atomicAdd(cnt + 64 * eb, 1u); list_tok[(size_t)eb * CAPL + s2] = tk * 2u + 1u; list_w[(size_t)eb * CAPL + s2] = w2; list_r[(size_t)eb * CAPL + s2] = rstd; tokslot[tk * 2u + 1u] = (unsigned)eb * CAPL + s2; }
    LDS_WAIT(); asm volatile("" ::: "memory");
}
template <class Dec>
__device__ __forceinline__ void transpose_jobs_dyn(volatile LAS unsigned* ctr, int cu, int ncu, int nitems, const Dec dec, LAS float* scr, int lane) {
    auto grab = [&]() -> int { unsigned j = 0; if (lane == 0) j = __hip_atomic_fetch_add((LAS unsigned*)ctr, 1u, __ATOMIC_RELAXED, __HIP_MEMORY_SCOPE_WORKGROUP); j = __builtin_amdgcn_readfirstlane(j); return cu + (int)j * ncu; };
    int it = grab(); if (it >= nitems) return;
    TJob cur; f32x4 v[8]; dec(it, cur); tj_load(cur, lane, v);
    for (;;) { const int nx = grab(); const bool hn = nx < nitems; TJob nj = cur; f32x4 nv[8];
        if (hn) { dec(nx, nj); tj_load(nj, lane, nv); }
        tj_store(cur, lane, v, scr);
        if (!hn) break;
        cur = nj;
#pragma unroll
        for (int i = 0; i < 8; ++i) v[i] = nv[i]; }
}
template <class Dec>
__device__ __forceinline__ void transpose_jobs_queue(unsigned* gctr, int first_item, int nbatches, const Dec dec, LAS float* scr, int lane) {
    unsigned bv = 0u; if (lane == 0) bv = __hip_atomic_fetch_add(gctr, 1u, __ATOMIC_RELAXED, __HIP_MEMORY_SCOPE_AGENT);
    int b = (int)__builtin_amdgcn_readfirstlane(bv);
    while (b < nbatches) {
        unsigned nv = 0u; if (lane == 0) nv = __hip_atomic_fetch_add(gctr, 1u, __ATOMIC_RELAXED, __HIP_MEMORY_SCOPE_AGENT);
        transpose_jobs<Dec>(first_item + 8 * b, 1, first_item + 8 * b + 8, dec, scr, lane);
        b = (int)__builtin_amdgcn_readfirstlane(nv); }
}
__device__ __forceinline__ void route_phase(const Args& a, const Ctx& F) {
    if (F.wave < 4) { LAS float* lg = (LAS float*)(F.lds + 8 * 16384) + F.wave * 768;
        for (int unit = F.vcu * 4 + F.wave; unit < T / 16; unit += F.G * 4) route_unit(a, F, unit, lg); }
    { LAS float* scr = (LAS float*)(F.lds + F.wave * 16384);
      DecExp dec{PIN(I_WEG), PIN(I_WEU), PIN(I_WED), PWS};
      transpose_jobs_dyn<DecExp>(F.ctl + 76, F.vcu, F.G, 2 * DecExp::I_GU, dec, scr, F.lane); }
}
__device__ __forceinline__ void moe_tables(const Args& a, const Ctx& F) {
    if (F.tid == 0) { const unsigned* cnt = (const unsigned*)(PWS + WS_CTL) + CW_CNT + a.bar_region * 4096; unsigned rb = 0, nt = 0;
        for (int e = 0; e < NE; ++e) { const unsigned c = __hip_atomic_load(cnt + 64 * e, __ATOMIC_RELAXED, __HIP_MEMORY_SCOPE_AGENT); const unsigned tiles = (c + 255u) >> 8; F.ctl[8 + e] = c; F.ctl[40 + e] = rb;
            for (unsigned i = 0; i < tiles && nt < 160u; ++i) F.ctl[80 + nt++] = (unsigned)e; rb += tiles * 256u; }
        F.ctl[72] = nt; }
    __syncthreads();
}
__device__ __forceinline__ void final_phase(const Args& a, const Ctx& F) {
    const int lane = (int)__builtin_amdgcn_mbcnt_hi(~0u, __builtin_amdgcn_mbcnt_lo(~0u, 0u));
    const int gw = F.vcu * NWAVES + F.wave, NGW = F.G * NWAVES; const unsigned char* Y = PWS + WS_XBC; const bf16* XD = (const bf16*)(PWS + WS_XD); const unsigned* tokslot = (const unsigned*)(PWS + WS_LR + 2 * MiB);
    for (int m = gw; m < T; m += NGW) { float* orow = POUT + (size_t)m * D; const v2u* xd = (const v2u*)(XD + (size_t)m * D) + lane;
        const unsigned ts0 = tokslot[2 * m], ts1 = tokslot[2 * m + 1];
        const size_t r0 = (size_t)F.ctl[40 + (ts0 >> 14)] + (ts0 & 16383u), r1 = (size_t)F.ctl[40 + (ts1 >> 14)] + (ts1 & 16383u);
        const unsigned* y0 = (const unsigned*)(Y + r0 * D) + lane; const unsigned* y1 = (const unsigned*)(Y + r1 * D) + lane;
        const f32x4* w4 = (const f32x4*)PIN(I_NFINAL) + lane; f32x4 v[8]; float s = 0.f;
#pragma unroll
        for (int j = 0; j < 8; ++j) { const unsigned p = y0[64 * j], q = y1[64 * j]; const v2u d2 = xd[64 * j];
            const f32x2 p0 = __builtin_amdgcn_cvt_pk_f32_fp8((int)p, false), p1 = __builtin_amdgcn_cvt_pk_f32_fp8((int)p, true), q0 = __builtin_amdgcn_cvt_pk_f32_fp8((int)q, false), q1 = __builtin_amdgcn_cvt_pk_f32_fp8((int)q, true);
            constexpr float ys = 1.0f / Y_SCALE;
            v[j] = (f32x4){bflo(d2.x) + ys * (p0[0] + q0[0]), bfhi(d2.x) + ys * (p0[1] + q0[1]), bflo(d2.y) + ys * (p1[0] + q1[0]), bfhi(d2.y) + ys * (p1[1] + q1[1])};
            s += (v[j].x * v[j].x + v[j].y * v[j].y) + (v[j].z * v[j].z + v[j].w * v[j].w); }
        const float rstd = 1.0f / sqrtf(wave_sum(s) * (1.f / D) + EPS);
#pragma unroll
        for (int j = 0; j < 8; ++j) { const f32x4 g = w4[64 * j]; ((f32x4*)orow + lane)[64 * j] = (f32x4){v[j].x * rstd * g.x, v[j].y * rstd * g.y, v[j].z * rstd * g.z, v[j].w * rstd * g.w}; } }
}

constexpr int N_PHASES = 12;
template <int VARIANT>
__global__ void __launch_bounds__(NWAVES * 64, 2) hybrid_fwd(Args args) {
    extern __shared__ __attribute__((aligned(16))) unsigned char lds_raw[];
    Ctx F; F.lds = (LAS unsigned char*)lds_raw; F.ctl = (volatile LAS unsigned*)(F.lds + LDSCTL_OFF);
    F.tid = threadIdx.x; F.lane = F.tid & 63; F.wave = __builtin_amdgcn_readfirstlane(F.tid >> 6);
    F.G = gridDim.x; { const int bx = blockIdx.x; F.vcu = (F.G % 8 == 0) ? (bx % 8) * (F.G / 8) + bx / 8 : bx; }
    for (int u = F.tid; u < (LDS_BYTES - LDSCTL_OFF) / 4; u += NWAVES * 64) ((LAS unsigned*)(F.lds + LDSCTL_OFF))[u] = 0u;
    __syncthreads();
    if (F.tid == 0) { LAS unsigned long long* pt = (LAS unsigned long long*)(F.lds + PTAB_OFF);
        pt[0] = (unsigned long long)args.in[0];
        pt[1] = (unsigned long long)args.in[1];
        pt[2] = (unsigned long long)args.in[2];
        pt[3] = (unsigned long long)args.in[3];
        pt[4] = (unsigned long long)args.in[4];
        pt[5] = (unsigned long long)args.in[5];
        pt[6] = (unsigned long long)args.in[6];
        pt[7] = (unsigned long long)args.in[7];
        pt[8] = (unsigned long long)args.in[8];
        pt[9] = (unsigned long long)args.in[9];
        pt[10] = (unsigned long long)args.in[10];
        pt[11] = (unsigned long long)args.in[11];
        pt[12] = (unsigned long long)args.in[12];
        pt[13] = (unsigned long long)args.in[13];
        pt[14] = (unsigned long long)args.in[14];
        pt[15] = (unsigned long long)args.in[15];
        pt[16] = (unsigned long long)args.in[16];
        pt[17] = (unsigned long long)args.in[17];
        pt[18] = (unsigned long long)args.in[18];
        pt[19] = (unsigned long long)args.in[19];
        pt[20] = (unsigned long long)args.in[20];
        pt[21] = (unsigned long long)args.in[21];
        pt[22] = (unsigned long long)args.in[22];
        pt[23] = (unsigned long long)args.in[23];
        pt[24] = (unsigned long long)args.in[24];
        pt[25] = (unsigned long long)args.in[25];
        pt[26] = (unsigned long long)args.in[26];
        pt[27] = (unsigned long long)args.in[27];
        pt[28] = (unsigned long long)args.in[28];
        pt[29] = (unsigned long long)args.in[29];
        pt[30] = (unsigned long long)args.in[30];
        pt[31] = (unsigned long long)args.out; pt[32] = (unsigned long long)args.ws; }
    __syncthreads();
    const unsigned mask = args.mask; const int lastp = 31 - __builtin_clz(mask | 1u);
    if (__builtin_popcount(mask) > 1) (void)xcd_barrier_post((unsigned*)(PWS + WS_CTL) + CW_BAR + args.bar_region * XCD_BAR_WORDS, F.ctl);
#define IN(k) (((mask >> (k)) & 1u) && (F.lane = (int)__builtin_amdgcn_mbcnt_hi(~0u, __builtin_amdgcn_mbcnt_lo(~0u, 0u)), F.tid = F.wave * 64 + F.lane, true))
#define SEAM(k) do { if (IN(k) && (k) != lastp) { XcdBarrier bar_; bar_.bar = (unsigned*)(PWS + WS_CTL) + CW_BAR + args.bar_region * XCD_BAR_WORDS; bar_.x = xb_xcc_id(); bar_.st = F.ctl; xcd_barrier(bar_); } } while (0)
    unsigned char* ws = PWS;
    if (IN(0)) { p0_prologue(args, F); } SEAM(0);
    if (IN(1)) { SchedDense S; S.so.init(T / 256, 28, F.G, (int)blockIdx.x); S.A = (const char*)(ws + WS_H); S.B = (const char*)(ws + WS_WIN); S.lda = D * 2; S.ldb = D * 2;
        Epi1a E{(bf16*)(ws + WS_YV), (bf16*)(ws + WS_XBC), (bf16*)(ws + WS_AP)};
        pg8::gemm_phase<Epi1a, SchedDense, false>(F.lds, D, D * 2, D * 2, S, E, (VARIANT & 1) != 0);
        dt_gemm(args, F); } SEAM(1);
    if (IN(2)) { ssd_pass_a(args, F);
        SchedS5 S{(const char*)(ws + WS_AP), (const char*)(ws + WS_S5WS), 512u, F.G, F.vcu}; EpiS5a E{(float*)(ws + WS_SL)};
        pg8::gemm_phase<EpiS5a, SchedS5, false>(F.lds, 256, APK * 2, 512, S, E, (VARIANT & 1) != 0); } SEAM(2);
    if (IN(3)) { scans(args, F); } SEAM(3);
    if (IN(4)) { ssd_pass_b(args, F);
        SchedS5 S{(const char*)(ws + WS_AP), (const char*)(ws + WS_S5TW), (unsigned)(APK * 2), F.G, F.vcu}; EpiS5b E{(bf16*)(ws + WS_SL)};
        pg8::gemm_phase<EpiS5b, SchedS5, false>(F.lds, APK, APK * 2, APK * 2, S, E, (VARIANT & 1) != 0); } SEAM(4);
    if (IN(5)) { { SchedDense S; S.so.init(T / 256, 16, F.G, (int)blockIdx.x); S.A = (const char*)(ws + WS_H8); S.B = (const char*)(ws + WS_WIN) + (size_t)7168 * D * 2; S.lda = D; S.ldb = D;
          Epi1b E{(bf16*)(ws + WS_XBC), PIN(I_GATEB), (const float*)(ws + WS_MISC)};
          pg8::gemm_phase<Epi1b, SchedDense, false, true, 0, true, 127, 122>(F.lds, D, D, D, S, E, (VARIANT & 1) != 0); }
        { SchedDense S; S.so.init(T / 256, 4, F.G, (int)blockIdx.x); S.A = (const char*)(ws + WS_SL); S.B = (const char*)(ws + WS_WGLU); S.lda = S5W * 2; S.ldb = S5W * 2;
          EpiGlu E{(const bf16*)(ws + WS_SL), (bf16*)(ws + WS_YV)};
          pg8::gemm_phase<EpiGlu, SchedDense, false>(F.lds, S5W, S5W * 2, S5W * 2, S, E, (VARIANT & 1) != 0); } } SEAM(5);
    if (IN(6)) { SchedDense S; S.so.init(T / 256, 8, F.G, (int)blockIdx.x); S.A = (const char*)(ws + WS_YV); S.B = (const char*)(ws + WS_WAB); S.lda = YVP * 2; S.ldb = YVP * 2;
        EpiAB E{(const bf16*)(ws + WS_XBC), (bf16*)(ws + WS_ST)};
        pg8::gemm_phase<EpiAB, SchedDense, false, true, 32>(F.lds, YVP, YVP * 2, YVP * 2, S, E, (VARIANT & 1) != 0); } SEAM(6);
    if (IN(8)) { SchedDense S; S.so.init(T / 256, 8, F.G, (int)blockIdx.x); S.A = (const char*)(ws + WS_ST); S.B = (const char*)(ws + WS_WOUT); S.lda = D * 2; S.ldb = D * 2;
        EpiOut E{(bf16*)(ws + WS_XD), PIN(I_X)};
        pg8::gemm_phase<EpiOut, SchedDense, false, true, 0, false, 127, 127, true>(F.lds, D, D * 2, D * 2, S, E, (VARIANT & 1) != 0); } SEAM(8);
    if (IN(9)) { route_phase(args, F); } SEAM(9);
    if (IN(10)) { moe_tables(args, F);
        SchedMoE S{F.ctl, (const char*)(ws + WS_H), (const char*)(ws + WS_ST), (const unsigned*)(ws + WS_LST), (unsigned)D, (size_t)1024 * D, (unsigned)D, 4, F.G, F.vcu, true};
        EpiGU E{(bf16*)(ws + WS_AP), (const unsigned*)(ws + WS_LST), (const float*)(ws + WS_LR)};
        pg8::gemm_phase<EpiGU, SchedMoE, true, true, 0, true, 127, 121>(F.lds, D, D, D, S, E, (VARIANT & 1) != 0);
        { LAS float* scr = (LAS float*)(F.lds + F.wave * 16384); DecExp dec{PIN(I_WEG), PIN(I_WEU), PIN(I_WED), PWS};
          transpose_jobs_queue<DecExp>((unsigned*)(ws + WS_CTL) + CW_CNT + args.bar_region * 4096 + 2560, 2 * DecExp::I_GU, DecExp::I_GU / 8, dec, scr, F.lane); } } SEAM(10);
    if (IN(11)) { moe_tables(args, F);
        SchedMoE S{F.ctl, (const char*)(ws + WS_AP), (const char*)(ws + WS_YV), (const unsigned*)(ws + WS_LST), (unsigned)FF, (size_t)D * FF, (unsigned)FF, 8, F.G, F.vcu, false};
        EpiDn E{(const float*)(ws + WS_LST + 2 * MiB), ws + WS_XBC};
        pg8::gemm_phase<EpiDn, SchedMoE, false, true, 0, true, 125, 122>(F.lds, FF, FF, FF, S, E, (VARIANT & 1) != 0); } SEAM(11);
    if (IN(12)) { moe_tables(args, F); final_phase(args, F); }
#undef IN
#undef SEAM
}

extern "C" void kernel_launch(void* const* d_in, const int* in_sizes, int n_in, void* d_out, int out_size, void* d_ws, size_t ws_size, hipStream_t stream) {
    static int grid = 0;
    if (grid == 0) {
        if (n_in != 31 || in_sizes[0] != T * D || out_size != T * D || ws_size < WS_END) { fprintf(stderr, "kernel_launch: unexpected shapes / workspace (n_in %d, ws %zu, need %zu)\n", n_in, ws_size, (size_t)WS_END); grid = -1; return; }
        int dev = 0, cus = 0;
        if (hipGetDevice(&dev) != hipSuccess || hipDeviceGetAttribute(&cus, hipDeviceAttributeMultiprocessorCount, dev) != hipSuccess) { grid = -1; return; }
        if (hipFuncSetAttribute((const void*)hybrid_fwd<0>, hipFuncAttributeMaxDynamicSharedMemorySize, LDS_BYTES) != hipSuccess) { fprintf(stderr, "kernel_launch: hipFuncSetAttribute failed\n"); grid = -1; return; }
#if defined(EXP_MASK)
        (void)hipFuncSetAttribute((const void*)hybrid_fwd<EXP_VARIANT>, hipFuncAttributeMaxDynamicSharedMemorySize, LDS_BYTES);
#endif
        int per_cu = 0;
        if (hipOccupancyMaxActiveBlocksPerMultiprocessor(&per_cu, (const void*)hybrid_fwd<0>, NWAVES * 64, LDS_BYTES) != hipSuccess || per_cu < 1) fprintf(stderr, "kernel_launch: occupancy query reports %d\n", per_cu);
        (void)hipGetLastError();
        grid = cus;
    }
    if (grid < 0) return;
    (void)hipMemsetAsync((char*)d_ws + WS_CTL, 0, CTL_ZERO_BYTES, stream);
    Args a{};
    for (int i = 0; i < 31; ++i) a.in[i] = (const float*)d_in[i];
    a.out = (float*)d_out; a.ws = (unsigned char*)d_ws;
#if defined(EXP_MASK)
    a.mask = EXP_MASK; a.variant = EXP_VARIANT; a.bar_region = 0;
    hipLaunchKernelGGL(hybrid_fwd<EXP_VARIANT>, dim3(grid), dim3(NWAVES * 64), LDS_BYTES, stream, a);
    a.mask = ((1u << (N_PHASES + 1)) - 1u) & ~(1u << 7); a.variant = 0; a.bar_region = 1;
    hipLaunchKernelGGL(hybrid_fwd<0>, dim3(grid), dim3(NWAVES * 64), LDS_BYTES, stream, a);
#elif MK_N_LAUNCHES == 1
    a.mask = ((1u << (N_PHASES + 1)) - 1u) & ~(1u << 7); a.variant = 0; a.bar_region = 0;
    hipLaunchKernelGGL(hybrid_fwd<0>, dim3(grid), dim3(NWAVES * 64), LDS_BYTES, stream, a);
#else
    for (int p = 0; p <= N_PHASES; ++p) { if (p == 7) continue; a.mask = 1u << p; a.variant = 0; a.bar_region = 0; hipLaunchKernelGGL(hybrid_fwd<0>, dim3(grid), dim3(NWAVES * 64), LDS_BYTES, stream, a); }
#endif
}
```

```cpp
#include <hip/hip_runtime.h>
#include <cstdio>
#include <cstdint>

#ifndef MK_N_LAUNCHES
#define MK_N_LAUNCHES 1
#endif
#ifndef EXP_VARIANT
#define EXP_VARIANT 0
#endif
#ifndef NAIVE_GEMM
#define NAIVE_GEMM 0
#endif

#define LAS __attribute__((address_space(3)))
#define GAS __attribute__((address_space(1)))
typedef unsigned short bf16;
typedef short bf16x8 __attribute__((ext_vector_type(8)));
typedef float f32x4 __attribute__((ext_vector_type(4)));
typedef float f32x2 __attribute__((ext_vector_type(2)));
typedef float f32x16 __attribute__((ext_vector_type(16)));
typedef unsigned v4u __attribute__((ext_vector_type(4)));
typedef unsigned v2u __attribute__((ext_vector_type(2)));
typedef GAS unsigned gu32;
typedef int v4i_ __attribute__((ext_vector_type(4)));
typedef int v8i_ __attribute__((ext_vector_type(8)));

constexpr int T = 16384, D = 2048;
constexpr int NH = 32, HP = 64, NGRP = 8, NST = 128, CHK = 64, NCHK = T / CHK;
constexpr int XBCD = 4096;
constexpr int S5W = 1024, S5G = 64, S5C = 16, S5N = 64, LS = 16, S5NC = T / LS;
constexpr int APK = 384;
constexpr int NE = 32, EPG = 8, FF = 512, CAPL = 16384;
constexpr int IN_DIM = 11296;
constexpr float EPS = 1e-6f;
constexpr int NWAVES = 8;

constexpr size_t MiB = 1u << 20;
constexpr size_t WS_CTL = 0, CTL_ZERO_BYTES = 1 * MiB;
constexpr size_t WS_WIN = 1 * MiB;
constexpr size_t WS_WAB = 46 * MiB;
constexpr size_t WS_WGLU = 58 * MiB, WS_WOUT = 80 * MiB;
constexpr size_t WS_S5WS = 60 * MiB;
constexpr size_t WS_S5TW = 68 * MiB;
constexpr size_t WS_XD = 1 * MiB;
constexpr size_t WS_H = 88 * MiB;
constexpr int YVP = 3072;
constexpr size_t WS_YV = 152 * MiB;
constexpr size_t WS_XBC = 248 * MiB;
constexpr size_t WS_ST = 376 * MiB;
constexpr size_t WS_AP = 504 * MiB;
constexpr size_t WS_DT = 552 * MiB;
constexpr size_t WS_MISC = 554 * MiB;
constexpr size_t WS_SL = 555 * MiB;
constexpr size_t WS_LST = 587 * MiB;
constexpr size_t WS_RT = 591 * MiB;
constexpr size_t WS_H8 = 592 * MiB;
constexpr size_t WS_LR = 624 * MiB;
constexpr size_t WS_END = 627 * MiB;
constexpr int CW_BAR = 4096;
constexpr int CW_CNT = 16384;

constexpr int LDS_BYTES = 163840;
constexpr int LDSCTL_OFF = 161792;

typedef __bf16 bf16x2_t __attribute__((ext_vector_type(2)));
__device__ __forceinline__ unsigned f2bf(float f) { return (unsigned)__builtin_bit_cast(unsigned short, (__bf16)f); }
__device__ __forceinline__ unsigned pk2(float lo, float hi) { const f32x2 v = {lo, hi}; const bf16x2_t b = __builtin_convertvector(v, bf16x2_t); return __builtin_bit_cast(unsigned, b); }
__device__ __forceinline__ unsigned pk4_fp8(float a, float b, float c, float d) { unsigned w = 0u; w = (unsigned)__builtin_amdgcn_cvt_pk_fp8_f32(a, b, (int)w, false); w = (unsigned)__builtin_amdgcn_cvt_pk_fp8_f32(c, d, (int)w, true); return w; }
__device__ __forceinline__ float bflo(unsigned w) { return __builtin_bit_cast(float, w << 16); }
__device__ __forceinline__ float bfhi(unsigned w) { return __builtin_bit_cast(float, w & 0xffff0000u); }
__device__ __forceinline__ float bf2f(bf16 h) { return __builtin_bit_cast(float, (unsigned)h << 16); }
__device__ __forceinline__ float wave_sum(float v) {
#pragma unroll
    for (int o = 1; o < 64; o <<= 1) v += __shfl_xor(v, o);
    return v;
}
__device__ __forceinline__ float sigmoidf_(float x) { return __builtin_amdgcn_rcpf(1.0f + __builtin_amdgcn_exp2f(-1.4426950408889634f * x)); }
__device__ __forceinline__ float siluf_(float x) { return x * __builtin_amdgcn_rcpf(1.0f + __builtin_amdgcn_exp2f(-1.4426950408889634f * x)); }
__device__ __forceinline__ float gelu_tanh(float x) { const float u = 0.7978845608028654f * (x + 0.044715f * x * x * x); return x * __builtin_amdgcn_rcpf(1.0f + __builtin_amdgcn_exp2f(-2.8853900817779268f * u)); }
#define LDS_WAIT() asm volatile("s_waitcnt lgkmcnt(0)" ::: "memory")
#define VM_WAIT() asm volatile("s_waitcnt vmcnt(0)" ::: "memory")

namespace pg8 {
constexpr int BM = 256, BK = 64, HALF = 128, HTB = HALF * BK * 2, STAGE_BYTES = 8 * HTB, NXCD = 8, WGM = 8;
__host__ __device__ __forceinline__ int lds_byte(int r, int c) { const int st = (r >> 4) * 2 + (c >> 5), rr = r & 15, cc = c & 31, ob = rr * 64 + cc * 2; return st * 1024 + (ob ^ (((ob >> 9) & 1) << 5)); }
__host__ __device__ __forceinline__ void stage_rc(int b, int& R, int& C) { const int st = b / 1024, sb = b % 1024, swz = sb ^ (((sb >> 9) & 1) << 5); R = (st >> 1) * 16 + swz / 64; C = (st & 1) * 32 + (swz % 64) / 2; }
__host__ __device__ __forceinline__ int perm32(int rho) { const int n = rho >> 4, i = rho & 15; return 8 * (i >> 2) + 4 * n + (i & 3); }

struct Unit { const char* A; const char* B; int row0, col0, e, nvalid, slot0; };

struct StaticOrder {
    int nM, nN, nwg, G, c;
    __device__ void init(int nM_, int nN_, int G_, int c_) { nM = nM_; nN = nN_; nwg = nM * nN; G = G_; c = c_; }
    __device__ bool next(int i, int& pm, int& pn) const {
        const long L = (long)i * G + c; if (L >= nwg) return false;
        int wgid = (int)L; { const int q = nwg / NXCD, r = nwg % NXCD, xcd = wgid % NXCD, off = wgid / NXCD; wgid = (xcd < r ? xcd * (q + 1) : r * (q + 1) + (xcd - r) * q) + off; }
        const int nig = WGM * nN, gid = wgid / nig, fm = gid * WGM, gsz = (nM - fm) < WGM ? (nM - fm) : WGM;
        pm = fm + ((wgid % nig) % gsz); pn = (wgid % nig) / gsz; return true;
    }
};

#if !NAIVE_GEMM
template <class Epi, class Sched, bool GATHER, bool SP2 = true, int MIDT = 0, bool FP8 = false, int SCA = 127, int SCB = 127, bool XADD = false>
__device__ __forceinline__ void gemm_phase(LAS unsigned char* lds, const int K, const unsigned lda, const unsigned ldb, const Sched& S, const Epi& E, const bool noepi = false) {
    const int tid = threadIdx.x, wid = __builtin_amdgcn_readfirstlane(tid >> 6), lane = tid & 63, wr = wid >> 2, wc = wid & 3, fr = lane & 15, fq = lane >> 4;
    const int nt = FP8 ? K / 128 : K / BK;
    unsigned voffA[2], voffB[2]; int gC0 = 0;
#pragma unroll
    for (int i = 0; i < 2; ++i) { int R, C; stage_rc(tid * 16 + i * 8192, R, C); const int Rb = (R & ~31) + perm32(R & 31);
        voffA[i] = (unsigned)R * lda + (unsigned)C * 2u; voffB[i] = (unsigned)Rb * ldb + (unsigned)C * 2u; if (i == 0) gC0 = C * 2; }
    const size_t kstep = (size_t)(BK * 2);
    const size_t hstepA = (size_t)HALF * lda, hstepB = (size_t)HALF * ldb;
    const unsigned ldsw = (unsigned)wid * 1024u;
    const int aoff = FP8 ? lds_byte(wr * 64 + fr, fq * 16) : lds_byte(wr * 64 + fr, fq * 8), boff = FP8 ? lds_byte(wc * 32 + fr, fq * 16) : lds_byte(wc * 32 + fr, fq * 8);
    constexpr int PIECE1 = FP8 ? 16 : 1024;
    unsigned gcur[2], gnxt[2];
    int scav = SCA, scbv = SCB;
    if constexpr (FP8) { asm volatile("" : "+v"(scav), "+v"(scbv)); }
#define PG8_SA(b, h) (((b) * 2 + (h)) * HTB)
#define PG8_SB(b, h) ((4 + (b) * 2 + (h)) * HTB)
#define PG8_GLDS(gptr, bufoff, i) __builtin_amdgcn_global_load_lds((const unsigned*)(gptr), (LAS unsigned*)(lds + (bufoff) + ldsw + (i) * 8192), 16, 0, 0)
#define PG8_STAGEB(bufoff, gbase) do { _Pragma("unroll") for (int _i = 0; _i < 2; ++_i) PG8_GLDS((const char*)(gbase) + voffB[0] + (size_t)(_i * 64) * ldb, bufoff, _i); } while (0)
#define PG8_STAGEA(bufoff, gbase, h, nx) do { _Pragma("unroll") for (int _i = 0; _i < 2; ++_i) { \
        const unsigned _pk = (nx) ? gnxt[h] : gcur[h]; const size_t _o = GATHER ? (size_t)((_i ? (_pk >> 16) : (_pk & 0xffffu)) * lda + (unsigned)gC0) : (size_t)voffA[0] + (size_t)(_i * 64) * lda + (size_t)(h) * hstepA; PG8_GLDS((const char*)(gbase) + _o, bufoff, _i); } } while (0)
#define PG8_LD16(off) (*(const LAS v4i_*)(lds + (off)))
#define PG8_LDA(dst, b, h) do { _Pragma("unroll") for (int m = 0; m < 4; ++m) { const v4i_ _lo = PG8_LD16(PG8_SA(b, h) + aoff + m * 2048), _hi = PG8_LD16(PG8_SA(b, h) + aoff + PIECE1 + m * 2048); \
        if constexpr (FP8) dst##8[m] = __builtin_shufflevector(_lo, _hi, 0, 1, 2, 3, 4, 5, 6, 7); else { dst##4[m][0] = _lo; dst##4[m][1] = _hi; } } } while (0)
#define PG8_LDB(dst, b, h) do { _Pragma("unroll") for (int n = 0; n < 2; ++n) { const v4i_ _lo = PG8_LD16(PG8_SB(b, h) + boff + n * 2048), _hi = PG8_LD16(PG8_SB(b, h) + boff + PIECE1 + n * 2048); \
        if constexpr (FP8) dst##8[n] = __builtin_shufflevector(_lo, _hi, 0, 1, 2, 3, 4, 5, 6, 7); else { dst##4[n][0] = _lo; dst##4[n][1] = _hi; } } } while (0)
#define PG8_MMA(ai, bj, At, Bt) do { __builtin_amdgcn_s_setprio(1); _Pragma("unroll") for (int m = 0; m < 4; ++m) _Pragma("unroll") for (int n = 0; n < 2; ++n) { \
        if constexpr (FP8) { asm volatile("v_mfma_scale_f32_16x16x128_f8f6f4 %0, %1, %2, %0, %3, %4 op_sel_hi:[0,0,0]" : "+v"(acc[ai][bj][m][n]) : "v"(Bt##8[n]), "v"(At##8[m]), "v"(scbv), "v"(scav)); } \
        else { _Pragma("unroll") for (int k = 0; k < 2; ++k) acc[ai][bj][m][n] = __builtin_amdgcn_mfma_f32_16x16x32_bf16(__builtin_bit_cast(bf16x8, Bt##4[n][k]), __builtin_bit_cast(bf16x8, At##4[m][k]), acc[ai][bj][m][n], 0, 0, 0); } } \
        __builtin_amdgcn_s_setprio(0); } while (0)
#define PG8_WAIT_V(n) asm volatile("s_waitcnt vmcnt(" #n ")" ::: "memory")
#define PG8_WAIT_L(n) asm volatile("s_waitcnt lgkmcnt(" #n ")" ::: "memory")
#define PG8_BAR __builtin_amdgcn_s_barrier()
#define PG8_SCHED __builtin_amdgcn_sched_barrier(0)
#define PG8_GOFFS(dst, u) do { if constexpr (GATHER) { int _r0, _r1, _c; stage_rc(tid * 16, _r0, _c); stage_rc(tid * 16 + 8192, _r1, _c); _Pragma("unroll") for (int _h = 0; _h < 2; ++_h) dst[_h] = S.row_idx(u, _h * HALF + _r0) | (S.row_idx(u, _h * HALF + _r1) << 16); } } while (0)
    Unit cur, nxt; int ui = 0;
    if (!S.next(0, cur)) return;
    f32x4 acc[2][2][4][2];
#define PG8_ACC_ALL(stmt) do { _Pragma("unroll") for (int a = 0; a < 2; ++a) _Pragma("unroll") for (int b = 0; b < 2; ++b) _Pragma("unroll") for (int m = 0; m < 4; ++m) _Pragma("unroll") for (int n = 0; n < 2; ++n) { stmt; } } while (0)
    PG8_ACC_ALL(acc[a][b][m][n] = ((f32x4){0.f, 0.f, 0.f, 0.f}));
    constexpr int XOFF0 = 8 * HTB, XOFF1 = 8 * HTB + 8192;
#define PG8_XISSUE(r0_, c0_, ai_, it_, bufoff) do { const int i_ = (it_); \
        const char* xg_ = (const char*)E.X + ((size_t)((r0_) + (ai_) * 128 + (i_ >> 2) * 16) * D + (size_t)((c0_) + ((i_ >> 1) & 1) * 128 + (i_ & 1) * 4)) * 4 \
            + (size_t)(unsigned)(((((tid >> 8) * 64) + ((tid >> 4) & 15)) * D + (((tid & 15) ^ ((tid >> 4) & 15)) * 8)) * 4); \
        PG8_GLDS(xg_, bufoff, 0); } while (0)
#define PG8_XCASE(AI_, S_) case S_: acc[AI_][((S_) >> 1) & 1][(S_) >> 2][(S_) & 1] += xv_; break;
#define PG8_XCONSUME(AI_, it_, bufoff) do { const f32x4 xv_ = *(const LAS f32x4*)(lds + (bufoff) + (16 * wr + fr) * 256 + (((4 * wc + fq) ^ fr) * 16)); \
        switch (it_) { PG8_XCASE(AI_, 0) PG8_XCASE(AI_, 1) PG8_XCASE(AI_, 2) PG8_XCASE(AI_, 3) PG8_XCASE(AI_, 4) PG8_XCASE(AI_, 5) PG8_XCASE(AI_, 6) PG8_XCASE(AI_, 7) \
                       PG8_XCASE(AI_, 8) PG8_XCASE(AI_, 9) PG8_XCASE(AI_, 10) PG8_XCASE(AI_, 11) PG8_XCASE(AI_, 12) PG8_XCASE(AI_, 13) PG8_XCASE(AI_, 14) PG8_XCASE(AI_, 15) default: break; } } while (0)
    v8i_ At8[4], B08[2], B18[2]; v4i_ At4[4][2], B04[2][2], B14[2][2];
    const char* cA = cur.A; const char* cB = cur.B;
#pragma unroll
    for (int h = 0; h < 2; ++h) { gcur[h] = 0u; gnxt[h] = 0u; }
    PG8_GOFFS(gcur, cur);
    if constexpr (SP2) {
    PG8_STAGEB(PG8_SB(0, 0), cB); PG8_STAGEB(PG8_SB(0, 1), cB + hstepB); PG8_STAGEA(PG8_SA(0, 0), cA, 0, false); PG8_STAGEA(PG8_SA(0, 1), cA, 1, false);
    if (wr == 1) PG8_BAR;
    PG8_WAIT_V(2); PG8_BAR;
    if constexpr (XADD) PG8_XISSUE(cur.row0, cur.col0, 0, 0, XOFF0);
    PG8_STAGEB(PG8_SB(1, 0), cB + kstep); PG8_STAGEA(PG8_SA(1, 0), cA + kstep, 0, false); PG8_STAGEB(PG8_SB(1, 1), cB + hstepB + kstep);
    if constexpr (XADD) PG8_WAIT_V(7); else PG8_WAIT_V(6);
    PG8_BAR;
    } else {
    PG8_STAGEB(PG8_SB(0, 0), cB); PG8_STAGEA(PG8_SA(0, 0), cA, 0, false); PG8_STAGEB(PG8_SB(0, 1), cB + hstepB); PG8_STAGEA(PG8_SA(0, 1), cA, 1, false);
    if (wr == 1) PG8_BAR;
    PG8_WAIT_V(4); PG8_BAR;
    PG8_STAGEB(PG8_SB(1, 0), cB + kstep); PG8_STAGEA(PG8_SA(1, 0), cA + kstep, 0, false); PG8_STAGEB(PG8_SB(1, 1), cB + hstepB + kstep);
    PG8_WAIT_V(6); PG8_BAR;
    }
    for (;;) {
        const bool has_next = S.next(ui + 1, nxt);
        const char* nA = has_next ? nxt.A : cA; const char* nB = has_next ? nxt.B : cB;
        if constexpr (GATHER) { if (has_next) { PG8_GOFFS(gnxt, nxt); } else {
            gnxt[0] = gcur[0]; gnxt[1] = gcur[1]; } }
#pragma unroll 1
        for (int t = 0; t < nt; t += 2) {
            const bool last = (t == nt - 2);
            if constexpr (MIDT > 0) { if (t == MIDT) E.mid(acc, cur, wr, wc, fr, fq); }
            const char* a1 = cA + (size_t)(t + 1) * kstep;
            const char* a2 = last ? nA : cA + (size_t)(t + 2) * kstep; const char* b2 = last ? nB : cB + (size_t)(t + 2) * kstep;
            const char* a3 = a2 + kstep; const char* b3 = b2 + kstep;
            if constexpr (SP2) {
            if constexpr (XADD) PG8_XISSUE(cur.row0, cur.col0, 1, t >> 1, XOFF1);
            PG8_LDB(B0, 0, 0); PG8_LDB(B1, 0, 1); PG8_SCHED; PG8_LDA(At, 0, 0); PG8_STAGEA(PG8_SA(1, 1), a1, 1, false);
            if constexpr (XADD) PG8_WAIT_V(10); else PG8_WAIT_V(8);
            PG8_WAIT_L(0); PG8_BAR; PG8_MMA(0, 0, At, B0); PG8_MMA(0, 1, At, B1); PG8_BAR; PG8_SCHED;
            PG8_LDA(At, 0, 1); PG8_STAGEB(PG8_SB(0, 0), b2); PG8_STAGEB(PG8_SB(0, 1), b2 + hstepB); PG8_STAGEA(PG8_SA(0, 0), a2, 0, last);
            if constexpr (XADD) PG8_WAIT_V(9); else PG8_WAIT_V(8);
            PG8_WAIT_L(0); PG8_BAR; PG8_MMA(1, 0, At, B0); PG8_MMA(1, 1, At, B1); PG8_BAR; PG8_SCHED;
            if constexpr (XADD) { PG8_XCONSUME(0, t >> 1, XOFF0); PG8_SCHED; }
            PG8_LDB(B0, 1, 0); PG8_LDB(B1, 1, 1); PG8_SCHED; PG8_LDA(At, 1, 0); PG8_STAGEA(PG8_SA(0, 1), a2, 1, last);
            PG8_WAIT_V(8); PG8_WAIT_L(0); PG8_BAR; PG8_MMA(0, 0, At, B0); PG8_MMA(0, 1, At, B1); PG8_BAR; PG8_SCHED;
            if constexpr (XADD) { PG8_XCONSUME(1, t >> 1, XOFF1); PG8_SCHED;
                const bool nn = last && has_next; PG8_XISSUE(nn ? nxt.row0 : cur.row0, nn ? nxt.col0 : cur.col0, 0, last ? 0 : (t >> 1) + 1, XOFF0); }
            PG8_LDA(At, 1, 1); PG8_STAGEB(PG8_SB(1, 0), b3); PG8_STAGEB(PG8_SB(1, 1), b3 + hstepB); PG8_STAGEA(PG8_SA(1, 0), a3, 0, last);
            if constexpr (XADD) PG8_WAIT_V(9); else PG8_WAIT_V(8);
            PG8_WAIT_L(0); PG8_BAR; PG8_MMA(1, 0, At, B0); PG8_MMA(1, 1, At, B1); PG8_BAR; PG8_SCHED;
            } else {
            PG8_LDB(B0, 0, 0); PG8_SCHED; PG8_LDA(At, 0, 0); PG8_STAGEA(PG8_SA(1, 1), a1, 1, false);
            PG8_WAIT_L(8); PG8_BAR; PG8_WAIT_L(0); PG8_MMA(0, 0, At, B0); PG8_BAR; PG8_SCHED;
            PG8_LDB(B1, 0, 1); PG8_STAGEB(PG8_SB(0, 0), b2);
            PG8_BAR; PG8_WAIT_L(0); PG8_MMA(0, 1, At, B1); PG8_BAR;
            PG8_LDA(At, 0, 1); PG8_STAGEA(PG8_SA(0, 0), a2, 0, last);
            PG8_BAR; PG8_WAIT_L(0); PG8_MMA(1, 0, At, B0); PG8_BAR; PG8_SCHED;
            PG8_STAGEB(PG8_SB(0, 1), b2 + hstepB);
            PG8_WAIT_V(6); PG8_BAR; PG8_MMA(1, 1, At, B1); PG8_BAR;
            PG8_LDB(B0, 1, 0); PG8_SCHED; PG8_LDA(At, 1, 0); PG8_STAGEA(PG8_SA(0, 1), a2, 1, last);
            PG8_WAIT_L(8); PG8_BAR; PG8_WAIT_L(0); PG8_MMA(0, 0, At, B0); PG8_BAR; PG8_SCHED;
            PG8_LDB(B1, 1, 1); PG8_STAGEB(PG8_SB(1, 0), b3);
            PG8_BAR; PG8_WAIT_L(0); PG8_MMA(0, 1, At, B1); PG8_BAR;
            PG8_LDA(At, 1, 1); PG8_STAGEA(PG8_SA(1, 0), a3, 0, last);
            PG8_BAR; PG8_WAIT_L(0); PG8_MMA(1, 0, At, B0); PG8_BAR; PG8_SCHED;
            PG8_STAGEB(PG8_SB(1, 1), b3 + hstepB);
            PG8_WAIT_V(6); PG8_BAR; PG8_MMA(1, 1, At, B1); PG8_BAR;
            }
        }
        if constexpr (FP8) { asm volatile("s_nop 15\n\ts_nop 15" ::: "memory"); }
        if (wr == 0) PG8_BAR;
        if (!noepi) E(acc, cur, wr, wc, fr, fq);
        else {
#pragma unroll
            for (int a = 0; a < 2; ++a)
#pragma unroll
                for (int b = 0; b < 2; ++b)
#pragma unroll
                    for (int m = 0; m < 4; ++m)
#pragma unroll
                        for (int n = 0; n < 2; ++n) asm volatile("" :: "v"(acc[a][b][m][n])); }
        if (!has_next) break;
        PG8_ACC_ALL(acc[a][b][m][n] = ((f32x4){0.f, 0.f, 0.f, 0.f}));
        cur = nxt; cA = nA; cB = nB; ++ui;
        if constexpr (GATHER) {
            gcur[0] = gnxt[0]; gcur[1] = gnxt[1]; }
        if (wr == 1) PG8_BAR;
    }
    PG8_WAIT_V(0);
    PG8_BAR;
#undef PG8_SA
#undef PG8_SB
#undef PG8_GLDS
#undef PG8_STAGEA
#undef PG8_STAGEB
#undef PG8_LDA
#undef PG8_LDB
#undef PG8_MMA
#undef PG8_WAIT_V
#undef PG8_WAIT_L
#undef PG8_BAR
#undef PG8_SCHED
#undef PG8_GOFFS
#undef PG8_ACC_ALL
#undef PG8_XISSUE
#undef PG8_XCASE
#undef PG8_XCONSUME
}
#else
template <class Epi, class Sched, bool GATHER>
__device__ __forceinline__ void gemm_phase(LAS unsigned char* lds, const int K, const unsigned lda, const unsigned ldb, const Sched& S, const Epi& E, const bool noepi = false) {
    const int tid = threadIdx.x, wid = __builtin_amdgcn_readfirstlane(tid >> 6), lane = tid & 63, wr = wid >> 2, wc = wid & 3, fr = lane & 15, fq = lane >> 4;
    Unit cur;
    for (int ui = 0; S.next(ui, cur); ++ui) {
        f32x4 acc[2][2][4][2];
#pragma unroll
        for (int a = 0; a < 2; ++a)
#pragma unroll
            for (int b = 0; b < 2; ++b)
#pragma unroll
                for (int m = 0; m < 4; ++m)
#pragma unroll
                    for (int n = 0; n < 2; ++n) acc[a][b][m][n] = (f32x4){0.f, 0.f, 0.f, 0.f};
        for (int k = 0; k < K; k += 8) {
            v4u av[2][4];
#pragma unroll
            for (int ai = 0; ai < 2; ++ai)
#pragma unroll
                for (int m = 0; m < 4; ++m) { const int r = ai * 128 + wr * 64 + m * 16 + fr; const size_t ro = GATHER ? (size_t)S.row_idx(cur, r) * lda : (size_t)r * lda; av[ai][m] = *(const v4u*)(cur.A + ro + (size_t)k * 2); }
#pragma unroll
            for (int bj = 0; bj < 2; ++bj)
#pragma unroll
                for (int n = 0; n < 2; ++n)
#pragma unroll
                    for (int j = 0; j < 4; ++j) { const int c = bj * 128 + wc * 32 + 8 * fq + 4 * n + j; const v4u bv = *(const v4u*)(cur.B + (size_t)c * ldb + (size_t)k * 2);
#pragma unroll
                        for (int ai = 0; ai < 2; ++ai)
#pragma unroll
                            for (int m = 0; m < 4; ++m) { const v4u a = av[ai][m]; float s = acc[ai][bj][m][n][j];
                                s += bflo(a.x) * bflo(bv.x) + bfhi(a.x) * bfhi(bv.x); s += bflo(a.y) * bflo(bv.y) + bfhi(a.y) * bfhi(bv.y);
                                s += bflo(a.z) * bflo(bv.z) + bfhi(a.z) * bfhi(bv.z); s += bflo(a.w) * bflo(bv.w) + bfhi(a.w) * bfhi(bv.w); acc[ai][bj][m][n][j] = s; } }
        }
        E(acc, cur, wr, wc, fr, fq);
    }
    __syncthreads();
}
#endif
}
using pg8::Unit;

#define XB_TMO      128
#define XB_XCNT(j)  (256  + 64 * (j))
#define XB_XSUB(j)  (1280 + 64 * (j))
#define XB_XGEN(j)  (2304 + 64 * (j))
#define XB_TOP      3328
#define XB_TOPGEN   3392
#define XCD_BAR_WORDS 3456
#define XB_SPIN_CAP (1u << 22)
__device__ __forceinline__ unsigned xb_ld(unsigned* p)              { return __hip_atomic_load(p, __ATOMIC_RELAXED, __HIP_MEMORY_SCOPE_AGENT); }
__device__ __forceinline__ unsigned xb_add(unsigned* p, unsigned v) { return __hip_atomic_fetch_add(p, v, __ATOMIC_RELAXED, __HIP_MEMORY_SCOPE_AGENT); }
__device__ __forceinline__ unsigned xb_xcc_id() { return (unsigned)__builtin_amdgcn_s_getreg((3 << 11) | 20) & 0xFu; }
#define XB_SPIN(cond, bar) do { unsigned _sp = 0; while (cond) { __builtin_amdgcn_s_sleep(1); \
    if ((++_sp & 255u) == 0u) { if (xb_ld(&(bar)[XB_TMO])) break; if (_sp > XB_SPIN_CAP) { atomicAdd(&(bar)[XB_TMO], 1u); break; } } } } while (0)
struct XcdBarrier { unsigned* bar; unsigned x; volatile LAS unsigned* st; };
__device__ __forceinline__ XcdBarrier xcd_barrier_post(unsigned* bar, volatile LAS unsigned* st) {
    XcdBarrier b; b.bar = bar; b.x = xb_xcc_id(); b.st = st;
    if (threadIdx.x == 0) (void)xb_add(&bar[XB_XCNT(b.x)], 1u);
    return b;
}
__device__ __forceinline__ void xcd_barrier_complete(unsigned* bar, unsigned x, unsigned& nloc, unsigned& nx) {
    const unsigned G = gridDim.x * gridDim.y * gridDim.z;
    unsigned sum, cnt, mine, sp = 0u;
    for (;;) {
        sum = 0u; cnt = 0u; mine = 0u;
#pragma unroll
        for (unsigned j = 0; j < 16; ++j) { const unsigned c = xb_ld(&bar[XB_XCNT(j)]); sum += c; cnt += (c > 0u) ? 1u : 0u; mine = (j == x) ? c : mine; }
        if (sum == G) break;
        __builtin_amdgcn_s_sleep(1);
        if ((++sp & 255u) == 0u) { if (xb_ld(&bar[XB_TMO])) break; if (sp > XB_SPIN_CAP) { atomicAdd(&bar[XB_TMO], 1u); break; } }
    }
    nloc = mine > 0u ? mine : 1u; nx = cnt > 0u ? cnt : 1u;
}
__device__ __forceinline__ void xcd_barrier(const XcdBarrier& b) {
    asm volatile("s_waitcnt vmcnt(0)" ::: "memory");
    __syncthreads();
    if (threadIdx.x == 0) {
        unsigned* bar = b.bar;
        __builtin_amdgcn_s_waitcnt(0);
        unsigned nloc = b.st[0], nx = b.st[1];
        if (nloc == 0u) { xcd_barrier_complete(bar, b.x, nloc, nx); b.st[0] = nloc; b.st[1] = nx; }
        const unsigned old = xb_add(&bar[XB_XSUB(b.x)], 1u);
        const unsigned gen = old / nloc;
        if (old + 1u == (gen + 1u) * nloc) {
            __builtin_amdgcn_fence(__ATOMIC_RELEASE, "agent");
            asm volatile("s_waitcnt vmcnt(0)" ::: "memory");
            const unsigned og = xb_add(&bar[XB_TOP], 1u);
            const unsigned tg = og / nx;
            if (og + 1u == (tg + 1u) * nx) xb_add(&bar[XB_TOPGEN], 1u);
            else XB_SPIN(xb_ld(&bar[XB_TOPGEN]) == tg, bar);
            __builtin_amdgcn_fence(__ATOMIC_ACQUIRE, "agent");
            xb_add(&bar[XB_XGEN(b.x)], 1u);
            asm volatile("s_waitcnt vmcnt(0)" ::: "memory");
        } else {
            XB_SPIN(xb_ld(&bar[XB_XGEN(b.x)]) == gen, bar);
            __builtin_amdgcn_fence(__ATOMIC_ACQUIRE, "agent");
            asm volatile("s_waitcnt vmcnt(0)" ::: "memory");
        }
    }
    __syncthreads();
}

struct Args { const float* in[31]; float* out; unsigned char* ws; unsigned mask; int variant, bar_region, pad; };
enum { I_X = 0, I_NMW, I_WIN, I_CONVW, I_CONVB, I_DTB, I_ALOG, I_DSSD, I_NSW, I_WAUP, I_LRE, I_LIM, I_LOGDT, I_BRE, I_BIM, I_CRE, I_CIM, I_S5D,
       I_WGLU, I_WBUP, I_GATEB, I_WOUT, I_NFW, I_WRG, I_BRG, I_WRE, I_BRE2, I_WEG, I_WEU, I_WED, I_NFINAL };
struct Ctx { LAS unsigned char* lds; volatile LAS unsigned* ctl; int tid, lane, wave, vcu, G; };
constexpr int PTAB_OFF = LDSCTL_OFF + 1024;
__device__ __forceinline__ unsigned long long ptab_get(LAS unsigned char* lds, int i) {
    const LAS unsigned* p = (const LAS unsigned*)(lds + PTAB_OFF + 8 * i); const unsigned lo = __builtin_amdgcn_readfirstlane(p[0]), hi = __builtin_amdgcn_readfirstlane(p[1]); return ((unsigned long long)hi << 32) | lo; }
#define PIN(i) ((const float*)ptab_get(F.lds, (i)))
#define POUT ((float*)ptab_get(F.lds, 31))
#define PWS ((unsigned char*)ptab_get(F.lds, 32))
#define PING(i) ((const float*)(const GAS float*)ptab_get(F.lds, (i)))
#define PWSG ((unsigned char*)(GAS unsigned char*)ptab_get(F.lds, 32))

struct TJob { const float* src; unsigned char* dst; int N, K; float scale; int fp8; };
__device__ __forceinline__ void tj_load(const TJob& j, int lane, f32x4 (&v)[8]) {
    const float* p = j.src + (size_t)(lane >> 3) * j.N + (lane & 7) * 4;
#pragma unroll
    for (int i = 0; i < 8; ++i) v[i] = __builtin_nontemporal_load((const f32x4*)(p + (size_t)(8 * i) * j.N));
}
__device__ __forceinline__ void tj_store(const TJob& j, int lane, const f32x4 (&v)[8], LAS float* scr) {
    LAS float* w = scr + (lane >> 3) * 33 + (lane & 7) * 4;
#pragma unroll
    for (int i = 0; i < 8; ++i) { w[i * 264 + 0] = v[i][0]; w[i * 264 + 1] = v[i][1]; w[i * 264 + 2] = v[i][2]; w[i * 264 + 3] = v[i][3]; }
    LDS_WAIT(); asm volatile("" ::: "memory");
    const int c = lane & 7;
#pragma unroll
    for (int jj = 0; jj < 4; ++jj) { const int n = (lane >> 3) + 8 * jj; const LAS float* s = scr + (8 * c) * 33 + n;
        if (j.fp8) { const float q = j.scale; v2u o; o.x = pk4_fp8(s[0 * 33] * q, s[1 * 33] * q, s[2 * 33] * q, s[3 * 33] * q); o.y = pk4_fp8(s[4 * 33] * q, s[5 * 33] * q, s[6 * 33] * q, s[7 * 33] * q);
            *(v2u*)(j.dst + (size_t)n * j.K + 8 * c) = o; }
        else { v4u o; o.x = pk2(s[0 * 33], s[1 * 33]); o.y = pk2(s[2 * 33], s[3 * 33]); o.z = pk2(s[4 * 33], s[5 * 33]); o.w = pk2(s[6 * 33], s[7 * 33]);
            *(v4u*)(j.dst + ((size_t)n * j.K + 8 * c) * 2) = o; } }
    LDS_WAIT(); asm volatile("" ::: "memory");
}
template <class Dec>
__device__ __forceinline__ void transpose_jobs(int first, int stride, int nitems, const Dec dec, LAS float* scr, int lane) {
    int it = first; if (it >= nitems) return;
    TJob cur; f32x4 v[8]; dec(it, cur); tj_load(cur, lane, v);
    for (;;) { const int nx = it + stride; const bool hn = nx < nitems; TJob nj = cur; f32x4 nv[8];
        if (hn) { dec(nx, nj); tj_load(nj, lane, nv); }
        tj_store(cur, lane, v, scr);
        if (!hn) break;
        cur = nj; it = nx;
#pragma unroll
        for (int i = 0; i < 8; ++i) v[i] = nv[i]; }
}
struct DecP0 {
    static constexpr int I_IN = 32 * (IN_DIM / 32), I_A = 32 * 64, I_G = 16 * 32, I_B = 16 * 64, I_O = 32 * 64, NITEMS = I_IN + I_A + I_G + I_B + I_O;
    const float *win, *wa, *wg, *wb, *wo; unsigned char* ws;
    __device__ __forceinline__ void operator()(int r, TJob& j) const {
        if (r < I_IN) { const int nb = r % (IN_DIM / 32), kb = r / (IN_DIM / 32); const int dr = 32 * nb; int sc; if (dr < 6144) sc = dr; else if (dr < 7168) sc = dr + 32; else if (dr < 11264) { const int rel = dr - 7168, within = rel & 255; sc = 7200 + (within >> 7) * 2048 + (rel >> 8) * 128 + (within & 127); } else sc = dr - 11264 + 6144;
            j.src = win + (size_t)(64 * kb) * IN_DIM + sc; if (dr >= 7168 && dr < 11264) { j.dst = ws + WS_WIN + (size_t)7168 * D * 2 + (size_t)(dr - 7168) * D + 64 * kb; j.scale = 32.f; j.fp8 = 1; } else { j.dst = ws + WS_WIN + ((size_t)dr * D + 64 * kb) * 2; j.scale = 1.f; j.fp8 = 0; } j.N = IN_DIM; j.K = D; return; } r -= I_IN;
        if (r < I_A) { j.src = wa + (size_t)(64 * (r / 64)) * D + 32 * (r % 64); j.dst = ws + WS_WAB + ((size_t)(32 * (r % 64)) * YVP + 64 * (r / 64)) * 2; j.scale = 1.f; j.fp8 = 0; j.N = D; j.K = YVP; return; } r -= I_A;
        if (r < I_G) { j.src = wg + (size_t)(64 * (r / 32)) * S5W + 32 * (r % 32); j.dst = ws + WS_WGLU + ((size_t)(32 * (r % 32)) * S5W + 64 * (r / 32)) * 2; j.scale = 1.f; j.fp8 = 0; j.N = S5W; j.K = S5W; return; } r -= I_G;
        if (r < I_B) { j.src = wb + (size_t)(64 * (r / 64)) * D + 32 * (r % 64); j.dst = ws + WS_WAB + ((size_t)(32 * (r % 64)) * YVP + 2048 + 64 * (r / 64)) * 2; j.scale = 1.f; j.fp8 = 0; j.N = D; j.K = YVP; return; } r -= I_B;
        j.src = wo + (size_t)(64 * (r / 64)) * D + 32 * (r % 64); j.dst = ws + WS_WOUT + ((size_t)(32 * (r % 64)) * D + 64 * (r / 64)) * 2; j.scale = 1.f; j.fp8 = 0; j.N = D; j.K = D; }
};
constexpr float WGU_SCALE = 64.f, WD_SCALE = 32.f, HID_SCALE = 4.f;
struct DecExp {
    static constexpr int I_GU = NE * 32 * 16, NITEMS = 3 * I_GU;
    const float *wg, *wu, *wd; unsigned char* ws;
    __device__ __forceinline__ void operator()(int it, TJob& j) const {
        if (it < 2 * I_GU) { const int which = it / I_GU, r = it % I_GU, e = r / 512, q = r % 512, kb = ((q >> 5) << 1) | (q & 1), nb = (q >> 1) & 15; const int j0 = 32 * nb;
            const int drow = (j0 >> 7) * 256 + which * 128 + (j0 & 127);
            j.src = (which ? wu : wg) + (size_t)e * D * FF + (size_t)(64 * kb) * FF + j0; j.dst = ws + WS_ST + ((size_t)e * 1024 + drow) * D + 64 * kb; j.N = FF; j.K = D; j.scale = WGU_SCALE; j.fp8 = 1; }
        else { const int r = it - 2 * I_GU, e = r / 512, q = r % 512, kb = ((q >> 7) << 1) | (q & 1), nb = (q >> 1) & 63;
            j.src = wd + (size_t)e * FF * D + (size_t)(64 * kb) * D + 32 * nb; j.dst = ws + WS_YV + ((size_t)e * D + 32 * nb) * FF + 64 * kb; j.N = D; j.K = FF; j.scale = WD_SCALE; j.fp8 = 1; }
    }
};
__device__ __forceinline__ void rms_row_to_bf16(const f32x4 (&v)[8], const f32x4 (&gw)[8]  , bf16* orow, unsigned char* orow8, int lane) {
    float s = 0.f;
#pragma unroll
    for (int j = 0; j < 8; ++j) s += (v[j].x * v[j].x + v[j].y * v[j].y) + (v[j].z * v[j].z + v[j].w * v[j].w);
    const float rstd = 1.0f / sqrtf(wave_sum(s) * (1.f / D) + EPS);
    v2u* o8 = (v2u*)orow + lane; unsigned* q8 = (unsigned*)orow8 + lane;
#pragma unroll
    for (int j = 0; j < 8; ++j) { const f32x4 g = gw[j]; const f32x4 hv = {v[j].x * rstd * g.x, v[j].y * rstd * g.y, v[j].z * rstd * g.z, v[j].w * rstd * g.w};
        v2u o; o.x = pk2(hv.x, hv.y); o.y = pk2(hv.z, hv.w); o8[64 * j] = o; q8[64 * j] = pk4_fp8(hv.x, hv.y, hv.z, hv.w); }
}

__device__ __forceinline__ void s5_mats_group(const Args& a, const Ctx& F, int g) {
    LAS float* L = (LAS float*)F.lds;
    LAS float* apr = L; LAS float* api = L + 17 * 64; LAS float* bbr = L + 2 * 17 * 64; LAS float* bbi = bbr + 1024; LAS float* cr = bbi + 1024; LAS float* ci = cr + 1024; LAS float* kt = ci + 1024;
    LAS float* cof = kt + 4096;
    const float dt = expf(PIN(I_LOGDT)[g]);
    if (F.tid < 64) { const int n = F.tid; const float lr = PIN(I_LRE)[g * 64 + n], li = PIN(I_LIM)[g * 64 + n];
        for (int m = 0; m <= 16; ++m) { const float mag = expf((float)m * lr * dt), ang = (float)m * li * dt; apr[m * 64 + n] = mag * cosf(ang); api[m * 64 + n] = mag * sinf(ang); }
        const float ar = expf(lr * dt) * cosf(li * dt), ai = expf(lr * dt) * sinf(li * dt);
        const float den = lr * lr + li * li, nr = ar - 1.0f, ni = ai;
        cof[n] = (nr * lr + ni * li) / den; cof[64 + n] = (ni * lr - nr * li) / den; }
    for (int i = F.tid; i < 1024; i += 512) { const int co = i >> 6, n = i & 63; cr[i] = PIN(I_CRE)[(size_t)g * 1024 + co * 64 + n]; ci[i] = PIN(I_CIM)[(size_t)g * 1024 + co * 64 + n]; }
    __syncthreads();
    for (int i = F.tid; i < 1024; i += 512) { const int n = i >> 4; const float br = PIN(I_BRE)[(size_t)g * 1024 + i], bi = PIN(I_BIM)[(size_t)g * 1024 + i]; const float c0 = cof[n], c1 = cof[64 + n];
        bbr[i] = c0 * br - c1 * bi; bbi[i] = c0 * bi + c1 * br; }
    __syncthreads();
    for (int i = F.tid; i < 4096; i += 512) { const int lag = i >> 8, co = (i >> 4) & 15, cin = i & 15; float s = 0.f;
        for (int n = 0; n < 64; ++n) { const float wr_ = apr[lag * 64 + n] * bbr[n * 16 + cin] - api[lag * 64 + n] * bbi[n * 16 + cin], wi_ = apr[lag * 64 + n] * bbi[n * 16 + cin] + api[lag * 64 + n] * bbr[n * 16 + cin];
            s += cr[co * 64 + n] * wr_ - ci[co * 64 + n] * wi_; }
        kt[i] = s; }
    __syncthreads();
    bf16* TW = (bf16*)(PWS + WS_S5TW) + (size_t)g * 256 * APK;
    for (int i = F.tid; i < 256 * APK / 2; i += 512) { const int row = (2 * i) / APK, k0 = (2 * i) % APK; const int l = row >> 4, co = row & 15; float v[2];
#pragma unroll
        for (int q = 0; q < 2; ++q) { const int k = k0 + q; float val;
            if (k < 256) { const int j = k >> 4, cin = k & 15; val = (l >= j) ? kt[(l - j) * 256 + co * 16 + cin] : 0.f; if (l == j && cin == co) val += PIN(I_S5D)[g * 16 + co]; }
            else if (k < 320) { const int n = k - 256; val = cr[co * 64 + n] * apr[(l + 1) * 64 + n] - ci[co * 64 + n] * api[(l + 1) * 64 + n]; }
            else { const int n = k - 320; val = -(cr[co * 64 + n] * api[(l + 1) * 64 + n] + ci[co * 64 + n] * apr[(l + 1) * 64 + n]); }
            v[q] = val; }
        *(unsigned*)(TW + 2 * i) = pk2(v[0], v[1]); }
    bf16* WS = (bf16*)(PWS + WS_S5WS) + (size_t)g * 256 * 256;
    for (int i = F.tid; i < 256 * 256 / 2; i += 512) { const int row = (2 * i) >> 8, k0 = (2 * i) & 255; float v[2];
#pragma unroll
        for (int q = 0; q < 2; ++q) { const int k = k0 + q, j = k >> 4, cin = k & 15; float val = 0.f;
            if (row < 64) { const int n = row; val = apr[(15 - j) * 64 + n] * bbr[n * 16 + cin] - api[(15 - j) * 64 + n] * bbi[n * 16 + cin]; }
            else if (row < 128) { const int n = row - 64; val = apr[(15 - j) * 64 + n] * bbi[n * 16 + cin] + api[(15 - j) * 64 + n] * bbr[n * 16 + cin]; }
            v[q] = val; }
        *(unsigned*)(WS + 2 * i) = pk2(v[0], v[1]); }
    __syncthreads();
}

__device__ __forceinline__ void p0_prologue(const Args& a, const Ctx& F) {
    if (F.vcu < S5G) s5_mats_group(a, F, F.vcu);
    LAS float* scr = (LAS float*)(F.lds + F.wave * 16384);
    const int gw = F.vcu * NWAVES + F.wave, NGW = F.G * NWAVES;
    { DecP0 dec{PING(I_WIN), PING(I_WAUP), PING(I_WGLU), PING(I_WBUP), PING(I_WOUT), PWSG};
      transpose_jobs<DecP0>(gw, NGW, DecP0::NITEMS, dec, scr, F.lane); }
    {
        unsigned* gctr = (unsigned*)(PWS + WS_CTL) + CW_CNT + a.bar_region * 4096 + 2624; const float* X = PIN(I_X); const float* nmw = PIN(I_NMW); unsigned char* wsb = PWS;
        unsigned bv = 0u; if (F.lane == 0) bv = __hip_atomic_fetch_add(gctr, 1u, __ATOMIC_RELAXED, __HIP_MEMORY_SCOPE_AGENT);
        int b = (int)__builtin_amdgcn_readfirstlane(bv);
        f32x4 gw[8];
#pragma unroll
        for (int j = 0; j < 8; ++j) gw[j] = ((const f32x4*)nmw)[F.lane + 64 * j];
        while (b < T / 8) { unsigned nv = 0u; if (F.lane == 0) nv = __hip_atomic_fetch_add(gctr, 1u, __ATOMIC_RELAXED, __HIP_MEMORY_SCOPE_AGENT);
            f32x4 v[8];
#pragma unroll
            for (int j = 0; j < 8; ++j) v[j] = ((const f32x4*)(X + (size_t)(8 * b) * D))[F.lane + 64 * j];
#pragma unroll 1
            for (int mi = 0; mi < 8; ++mi) { const int m = 8 * b + mi; f32x4 vn[8];
                const int mn = (mi + 1 < 8) ? m + 1 : m;
#pragma unroll
                for (int j = 0; j < 8; ++j) vn[j] = ((const f32x4*)(X + (size_t)mn * D))[F.lane + 64 * j];
                rms_row_to_bf16(v, gw, (bf16*)(wsb + WS_H) + (size_t)m * D, wsb + WS_H8 + (size_t)m * D, F.lane);
#pragma unroll
                for (int j = 0; j < 8; ++j) v[j] = vn[j]; }
            b = (int)__builtin_amdgcn_readfirstlane(nv); } }
    for (int i = gw * 64 + F.lane; i < 48 * D; i += NGW * 64) { const int col = i / D, k = i % D; float w = 0.f;
        if (col < 4) w = PIN(I_WRG)[k * 4 + col]; else if (col >= 16) w = PIN(I_WRE)[k * 32 + (col - 16)];
        const unsigned hi = f2bf(w); const float lo = w - bf2f((bf16)hi);
        ((bf16*)(PWS + WS_RT))[i] = (bf16)hi; ((bf16*)(PWS + WS_RT))[48 * D + i] = (bf16)f2bf(lo); }
}

struct SchedDense {
    pg8::StaticOrder so; const char* A; const char* B; unsigned lda, ldb;
    __device__ __forceinline__ bool next(int i, Unit& u) const { int pm, pn; if (!so.next(i, pm, pn)) return false;
        u.A = A + (size_t)pm * 256 * lda; u.B = B + (size_t)pn * 256 * ldb; u.row0 = pm * 256; u.col0 = pn * 256; u.e = 0; u.nvalid = 256; return true; }
    __device__ __forceinline__ unsigned row_idx(const Unit&, int) const { return 0u; }
};
struct SchedS5 {
    const char* A; const char* B; unsigned ldb; int G, c;
    __device__ __forceinline__ bool next(int i, Unit& u) const { const int idx = i * G + c; if (idx >= 256) return false; const int g = idx >> 2, mt = idx & 3;
        u.A = A + (size_t)(g * 1024 + mt * 256) * (APK * 2); u.B = B + (size_t)g * 256 * ldb; u.row0 = g * 1024 + mt * 256; u.col0 = 0; u.e = g; u.nvalid = 256; return true; }
    __device__ __forceinline__ unsigned row_idx(const Unit&, int) const { return 0u; }
};
struct SchedMoE {
    volatile LAS unsigned* ctl; const char* A; const char* B; const unsigned* list_tok; unsigned lda; size_t bstride_e; unsigned ldb; int NN, G, c; bool gather;
    __device__ __forceinline__ bool next(int i, Unit& u) const { const int idx = i * G + c; const int NT = (int)ctl[72]; if (idx >= NT * NN) return false;
        const int mtg = idx / NN, pn = idx % NN; const int e = (int)ctl[80 + mtg]; const int rb = (int)ctl[40 + e]; const int mtl = mtg - (rb >> 8); const int cnt = (int)ctl[8 + e];
        u.e = e; u.nvalid = cnt - mtl * 256; u.slot0 = mtl * 256; u.B = B + (size_t)e * bstride_e + (size_t)pn * 256 * ldb;
        if (gather) { u.A = A; u.row0 = rb + mtl * 256; u.col0 = pn * 128; }
        else { u.A = A + (size_t)(rb + mtl * 256) * lda; u.row0 = rb + mtl * 256; u.col0 = pn * 256; }
        return true; }
    __device__ __forceinline__ unsigned row_idx(const Unit& u, int r) const {
        const unsigned tokk = (r < u.nvalid) ? list_tok[(size_t)u.e * CAPL + u.slot0 + r] : 0u; return tokk >> 1; }
};

#define EPI_BEGIN _Pragma("unroll") for (int ai = 0; ai < 2; ++ai) _Pragma("unroll") for (int m = 0; m < 4; ++m) { const int r = ai * 128 + wr * 64 + m * 16 + fr; \
    _Pragma("unroll") for (int bj = 0; bj < 2; ++bj) { const int c = bj * 128 + wc * 32 + 8 * fq; const f32x4 v0 = acc[ai][bj][m][0], v1 = acc[ai][bj][m][1];
#define EPI_END } }
__device__ __forceinline__ v4u pack8(const f32x4 a, const f32x4 b) { v4u w; w.x = pk2(a[0], a[1]); w.y = pk2(a[2], a[3]); w.z = pk2(b[0], b[1]); w.w = pk2(b[2], b[3]); return w; }
__device__ __forceinline__ void unpack8(const v4u w, float (&f)[8]) { f[0] = bflo(w.x); f[1] = bfhi(w.x); f[2] = bflo(w.y); f[3] = bfhi(w.y); f[4] = bflo(w.z); f[5] = bfhi(w.z); f[6] = bflo(w.w); f[7] = bfhi(w.w); }

struct Epi1a {
    bf16* ZS; bf16* XBC; bf16* AP;
    __device__ __forceinline__ void operator()(const f32x4 (&acc)[2][2][4][2], const Unit& u, int wr, int wc, int fr, int fq) const {
        EPI_BEGIN  const int row = u.row0 + r, col = u.col0 + c;
            if (col < 2048) { f32x4 a = v0, b = v1;
#pragma unroll
                for (int j = 0; j < 4; ++j) { a[j] = siluf_(a[j]); b[j] = siluf_(b[j]); }
                *(v4u*)(ZS + (size_t)row * YVP + col) = pack8(a, b); }
            else if (col < 6144) { *(v4u*)(XBC + (size_t)row * XBCD + (col - 2048)) = pack8(v0, v1); }
            else { const int cc = col - 6144, g = cc >> 4, ci0 = cc & 15; *(v4u*)(AP + ((size_t)(g * S5NC + (row >> 4)) * APK + (row & 15) * 16 + ci0)) = pack8(v0, v1); }  EPI_END
    }
};
struct EpiS5a {
    float* SL;
    __device__ __forceinline__ void operator()(const f32x4 (&acc)[2][2][4][2], const Unit& u, int wr, int wc, int fr, int fq) const {
        EPI_BEGIN  if (bj == 0) { float* p = SL + (size_t)(u.row0 + r) * 128 + c; *(f32x4*)p = v0; *(f32x4*)(p + 4) = v1; }  EPI_END
    }
};
struct EpiS5b {
    bf16* V;
    __device__ __forceinline__ void operator()(const f32x4 (&acc)[2][2][4][2], const Unit& u, int wr, int wc, int fr, int fq) const {
        EPI_BEGIN  const int chunk = (u.row0 + r) & 1023, g = u.e, l = c >> 4, co0 = c & 15; f32x4 a = v0, b = v1;
#pragma unroll
            for (int j = 0; j < 4; ++j) { a[j] = gelu_tanh(a[j]); b[j] = gelu_tanh(b[j]); }
            *(v4u*)(V + (size_t)(chunk * 16 + l) * S5W + g * 16 + co0) = pack8(a, b);  EPI_END
    }
};
struct Epi1b {
    bf16* Gt; const float* gb; const float* ssq;
    __device__ __forceinline__ void operator()(const f32x4 (&acc)[2][2][4][2], const Unit& u, int wr, int wc, int fr, int fq) const {
        const int j0 = (u.col0 >> 1) + wc * 32 + 8 * fq;
        const f32x4 ba0 = *(const f32x4*)(gb + j0), ba1 = *(const f32x4*)(gb + j0 + 4), bb0 = *(const f32x4*)(gb + 2048 + j0), bb1 = *(const f32x4*)(gb + 2048 + j0 + 4);
#pragma unroll
        for (int ai = 0; ai < 2; ++ai) { f32x4 sq0[4], sq1[4];
#pragma unroll
            for (int m = 0; m < 4; ++m) { const int row = u.row0 + ai * 128 + wr * 64 + m * 16 + fr; sq0[m] = *(const f32x4*)(ssq + (size_t)row * 8); sq1[m] = *(const f32x4*)(ssq + (size_t)row * 8 + 4); }
#pragma unroll
            for (int m = 0; m < 4; ++m) { const int row = u.row0 + ai * 128 + wr * 64 + m * 16 + fr; const f32x4 s0 = sq0[m], s1 = sq1[m];
                const float tot = ((s0[0] + s0[1]) + (s0[2] + s0[3])) + ((s1[0] + s1[1]) + (s1[2] + s1[3])); const float rstd = 1.0f / sqrtf(tot * (1.f / D) + EPS);
                f32x4 r0, r1, g0, g1;
#pragma unroll
                for (int j = 0; j < 4; ++j) { const float a0 = sigmoidf_(acc[ai][0][m][0][j] + ba0[j]), a1 = sigmoidf_(acc[ai][0][m][1][j] + ba1[j]);
                    g0[j] = fmaxf(sigmoidf_(acc[ai][1][m][0][j] + bb0[j]), 1e-20f); g1[j] = fmaxf(sigmoidf_(acc[ai][1][m][1][j] + bb1[j]), 1e-20f);
                    r0[j] = a0 * rstd * __builtin_amdgcn_rcpf(g0[j]); r1[j] = a1 * rstd * __builtin_amdgcn_rcpf(g1[j]); }
                *(v4u*)(Gt + (size_t)row * 4096 + j0) = pack8(r0, r1); *(v4u*)(Gt + (size_t)row * 4096 + 2048 + j0) = pack8(g0, g1); } }
    }
};
struct EpiGlu {
    const bf16* V; bf16* YV;
    __device__ __forceinline__ void operator()(const f32x4 (&acc)[2][2][4][2], const Unit& u, int wr, int wc, int fr, int fq) const {
#pragma unroll
        for (int ai = 0; ai < 2; ++ai) { v4u vq[4][2];
#pragma unroll
            for (int m = 0; m < 4; ++m)
#pragma unroll
                for (int bj = 0; bj < 2; ++bj) vq[m][bj] = *(const v4u*)(V + (size_t)(u.row0 + ai * 128 + wr * 64 + m * 16 + fr) * S5W + u.col0 + bj * 128 + wc * 32 + 8 * fq);
#pragma unroll
            for (int m = 0; m < 4; ++m)
#pragma unroll
                for (int bj = 0; bj < 2; ++bj) { const int r = ai * 128 + wr * 64 + m * 16 + fr, c = bj * 128 + wc * 32 + 8 * fq; const f32x4 v0 = acc[ai][bj][m][0], v1 = acc[ai][bj][m][1];
                    float vv[8]; unpack8(vq[m][bj], vv); f32x4 a, b;
#pragma unroll
                    for (int j = 0; j < 4; ++j) { a[j] = vv[j] * sigmoidf_(v0[j]); b[j] = vv[4 + j] * sigmoidf_(v1[j]); }
                    *(v4u*)(YV + (size_t)(u.row0 + r) * YVP + 2048 + u.col0 + c) = pack8(a, b); } }
    }
};
struct EpiAB {
    const bf16* Gt; bf16* MG;
    __device__ __forceinline__ void mid(f32x4 (&acc)[2][2][4][2], const Unit& u, int wr, int wc, int fr, int fq) const {
        unsigned base = (unsigned)((u.row0 + wr * 64 + fr) * 4096 + u.col0 + wc * 32 + 8 * fq) * 2u;
        asm volatile("" : "+v"(base));
        const char* gp = (const char*)Gt;
#pragma unroll
        for (int ai = 0; ai < 2; ++ai)
#pragma unroll
            for (int m = 0; m < 4; ++m)
#pragma unroll
                for (int bj = 0; bj < 2; ++bj) { float rr[8]; unpack8(*(const v4u*)(gp + (size_t)(base + (unsigned)((ai * 128 + m * 16) * 4096 + bj * 128) * 2u)), rr);
#pragma unroll
                    for (int j = 0; j < 4; ++j) { acc[ai][bj][m][0][j] *= rr[j]; acc[ai][bj][m][1][j] *= rr[4 + j]; } }
    }
    __device__ __forceinline__ void operator()(const f32x4 (&acc)[2][2][4][2], const Unit& u, int wr, int wc, int fr, int fq) const {
#pragma unroll
        for (int ai = 0; ai < 2; ++ai) { v4u gq[4][2];
#pragma unroll
            for (int m = 0; m < 4; ++m)
#pragma unroll
                for (int bj = 0; bj < 2; ++bj) gq[m][bj] = *(const v4u*)(Gt + (size_t)(u.row0 + ai * 128 + wr * 64 + m * 16 + fr) * 4096 + 2048 + u.col0 + bj * 128 + wc * 32 + 8 * fq);
#pragma unroll
            for (int m = 0; m < 4; ++m)
#pragma unroll
                for (int bj = 0; bj < 2; ++bj) { const int row = u.row0 + ai * 128 + wr * 64 + m * 16 + fr, col = u.col0 + bj * 128 + wc * 32 + 8 * fq; const f32x4 v0 = acc[ai][bj][m][0], v1 = acc[ai][bj][m][1];
                    float gg[8]; unpack8(gq[m][bj], gg); f32x4 a, b;
#pragma unroll
                    for (int j = 0; j < 4; ++j) { a[j] = gg[j] * v0[j]; b[j] = gg[4 + j] * v1[j]; }
                    *(v4u*)(MG + (size_t)row * D + col) = pack8(a, b); } }
    }
};
struct EpiOut {
    bf16* XD; const float* X;
    __device__ __forceinline__ void operator()(const f32x4 (&acc)[2][2][4][2], const Unit& u, int wr, int wc, int fr, int fq) const {
        EPI_BEGIN *(v4u*)(XD + (size_t)(u.row0 + r) * D + u.col0 + c) = pack8(v0, v1); EPI_END
    }
};
struct EpiGU {
    bf16* HID; const unsigned* list_tok; const float* rstd2;
    __device__ __forceinline__ void operator()(const f32x4 (&acc)[2][2][4][2], const Unit& u, int wr, int wc, int fr, int fq) const {
        float scq[2][4];
#pragma unroll
        for (int ai = 0; ai < 2; ++ai)
#pragma unroll
            for (int m = 0; m < 4; ++m) { const int r = ai * 128 + wr * 64 + m * 16 + fr; scq[ai][m] = (r < u.nvalid) ? rstd2[(size_t)u.e * CAPL + u.slot0 + r] : 0.f; }
#pragma unroll
        for (int ai = 0; ai < 2; ++ai)
#pragma unroll
            for (int m = 0; m < 4; ++m) { const int r = ai * 128 + wr * 64 + m * 16 + fr; if (r < u.nvalid) { const float sc = scq[ai][m]; f32x4 a, b;
#pragma unroll
                for (int j = 0; j < 4; ++j) { a[j] = siluf_(sc * acc[ai][0][m][0][j]) * (sc * acc[ai][1][m][0][j]); b[j] = siluf_(sc * acc[ai][0][m][1][j]) * (sc * acc[ai][1][m][1][j]); }
                { v2u o8; o8.x = pk4_fp8(a[0] * HID_SCALE, a[1] * HID_SCALE, a[2] * HID_SCALE, a[3] * HID_SCALE); o8.y = pk4_fp8(b[0] * HID_SCALE, b[1] * HID_SCALE, b[2] * HID_SCALE, b[3] * HID_SCALE);
                  *(v2u*)((unsigned char*)HID + (size_t)(u.row0 + r) * FF + u.col0 + wc * 32 + 8 * fq) = o8; } } }
    }
};
constexpr float Y_SCALE = 16.f;
struct EpiDn {
    const float* list_w; unsigned char* Y;
    __device__ __forceinline__ void operator()(const f32x4 (&acc)[2][2][4][2], const Unit& u, int wr, int wc, int fr, int fq) const {
        const float* wp = list_w + (unsigned)(u.e * CAPL + u.slot0 + wr * 64 + fr);
        float wq[2][4];
#pragma unroll
        for (int ai = 0; ai < 2; ++ai)
#pragma unroll
            for (int m = 0; m < 4; ++m) wq[ai][m] = wp[ai * 128 + m * 16];
#pragma unroll
        for (int ai = 0; ai < 2; ++ai)
#pragma unroll
            for (int m = 0; m < 4; ++m) { const int r = ai * 128 + wr * 64 + m * 16 + fr; const float w = wq[ai][m] * Y_SCALE;
#pragma unroll
                for (int bj = 0; bj < 2; ++bj) { const int col = u.col0 + bj * 128 + wc * 32 + 8 * fq; const f32x4 a = acc[ai][bj][m][0] * w, b = acc[ai][bj][m][1] * w;
                    v2u o; o.x = pk4_fp8(a[0], a[1], a[2], a[3]); o.y = pk4_fp8(b[0], b[1], b[2], b[3]); if (r < u.nvalid) *(v2u*)(Y + (size_t)(u.row0 + r) * D + col) = o; } }
    }
};

__device__ __forceinline__ void dt_gemm(const Args& a, const Ctx& F) {
    const bf16* Hb = (const bf16*)(PWS + WS_H); const bf16* Wd = (const bf16*)(PWS + WS_WIN) + (size_t)11264 * D; float* DT = (float*)(PWS + WS_DT);
    LAS float* part = (LAS float*)F.lds;
    const int r = F.lane & 31, hh = F.lane >> 5;
    for (int unit = F.vcu; unit < T / 64; unit += F.G) {
        const int r0 = unit * 64; f32x16 acc0, acc1;
#pragma unroll
        for (int j = 0; j < 16; ++j) { acc0[j] = 0.f; acc1[j] = 0.f; }
#pragma unroll 4
        for (int ks = 0; ks < 16; ++ks) { const int k = F.wave * 256 + ks * 16 + hh * 8;
            const bf16x8 a0 = *(const bf16x8*)(Hb + (size_t)(r0 + r) * D + k), a1 = *(const bf16x8*)(Hb + (size_t)(r0 + 32 + r) * D + k), b = *(const bf16x8*)(Wd + (size_t)r * D + k);
            acc0 = __builtin_amdgcn_mfma_f32_32x32x16_bf16(a0, b, acc0, 0, 0, 0); acc1 = __builtin_amdgcn_mfma_f32_32x32x16_bf16(a1, b, acc1, 0, 0, 0); }
#pragma unroll
        for (int j = 0; j < 16; ++j) { part[((F.wave * 2 + 0) * 16 + j) * 64 + F.lane] = acc0[j]; part[((F.wave * 2 + 1) * 16 + j) * 64 + F.lane] = acc1[j]; }
        __syncthreads();
        for (int o = F.tid; o < 2048; o += 512) { const int row = o >> 5, col = o & 31; const int i = row >> 5, rr = row & 31, h2 = (rr >> 2) & 1, reg = (rr & 3) + 4 * (rr >> 3), ln = col + 32 * h2; float s = 0.f;
#pragma unroll
            for (int w = 0; w < 8; ++w) s += part[((w * 2 + i) * 16 + reg) * 64 + ln];
            s += PIN(I_DTB)[col]; DT[(size_t)(r0 + row) * 32 + col] = s > 20.f ? s : log1pf(expf(s)); }
        __syncthreads();
    }
}

constexpr int SEGC = 8, NSEG = NCHK / SEGC;
constexpr int SQ_XT = 0;
constexpr int SQ_BC = 36864;
constexpr int SQ_BT = SQ_BC + 17408;
constexpr int SQ_CC = SQ_BT + 18432;
constexpr int SQ_DT = SQ_CC + 17408;
constexpr int SQ_Y = SQ_DT + 4352;
constexpr int SQ_W = SQ_Y + 33792;
static_assert(SQ_W + 10240 <= LDSCTL_OFF, "SSD (sequential) LDS map");

template <int NTOK>
__device__ __forceinline__ void conv_pair(const LAS float* wl, int lc, const v4u (&rawv)[NTOK + 3], int d, float (&o)[NTOK][2]) {
    f32x2 w[4]; const f32x2 bias = *(const LAS f32x2*)(wl + 4 * 512 + lc);
#pragma unroll
    for (int k = 0; k < 4; ++k) w[k] = *(const LAS f32x2*)(wl + k * 512 + lc);
#pragma unroll
    for (int tt = 0; tt < NTOK; ++tt) { float s0 = bias[0], s1 = bias[1];
#pragma unroll
        for (int k = 0; k < 4; ++k) { const unsigned uu = rawv[tt + k][d]; s0 += w[k][0] * bflo(uu); s1 += w[k][1] * bfhi(uu); }
        o[tt][0] = siluf_(s0); o[tt][1] = siluf_(s1); }
}
template <bool SCALE>
__device__ __forceinline__ void conv_xs_to_lds(const LAS float* wl, int lc, const v4u (&rx)[7], LAS bf16* dst  , const f32x4 sc) {
#pragma unroll
    for (int d = 0; d < 4; ++d) { float o[4][2]; conv_pair<4>(wl, lc + 2 * d, rx, d, o);
        if constexpr (SCALE) {
#pragma unroll
            for (int tt = 0; tt < 4; ++tt) { o[tt][0] *= sc[tt]; o[tt][1] *= sc[tt]; } }
        v2u w0, w1; w0.x = pk2(o[0][0], o[1][0]); w0.y = pk2(o[2][0], o[3][0]); w1.x = pk2(o[0][1], o[1][1]); w1.y = pk2(o[2][1], o[3][1]);
        *(LAS v2u*)(dst + (2 * d) * 72) = w0; *(LAS v2u*)(dst + (2 * d + 1) * 72) = w1; }
}
template <bool NAT, bool TR>
__device__ __forceinline__ void conv_bc_to_lds(const LAS float* wl, int lc, const v4u (&rb)[5], LAS bf16* nat, LAS bf16* tr) {
    v4u n0, n1;
#pragma unroll
    for (int d = 0; d < 4; ++d) { float o[2][2]; conv_pair<2>(wl, lc + 2 * d, rb, d, o);
        if constexpr (NAT) { n0[d] = pk2(o[0][0], o[0][1]); n1[d] = pk2(o[1][0], o[1][1]); }
        if constexpr (TR) { *(LAS unsigned*)(tr + (2 * d) * 72) = pk2(o[0][0], o[1][0]); *(LAS unsigned*)(tr + (2 * d + 1) * 72) = pk2(o[0][1], o[1][1]); } }
    if constexpr (NAT) { *(LAS v4u*)nat = n0; *(LAS v4u*)(nat + 136) = n1; }
}
__device__ __forceinline__ void conv_weights_to_lds(const Args& a, const Ctx& F, int g) {
    LAS float* wl = (LAS float*)(F.lds + SQ_W);
    for (int i = F.tid; i < 5 * 512; i += NWAVES * 64) { const int k = i >> 9, lc = i & 511; const int ch = lc < 256 ? g * 256 + lc : (lc < 384 ? 2048 + g * 128 + (lc - 256) : 3072 + g * 128 + (lc - 384));
        wl[i] = k < 4 ? PIN(I_CONVW)[k * XBCD + ch] : PIN(I_CONVB)[ch]; }
    __syncthreads();
}
template <int NR>
__device__ __forceinline__ void rows_load(const unsigned char* ws, unsigned off, int t0, v4u (&raw)[NR]) {
#pragma unroll
    for (int i = 0; i < NR; ++i) { v4u v = (v4u){0u, 0u, 0u, 0u}; if (t0 + i >= 0) v = *(const v4u*)(ws + (size_t)(off + (unsigned)i * (XBCD * 2))); raw[i] = v; }
}

__device__ __forceinline__ float seq_dt_setup(const Args& a, const Ctx& F, float av  , float dtv, int buf) {
    LAS float* dts = (LAS float*)(F.lds + SQ_DT); LAS float* acs = dts + 256; LAS float* wsc = dts + 512; LAS float* eacs = dts + 768; LAS float* cdec = dts + 1024;
    float tot = 0.f;
    if (F.wave < 4) {
        float s = dtv * av;
#pragma unroll
        for (int o = 1; o < 64; o <<= 1) { const float t = __shfl_up(s, o); if (F.lane >= o) s += t; }
        tot = __shfl(s, 63);
        dts[F.wave * 64 + F.lane] = dtv; acs[F.wave * 64 + F.lane] = s; wsc[F.wave * 64 + F.lane] = dtv * __expf(tot - s); eacs[F.wave * 64 + F.lane] = __expf(s);
        if (F.lane == 63) cdec[buf * 4 + F.wave] = __expf(tot); }
    return tot;
}
__device__ __forceinline__ bf16x8 pack_frag(const f32x16& X, int kk) { v4u w; w.x = pk2(X[8 * kk], X[8 * kk + 1]); w.y = pk2(X[8 * kk + 2], X[8 * kk + 3]); w.z = pk2(X[8 * kk + 4], X[8 * kk + 5]); w.w = pk2(X[8 * kk + 6], X[8 * kk + 7]); return __builtin_bit_cast(bf16x8, w); }
__device__ __forceinline__ void seq_state_update(const Ctx& F, f32x16 (&acc)[4], int hd, int pt, float cd) {
    const LAS bf16* xT = (const LAS bf16*)(F.lds + SQ_XT); const LAS bf16* Bt = (const LAS bf16*)(F.lds + SQ_BT); const LAS float* wsc = (const LAS float*)(F.lds + SQ_DT) + 512;
    const int r = F.lane & 31, hh = F.lane >> 5;
#pragma unroll
    for (int i = 0; i < 4; ++i) acc[i] = acc[i] * cd;
#pragma unroll
    for (int ks = 0; ks < 4; ++ks) { const v4u xw = *(const LAS v4u*)(xT + (hd * 64 + 32 * pt + r) * 72 + 16 * ks + 8 * hh); float xv[8]; unpack8(xw, xv);
        const f32x4 w0 = *(const LAS f32x4*)(wsc + hd * 64 + 16 * ks + 8 * hh), w1 = *(const LAS f32x4*)(wsc + hd * 64 + 16 * ks + 8 * hh + 4);
        v4u sw; sw.x = pk2(xv[0] * w0[0], xv[1] * w0[1]); sw.y = pk2(xv[2] * w0[2], xv[3] * w0[3]); sw.z = pk2(xv[4] * w1[0], xv[5] * w1[1]); sw.w = pk2(xv[6] * w1[2], xv[7] * w1[3]);
        const bf16x8 bfr = __builtin_bit_cast(bf16x8, sw);
#pragma unroll
        for (int i = 0; i < 4; ++i) { const bf16x8 afr = *(const LAS bf16x8*)(Bt + (32 * i + r) * 72 + 16 * ks + 8 * hh); acc[i] = __builtin_amdgcn_mfma_f32_32x32x16_bf16(afr, bfr, acc[i], 0, 0, 0); }
        if (ks & 1) __builtin_amdgcn_sched_barrier(0); }
}
__device__ __forceinline__ size_t seg_state_off(int g, int seg, int hd) { return ((size_t)(g * NSEG + seg) * 4 + hd) * 8192; }

__device__ __forceinline__ void ssd_pass_a(const Args& a, const Ctx& F) {
    LAS bf16* xT = (LAS bf16*)(F.lds + SQ_XT); LAS bf16* Bt = (LAS bf16*)(F.lds + SQ_BT); const LAS float* cdec = (const LAS float*)(F.lds + SQ_DT) + 1024; const LAS float* wl = (const LAS float*)(F.lds + SQ_W);
    for (int u = F.vcu; u < NGRP * NSEG; u += F.G) {
        const int g = u >> 5, seg = u & 31; const int hd = F.wave >> 1, pt = F.wave & 1, r = F.lane & 31, hh = F.lane >> 5;
        const int cgx = F.tid >> 4, l0x = (F.tid & 15) * 4, cgb = F.tid >> 5, l0b = (F.tid & 31) * 2;
        conv_weights_to_lds(a, F, g);
        f32x16 acc[4];
#pragma unroll
        for (int i = 0; i < 4; ++i)
#pragma unroll
            for (int j = 0; j < 16; ++j) acc[i][j] = 0.f;
        float totsum = 0.f;
        const float avh = -expf(PIN(I_ALOG)[4 * g + (F.wave & 3)]);
        const int t0 = seg * SEGC * CHK;
        const unsigned char* wsb = PWS;
        unsigned ox = (unsigned)(WS_XBC + ((size_t)(t0 + l0x) * XBCD + g * 256 + cgx * 8) * 2 - 3 * XBCD * 2);
        unsigned ob = (unsigned)(WS_XBC + ((size_t)(t0 + l0b) * XBCD + 2048 + g * 128 + cgb * 8) * 2 - 3 * XBCD * 2);
        unsigned odt = (unsigned)(WS_DT + ((size_t)(t0 + F.lane) * 32 + 4 * g + (F.wave & 3)) * 4);
        v4u rx[7];
        rows_load<7>(wsb, ox, t0 + l0x - 3, rx);
        float dtv = *(const float*)(wsb + odt);
#pragma unroll 1
        for (int k = 0; k < SEGC; ++k) {
            v4u rb[5];
            rows_load<5>(wsb, ob, t0 + k * CHK + l0b - 3, rb);
            totsum += seq_dt_setup(a, F, avh, dtv, k & 1);
            { const int hx = cgx >> 3, p0 = (cgx & 7) * 8;
              conv_xs_to_lds<false>(wl, cgx * 8, rx, xT + (hx * 64 + p0) * 72 + l0x, (f32x4){1.f, 1.f, 1.f, 1.f});
              conv_bc_to_lds<false, true>(wl, 256 + cgb * 8, rb, Bt, Bt + (cgb * 8) * 72 + l0b); }
            ox += CHK * XBCD * 2; ob += CHK * XBCD * 2; odt += CHK * 32 * 4;
            if (k + 1 < SEGC) { rows_load<7>(wsb, ox, 0, rx); dtv = *(const float*)(wsb + odt); }
            __syncthreads();
            seq_state_update(F, acc, hd, pt, cdec[(k & 1) * 4 + hd]);
            __syncthreads();
        }
        bf16* st = (bf16*)(PWS + WS_ST) + seg_state_off(g, seg, hd); const int p = 32 * pt + r;
#pragma unroll
        for (int i = 0; i < 4; ++i)
#pragma unroll
            for (int q = 0; q < 4; ++q) { v2u w; w.x = pk2(acc[i][4 * q], acc[i][4 * q + 1]); w.y = pk2(acc[i][4 * q + 2], acc[i][4 * q + 3]); *(v2u*)(st + ((4 * i + q) * 64 + p) * 8 + 4 * hh) = w; }
        if (F.wave < 4 && F.lane == 63) ((float*)(PWS + WS_MISC + 768 * 1024))[(g * NSEG + seg) * 4 + F.wave] = __expf(totsum);
        __syncthreads();
    }
}

__device__ __forceinline__ void ssd_pass_b(const Args& a, const Ctx& F) {
    LAS bf16* xT = (LAS bf16*)(F.lds + SQ_XT); LAS bf16* Bc = (LAS bf16*)(F.lds + SQ_BC); LAS bf16* Bt = (LAS bf16*)(F.lds + SQ_BT); LAS bf16* Cc = (LAS bf16*)(F.lds + SQ_CC);
    LAS float* dts = (LAS float*)(F.lds + SQ_DT); LAS float* acs = dts + 256; LAS float* eacs = dts + 768; const LAS float* cdec = dts + 1024; LAS bf16* yb = (LAS bf16*)(F.lds + SQ_Y); const LAS float* wl = (const LAS float*)(F.lds + SQ_W);
    for (int u = F.vcu; u < NGRP * NSEG; u += F.G) {
        const int g = u >> 5, seg = u & 31; const int hd = F.wave >> 1, pt = F.wave & 1, r = F.lane & 31, hh = F.lane >> 5, head = 4 * g + hd;
        const int cgx = F.tid >> 4, l0x = (F.tid & 15) * 4, cgb = F.tid >> 5, l0b = (F.tid & 31) * 2;
        conv_weights_to_lds(a, F, g);
        f32x16 acc[4];
        { const bf16* st = (const bf16*)(PWS + WS_ST) + seg_state_off(g, seg, hd); const int p = 32 * pt + r;
#pragma unroll
          for (int i = 0; i < 4; ++i)
#pragma unroll
              for (int q = 0; q < 4; ++q) { const v2u w = *(const v2u*)(st + ((4 * i + q) * 64 + p) * 8 + 4 * hh); acc[i][4 * q] = bflo(w.x); acc[i][4 * q + 1] = bfhi(w.x); acc[i][4 * q + 2] = bflo(w.y); acc[i][4 * q + 3] = bfhi(w.y); } }
        const float dsk = PIN(I_DSSD)[head]; const float avh = -expf(PIN(I_ALOG)[4 * g + (F.wave & 3)]);
        const int t0 = seg * SEGC * CHK;
        unsigned char* wsb = PWS;
        unsigned ox = (unsigned)(WS_XBC + ((size_t)(t0 + l0x) * XBCD + g * 256 + cgx * 8) * 2 - 3 * XBCD * 2);
        unsigned ob = (unsigned)(WS_XBC + ((size_t)(t0 + l0b) * XBCD + 2048 + g * 128 + cgb * 8) * 2 - 3 * XBCD * 2);
        unsigned odt = (unsigned)(WS_DT + ((size_t)(t0 + F.lane) * 32 + 4 * g + (F.wave & 3)) * 4);
        const int gcx = F.tid & 31;
        unsigned oz = (unsigned)(WS_YV + ((size_t)(t0 + (F.tid >> 5) * 4) * YVP + g * 256 + gcx * 8) * 2);
        unsigned oss = (unsigned)(WS_MISC + ((size_t)(t0 + (F.tid >> 5) * 4) * 8 + g) * 4);
#pragma unroll 1
        for (int k = 0; k < SEGC; ++k) {
            v4u rx[7], rb[5], rc[5];
            const float dtv = *(const float*)(wsb + odt);
            rows_load<7>(wsb, ox, t0 + k * CHK + l0x - 3, rx); rows_load<5>(wsb, ob, t0 + k * CHK + l0b - 3, rb); rows_load<5>(wsb, ob + 2048, t0 + k * CHK + l0b - 3, rc);
            (void)seq_dt_setup(a, F, avh, dtv, k & 1);
            { const int hx = cgx >> 3, p0 = (cgx & 7) * 8;
              conv_xs_to_lds<false>(wl, cgx * 8, rx, xT + (hx * 64 + p0) * 72 + l0x, (f32x4){1.f, 1.f, 1.f, 1.f});
              conv_bc_to_lds<true, true>(wl, 256 + cgb * 8, rb, Bc + l0b * 136 + cgb * 8, Bt + (cgb * 8) * 72 + l0b);
              conv_bc_to_lds<true, false>(wl, 384 + cgb * 8, rc, Cc + l0b * 136 + cgb * 8, Cc); }
            __syncthreads();
            {
                const LAS bf16* xrow = xT + (hd * 64 + 32 * pt + r) * 72; const int pcol = hd * 64 + 32 * pt + r;
#pragma unroll
                for (int lt = 0; lt < 2; ++lt) {
                    f32x16 y;
#pragma unroll
                    for (int j = 0; j < 16; ++j) y[j] = 0.f;
#pragma unroll
                    for (int i = 0; i < 4; ++i)
#pragma unroll
                        for (int kk = 0; kk < 2; ++kk) { const bf16x8 bs = pack_frag(acc[i], kk); const int nb = 32 * i + 16 * kk + 4 * hh;
                            const v2u lo = *(const LAS v2u*)(Cc + (32 * lt + r) * 136 + nb), hi = *(const LAS v2u*)(Cc + (32 * lt + r) * 136 + nb + 8); const v4u c0 = (v4u){lo.x, lo.y, hi.x, hi.y};
                            y = __builtin_amdgcn_mfma_f32_32x32x16_bf16(__builtin_bit_cast(bf16x8, c0), bs, y, 0, 0, 0); }
#pragma unroll
                    for (int q = 0; q < 4; ++q) { const f32x4 e0 = *(const LAS f32x4*)(eacs + hd * 64 + 32 * lt + 8 * q + 4 * hh);
#pragma unroll
                        for (int i = 0; i < 4; ++i) y[4 * q + i] *= e0[i]; }
                    __builtin_amdgcn_sched_barrier(0);
                    const float al = acs[hd * 64 + 32 * lt + r];
#pragma unroll
                    for (int st = 0; st <= lt; ++st) {
                        f32x16 X;
#pragma unroll
                        for (int j = 0; j < 16; ++j) X[j] = 0.f;
#pragma unroll
                        for (int ks = 0; ks < 8; ++ks) { const int ko = 16 * ks + 8 * hh;
                            const bf16x8 a0 = *(const LAS bf16x8*)(Bc + (32 * st + r) * 136 + ko), b0 = *(const LAS bf16x8*)(Cc + (32 * lt + r) * 136 + ko);
                            X = __builtin_amdgcn_mfma_f32_32x32x16_bf16(a0, b0, X, 0, 0, 0); }
#pragma unroll
                        for (int q = 0; q < 4; ++q) { const int sb = 8 * q + 4 * hh;
                            const f32x4 as0 = *(const LAS f32x4*)(acs + hd * 64 + 32 * st + sb), ds0 = *(const LAS f32x4*)(dts + hd * 64 + 32 * st + sb);
#pragma unroll
                            for (int i = 0; i < 4; ++i) { const int j = 4 * q + i; const float v = X[j] * __expf(al - as0[i]) * ds0[i]; X[j] = (st < lt || r >= sb + i) ? v : 0.f; } }
#pragma unroll
                        for (int kk = 0; kk < 2; ++kk) { const int sb = 32 * st + 16 * kk + 4 * hh;
                            const v2u lo = *(const LAS v2u*)(xrow + sb), hi = *(const LAS v2u*)(xrow + sb + 8); const v4u wa = (v4u){lo.x, lo.y, hi.x, hi.y};
                            y = __builtin_amdgcn_mfma_f32_32x32x16_bf16(pack_frag(X, kk), __builtin_bit_cast(bf16x8, wa), y, 0, 0, 0); }
                        __builtin_amdgcn_sched_barrier(0);
                    }
#pragma unroll
                    for (int q = 0; q < 4; ++q) { const int lb = 32 * lt + 8 * q + 4 * hh;
                        const v2u xa = *(const LAS v2u*)(xrow + lb); const float xa4[4] = {bflo(xa.x), bfhi(xa.x), bflo(xa.y), bfhi(xa.y)};
#pragma unroll
                        for (int i = 0; i < 4; ++i) yb[(lb + i) * 264 + pcol] = (bf16)f2bf(y[4 * q + i] + dsk * xa4[i]); }
                    __builtin_amdgcn_sched_barrier(0);
                }
                seq_state_update(F, acc, hd, pt, cdec[(k & 1) * 4 + hd]);
            }
            ox += CHK * XBCD * 2; ob += CHK * XBCD * 2; odt += CHK * 32 * 4;
            v4u zq[4];
#pragma unroll
            for (int i = 0; i < 4; ++i) zq[i] = *(const v4u*)(wsb + (size_t)(oz + (unsigned)i * (YVP * 2)));
            const float* nw = PIN(I_NSW) + g * 256 + gcx * 8; const f32x4 n0 = *(const f32x4*)nw, n1 = *(const f32x4*)(nw + 4);
            __syncthreads();
            {
#pragma unroll
              for (int i = 0; i < 4; ++i) { const int l = (F.tid >> 5) * 4 + i;
                  float zz[8], yy[8]; unpack8(zq[i], zz); unpack8(*(const LAS v4u*)(yb + l * 264 + gcx * 8), yy);
                  f32x4 g0, g1; float sq = 0.f;
#pragma unroll
                  for (int j = 0; j < 4; ++j) { g0[j] = yy[j] * zz[j]; g1[j] = yy[4 + j] * zz[4 + j]; sq += g0[j] * g0[j] + g1[j] * g1[j]; }
                  *(v4u*)(wsb + (size_t)(oz + (unsigned)i * (YVP * 2))) = pack8(g0 * n0, g1 * n1);
#pragma unroll
                  for (int o = 1; o < 32; o <<= 1) sq += __shfl_xor(sq, o);
                  if (gcx == 0) *(float*)(wsb + (size_t)(oss + (unsigned)i * 32)) = sq; } }
            oz += CHK * YVP * 2; oss += CHK * 8 * 4;
        }
        __syncthreads();
    }
}

__device__ __forceinline__ void seg_scan(const Args& a, const Ctx& F) {
    for (int it = F.vcu * NWAVES + F.wave; it < 2048; it += F.G * NWAVES) { const int gh = it >> 6, sl = it & 63, g = gh >> 2, hd = gh & 3;
        bf16* base = (bf16*)(PWS + WS_ST) + seg_state_off(g, 0, hd) + sl * 128 + F.lane * 2; const float* cd = (const float*)(PWS + WS_MISC + 768 * 1024) + (size_t)g * NSEG * 4 + hd; constexpr size_t CS = (size_t)4 * 8192;
        unsigned v[NSEG]; float d[NSEG];
#pragma unroll
        for (int j = 0; j < NSEG; ++j) { v[j] = *(const unsigned*)(base + (size_t)j * CS); d[j] = cd[j * 4]; }
        float c0 = 0.f, c1 = 0.f;
#pragma unroll
        for (int j = 0; j < NSEG; ++j) { *(unsigned*)(base + (size_t)j * CS) = pk2(c0, c1); c0 = c0 * d[j] + bflo(v[j]); c1 = c1 * d[j] + bfhi(v[j]); } }
}

__device__ __forceinline__ void scans(const Args& a, const Ctx& F) {
    if (F.G == 256) {
        const int g = F.vcu & 63, q = F.vcu >> 6, n = F.lane; const float dt = expf(PIN(I_LOGDT)[g]), lr = PIN(I_LRE)[g * 64 + n], li = PIN(I_LIM)[g * 64 + n];
        const float mag = expf(16.f * lr * dt), ang = 16.f * li * dt, ar = mag * cosf(ang), ai = mag * sinf(ang);
        const float* SLg = (const float*)(PWS + WS_SL) + (size_t)g * S5NC * 128 + n; bf16* APg = (bf16*)(PWS + WS_AP) + (size_t)g * S5NC * APK + 256 + n;
        LAS float* ex = (LAS float*)F.lds;
        const int B = 8 * q + F.wave;
        for (int j = 0; j <= q; ++j) { const int b = F.wave + 8 * j; if (j == q && F.wave == 7) break;
            const float* SLp = SLg + (size_t)(32 * b) * 128; float sr = 0.f, si = 0.f;
            { float ra[32], ia[32];
#pragma unroll
                for (int jj = 0; jj < 32; ++jj) { ra[jj] = SLp[(size_t)jj * 128]; ia[jj] = SLp[(size_t)jj * 128 + 64]; }
#pragma unroll
                for (int jj = 0; jj < 32; ++jj) { const float nr = ar * sr - ai * si + ra[jj], ni = ar * si + ai * sr + ia[jj]; sr = nr; si = ni; } }
            ex[b * 128 + n] = sr; ex[b * 128 + 64 + n] = si; }
        __syncthreads();
        float pr = ar, pi = ai;
#pragma unroll
        for (int k = 0; k < 5; ++k) { const float t = pr * pr - pi * pi; pi = 2.f * pr * pi; pr = t; }
        float sr = 0.f, si = 0.f;
        for (int b = 0; b < B; ++b) { const float er = ex[b * 128 + n], ei = ex[b * 128 + 64 + n]; const float nr = pr * sr - pi * si + er, ni = pr * si + pi * sr + ei; sr = nr; si = ni; }
        { const float* SLp = SLg + (size_t)(32 * B) * 128; bf16* AP = APg + (size_t)(32 * B) * APK;
          { float ra[32], ia[32];
#pragma unroll
            for (int jj = 0; jj < 32; ++jj) { ra[jj] = SLp[(size_t)jj * 128]; ia[jj] = SLp[(size_t)jj * 128 + 64]; }
#pragma unroll
            for (int jj = 0; jj < 32; ++jj) { AP[(size_t)jj * APK] = (bf16)f2bf(sr); AP[(size_t)jj * APK + 64] = (bf16)f2bf(si);
                const float nr = ar * sr - ai * si + ra[jj], ni = ar * si + ai * sr + ia[jj]; sr = nr; si = ni; } } }
        __syncthreads();
    } else
    if (F.vcu < S5G) {
        const int g = F.vcu, n = F.lane; const float dt = expf(PIN(I_LOGDT)[g]), lr = PIN(I_LRE)[g * 64 + n], li = PIN(I_LIM)[g * 64 + n];
        const float mag = expf(16.f * lr * dt), ang = 16.f * li * dt, ar = mag * cosf(ang), ai = mag * sinf(ang);
        const float* SLp = (const float*)(PWS + WS_SL) + ((size_t)g * S5NC + 128 * F.wave) * 128 + n; bf16* AP = (bf16*)(PWS + WS_AP) + ((size_t)g * S5NC + 128 * F.wave) * APK + 256 + n;
        LAS float* ex = (LAS float*)F.lds;
        float sr = 0.f, si = 0.f;
        for (int cb = 0; cb < 128; cb += 16) { float ra[16], ia[16];
#pragma unroll
            for (int j = 0; j < 16; ++j) { ra[j] = SLp[(size_t)(cb + j) * 128]; ia[j] = SLp[(size_t)(cb + j) * 128 + 64]; }
#pragma unroll
            for (int j = 0; j < 16; ++j) { const float nr = ar * sr - ai * si + ra[j], ni = ar * si + ai * sr + ia[j]; sr = nr; si = ni; } }
        ex[F.wave * 128 + n] = sr; ex[F.wave * 128 + 64 + n] = si;
        __syncthreads();
        float pr = ar, pi = ai;
#pragma unroll
        for (int q = 0; q < 7; ++q) { const float t = pr * pr - pi * pi; pi = 2.f * pr * pi; pr = t; }
        sr = 0.f; si = 0.f;
        for (int w = 0; w < F.wave; ++w) { const float er = ex[w * 128 + n], ei = ex[w * 128 + 64 + n]; const float nr = pr * sr - pi * si + er, ni = pr * si + pi * sr + ei; sr = nr; si = ni; }
        for (int cb = 0; cb < 128; cb += 16) { float ra[16], ia[16];
#pragma unroll
            for (int j = 0; j < 16; ++j) { ra[j] = SLp[(size_t)(cb + j) * 128]; ia[j] = SLp[(size_t)(cb + j) * 128 + 64]; }
#pragma unroll
            for (int j = 0; j < 16; ++j) { AP[(size_t)(cb + j) * APK] = (bf16)f2bf(sr); AP[(size_t)(cb + j) * APK + 64] = (bf16)f2bf(si);
                const float nr = ar * sr - ai * si + ra[j], ni = ar * si + ai * sr + ia[j]; sr = nr; si = ni; } }
        __syncthreads();
    }
    seg_scan(a, F);
}

__device__ __forceinline__ void route_tail(const Args& a, const Ctx& F, int t0, const f32x4 acc0, const f32x4 acc1, const f32x4 acc2, float ssq, LAS float* lg  , float bg, float be0, float be1  ) {
    const int row = F.lane & 15, kq = F.lane >> 4;
    ssq += __shfl_xor(ssq, 16); ssq += __shfl_xor(ssq, 32);
    const float rstd = 1.0f / sqrtf(ssq * (1.f / D) + EPS);
    if (kq == 0) ((float*)(PWS + WS_MISC + 800 * 1024))[t0 + row] = rstd;
#pragma unroll
    for (int reg = 0; reg < 4; ++reg) { const int tok = 4 * kq + reg; const float rs = __shfl(rstd, tok);
        lg[tok * 48 + row] = rs * acc0[reg] + bg; lg[tok * 48 + 16 + row] = rs * acc1[reg] + be0; lg[tok * 48 + 32 + row] = rs * acc2[reg] + be1; }
    LDS_WAIT(); asm volatile("" ::: "memory");
    if (F.lane < 16) { const int tok = F.lane; const LAS float* lq = lg + tok * 48;
        unsigned* cnt = (unsigned*)(PWS + WS_CTL) + CW_CNT + a.bar_region * 4096; unsigned* list_tok = (unsigned*)(PWS + WS_LST); float* list_w = (float*)(PWS + WS_LST + 2 * MiB);
        float g4[4]; int grp = 0; float gmax;
#pragma unroll
        for (int j = 0; j < 4; ++j) g4[j] = lq[j];
        gmax = g4[0];
#pragma unroll
        for (int j = 1; j < 4; ++j) if (g4[j] > gmax) { gmax = g4[j]; grp = j; }
        float den = 0.f;
#pragma unroll
        for (int j = 0; j < 4; ++j) den += expf(g4[j] - gmax);
        const float pg = 1.0f / den;
        float v1 = -INFINITY, v2 = -INFINITY; int i1 = 0, i2 = 0;
        for (int j = 0; j < 8; ++j) { const float le = lq[16 + grp * 8 + j];
            if (le > v1) { v2 = v1; i2 = i1; v1 = le; i1 = j; } else if (le > v2) { v2 = le; i2 = j; } }
        const float e2 = expf(v2 - v1), w1 = pg / (1.0f + e2), w2 = pg * e2 / (1.0f + e2);
        const int ea = grp * 8 + i1, eb = grp * 8 + i2; const unsigned tk = (unsigned)(t0 + tok);
        float* list_r = (float*)(PWS + WS_LR); unsigned* tokslot = (unsigned*)(PWS + WS_LR + 2 * MiB);
        const unsigned s1 = atomicAdd(cnt + 64 * ea, 1u), s2 = atomicAdd(cnt + 64 * eb, 1u);
        list_tok[(size_t)ea * CAPL + s1] = tk * 2u; list_w[(size_t)ea * CAPL + s1] = w1; list_r[(size_t)ea * CAPL + s1] = rstd; tokslot[tk * 2u] = (unsigned)ea * CAPL + s1;
        list_tok[(size_t)eb * CAPL + s2] = tk * 2u + 1u; list_w[(size_t)eb * CAPL + s2] = w2; list_r[(size_t)eb * CAPL + s2] = rstd; tokslot[tk * 2u + 1u] = (unsigned)eb * CAPL + s2; }
    LDS_WAIT(); asm volatile("" ::: "memory");
}
__device__ __forceinline__ void route_unit2(const Args& a, const Ctx& F, int unit, int half, LAS float* pb, volatile LAS unsigned* flag, unsigned gen, LAS float* lg) {
    const int t0 = unit * 32, row = F.lane & 15, kq = F.lane >> 4;
    const bf16* xd = (const bf16*)(PWS + WS_XD) + (size_t)(t0 + row) * D + 8 * kq; unsigned char* h2 = PWS + WS_H + (size_t)(t0 + row) * D + 8 * kq;
    const float* nf = PIN(I_NFW) + 8 * kq; const bf16* wt = (const bf16*)(PWS + WS_RT) + (size_t)row * D + 8 * kq;
    const float bg = (row < 4) ? PIN(I_BRG)[row] : 0.f, be0 = PIN(I_BRE2)[row], be1 = PIN(I_BRE2)[16 + row];
    f32x4 acc[2][3]; float ssq[2];
#pragma unroll
    for (int i = 0; i < 2; ++i) { ssq[i] = 0.f;
#pragma unroll
        for (int c = 0; c < 3; ++c) acc[i][c] = (f32x4){0.f, 0.f, 0.f, 0.f}; }
#pragma unroll 4
    for (int ks = 32 * half; ks < 32 * half + 32; ++ks) { const int k = 32 * ks;
        const f32x4 g0 = *(const f32x4*)(nf + k), g1 = *(const f32x4*)(nf + k + 4);
        const bf16x8 b0h = *(const bf16x8*)(wt + k), b1h = *(const bf16x8*)(wt + (size_t)16 * D + k), b2h = *(const bf16x8*)(wt + (size_t)32 * D + k);
        const bf16x8 b0l = *(const bf16x8*)(wt + (size_t)48 * D + k), b1l = *(const bf16x8*)(wt + (size_t)64 * D + k), b2l = *(const bf16x8*)(wt + (size_t)80 * D + k);
#pragma unroll
        for (int i = 0; i < 2; ++i) { float dd[8]; unpack8(*(const v4u*)(xd + (size_t)(16 * i) * D + k), dd);
            f32x4 m0, m1;
#pragma unroll
            for (int j = 0; j < 4; ++j) { m0[j] = dd[j]; m1[j] = dd[4 + j]; ssq[i] += m0[j] * m0[j] + m1[j] * m1[j]; }
            const f32x4 hq0 = m0 * g0, hq1 = m1 * g1; const v4u hv = pack8(hq0, hq1); { v2u o8; o8.x = pk4_fp8(hq0[0], hq0[1], hq0[2], hq0[3]); o8.y = pk4_fp8(hq1[0], hq1[1], hq1[2], hq1[3]); *(v2u*)(h2 + (size_t)(16 * i) * D + k) = o8; } const bf16x8 af = __builtin_bit_cast(bf16x8, hv);
            acc[i][0] = __builtin_amdgcn_mfma_f32_16x16x32_bf16(af, b0h, acc[i][0], 0, 0, 0); acc[i][1] = __builtin_amdgcn_mfma_f32_16x16x32_bf16(af, b1h, acc[i][1], 0, 0, 0); acc[i][2] = __builtin_amdgcn_mfma_f32_16x16x32_bf16(af, b2h, acc[i][2], 0, 0, 0);
            acc[i][0] = __builtin_amdgcn_mfma_f32_16x16x32_bf16(af, b0l, acc[i][0], 0, 0, 0); acc[i][1] = __builtin_amdgcn_mfma_f32_16x16x32_bf16(af, b1l, acc[i][1], 0, 0, 0); acc[i][2] = __builtin_amdgcn_mfma_f32_16x16x32_bf16(af, b2l, acc[i][2], 0, 0, 0); } }
    if (half == 1) {
        while (flag[2] + 1u < gen) __builtin_amdgcn_s_sleep(2);
#pragma unroll
        for (int i = 0; i < 2; ++i) { pb[(24 + i) * 64 + F.lane] = ssq[i];
#pragma unroll
            for (int c = 0; c < 3; ++c)
#pragma unroll
                for (int j = 0; j < 4; ++j) pb[((i * 3 + c) * 4 + j) * 64 + F.lane] = acc[i][c][j]; }
        LDS_WAIT(); asm volatile("" ::: "memory");
        if (F.lane == 0) *flag = gen;
    } else {
        while (*flag < gen) __builtin_amdgcn_s_sleep(2);
        asm volatile("" ::: "memory");
#pragma unroll
        for (int i = 0; i < 2; ++i) { ssq[i] += pb[(24 + i) * 64 + F.lane];
#pragma unroll
            for (int c = 0; c < 3; ++c)
#pragma unroll
                for (int j = 0; j < 4; ++j) acc[i][c][j] += pb[((i * 3 + c) * 4 + j) * 64 + F.lane]; }
        LDS_WAIT(); asm volatile("" ::: "memory");
        if (F.lane == 0) flag[2] = gen;
#pragma unroll
        for (int i = 0; i < 2; ++i) route_tail(a, F, t0 + 16 * i, acc[i][0], acc[i][1], acc[i][2], ssq[i], lg, bg, be0, be1);
    }
}
template <class Dec>
__device__ __forceinline__ void transpose_jobs_dyn(volatile LAS unsigned* ctr, int cu, int ncu, int nitems, const Dec dec, LAS float* scr, int lane) {
    auto grab = [&]() -> int { unsigned j = 0; if (lane == 0) j = __hip_atomic_fetch_add((LAS unsigned*)ctr, 1u, __ATOMIC_RELAXED, __HIP_MEMORY_SCOPE_WORKGROUP); j = __builtin_amdgcn_readfirstlane(j); return cu + (int)j * ncu; };
    int it = grab(); if (it >= nitems) return;
    TJob cur; f32x4 v[8]; dec(it, cur); tj_load(cur, lane, v);
    for (;;) { const int nx = grab(); const bool hn = nx < nitems; TJob nj = cur; f32x4 nv[8];
        if (hn) { dec(nx, nj); tj_load(nj, lane, nv); }
        tj_store(cur, lane, v, scr);
        if (!hn) break;
        cur = nj;
#pragma unroll
        for (int i = 0; i < 8; ++i) v[i] = nv[i]; }
}
template <class Dec, int QB>
__device__ __forceinline__ void transpose_jobs_queue(unsigned* gctr, int first_item, int nbatches, const Dec dec, LAS float* scr, int lane) {
    unsigned bv = 0u; if (lane == 0) bv = __hip_atomic_fetch_add(gctr, 1u, __ATOMIC_RELAXED, __HIP_MEMORY_SCOPE_AGENT);
    int b = (int)__builtin_amdgcn_readfirstlane(bv);
    while (b < nbatches) {
        unsigned nv = 0u; if (lane == 0) nv = __hip_atomic_fetch_add(gctr, 1u, __ATOMIC_RELAXED, __HIP_MEMORY_SCOPE_AGENT);
        transpose_jobs<Dec>(first_item + QB * b, 1, first_item + QB * b + QB, dec, scr, lane);
        b = (int)__builtin_amdgcn_readfirstlane(nv); }
}
__device__ __forceinline__ void route_phase(const Args& a, const Ctx& F) {
    if (F.wave < 4) { const int p = F.wave & 1, half = F.wave >> 1;
        LAS float* lg = (LAS float*)(F.lds + 8 * 16384) + F.wave * 768; LAS float* pb = (LAS float*)(F.lds + 8 * 16384 + 4 * 3072) + p * (26 * 64); volatile LAS unsigned* flag = F.ctl + 248 + p;
        unsigned gen = 0u;
        for (int unit = F.vcu * 2 + p; unit < T / 32; unit += F.G * 2) { ++gen; route_unit2(a, F, unit, half, pb, flag, gen, lg); } }
    { LAS float* scr = (LAS float*)(F.lds + F.wave * 16384);
      DecExp dec{PING(I_WEG), PING(I_WEU), PING(I_WED), PWSG};
      transpose_jobs_dyn<DecExp>(F.ctl + 76, F.vcu, F.G, 2 * DecExp::I_GU, dec, scr, F.lane); }
}
__device__ __forceinline__ void moe_tables(const Args& a, const Ctx& F) {
    if (F.wave == 0) {
        const unsigned* cnt = (const unsigned*)(PWS + WS_CTL) + CW_CNT + a.bar_region * 4096; const int e = F.lane;
        unsigned c = 0u; if (e < NE) c = __hip_atomic_load(cnt + 64 * e, __ATOMIC_RELAXED, __HIP_MEMORY_SCOPE_AGENT);
        const unsigned tiles = (c + 255u) >> 8; unsigned inc = tiles;
#pragma unroll
        for (int o = 1; o < 32; o <<= 1) { const unsigned t = __shfl_up(inc, o); if (e >= o) inc += t; }
        const unsigned excl = inc - tiles;
        if (e < NE) { F.ctl[8 + e] = c; F.ctl[40 + e] = excl * 256u;
            for (unsigned i = 0; i < tiles; ++i) { const unsigned idx = excl + i; if (idx < 160u) F.ctl[80 + idx] = (unsigned)e; } }
        const unsigned total = __shfl(inc, NE - 1);
        if (e == 0) F.ctl[72] = total < 160u ? total : 160u; }
    __syncthreads();
}
__device__ __forceinline__ void final_phase(const Args& a, const Ctx& F) {
    const int lane = (int)__builtin_amdgcn_mbcnt_hi(~0u, __builtin_amdgcn_mbcnt_lo(~0u, 0u));
    const int gw = F.vcu * NWAVES + F.wave, NGW = F.G * NWAVES; const unsigned char* Y = PWS + WS_XBC; const bf16* XD = (const bf16*)(PWS + WS_XD); const unsigned* tokslot = (const unsigned*)(PWS + WS_LR + 2 * MiB);
    f32x4 w4r[8];
#pragma unroll
    for (int j = 0; j < 8; ++j) w4r[j] = ((const f32x4*)PIN(I_NFINAL))[lane + 64 * j];
    unsigned tn0 = 0u, tn1 = 0u; if (gw < T) { tn0 = tokslot[2 * gw]; tn1 = tokslot[2 * gw + 1]; }
    for (int m = gw; m < T; m += NGW) { float* orow = POUT + (size_t)m * D; const v2u* xd = (const v2u*)(XD + (size_t)m * D) + lane;
        const unsigned ts0 = tn0, ts1 = tn1;
        if (m + NGW < T) { tn0 = tokslot[2 * (m + NGW)]; tn1 = tokslot[2 * (m + NGW) + 1]; }
        const size_t r0 = (size_t)F.ctl[40 + (ts0 >> 14)] + (ts0 & 16383u), r1 = (size_t)F.ctl[40 + (ts1 >> 14)] + (ts1 & 16383u);
        const unsigned* y0 = (const unsigned*)(Y + r0 * D) + lane; const unsigned* y1 = (const unsigned*)(Y + r1 * D) + lane;
        f32x4 v[8]; float s = 0.f;
#pragma unroll
        for (int j = 0; j < 8; ++j) { const unsigned p = y0[64 * j], q = y1[64 * j]; const v2u d2 = xd[64 * j];
            const f32x2 p0 = __builtin_amdgcn_cvt_pk_f32_fp8((int)p, false), p1 = __builtin_amdgcn_cvt_pk_f32_fp8((int)p, true), q0 = __builtin_amdgcn_cvt_pk_f32_fp8((int)q, false), q1 = __builtin_amdgcn_cvt_pk_f32_fp8((int)q, true);
            constexpr float ys = 1.0f / Y_SCALE;
            v[j] = (f32x4){bflo(d2.x) + ys * (p0[0] + q0[0]), bfhi(d2.x) + ys * (p0[1] + q0[1]), bflo(d2.y) + ys * (p1[0] + q1[0]), bfhi(d2.y) + ys * (p1[1] + q1[1])};
            s += (v[j].x * v[j].x + v[j].y * v[j].y) + (v[j].z * v[j].z + v[j].w * v[j].w); }
        const float rstd = 1.0f / sqrtf(wave_sum(s) * (1.f / D) + EPS);
#pragma unroll
        for (int j = 0; j < 8; ++j) { const f32x4 g = w4r[j]; ((f32x4*)orow + lane)[64 * j] = (f32x4){v[j].x * rstd * g.x, v[j].y * rstd * g.y, v[j].z * rstd * g.z, v[j].w * rstd * g.w}; } }
}

constexpr int N_PHASES = 12;
template <int VARIANT>
__global__ void __launch_bounds__(NWAVES * 64, 2) hybrid_fwd(Args args) {
    extern __shared__ __attribute__((aligned(16))) unsigned char lds_raw[];
    Ctx F; F.lds = (LAS unsigned char*)lds_raw; F.ctl = (volatile LAS unsigned*)(F.lds + LDSCTL_OFF);
    F.tid = threadIdx.x; F.lane = F.tid & 63; F.wave = __builtin_amdgcn_readfirstlane(F.tid >> 6);
    F.G = gridDim.x; { const int bx = blockIdx.x; F.vcu = (F.G % 8 == 0) ? (bx % 8) * (F.G / 8) + bx / 8 : bx; }
    for (int u = F.tid; u < (LDS_BYTES - LDSCTL_OFF) / 4; u += NWAVES * 64) ((LAS unsigned*)(F.lds + LDSCTL_OFF))[u] = 0u;
    __syncthreads();
    if (F.tid == 0) { LAS unsigned long long* pt = (LAS unsigned long long*)(F.lds + PTAB_OFF);
        pt[0] = (unsigned long long)args.in[0];
        pt[1] = (unsigned long long)args.in[1];
        pt[2] = (unsigned long long)args.in[2];
        pt[3] = (unsigned long long)args.in[3];
        pt[4] = (unsigned long long)args.in[4];
        pt[5] = (unsigned long long)args.in[5];
        pt[6] = (unsigned long long)args.in[6];
        pt[7] = (unsigned long long)args.in[7];
        pt[8] = (unsigned long long)args.in[8];
        pt[9] = (unsigned long long)args.in[9];
        pt[10] = (unsigned long long)args.in[10];
        pt[11] = (unsigned long long)args.in[11];
        pt[12] = (unsigned long long)args.in[12];
        pt[13] = (unsigned long long)args.in[13];
        pt[14] = (unsigned long long)args.in[14];
        pt[15] = (unsigned long long)args.in[15];
        pt[16] = (unsigned long long)args.in[16];
        pt[17] = (unsigned long long)args.in[17];
        pt[18] = (unsigned long long)args.in[18];
        pt[19] = (unsigned long long)args.in[19];
        pt[20] = (unsigned long long)args.in[20];
        pt[21] = (unsigned long long)args.in[21];
        pt[22] = (unsigned long long)args.in[22];
        pt[23] = (unsigned long long)args.in[23];
        pt[24] = (unsigned long long)args.in[24];
        pt[25] = (unsigned long long)args.in[25];
        pt[26] = (unsigned long long)args.in[26];
        pt[27] = (unsigned long long)args.in[27];
        pt[28] = (unsigned long long)args.in[28];
        pt[29] = (unsigned long long)args.in[29];
        pt[30] = (unsigned long long)args.in[30];
        pt[31] = (unsigned long long)args.out; pt[32] = (unsigned long long)args.ws; }
    __syncthreads();
    const unsigned mask = args.mask; const int lastp = 31 - __builtin_clz(mask | 1u);
    if (__builtin_popcount(mask) > 1) (void)xcd_barrier_post((unsigned*)(PWS + WS_CTL) + CW_BAR + args.bar_region * XCD_BAR_WORDS, F.ctl);
#define IN(k) (((mask >> (k)) & 1u) && (F.lane = (int)__builtin_amdgcn_mbcnt_hi(~0u, __builtin_amdgcn_mbcnt_lo(~0u, 0u)), F.tid = F.wave * 64 + F.lane, true))
#define SEAM(k) do { if (IN(k) && (k) != lastp) { XcdBarrier bar_; bar_.bar = (unsigned*)(PWS + WS_CTL) + CW_BAR + args.bar_region * XCD_BAR_WORDS; bar_.x = xb_xcc_id(); bar_.st = F.ctl; xcd_barrier(bar_); } } while (0)
    unsigned char* ws = PWS;
    if (IN(0)) { p0_prologue(args, F); } SEAM(0);
    if (IN(1)) { SchedDense S; S.so.init(T / 256, 28, F.G, (int)blockIdx.x); S.A = (const char*)(ws + WS_H); S.B = (const char*)(ws + WS_WIN); S.lda = D * 2; S.ldb = D * 2;
        Epi1a E{(bf16*)(ws + WS_YV), (bf16*)(ws + WS_XBC), (bf16*)(ws + WS_AP)};
        pg8::gemm_phase<Epi1a, SchedDense, false>(F.lds, D, D * 2, D * 2, S, E, (VARIANT & 1) != 0);
        dt_gemm(args, F); } SEAM(1);
    if (IN(2)) { ssd_pass_a(args, F);
        SchedS5 S{(const char*)(ws + WS_AP), (const char*)(ws + WS_S5WS), 512u, F.G, F.vcu}; EpiS5a E{(float*)(ws + WS_SL)};
        pg8::gemm_phase<EpiS5a, SchedS5, false>(F.lds, 256, APK * 2, 512, S, E, (VARIANT & 1) != 0); } SEAM(2);
    if (IN(3)) { scans(args, F); } SEAM(3);
    if (IN(4)) { ssd_pass_b(args, F);
        SchedS5 S{(const char*)(ws + WS_AP), (const char*)(ws + WS_S5TW), (unsigned)(APK * 2), F.G, F.vcu}; EpiS5b E{(bf16*)(ws + WS_SL)};
        pg8::gemm_phase<EpiS5b, SchedS5, false>(F.lds, APK, APK * 2, APK * 2, S, E, (VARIANT & 1) != 0); } SEAM(4);
    if (IN(5)) { { SchedDense S; S.so.init(T / 256, 16, F.G, (int)blockIdx.x); S.A = (const char*)(ws + WS_H8); S.B = (const char*)(ws + WS_WIN) + (size_t)7168 * D * 2; S.lda = D; S.ldb = D;
          Epi1b E{(bf16*)(ws + WS_XBC), PIN(I_GATEB), (const float*)(ws + WS_MISC)};
          pg8::gemm_phase<Epi1b, SchedDense, false, true, 0, true, 127, 122>(F.lds, D, D, D, S, E, (VARIANT & 1) != 0); }
        { SchedDense S; S.so.init(T / 256, 4, F.G, (int)blockIdx.x); S.A = (const char*)(ws + WS_SL); S.B = (const char*)(ws + WS_WGLU); S.lda = S5W * 2; S.ldb = S5W * 2;
          EpiGlu E{(const bf16*)(ws + WS_SL), (bf16*)(ws + WS_YV)};
          pg8::gemm_phase<EpiGlu, SchedDense, false>(F.lds, S5W, S5W * 2, S5W * 2, S, E, (VARIANT & 1) != 0); } } SEAM(5);
    if (IN(6)) { SchedDense S; S.so.init(T / 256, 8, F.G, (int)blockIdx.x); S.A = (const char*)(ws + WS_YV); S.B = (const char*)(ws + WS_WAB); S.lda = YVP * 2; S.ldb = YVP * 2;
        EpiAB E{(const bf16*)(ws + WS_XBC), (bf16*)(ws + WS_ST)};
        pg8::gemm_phase<EpiAB, SchedDense, false, true, 32>(F.lds, YVP, YVP * 2, YVP * 2, S, E, (VARIANT & 1) != 0); } SEAM(6);
    if (IN(8)) { SchedDense S; S.so.init(T / 256, 8, F.G, (int)blockIdx.x); S.A = (const char*)(ws + WS_ST); S.B = (const char*)(ws + WS_WOUT); S.lda = D * 2; S.ldb = D * 2;
        EpiOut E{(bf16*)(ws + WS_XD), PIN(I_X)};
        pg8::gemm_phase<EpiOut, SchedDense, false, true, 0, false, 127, 127, true>(F.lds, D, D * 2, D * 2, S, E, (VARIANT & 1) != 0); } SEAM(8);
    if (IN(9)) { route_phase(args, F); } SEAM(9);
    if (IN(10)) { moe_tables(args, F);
        SchedMoE S{F.ctl, (const char*)(ws + WS_H), (const char*)(ws + WS_ST), (const unsigned*)(ws + WS_LST), (unsigned)D, (size_t)1024 * D, (unsigned)D, 4, F.G, F.vcu, true};
        EpiGU E{(bf16*)(ws + WS_AP), (const unsigned*)(ws + WS_LST), (const float*)(ws + WS_LR)};
        pg8::gemm_phase<EpiGU, SchedMoE, true, true, 0, true, 127, 121>(F.lds, D, D, D, S, E, (VARIANT & 1) != 0);
        { LAS float* scr = (LAS float*)(F.lds + F.wave * 16384); DecExp dec{PING(I_WEG), PING(I_WEU), PING(I_WED), PWSG};
          transpose_jobs_queue<DecExp, 4>((unsigned*)(ws + WS_CTL) + CW_CNT + args.bar_region * 4096 + 2560, 2 * DecExp::I_GU, DecExp::I_GU / 4, dec, scr, F.lane); } } SEAM(10);
    if (IN(11)) { moe_tables(args, F);
        SchedMoE S{F.ctl, (const char*)(ws + WS_AP), (const char*)(ws + WS_YV), (const unsigned*)(ws + WS_LST), (unsigned)FF, (size_t)D * FF, (unsigned)FF, 8, F.G, F.vcu, false};
        EpiDn E{(const float*)(ws + WS_LST + 2 * MiB), ws + WS_XBC};
        pg8::gemm_phase<EpiDn, SchedMoE, false, true, 0, true, 125, 122>(F.lds, FF, FF, FF, S, E, (VARIANT & 1) != 0); } SEAM(11);
    if (IN(12)) { moe_tables(args, F); final_phase(args, F); }
#undef IN
#undef SEAM
}

extern "C" void kernel_launch(void* const* d_in, const int* in_sizes, int n_in, void* d_out, int out_size, void* d_ws, size_t ws_size, hipStream_t stream) {
    static int grid = 0;
    if (grid == 0) {
        if (n_in != 31 || in_sizes[0] != T * D || out_size != T * D || ws_size < WS_END) { fprintf(stderr, "kernel_launch: unexpected shapes / workspace (n_in %d, ws %zu, need %zu)\n", n_in, ws_size, (size_t)WS_END); grid = -1; return; }
        int dev = 0, cus = 0;
        if (hipGetDevice(&dev) != hipSuccess || hipDeviceGetAttribute(&cus, hipDeviceAttributeMultiprocessorCount, dev) != hipSuccess) { grid = -1; return; }
        if (hipFuncSetAttribute((const void*)hybrid_fwd<0>, hipFuncAttributeMaxDynamicSharedMemorySize, LDS_BYTES) != hipSuccess) { fprintf(stderr, "kernel_launch: hipFuncSetAttribute failed\n"); grid = -1; return; }
#if defined(EXP_MASK)
        (void)hipFuncSetAttribute((const void*)hybrid_fwd<EXP_VARIANT>, hipFuncAttributeMaxDynamicSharedMemorySize, LDS_BYTES);
#endif
        int per_cu = 0;
        if (hipOccupancyMaxActiveBlocksPerMultiprocessor(&per_cu, (const void*)hybrid_fwd<0>, NWAVES * 64, LDS_BYTES) != hipSuccess || per_cu < 1) fprintf(stderr, "kernel_launch: occupancy query reports %d\n", per_cu);
        (void)hipGetLastError();
        grid = cus;
    }
    if (grid < 0) return;
    (void)hipMemsetAsync((char*)d_ws + WS_CTL, 0, CTL_ZERO_BYTES, stream);
    Args a{};
    for (int i = 0; i < 31; ++i) a.in[i] = (const float*)d_in[i];
    a.out = (float*)d_out; a.ws = (unsigned char*)d_ws;
#if defined(EXP_MASK)
    a.mask = EXP_MASK; a.variant = EXP_VARIANT; a.bar_region = 0;
    hipLaunchKernelGGL(hybrid_fwd<EXP_VARIANT>, dim3(grid), dim3(NWAVES * 64), LDS_BYTES, stream, a);
    a.mask = ((1u << (N_PHASES + 1)) - 1u) & ~(1u << 7); a.variant = 0; a.bar_region = 1;
    hipLaunchKernelGGL(hybrid_fwd<0>, dim3(grid), dim3(NWAVES * 64), LDS_BYTES, stream, a);
#elif MK_N_LAUNCHES == 1
    a.mask = ((1u << (N_PHASES + 1)) - 1u) & ~(1u << 7); a.variant = 0; a.bar_region = 0;
    hipLaunchKernelGGL(hybrid_fwd<0>, dim3(grid), dim3(NWAVES * 64), LDS_BYTES, stream, a);
#else
    for (int p = 0; p <= N_PHASES; ++p) { if (p == 7) continue; a.mask = 1u << p; a.variant = 0; a.bar_region = 0; hipLaunchKernelGGL(hybrid_fwd<0>, dim3(grid), dim3(NWAVES * 64), LDS_BYTES, stream, a); }
#endif
}
```
